# Optimizing an MI355X kernel written in HIP

```python
import math
import jax
import jax.numpy as jnp
from jax import lax
import numpy as np

D_MODEL = 1024
BATCH = 16
SEQ = 2048
DEPTH = 2

GRID_W = 64
CTX_LEN = 256
N_EVEN = (DEPTH + 1) // 2
N_ODD = DEPTH // 2
N_MOD = 6
D_FF = 4 * D_MODEL
HEAD_DIM = D_MODEL // 16
MLA_HEADS = 8
MLA_NOPE = HEAD_DIM
MLA_ROPE = HEAD_DIM // 2
MLA_V = HEAD_DIM
MLA_Q_LORA = 3 * D_MODEL // 8
MLA_KV_LORA = D_MODEL // 4
GQA_HEADS = 8
GQA_KV_HEADS = 2
GQA_DIM = HEAD_DIM
ATTN_PARTS = (MLA_Q_LORA, MLA_KV_LORA, MLA_ROPE,
              GQA_HEADS * GQA_DIM, GQA_KV_HEADS * GQA_DIM, GQA_KV_HEADS * GQA_DIM)
ATTN_IN = sum(ATTN_PARTS)
ATTN_SPLITS = tuple(sum(ATTN_PARTS[:i + 1]) for i in range(len(ATTN_PARTS) - 1))
MIX_WIDTH = MLA_HEADS * MLA_V + GQA_HEADS * GQA_DIM
ROPE_THETA = 10000.0
Q_BLOCK = 128
HYENA_ORDER = 2
HYENA_SHORT = 3
HYENA_BANDS = 8
HYENA_EMB = 1 + 2 * HYENA_BANDS
HYENA_FILTER_HIDDEN = 64
HYENA_FAST_DECAY = 0.3
HYENA_SLOW_DECAY = 1.5
HYENA_TARGET = 1e-2
EPS = 1e-6

kernel_name = "hybrid_mla_gqa_hyena_dit"

F32 = jnp.float32


def rmsnorm(x, g):
    xf = x.astype(F32)
    y = xf * lax.rsqrt(jnp.mean(xf * xf, axis=-1, keepdims=True) + EPS)
    return (y * g.astype(F32)).astype(x.dtype)


def modulate(x, g, shift, scale):
    return rmsnorm(x, g) * (1 + scale) + shift


def _rotate(x, ang):
    n = ang.shape[-1]
    cos = jnp.cos(ang)[None, :, None, :]
    sin = jnp.sin(ang)[None, :, None, :]
    a = x[..., :n].astype(F32)
    b = x[..., n:].astype(F32)
    return jnp.concatenate([a * cos - b * sin, a * sin + b * cos], axis=-1).astype(x.dtype)


def rope_2d(x, row, col):
    half = x.shape[-1] // 2
    nf = half // 2
    inv = ROPE_THETA ** (-jnp.arange(nf, dtype=F32) / nf)
    ang_r = row.astype(F32)[:, None] * inv[None]
    ang_c = col.astype(F32)[:, None] * inv[None]
    return jnp.concatenate([_rotate(x[..., :half], ang_r), _rotate(x[..., half:], ang_c)], axis=-1)


def block_attention(q, k, v):
    B, S, Hq, dk = q.shape
    Hk, dv = k.shape[2], v.shape[-1]
    G = Hq // Hk
    nb = S // Q_BLOCK
    scale = 1.0 / math.sqrt(dk)
    qb = q.reshape(B, nb, Q_BLOCK, Hk, G, dk).transpose(1, 0, 2, 3, 4, 5)

    def one(qblk):
        s = jnp.einsum('bqhgd,bkhd->bhgqk', qblk, k, preferred_element_type=F32) * scale
        p = jax.nn.softmax(s, axis=-1).astype(v.dtype)
        return jnp.einsum('bhgqk,bkhe->bqhge', p, v)

    o = lax.map(one, qb)
    return o.transpose(1, 0, 2, 3, 4, 5).reshape(B, S, Hq, dv)


def attn_heads(z, q_a_g, w_q_b, kv_a_g, w_kv_b, q_norm_g, k_norm_g, pos):
    B, L, _ = z.shape
    cq, ckv, kr, gq, gk, gv = jnp.split(z, ATTN_SPLITS, axis=-1)
    q = (rmsnorm(cq, q_a_g) @ w_q_b).reshape(B, L, MLA_HEADS, MLA_NOPE + MLA_ROPE)
    q_nope, q_rope = q[..., :MLA_NOPE], q[..., MLA_NOPE:]
    kv = (rmsnorm(ckv, kv_a_g) @ w_kv_b).reshape(B, L, MLA_HEADS, MLA_NOPE + MLA_V)
    k_nope, v_mla = kv[..., :MLA_NOPE], kv[..., MLA_NOPE:]
    k_rope = kr[:, :, None, :]
    gq = rmsnorm(gq.reshape(B, L, GQA_HEADS, GQA_DIM), q_norm_g)
    gk = rmsnorm(gk.reshape(B, L, GQA_KV_HEADS, GQA_DIM), k_norm_g)
    gv = gv.reshape(B, L, GQA_KV_HEADS, GQA_DIM)
    if pos is not None:
        row, col = pos
        q_rope = rope_2d(q_rope, row, col)
        k_rope = rope_2d(k_rope, row, col)
        gq = rope_2d(gq, row, col)
        gk = rope_2d(gk, row, col)
    q_mla = jnp.concatenate([q_nope, q_rope], axis=-1)
    k_mla = jnp.concatenate([k_nope, jnp.broadcast_to(k_rope, (B, L, MLA_HEADS, MLA_ROPE))], axis=-1)
    return q_mla, k_mla, v_mla, gq, gk, gv


def attention_mixer(hl, hc, w_in, q_a_g, w_q_b, kv_a_g, w_kv_b, q_norm_g, k_norm_g, w_out,
                    row, col, need_ctx):
    B, S, _ = hl.shape
    lat = attn_heads(hl @ w_in, q_a_g, w_q_b, kv_a_g, w_kv_b, q_norm_g, k_norm_g, (row, col))
    cx = attn_heads(hc @ w_in, q_a_g, w_q_b, kv_a_g, w_kv_b, q_norm_g, k_norm_g, None)
    k_mla = jnp.concatenate([cx[1], lat[1]], axis=1)
    v_mla = jnp.concatenate([cx[2], lat[2]], axis=1)
    k_gqa = jnp.concatenate([cx[4], lat[4]], axis=1)
    v_gqa = jnp.concatenate([cx[5], lat[5]], axis=1)
    o_lat = jnp.concatenate([
        block_attention(lat[0], k_mla, v_mla).reshape(B, S, MLA_HEADS * MLA_V),
        block_attention(lat[3], k_gqa, v_gqa).reshape(B, S, GQA_HEADS * GQA_DIM)], axis=-1) @ w_out
    o_ctx = None
    if need_ctx:
        Lc = hc.shape[1]
        o_ctx = jnp.concatenate([
            block_attention(cx[0], cx[1], cx[2]).reshape(B, Lc, MLA_HEADS * MLA_V),
            block_attention(cx[3], cx[4], cx[5]).reshape(B, Lc, GQA_HEADS * GQA_DIM)], axis=-1) @ w_out
    return o_lat, o_ctx


def short_conv(z, w, b):
    L = z.shape[1]
    p = HYENA_SHORT // 2
    zp = jnp.pad(z, ((0, 0), (p, p), (0, 0)))
    out = b
    for j in range(HYENA_SHORT):
        out = out + zp[:, j:j + L] * w[j]
    return out


def hyena_filters(L, f_w1, f_b1, f_w2, f_b2, f_w3, f_b3, f_freq, f_w4):
    t = jnp.arange(L, dtype=F32)
    t_norm = t / L
    w = 2.0 * math.pi * t / L
    bands = jnp.linspace(1e-4, HYENA_BANDS - 1, HYENA_BANDS, dtype=F32)
    fw = w[:, None] * bands[None]
    feats = jnp.concatenate([t_norm[:, None], jnp.cos(fw), -jnp.sin(fw)], axis=-1)
    fr = f_freq.astype(F32)
    h = jnp.sin(fr[0] * (feats @ f_w1.astype(F32) + f_b1.astype(F32)))
    h = jnp.sin(fr[1] * (h @ f_w2.astype(F32) + f_b2.astype(F32)))
    h = jnp.sin(fr[2] * (h @ f_w3.astype(F32) + f_b3.astype(F32)))
    h = (h @ f_w4.astype(F32)).reshape(L, 2, HYENA_ORDER, D_MODEL)
    max_decay = math.log(HYENA_TARGET) / HYENA_FAST_DECAY
    min_decay = math.log(HYENA_TARGET) / HYENA_SLOW_DECAY
    deltas = jnp.abs(jnp.linspace(min_decay, max_decay, D_MODEL, dtype=F32))
    window = jnp.exp(-t_norm[:, None] * deltas[None])
    h = h * window[:, None, None, :]
    h = h * lax.rsqrt(jnp.sum(h * h, axis=(0, 1), keepdims=True) + EPS)
    return h[:, 0], h[:, 1]


def bidir_long_conv(u, hf, hb, skip):
    L = u.shape[1]
    kfull = jnp.concatenate([hf, jnp.zeros_like(hf[:1]), hb[:0:-1]], axis=0)
    K = jnp.fft.rfft(kfull, n=2 * L, axis=0)
    uf = u.astype(F32)
    U = jnp.fft.rfft(uf, n=2 * L, axis=1)
    y = jnp.fft.irfft(U * K[None], n=2 * L, axis=1)[:, :L]
    return (y + uf * skip.astype(F32)).astype(u.dtype)


def hyena_mixer(h, w_in, conv_w, conv_b, f_w1, f_b1, f_w2, f_b2, f_w3, f_b3, f_freq, f_w4,
                skip, w_out):
    L = h.shape[1]
    z = short_conv(h @ w_in, conv_w, conv_b)
    x1, x2, v = jnp.split(z, 3, axis=-1)
    hf, hb = hyena_filters(L, f_w1, f_b1, f_w2, f_b2, f_w3, f_b3, f_freq, f_w4)
    y = v
    for n, gate in enumerate((x1, x2)):
        y = gate * bidir_long_conv(y, hf[:, n], hb[:, n], skip[n])
    return y @ w_out


def sq_relu_mlp(h, w1, w2):
    return jnp.square(jax.nn.relu(h @ w1)) @ w2


def setup_inputs(seed: int = 0) -> dict:
    key = jax.random.key(seed)
    ks = list(jax.random.split(key, 40))

    def nrm(shape, scale):
        return jax.random.normal(ks.pop(), shape, F32) * scale

    def gain(shape):
        return 1.0 + nrm(shape, 0.02)

    D = D_MODEL
    return {
        'x': nrm((BATCH, SEQ, D), 1.0),
        'c': nrm((BATCH, D), 1.0),
        'ctx': nrm((BATCH, CTX_LEN, D), 1.0),
        'c_ctx': nrm((D,), 1.0),
        'w_mod': nrm((DEPTH, D, N_MOD * D), 0.5 * D ** -0.5),
        'b_mod': nrm((DEPTH, N_MOD * D), 0.02),
        'norm1_g': gain((DEPTH, D)),
        'norm2_g': gain((DEPTH, D)),
        'mlp_w1': nrm((DEPTH, D, D_FF), D ** -0.5),
        'mlp_w2': nrm((DEPTH, D_FF, D), D_FF ** -0.5),
        'a_w_in': nrm((N_EVEN, D, ATTN_IN), D ** -0.5),
        'a_q_a_g': gain((N_EVEN, MLA_Q_LORA)),
        'a_w_q_b': nrm((N_EVEN, MLA_Q_LORA, MLA_HEADS * (MLA_NOPE + MLA_ROPE)), MLA_Q_LORA ** -0.5),
        'a_kv_a_g': gain((N_EVEN, MLA_KV_LORA)),
        'a_w_kv_b': nrm((N_EVEN, MLA_KV_LORA, MLA_HEADS * (MLA_NOPE + MLA_V)), MLA_KV_LORA ** -0.5),
        'a_q_norm_g': gain((N_EVEN, GQA_DIM)),
        'a_k_norm_g': gain((N_EVEN, GQA_DIM)),
        'a_w_out': nrm((N_EVEN, MIX_WIDTH, D), MIX_WIDTH ** -0.5),
        'h_w_in': nrm((N_ODD, D, 3 * D), D ** -0.5),
        'h_conv_w': nrm((N_ODD, HYENA_SHORT, 3 * D), HYENA_SHORT ** -0.5),
        'h_conv_b': nrm((N_ODD, 3 * D), 0.02),
        'h_f_w1': nrm((N_ODD, HYENA_EMB, HYENA_FILTER_HIDDEN), HYENA_EMB ** -0.5),
        'h_f_b1': nrm((N_ODD, HYENA_FILTER_HIDDEN), 0.1),
        'h_f_w2': nrm((N_ODD, HYENA_FILTER_HIDDEN, HYENA_FILTER_HIDDEN), HYENA_FILTER_HIDDEN ** -0.5),
        'h_f_b2': nrm((N_ODD, HYENA_FILTER_HIDDEN), 0.1),
        'h_f_w3': nrm((N_ODD, HYENA_FILTER_HIDDEN, HYENA_FILTER_HIDDEN), HYENA_FILTER_HIDDEN ** -0.5),
        'h_f_b3': nrm((N_ODD, HYENA_FILTER_HIDDEN), 0.1),
        'h_f_freq': gain((N_ODD, 3, HYENA_FILTER_HIDDEN)),
        'h_f_w4': nrm((N_ODD, HYENA_FILTER_HIDDEN, 2 * HYENA_ORDER * D), HYENA_FILTER_HIDDEN ** -0.5),
        'h_skip': nrm((N_ODD, HYENA_ORDER, D), 0.3),
        'h_w_out': nrm((N_ODD, D, D), D ** -0.5),
        'final_g': gain((D,)),
    }


def reference(x, c, ctx, c_ctx, w_mod, b_mod, norm1_g, norm2_g, mlp_w1, mlp_w2,
              a_w_in, a_q_a_g, a_w_q_b, a_kv_a_g, a_w_kv_b, a_q_norm_g, a_k_norm_g, a_w_out,
              h_w_in, h_conv_w, h_conv_b, h_f_w1, h_f_b1, h_f_w2, h_f_b2, h_f_w3, h_f_b3,
              h_f_freq, h_f_w4, h_skip, h_w_out, final_g):
    S = x.shape[1]
    rows = S // GRID_W
    rr, cc = jnp.meshgrid(jnp.arange(rows, dtype=jnp.int32), jnp.arange(GRID_W, dtype=jnp.int32),
                          indexing='ij')
    row, col = rr.reshape(-1), cc.reshape(-1)
    silu_c = jax.nn.silu(c)
    silu_cc = jax.nn.silu(c_ctx)
    for i in range(DEPTH):
        ctx_live = any(j % 2 == 0 for j in range(i + 1, DEPTH))
        j = i // 2
        m_l = (silu_c @ w_mod[i] + b_mod[i])[:, None, :]
        m_c = (silu_cc @ w_mod[i] + b_mod[i])[None, None, :]
        sh1, sc1, g1, sh2, sc2, g2 = jnp.split(m_l, N_MOD, axis=-1)
        csh1, csc1, cg1, csh2, csc2, cg2 = jnp.split(m_c, N_MOD, axis=-1)
        hl = modulate(x, norm1_g[i], sh1, sc1)
        if i % 2 == 0:
            hc = modulate(ctx, norm1_g[i], csh1, csc1)
            ol, oc = attention_mixer(hl, hc, a_w_in[j], a_q_a_g[j], a_w_q_b[j], a_kv_a_g[j],
                                     a_w_kv_b[j], a_q_norm_g[j], a_k_norm_g[j], a_w_out[j],
                                     row, col, ctx_live)
        else:
            hy = (h_w_in[j], h_conv_w[j], h_conv_b[j], h_f_w1[j], h_f_b1[j], h_f_w2[j], h_f_b2[j],
                  h_f_w3[j], h_f_b3[j], h_f_freq[j], h_f_w4[j], h_skip[j], h_w_out[j])
            ol = hyena_mixer(hl, *hy)
            oc = None
            if ctx_live:
                oc = hyena_mixer(modulate(ctx, norm1_g[i], csh1, csc1), *hy)
        x = x + g1 * ol
        x = x + g2 * sq_relu_mlp(modulate(x, norm2_g[i], sh2, sc2), mlp_w1[i], mlp_w2[i])
        if ctx_live:
            ctx = ctx + cg1 * oc
            ctx = ctx + cg2 * sq_relu_mlp(modulate(ctx, norm2_g[i], csh2, csc2), mlp_w1[i], mlp_w2[i])
    return rmsnorm(x, final_g)
```

```cpp
#include <hip/hip_runtime.h>
#include <hip/hip_cooperative_groups.h>
#include <cstdio>
#include <cstdint>
namespace cg = cooperative_groups;

#ifndef ONE_LAUNCH
#define ONE_LAUNCH 1
#endif
#ifndef SIMPLE_GEMM
#define SIMPLE_GEMM 0
#endif
#ifndef NAIVE_ATTN
#define NAIVE_ATTN 0
#endif
#ifndef NAIVE_CONV
#define NAIVE_CONV 0
#endif

#ifndef PHASE_MASK
#define PHASE_MASK 0xFFFFFFFFu
#endif
#define PHON(x) (((PHASE_MASK) >> (x)) & 1u)
#define LAS __attribute__((address_space(3)))
typedef unsigned short bf16_t;
typedef short bf16x8 __attribute__((ext_vector_type(8)));
typedef short s16x4 __attribute__((ext_vector_type(4)));
typedef float f32x2 __attribute__((ext_vector_type(2)));
typedef float f32x4 __attribute__((ext_vector_type(4)));
typedef float f32x16 __attribute__((ext_vector_type(16)));
typedef unsigned u32x2 __attribute__((ext_vector_type(2)));
typedef unsigned u32x4 __attribute__((ext_vector_type(4)));
typedef __bf16 bf16x2_t __attribute__((ext_vector_type(2)));

constexpr int NB = 16, SEQ = 2048, DM = 1024, CTXL = 256, TKEYS = CTXL + SEQ;
constexpr int ML = NB * SEQ;
constexpr int MC = NB * CTXL;
constexpr int MT = ML + MC;
constexpr int NMOD = 6 * DM;
constexpr int ZW = 1536;
constexpr float EPS = 1e-6f;
constexpr int NWAVES = 8, NTHREADS = 512, GRID = 256, NGW = GRID * NWAVES;
constexpr int LDS_BYTES = 147456;
constexpr int ZC_CQ = 0, ZC_CKV = 384, ZC_KR = 640, ZC_GQ = 672, ZC_GK = 1184, ZC_GV = 1312;
constexpr float LOG2E = 1.4426950408889634f;
constexpr float QSCALE_MLA = 0.10206207261596577f * LOG2E;
constexpr float QSCALE_GQA = 0.125f * LOG2E;

constexpr size_t MiB = 1ull << 20;
constexpr size_t WS_CTL = 0;
constexpr size_t WS_MODL = 1 * MiB;
constexpr size_t WS_MODC = 1 * MiB + 786432;
constexpr size_t WS_H3 = 2 * MiB;
constexpr size_t WS_WIN = 4 * MiB, WS_WQB = 7 * MiB, WS_WKVB = 8 * MiB, WS_WOUT = 9 * MiB;
constexpr size_t WS_W1_0 = 11 * MiB, WS_W2_0 = 19 * MiB, WS_W1_1 = 27 * MiB, WS_W2_1 = 35 * MiB, WS_HIN = 43 * MiB, WS_HOUT = 49 * MiB;
constexpr size_t WS_XW = 52 * MiB;
constexpr size_t WS_HL = 180 * MiB;
constexpr size_t WS_Z = 252 * MiB, WS_CQN = 360 * MiB, WS_CKVN = 384 * MiB, WS_KROPE = 402 * MiB, WS_QG = 405 * MiB, WS_KG = 437 * MiB, WS_VG = 446 * MiB, WS_QM = 455 * MiB;
constexpr size_t WS_KV = WS_HL, WS_O = 252 * MiB;
constexpr size_t WS_HID = 252 * MiB;
constexpr size_t WS_ZT = 252 * MiB, WS_Y2T = WS_HL, WS_Y2 = 252 * MiB;
constexpr size_t WS_QMR = 316 * MiB;
constexpr size_t WS_FILT = 4 * MiB, WS_U0T = 444 * MiB, WS_Y1T = 380 * MiB;
constexpr size_t WS_END = 508 * MiB;

struct Params { const float* in[32]; float* out; unsigned char* ws; int ph_lo, ph_hi; };
#define CAS __attribute__((address_space(4)))
typedef const float* cfptr_t;
struct Ctx { const CAS cfptr_t* in; float* out; unsigned char* ws; int tid, bid, nblk; };

enum { I_X = 0, I_C, I_CTX, I_CCTX, I_WMOD, I_BMOD, I_N1G, I_N2G, I_W1, I_W2, I_AWIN, I_AQAG, I_AWQB, I_AKVAG, I_AWKVB, I_AQNG, I_AKNG, I_AWOUT,
       I_HWIN, I_HCW, I_HCB, I_FW1, I_FB1, I_FW2, I_FB2, I_FW3, I_FB3, I_FFREQ, I_FW4, I_HSKIP, I_HWOUT, I_FINALG };

__device__ __forceinline__ unsigned f2bf(float f) { unsigned u = __float_as_uint(f); return (u + 0x7fffu + ((u >> 16) & 1u)) >> 16; }
__device__ __forceinline__ float bf2f(unsigned h) { return __uint_as_float(h << 16); }
__device__ __forceinline__ unsigned cvtpk(float lo, float hi) { f32x2 v = {lo, hi}; bf16x2_t b = __builtin_convertvector(v, bf16x2_t); return __builtin_bit_cast(unsigned, b); }
__device__ __forceinline__ float wave_sum(float v) {
#pragma unroll
    for (int o = 1; o < 64; o <<= 1) v += __shfl_xor(v, o);
    return v;
}
__device__ __forceinline__ float fsin(float x) { return __builtin_amdgcn_sinf(__builtin_amdgcn_fractf(x * 0.15915494309189535f)); }
__device__ __forceinline__ float fcos(float x) { return __builtin_amdgcn_cosf(__builtin_amdgcn_fractf(x * 0.15915494309189535f)); }
__device__ __forceinline__ float inv_theta(float x) { return exp2f(-x * 13.287712379549449f); }
__device__ __forceinline__ float bflo(unsigned w) { return __uint_as_float(w << 16); }
__device__ __forceinline__ float bfhi(unsigned w) { return __uint_as_float(w & 0xffff0000u); }

namespace pg8 {
constexpr int BM = 256, BK = 64, HALF = 128, HTB = HALF * BK * 2, STAGE_BYTES = 8 * HTB, NXCD = 8, WGM = 8;
__host__ __device__ __forceinline__ int lds_byte(int r, int c) { const int st = (r >> 4) * 2 + (c >> 5), rr = r & 15, cc = c & 31, ob = rr * 64 + cc * 2; return st * 1024 + (ob ^ (((ob >> 9) & 1) << 5)); }
__host__ __device__ __forceinline__ void stage_rc(int b, int& R, int& C) { const int st = b / 1024, sb = b % 1024, swz = sb ^ (((sb >> 9) & 1) << 5); R = (st >> 1) * 16 + swz / 64; C = (st & 1) * 32 + (swz % 64) / 2; }
__host__ __device__ __forceinline__ int perm32(int rho) { const int n = rho >> 4, i = rho & 15; return 8 * (i >> 2) + 4 * n + (i & 3); }

struct Unit { int pm, pn; };
struct Gemm { const bf16_t* A; const bf16_t* Bt; int M, N, K; };

struct StaticOrder {
    int nM, nN, nwg, G, c;
    __host__ __device__ void init(int M, int N, int G_, int c_) { nM = M / BM; nN = N / BM; nwg = nM * nN; G = G_; c = c_; }
    __host__ __device__ bool next(int i, Unit& u) const {
        const long L = (long)i * G + c; if (L >= nwg) return false;
        int wgid = (int)L; { const int q = nwg / NXCD, r = nwg % NXCD, xcd = wgid % NXCD, off = wgid / NXCD; wgid = (xcd < r ? xcd * (q + 1) : r * (q + 1) + (xcd - r) * q) + off; }
        const int nig = WGM * nN, gid = wgid / nig, fm = gid * WGM, gsz = (nM - fm) < WGM ? (nM - fm) : WGM;
        u.pm = fm + ((wgid % nig) % gsz); u.pn = (wgid % nig) / gsz; return true;
    }
    __device__ __forceinline__ void a_ready(const Unit&) const {}
    __device__ __forceinline__ void done(const Unit&) const {}
};

struct EpiAny {
    static constexpr bool AFTER_DRAIN = false;
    int kind; bf16_t* O; int ldc; const float* base; float* out; const float* gate;
    __device__ __forceinline__ bool perm() const { return kind != 2; }
    __device__ __forceinline__ void operator()(const f32x4 (&acc)[2][2][4][2], const Unit& u, int wr, int wc, int fr, int fq) const {
        const int row0 = u.pm * BM + wr * 64 + fr;
        if (kind != 2) {
            const int col0 = u.pn * BM + wc * 32 + 8 * fq; const bool act = kind == 1;
#pragma unroll
            for (int ai = 0; ai < 2; ++ai)
#pragma unroll
                for (int m = 0; m < 4; ++m) { bf16_t* rowp = O + (size_t)(row0 + ai * HALF + m * 16) * ldc + col0;
#pragma unroll
                    for (int bj = 0; bj < 2; ++bj) { f32x4 v0 = acc[ai][bj][m][0], v1 = acc[ai][bj][m][1];
                        if (act) {
#pragma unroll
                            for (int e = 0; e < 4; ++e) { const float a = fmaxf(v0[e], 0.f), b = fmaxf(v1[e], 0.f); v0[e] = a * a; v1[e] = b * b; } }
                        u32x4 w; w.x = cvtpk(v0[0], v0[1]); w.y = cvtpk(v0[2], v0[3]); w.z = cvtpk(v1[0], v1[1]); w.w = cvtpk(v1[2], v1[3]);
                        *(u32x4*)(rowp + bj * HALF) = w; } }
        } else {
            const int col0 = u.pn * BM + wc * 32 + 4 * fq;
            const float* gp = gate + (size_t)((u.pm * BM) / SEQ) * NMOD + col0;
            f32x4 gv[2][2];
#pragma unroll
            for (int bj = 0; bj < 2; ++bj)
#pragma unroll
                for (int n = 0; n < 2; ++n) gv[bj][n] = *(const f32x4*)(gp + bj * HALF + n * 16);
#pragma unroll
            for (int ai = 0; ai < 2; ++ai)
#pragma unroll
                for (int m = 0; m < 4; ++m) { const size_t off = (size_t)(row0 + ai * HALF + m * 16) * DM + col0;
#pragma unroll
                    for (int bj = 0; bj < 2; ++bj)
#pragma unroll
                        for (int n = 0; n < 2; ++n) { const f32x4 x = *(const f32x4*)(base + off + bj * HALF + n * 16);
                            *(f32x4*)(out + off + bj * HALF + n * 16) = x + gv[bj][n] * acc[ai][bj][m][n]; } }
        }
    }
};

template <class Epi, class Sched>
__device__ __forceinline__ void gemm_simple(const int tid, const Gemm g, const Sched& S, const Epi& E) {
    const int  wid = __builtin_amdgcn_readfirstlane(tid >> 6), lane = tid & 63, wr = wid >> 2, wc = wid & 3, fr = lane & 15, fq = lane >> 4;
    const int K = g.K;
    Unit u;
    for (int ui = 0; S.next(ui, u); ++ui) {
        f32x4 acc[2][2][4][2];
#pragma unroll
        for (int a = 0; a < 2; ++a)
#pragma unroll
            for (int b = 0; b < 2; ++b)
#pragma unroll
                for (int m = 0; m < 4; ++m)
#pragma unroll
                    for (int n = 0; n < 2; ++n) acc[a][b][m][n] = (f32x4){0.f, 0.f, 0.f, 0.f};
        const bf16_t* Ab = g.A + (size_t)(u.pm * BM + wr * 64 + fr) * K + fq * 8;
        const bf16_t* Bb = g.Bt + (size_t)(u.pn * BM + wc * 32) * K + fq * 8;
        for (int k0 = 0; k0 < K; k0 += 32) {
            bf16x8 At[2][4], Bf[2][2];
#pragma unroll
            for (int ai = 0; ai < 2; ++ai)
#pragma unroll
                for (int m = 0; m < 4; ++m) At[ai][m] = *(const bf16x8*)(Ab + (size_t)(ai * HALF + m * 16) * K + k0);
#pragma unroll
            for (int bj = 0; bj < 2; ++bj)
#pragma unroll
                for (int n = 0; n < 2; ++n) { const int rr = E.perm() ? perm32(16 * n + fr) : (16 * n + fr);
                    Bf[bj][n] = *(const bf16x8*)(Bb + (size_t)(bj * HALF + rr) * K + k0); }
#pragma unroll
            for (int ai = 0; ai < 2; ++ai)
#pragma unroll
                for (int bj = 0; bj < 2; ++bj)
#pragma unroll
                    for (int m = 0; m < 4; ++m)
#pragma unroll
                        for (int n = 0; n < 2; ++n) acc[ai][bj][m][n] = __builtin_amdgcn_mfma_f32_16x16x32_bf16(Bf[bj][n], At[ai][m], acc[ai][bj][m][n], 0, 0, 0);
        }
        E(acc, u, wr, wc, fr, fq);
    }
}

template <class Epi, class Sched, bool ALIGN_EPI = true>
__device__ __forceinline__ void gemm_phase(const int tid, LAS unsigned char* lds, const Gemm g, const Sched& S, const Epi& E) {
    const int  wid = __builtin_amdgcn_readfirstlane(tid >> 6), lane = tid & 63, wr = wid >> 2, wc = wid & 3, fr = lane & 15, fq = lane >> 4;
    const int K = g.K, nt = K / BK;
    unsigned voffA[2], voffB[2];
#pragma unroll
    for (int i = 0; i < 2; ++i) { int R, C; stage_rc(tid * 16 + i * 8192, R, C); const int Rb = E.perm() ? ((R & ~31) + perm32(R & 31)) : R;
        voffA[i] = (unsigned)(R * K + C) * 2u; voffB[i] = (unsigned)(Rb * K + C) * 2u; }
    const size_t kstep = (size_t)(BK * 2);
    const size_t hstep = (size_t)HALF * K * 2;
    const size_t tstep = 2 * hstep;
    const unsigned ldsw = (unsigned)wid * 1024u;
    const int aoff = lds_byte(wr * 64 + fr, fq * 8), boff = lds_byte(wc * 32 + fr, fq * 8);
#define PG8_SA(b, h) (((b) * 2 + (h)) * HTB)
#define PG8_SB(b, h) ((4 + (b) * 2 + (h)) * HTB)
#define PG8_STAGE(bufoff, gbase, voff) do { _Pragma("unroll") for (int _i = 0; _i < 2; ++_i) \
        __builtin_amdgcn_global_load_lds((const unsigned*)((const char*)(gbase) + (voff)[_i]), (LAS unsigned*)(lds + (bufoff) + ldsw + _i * 8192), 16, 0, 0); } while (0)
#define PG8_LDA(dst, b, h) do { _Pragma("unroll") for (int m = 0; m < 4; ++m) _Pragma("unroll") for (int k = 0; k < 2; ++k) dst[m][k] = *(const LAS bf16x8*)(lds + PG8_SA(b, h) + aoff + m * 2048 + k * 1024); } while (0)
#define PG8_LDB(dst, b, h) do { _Pragma("unroll") for (int n = 0; n < 2; ++n) _Pragma("unroll") for (int k = 0; k < 2; ++k) dst[n][k] = *(const LAS bf16x8*)(lds + PG8_SB(b, h) + boff + n * 2048 + k * 1024); } while (0)
#define PG8_MMA(ai, bj, At, Bt) do { __builtin_amdgcn_s_setprio(1); _Pragma("unroll") for (int m = 0; m < 4; ++m) _Pragma("unroll") for (int n = 0; n < 2; ++n) _Pragma("unroll") for (int k = 0; k < 2; ++k) \
        acc[ai][bj][m][n] = __builtin_amdgcn_mfma_f32_16x16x32_bf16(Bt[n][k], At[m][k], acc[ai][bj][m][n], 0, 0, 0); __builtin_amdgcn_s_setprio(0); } while (0)
#define PG8_WAIT_V(n) asm volatile("s_waitcnt vmcnt(" #n ")" ::: "memory")
#define PG8_WAIT_L(n) asm volatile("s_waitcnt lgkmcnt(" #n ")" ::: "memory")
#define PG8_BAR __builtin_amdgcn_s_barrier()
#define PG8_SCHED __builtin_amdgcn_sched_barrier(0)
    Unit cur, nxt; int ui = 0;
    if (!S.next(0, cur)) return;
    f32x4 acc[2][2][4][2];
#pragma unroll
    for (int a = 0; a < 2; ++a)
#pragma unroll
        for (int b = 0; b < 2; ++b)
#pragma unroll
            for (int m = 0; m < 4; ++m)
#pragma unroll
                for (int n = 0; n < 2; ++n) acc[a][b][m][n] = (f32x4){0.f, 0.f, 0.f, 0.f};
    bf16x8 At[4][2], B0[2][2], B1[2][2];
    const char* cA = (const char*)g.A + (size_t)cur.pm * tstep; const char* cB = (const char*)g.Bt + (size_t)cur.pn * tstep;
    S.a_ready(cur);
    PG8_STAGE(PG8_SB(0, 0), cB, voffB); PG8_STAGE(PG8_SB(0, 1), cB + hstep, voffB); PG8_STAGE(PG8_SA(0, 0), cA, voffA); PG8_STAGE(PG8_SA(0, 1), cA + hstep, voffA);
    if (wr == 1) PG8_BAR;
    PG8_WAIT_V(2); PG8_BAR;
    PG8_STAGE(PG8_SB(1, 0), cB + kstep, voffB); PG8_STAGE(PG8_SA(1, 0), cA + kstep, voffA); PG8_STAGE(PG8_SB(1, 1), cB + hstep + kstep, voffB);
    PG8_WAIT_V(6); PG8_BAR;
    for (;;) {
        const bool has_next = S.next(ui + 1, nxt);
        const char* nA = has_next ? (const char*)g.A + (size_t)nxt.pm * tstep : cA; const char* nB = has_next ? (const char*)g.Bt + (size_t)nxt.pn * tstep : cB;
        for (int t = 0; t < nt; t += 2) {
            const bool last = (t == nt - 2);
            const char* a1 = cA + (size_t)(t + 1) * kstep;
            const char* a2 = last ? nA : cA + (size_t)(t + 2) * kstep; const char* b2 = last ? nB : cB + (size_t)(t + 2) * kstep;
            const char* a3 = a2 + kstep; const char* b3 = b2 + kstep;
            if (last && has_next) S.a_ready(nxt);
            PG8_LDB(B0, 0, 0); PG8_LDB(B1, 0, 1); PG8_SCHED; PG8_LDA(At, 0, 0); PG8_STAGE(PG8_SA(1, 1), a1 + hstep, voffA);
            PG8_WAIT_V(8); PG8_WAIT_L(0); PG8_BAR; PG8_MMA(0, 0, At, B0); PG8_MMA(0, 1, At, B1); PG8_BAR; PG8_SCHED;
            PG8_LDA(At, 0, 1); PG8_STAGE(PG8_SB(0, 0), b2, voffB); PG8_STAGE(PG8_SB(0, 1), b2 + hstep, voffB); PG8_STAGE(PG8_SA(0, 0), a2, voffA);
            PG8_WAIT_V(8); PG8_WAIT_L(0); PG8_BAR; PG8_MMA(1, 0, At, B0); PG8_MMA(1, 1, At, B1); PG8_BAR; PG8_SCHED;
            PG8_LDB(B0, 1, 0); PG8_LDB(B1, 1, 1); PG8_SCHED; PG8_LDA(At, 1, 0); PG8_STAGE(PG8_SA(0, 1), a2 + hstep, voffA);
            PG8_WAIT_V(8); PG8_WAIT_L(0); PG8_BAR; PG8_MMA(0, 0, At, B0); PG8_MMA(0, 1, At, B1); PG8_BAR; PG8_SCHED;
            PG8_LDA(At, 1, 1); PG8_STAGE(PG8_SB(1, 0), b3, voffB); PG8_STAGE(PG8_SB(1, 1), b3 + hstep, voffB); PG8_STAGE(PG8_SA(1, 0), a3, voffA);
            PG8_WAIT_V(8); PG8_WAIT_L(0); PG8_BAR; PG8_MMA(1, 0, At, B0); PG8_MMA(1, 1, At, B1); PG8_BAR; PG8_SCHED;
        }
        if constexpr (ALIGN_EPI) { if (wr == 0) PG8_BAR; }
        E(acc, cur, wr, wc, fr, fq); S.done(cur);
        if (!has_next) break;
#pragma unroll
        for (int a = 0; a < 2; ++a)
#pragma unroll
            for (int b = 0; b < 2; ++b)
#pragma unroll
                for (int m = 0; m < 4; ++m)
#pragma unroll
                    for (int n = 0; n < 2; ++n) acc[a][b][m][n] = (f32x4){0.f, 0.f, 0.f, 0.f};
        cur = nxt; cA = nA; cB = nB; ++ui;
        if constexpr (ALIGN_EPI) { if (wr == 1) PG8_BAR; }
    }
    PG8_WAIT_V(0);
    if constexpr (!ALIGN_EPI) { if (wr == 0) PG8_BAR; }
    PG8_BAR;
#undef PG8_SA
#undef PG8_SB
#undef PG8_STAGE
#undef PG8_LDA
#undef PG8_LDB
#undef PG8_MMA
#undef PG8_WAIT_V
#undef PG8_WAIT_L
#undef PG8_BAR
#undef PG8_SCHED
}
}

struct GemmJob { const bf16_t* A; const bf16_t* Bt; int M, N, K; pg8::EpiAny E; };
__device__ __forceinline__ void run_gemm(const Ctx& p, LAS unsigned char* lds, const GemmJob& J) {
    pg8::Gemm g{J.A, J.Bt, J.M, J.N, J.K}; pg8::StaticOrder S; S.init(J.M, J.N, p.nblk, p.bid);
#if SIMPLE_GEMM
    pg8::gemm_simple<pg8::EpiAny, pg8::StaticOrder>(p.tid, g, S, J.E);
#else
    pg8::gemm_phase<pg8::EpiAny, pg8::StaticOrder, true>(p.tid, lds, g, S, J.E);
#endif
    __syncthreads();
}

__device__ __forceinline__ void transpose_item(const float* W, int K, int N, bf16_t* WT, LAS float* scr, int item, int lane) {
    const int nblk = N / 32, kb = item / nblk, nb = item % nblk, k0 = 64 * kb, n0 = 32 * nb;
#pragma unroll 4
    for (int i = 0; i < 32; ++i) { const int kk = 2 * i + (lane >> 5); scr[kk * 33 + (lane & 31)] = W[(size_t)(k0 + kk) * N + n0 + (lane & 31)]; }
    asm volatile("s_waitcnt lgkmcnt(0)" ::: "memory");
    const int c = lane & 7;
#pragma unroll
    for (int j = 0; j < 4; ++j) { const int n = (lane >> 3) + 8 * j; const LAS float* s = scr + (8 * c) * 33 + n;
        u32x4 o; o.x = cvtpk(s[0 * 33], s[1 * 33]); o.y = cvtpk(s[2 * 33], s[3 * 33]); o.z = cvtpk(s[4 * 33], s[5 * 33]); o.w = cvtpk(s[6 * 33], s[7 * 33]);
        *(u32x4*)(WT + (size_t)(n0 + n) * K + k0 + 8 * c) = o; }
    asm volatile("s_waitcnt lgkmcnt(0)" ::: "memory");
}

__device__ __forceinline__ float silu_f(float v) { return v / (1.0f + expf(-v)); }

__device__ __forceinline__ void phase_prologue(const Ctx& p, LAS unsigned char* lds) {
    const int tid = p.tid, lane = tid & 63, wave = __builtin_amdgcn_readfirstlane(tid >> 6);
    unsigned char* ws = p.ws;
#ifndef PRO_SKIP1
    {
        LAS float* S = (LAS float*)lds;
        LAS float* red = (LAS float*)(lds + 69632);
        float* MODL = (float*)(ws + WS_MODL); float* MODC = (float*)(ws + WS_MODC);
        if (p.bid < 192) {
            for (int i = tid; i < 17 * 1024; i += NTHREADS) { const float v = (i < 16 * 1024) ? p.in[I_C][i] : p.in[I_CCTX][i - 16 * 1024]; S[i] = silu_f(v); }
            __syncthreads();
            for (int it = p.bid; it < 192; it += p.nblk) {
                const int layer = it / 96, n0 = (it % 96) * 64;
                const float* W = p.in[I_WMOD] + (size_t)layer * DM * NMOD + n0 + lane;
                float acc[17];
#pragma unroll
                for (int b = 0; b < 17; ++b) acc[b] = 0.f;
#pragma unroll 2
                for (int kk = 0; kk < 128; ++kk) { const int k = wave * 128 + kk; const float w = W[(size_t)k * NMOD];
#pragma unroll
                    for (int b = 0; b < 17; ++b) acc[b] += S[b * 1024 + k] * w; }
#pragma unroll
                for (int b = 0; b < 17; ++b) red[(wave * 17 + b) * 64 + lane] = acc[b];
                __syncthreads();
                for (int idx = tid; idx < 17 * 64; idx += NTHREADS) { const int b = idx >> 6, l = idx & 63; float s = p.in[I_BMOD][layer * NMOD + n0 + l];
#pragma unroll
                    for (int w = 0; w < 8; ++w) s += red[(w * 17 + b) * 64 + l];
                    if (b < 16) MODL[(size_t)(layer * 16 + b) * NMOD + n0 + l] = s; else if (layer == 0) MODC[n0 + l] = s; }
                __syncthreads();
            }
        }
        __syncthreads();
    }
#endif
    const int gw = p.bid * NWAVES + wave, ngw = p.nblk * NWAVES;
#ifndef PRO_SKIP2
    {
        float* H3 = (float*)(ws + WS_H3);
        const float* w1 = p.in[I_FW1]; const float* b1 = p.in[I_FB1]; const float* w2 = p.in[I_FW2]; const float* b2 = p.in[I_FB2];
        const float* w3 = p.in[I_FW3]; const float* b3 = p.in[I_FB3]; const float* fr = p.in[I_FFREQ];
        for (int t = gw; t < SEQ; t += ngw) {
            const float tf = (float)t, tn = tf / 2048.0f, w = 6.283185307179586f * tf / 2048.0f;
            float feat = 0.f;
            if (lane == 0) feat = tn;
            else if (lane < 17) { const int bi = (lane - 1) & 7; const float band = 1e-4f + (float)bi * ((7.0f - 1e-4f) / 7.0f); const float fw = w * band; feat = (lane < 9) ? fcos(fw) : -fsin(fw); }
            float a = b1[lane];
#pragma unroll
            for (int i = 0; i < 17; ++i) a += __shfl(feat, i) * w1[i * 64 + lane];
            float h = fsin(fr[lane] * a);
            a = b2[lane];
#pragma unroll 4
            for (int k = 0; k < 64; ++k) a += __shfl(h, k) * w2[k * 64 + lane];
            h = fsin(fr[64 + lane] * a);
            a = b3[lane];
#pragma unroll 4
            for (int k = 0; k < 64; ++k) a += __shfl(h, k) * w3[k * 64 + lane];
            h = fsin(fr[128 + lane] * a);
            H3[t * 64 + lane] = h;
        }
    }
#endif
#ifndef PRO_SKIP3
    {
        LAS float* scr = (LAS float*)(lds + wave * 16384);
        struct TJob { int in_idx; size_t in_off; int K, N; size_t ws_off; };
        const TJob jobs[10] = {
            {I_AWIN, 0, 1024, 1440, WS_WIN}, {I_AWQB, 0, 384, 768, WS_WQB}, {I_AWKVB, 0, 256, 1024, WS_WKVB}, {I_AWOUT, 0, 1024, 1024, WS_WOUT},
            {I_W1, 0, 1024, 4096, WS_W1_0}, {I_W2, 0, 4096, 1024, WS_W2_0}, {I_W1, (size_t)1024 * 4096, 1024, 4096, WS_W1_1}, {I_W2, (size_t)4096 * 1024, 4096, 1024, WS_W2_1},
            {I_HWIN, 0, 1024, 3072, WS_HIN}, {I_HWOUT, 0, 1024, 1024, WS_HOUT}};
        int base = 0;
#pragma unroll
        for (int j = 0; j < 10; ++j) {
            const int K = jobs[j].K, N = jobs[j].N, nitems = (K / 64) * (N / 32);
            const float* W = p.in[jobs[j].in_idx] + jobs[j].in_off; bf16_t* WT = (bf16_t*)(ws + jobs[j].ws_off);
            int first = gw - (base % ngw); if (first < 0) first += ngw;
            for (int it = first; it < nitems; it += ngw) transpose_item(W, K, N, WT, scr, it, lane);
            base += nitems;
        }
        u32x4* z = (u32x4*)((bf16_t*)(ws + WS_WIN) + (size_t)1440 * 1024);
        for (int i = p.bid * NTHREADS + tid; i < 96 * 1024 / 8; i += p.nblk * NTHREADS) z[i] = (u32x4){0u, 0u, 0u, 0u};
    }
#endif
}

__device__ __forceinline__ void modulate_chunk(const float* src, int row0, int nrows, const float* g, const float* sc, const float* sh, bf16_t* dst, int lane) {
    f32x4 gs[4], sv[4];
#pragma unroll
    for (int j = 0; j < 4; ++j) { const int c4 = lane + 64 * j; const f32x4 gg = ((const f32x4*)g)[c4], ss = ((const f32x4*)sc)[c4]; gs[j] = gg * (ss + 1.0f); sv[j] = ((const f32x4*)sh)[c4]; }
    for (int r = row0; r < row0 + nrows; ++r) {
        const f32x4* xr = (const f32x4*)(src + (size_t)r * DM) + lane;
        f32x4 v[4]; float s = 0.f;
#pragma unroll
        for (int j = 0; j < 4; ++j) { v[j] = xr[64 * j]; s += (v[j].x * v[j].x + v[j].y * v[j].y) + (v[j].z * v[j].z + v[j].w * v[j].w); }
        const float rstd = rsqrtf(wave_sum(s) * (1.0f / DM) + EPS);
        u32x2* o8 = (u32x2*)(dst + (size_t)r * DM) + lane;
#pragma unroll
        for (int j = 0; j < 4; ++j) { const f32x4 y = v[j] * rstd * gs[j] + sv[j]; u32x2 w; w.x = cvtpk(y.x, y.y); w.y = cvtpk(y.z, y.w); o8[64 * j] = w; }
    }
}
__device__ __forceinline__ void phase_modulate(const Ctx& p, const float* src, int layer, const float* g, int shoff, int scoff, bool with_ctx) {
    const int lane = p.tid & 63, wave = __builtin_amdgcn_readfirstlane(p.tid >> 6);
    const int gw = p.bid * NWAVES + wave;
    const float* MODL = (const float*)(p.ws + WS_MODL); const float* MODC = (const float*)(p.ws + WS_MODC);
    bf16_t* HL = (bf16_t*)(p.ws + WS_HL);
    {   const int per = ML / NGW, row0 = gw * per, b = row0 / SEQ; const float* mv = MODL + (size_t)(layer * 16 + b) * NMOD;
        modulate_chunk(src, row0, per, g, mv + scoff, mv + shoff, HL, lane); }
    if (with_ctx) { const int per = MC / NGW, row0 = gw * per;
        modulate_chunk(p.in[I_CTX], row0, per, g, MODC + scoff, MODC + shoff, HL + (size_t)ML * DM, lane); }
}
__device__ __forceinline__ void phase_final(const Ctx& p) {
    const int lane = p.tid & 63, wave = __builtin_amdgcn_readfirstlane(p.tid >> 6);
    const int gw = p.bid * NWAVES + wave, per = ML / NGW;
    const float* X = (const float*)(p.ws + WS_XW); const float* g = p.in[I_FINALG];
    f32x4 gs[4];
#pragma unroll
    for (int j = 0; j < 4; ++j) gs[j] = ((const f32x4*)g)[lane + 64 * j];
    for (int r = gw * per; r < (gw + 1) * per; ++r) {
        const f32x4* xr = (const f32x4*)(X + (size_t)r * DM) + lane; f32x4 v[4]; float s = 0.f;
#pragma unroll
        for (int j = 0; j < 4; ++j) { v[j] = xr[64 * j]; s += (v[j].x * v[j].x + v[j].y * v[j].y) + (v[j].z * v[j].z + v[j].w * v[j].w); }
        const float rstd = rsqrtf(wave_sum(s) * (1.0f / DM) + EPS);
        f32x4* o = (f32x4*)(p.out + (size_t)r * DM) + lane;
#pragma unroll
        for (int j = 0; j < 4; ++j) o[64 * j] = v[j] * rstd * gs[j];
    }
}

__device__ __forceinline__ void zpost_row(const Ctx& p, int row, bool latent, int lane, const LAS f32x2* tabM, const LAS f32x2* tabG) {
    unsigned char* ws = p.ws;
    const bf16_t* z = (const bf16_t*)(ws + WS_Z) + (size_t)row * ZW;
    int prow = 0, pcol = 0;
    if (latent) { const int s = row & (SEQ - 1); prow = s >> 6; pcol = s & 63; }
    if (latent) {
        float v[6], ss = 0.f;
#pragma unroll
        for (int i = 0; i < 6; ++i) { v[i] = bf2f(z[ZC_CQ + lane + 64 * i]); ss += v[i] * v[i]; }
        const float rstd = rsqrtf(wave_sum(ss) * (1.0f / 384.0f) + EPS);
        bf16_t* o = (bf16_t*)(ws + WS_CQN) + (size_t)row * 384;
#pragma unroll
        for (int i = 0; i < 6; ++i) o[lane + 64 * i] = (bf16_t)f2bf(v[i] * rstd * p.in[I_AQAG][lane + 64 * i]);
    }
    {
        float v[4], ss = 0.f;
#pragma unroll
        for (int i = 0; i < 4; ++i) { v[i] = bf2f(z[ZC_CKV + lane + 64 * i]); ss += v[i] * v[i]; }
        const float rstd = rsqrtf(wave_sum(ss) * (1.0f / 256.0f) + EPS);
        bf16_t* o = (bf16_t*)(ws + WS_CKVN) + (size_t)row * 256;
#pragma unroll
        for (int i = 0; i < 4; ++i) o[lane + 64 * i] = (bf16_t)f2bf(v[i] * rstd * p.in[I_AKVAG][lane + 64 * i]);
    }
    {
        const int d = lane & 31; const float y = bf2f(z[ZC_KR + d]);
        const float pr = __shfl_xor(y, 8);
        float o = y;
        if (latent) { const int pos = (d & 16) ? pcol : prow; const f32x2 cs = tabM[pos * 8 + (d & 7)];
            o = (d & 8) ? (pr * cs.y + y * cs.x) : (y * cs.x - pr * cs.y); }
        if (lane < 32) ((bf16_t*)(ws + WS_KROPE))[(size_t)row * 32 + d] = (bf16_t)f2bf(o);
    }
    if (latent) {
        const float gq = p.in[I_AQNG][lane];
        const int pos = (lane & 32) ? pcol : prow; const f32x2 cs = tabG[pos * 16 + (lane & 15)];
        bf16_t* o = (bf16_t*)(ws + WS_QG) + (size_t)row * 512;
#pragma unroll
        for (int hh = 0; hh < 8; ++hh) {
            const float v = bf2f(z[ZC_GQ + 64 * hh + lane]);
            const float rstd = rsqrtf(wave_sum(v * v) * (1.0f / 64.0f) + EPS);
            const float y = v * rstd * gq, pr = __shfl_xor(y, 16);
            const float r = (lane & 16) ? (pr * cs.y + y * cs.x) : (y * cs.x - pr * cs.y);
            o[64 * hh + lane] = (bf16_t)f2bf(r * QSCALE_GQA);
        }
    }
    {
        const float gk = p.in[I_AKNG][lane];
        f32x2 cs = {1.f, 0.f};
        if (latent) { const int pos = (lane & 32) ? pcol : prow; cs = tabG[pos * 16 + (lane & 15)]; }
        bf16_t* o = (bf16_t*)(ws + WS_KG) + (size_t)row * 128;
#pragma unroll
        for (int hh = 0; hh < 2; ++hh) {
            const float v = bf2f(z[ZC_GK + 64 * hh + lane]);
            const float rstd = rsqrtf(wave_sum(v * v) * (1.0f / 64.0f) + EPS);
            const float y = v * rstd * gk, pr = __shfl_xor(y, 16);
            const float r = (lane & 16) ? (pr * cs.y + y * cs.x) : (y * cs.x - pr * cs.y);
            o[64 * hh + lane] = (bf16_t)f2bf(r);
        }
    }
    {
        bf16_t* o = (bf16_t*)(ws + WS_VG) + (size_t)row * 128;
        o[lane] = z[ZC_GV + lane]; o[64 + lane] = z[ZC_GV + 64 + lane];
    }
}
__device__ __forceinline__ void phase_zpost(const Ctx& p, LAS unsigned char* lds) {
    const int tid = p.tid, lane = tid & 63, wave = __builtin_amdgcn_readfirstlane(tid >> 6);
    LAS f32x2* tabM = (LAS f32x2*)lds;
    LAS f32x2* tabG = (LAS f32x2*)(lds + 4096);
    for (int i = tid; i < 512; i += NTHREADS) { const int pos = i >> 3, f = i & 7; const float inv = inv_theta((float)f / 8.0f); const float a = (float)pos * inv; tabM[i] = (f32x2){fcos(a), fsin(a)}; }
    for (int i = tid; i < 1024; i += NTHREADS) { const int pos = i >> 4, f = i & 15; const float inv = inv_theta((float)f / 16.0f); const float a = (float)pos * inv; tabG[i] = (f32x2){fcos(a), fsin(a)}; }
    __syncthreads();
    const int gw = p.bid * NWAVES + wave;
    { const int per = ML / NGW; for (int r = gw * per; r < (gw + 1) * per; ++r) zpost_row(p, r, true, lane, tabM, tabG); }
    { const int per = MC / NGW; for (int r = gw * per; r < (gw + 1) * per; ++r) zpost_row(p, ML + r, false, lane, tabM, tabG); }
    __syncthreads();
}

__device__ __forceinline__ int crow(int r, int hi) { return (r & 3) + 8 * (r >> 2) + 4 * hi; }
__device__ __forceinline__ size_t key_row(int b, int t) { return t < CTXL ? (size_t)(ML + b * CTXL + t) : (size_t)(b * SEQ + (t - CTXL)); }

template <int DK>
__device__ __forceinline__ void attn_naive_one(const Ctx& p, int b, int h, int q) {
    unsigned char* ws = p.ws;
    const bf16_t* KV = (const bf16_t*)(ws + WS_KV); const bf16_t* KR = (const bf16_t*)(ws + WS_KROPE);
    const bf16_t* KG = (const bf16_t*)(ws + WS_KG); const bf16_t* VG = (const bf16_t*)(ws + WS_VG);
    const size_t row = (size_t)b * SEQ + q;
    float qv[DK];
    {
        const bf16_t* qp = (DK == 96) ? (const bf16_t*)(ws + WS_QMR) + row * 768 + h * 96 : (const bf16_t*)(ws + WS_QG) + row * 512 + (h - 8) * 64;
#pragma unroll
        for (int d8 = 0; d8 < DK / 8; ++d8) { const u32x4 w = *(const u32x4*)(qp + 8 * d8);
            qv[8 * d8 + 0] = bflo(w.x); qv[8 * d8 + 1] = bfhi(w.x); qv[8 * d8 + 2] = bflo(w.y); qv[8 * d8 + 3] = bfhi(w.y);
            qv[8 * d8 + 4] = bflo(w.z); qv[8 * d8 + 5] = bfhi(w.z); qv[8 * d8 + 6] = bflo(w.w); qv[8 * d8 + 7] = bfhi(w.w); }
    }
    float o[64];
#pragma unroll
    for (int d = 0; d < 64; ++d) o[d] = 0.f;
    float m = -1e30f, l = 0.f;
    for (int t = 0; t < TKEYS; ++t) {
        const size_t kr = key_row(b, t);
        float s = 0.f;
        const bf16_t* vp;
        if (DK == 96) {
            const bf16_t* kp = KV + kr * 1024 + h * 128; const bf16_t* rp = KR + kr * 32;
#pragma unroll
            for (int d = 0; d < 64; ++d) s += qv[d] * bf2f(kp[d]);
#pragma unroll
            for (int d = 0; d < 32; ++d) s += qv[64 + d] * bf2f(rp[d]);
            vp = kp + 64;
        } else {
            const int kvh = (h - 8) >> 2; const bf16_t* kp = KG + kr * 128 + kvh * 64;
#pragma unroll
            for (int d = 0; d < 64; ++d) s += qv[d] * bf2f(kp[d]);
            vp = VG + kr * 128 + kvh * 64;
        }
        const float mn = fmaxf(m, s), al = exp2f(m - mn), pe = exp2f(s - mn);
        l = l * al + pe; m = mn;
#pragma unroll
        for (int d = 0; d < 64; ++d) o[d] = o[d] * al + pe * bf2f(vp[d]);
    }
    const float rl = 1.0f / l;
    bf16_t* op = (bf16_t*)(ws + WS_O) + row * 1024 + h * 64;
#pragma unroll
    for (int d = 0; d < 64; ++d) op[d] = (bf16_t)f2bf(o[d] * rl);
}
__device__ __forceinline__ void phase_naive_qrope(const Ctx& p) {
    const bf16_t* QM = (const bf16_t*)(p.ws + WS_QM); bf16_t* QMR = (bf16_t*)(p.ws + WS_QMR);
    for (size_t idx = (size_t)p.bid * NTHREADS + p.tid; idx < (size_t)ML * 768; idx += (size_t)p.nblk * NTHREADS) {
        const int col = (int)(idx % 768), d = col % 96; const size_t row = idx / 768; const int q = (int)(row & (SEQ - 1));
        float v = bf2f(QM[idx]);
        if (d >= 64) {
            const int e = d - 64, prow = q >> 6, pcol = q & 63;
            const int pos = (e & 16) ? pcol : prow; const float inv = inv_theta((float)(e & 7) / 8.0f); const float ang = (float)pos * inv;
            const float cs = fcos(ang), sn = fsin(ang);
            const float a = bf2f(QM[idx - e + (e & ~8)]), bb = bf2f(QM[idx - e + (e | 8)]);
            v = (e & 8) ? (a * sn + bb * cs) : (a * cs - bb * sn);
        }
        QMR[idx] = (bf16_t)f2bf(v * QSCALE_MLA);
    }
}
__device__ __forceinline__ void phase_attn_naive(const Ctx& p) {
    for (int idx = p.bid * NTHREADS + p.tid; idx < NB * 16 * SEQ; idx += p.nblk * NTHREADS) {
        const int q = idx & (SEQ - 1), h = (idx >> 11) & 15, b = idx >> 15;
        if (h < 8) attn_naive_one<96>(p, b, h, q); else attn_naive_one<64>(p, b, h, q);
    }
}

template <int DK>
__device__ __forceinline__ void attn_unit(const Ctx& p, int b, int h, int qb, LAS unsigned char* lds) {
    constexpr int NC = DK / 8;
    constexpr int ND = DK / 16;
    constexpr int KB = 12288, VB = 8192;
    unsigned char* ws = p.ws;
    const int tid = p.tid, lane = tid & 63, r32 = lane & 31, hi = lane >> 5; const int wid = __builtin_amdgcn_readfirstlane(tid >> 6);
    const bf16_t* KV = (const bf16_t*)(ws + WS_KV); const bf16_t* KR = (const bf16_t*)(ws + WS_KROPE);
    const bf16_t* KG = (const bf16_t*)(ws + WS_KG); const bf16_t* VG = (const bf16_t*)(ws + WS_VG);
    const int kvh = (h - 8) >> 2;
    LAS unsigned char* Kb = lds; LAS unsigned char* Vb = lds + 2 * KB; LAS float* wsf = (LAS float*)(lds + 2 * KB + 2 * VB) + wid * 64;
    const int qs = qb * 256 + wid * 32 + r32;
    const size_t qrow = (size_t)b * SEQ + qs;
    bf16x8 qr[ND];
    if (DK == 96) {
        const bf16_t* qp = (const bf16_t*)(ws + WS_QM) + qrow * 768 + h * 96;
#pragma unroll
        for (int d0 = 0; d0 < 4; ++d0) { const u32x4 w = *(const u32x4*)(qp + 16 * d0 + 8 * hi); u32x4 o;
            o.x = cvtpk(bflo(w.x) * QSCALE_MLA, bfhi(w.x) * QSCALE_MLA); o.y = cvtpk(bflo(w.y) * QSCALE_MLA, bfhi(w.y) * QSCALE_MLA);
            o.z = cvtpk(bflo(w.z) * QSCALE_MLA, bfhi(w.z) * QSCALE_MLA); o.w = cvtpk(bflo(w.w) * QSCALE_MLA, bfhi(w.w) * QSCALE_MLA);
            qr[d0] = __builtin_bit_cast(bf16x8, o); }
        const int prow = qs >> 6, pcol = qs & 63;
#pragma unroll
        for (int c = 0; c < 2; ++c) {
            const u32x4 wa = *(const u32x4*)(qp + 64 + 16 * c);
            const u32x4 wb = *(const u32x4*)(qp + 64 + 16 * c + 8);
            const float pos = (float)(c == 0 ? prow : pcol);
            float av[8] = {bflo(wa.x), bfhi(wa.x), bflo(wa.y), bfhi(wa.y), bflo(wa.z), bfhi(wa.z), bflo(wa.w), bfhi(wa.w)};
            float bv[8] = {bflo(wb.x), bfhi(wb.x), bflo(wb.y), bfhi(wb.y), bflo(wb.z), bfhi(wb.z), bflo(wb.w), bfhi(wb.w)};
            float ov[8];
#pragma unroll
            for (int j = 0; j < 8; ++j) { const float inv = inv_theta((float)j / 8.0f); const float ang = pos * inv; const float cs = fcos(ang), sn = fsin(ang);
                const float lo = av[j] * cs - bv[j] * sn, hv = av[j] * sn + bv[j] * cs; ov[j] = (hi ? hv : lo) * QSCALE_MLA; }
            u32x4 o; o.x = cvtpk(ov[0], ov[1]); o.y = cvtpk(ov[2], ov[3]); o.z = cvtpk(ov[4], ov[5]); o.w = cvtpk(ov[6], ov[7]);
            qr[4 + c] = __builtin_bit_cast(bf16x8, o);
        }
    } else {
        const bf16_t* qp = (const bf16_t*)(ws + WS_QG) + qrow * 512 + (h - 8) * 64;
#pragma unroll
        for (int d0 = 0; d0 < ND; ++d0) qr[d0] = *(const bf16x8*)(qp + 16 * d0 + 8 * hi);
    }
    const int kkey = tid & 63, kc0 = tid >> 6;
    const int vkv = tid >> 3, vdc = tid & 7;
    const unsigned kdst0 = kc0 * 1024 + kkey * 16, kdst1 = (kc0 + 8) * 1024 + kkey * 16;
    const unsigned vdst = (vdc >> 2) * 4096 + (vkv >> 4) * 1024 + (vkv & 15) * 64 + (vdc & 3) * 16;
    u32x4 kreg0, kreg1 = {0u, 0u, 0u, 0u}, vreg;
    auto load_tile = [&](int kt) {
        const size_t rk = key_row(b, kt * 64 + kkey), rv = key_row(b, kt * 64 + vkv);
        if (DK == 96) {
            kreg0 = *(const u32x4*)(KV + rk * 1024 + h * 128 + 8 * kc0);
            if (wid < 4) kreg1 = *(const u32x4*)(KR + rk * 32 + 8 * kc0);
            vreg = *(const u32x4*)(KV + rv * 1024 + h * 128 + 64 + 8 * vdc);
        } else {
            kreg0 = *(const u32x4*)(KG + rk * 128 + kvh * 64 + 8 * kc0);
            vreg = *(const u32x4*)(VG + rv * 128 + kvh * 64 + 8 * vdc);
        }
    };
    auto store_tile = [&](int buf) {
        *(LAS u32x4*)(Kb + buf * KB + kdst0) = kreg0;
        if (DK == 96) { if (wid < 4) *(LAS u32x4*)(Kb + buf * KB + kdst1) = kreg1; }
        *(LAS u32x4*)(Vb + buf * VB + vdst) = vreg;
    };
    f32x16 o0 = {}, o1 = {};
    float mrun = -1e30f, lrun = 0.f;
    const unsigned kfo = hi * 1024 + r32 * 16;
    const unsigned vfo = ((lane >> 4) & 1) * 32 + (lane & 3) * 8 + (4 * hi + ((lane & 15) >> 2)) * 64;
    load_tile(0); store_tile(0);
    __syncthreads();
    constexpr int NT = TKEYS / 64;
    for (int kt = 0; kt < NT; ++kt) {
        const int buf = kt & 1;
        if (kt + 1 < NT) load_tile(kt + 1);
        f32x16 p0 = {}, p1 = {};
        const LAS unsigned char* kp = Kb + buf * KB + kfo;
#pragma unroll
        for (int d0 = 0; d0 < ND; ++d0) {
            const bf16x8 k0 = *(const LAS bf16x8*)(kp + d0 * 2048), k1 = *(const LAS bf16x8*)(kp + d0 * 2048 + 512);
            p0 = __builtin_amdgcn_mfma_f32_32x32x16_bf16(k0, qr[d0], p0, 0, 0, 0);
            p1 = __builtin_amdgcn_mfma_f32_32x32x16_bf16(k1, qr[d0], p1, 0, 0, 0);
        }
        float mx = fmaxf(p0[0], p1[0]);
#pragma unroll
        for (int r = 1; r < 16; ++r) mx = fmaxf(mx, fmaxf(p0[r], p1[r]));
        mx = fmaxf(mx, __shfl_xor(mx, 32));
        const float mnew = fmaxf(mrun, mx), alpha = __builtin_amdgcn_exp2f(mrun - mnew);
        mrun = mnew;
        float rs = 0.f;
#pragma unroll
        for (int r = 0; r < 16; ++r) { p0[r] = __builtin_amdgcn_exp2f(p0[r] - mnew); p1[r] = __builtin_amdgcn_exp2f(p1[r] - mnew); rs += p0[r] + p1[r]; }
        lrun = lrun * alpha + rs;
        if (hi == 0) wsf[r32] = alpha;
        asm volatile("s_waitcnt lgkmcnt(0)" ::: "memory");
#pragma unroll
        for (int g4 = 0; g4 < 4; ++g4) { const f32x4 a4 = *(const LAS f32x4*)(wsf + 8 * g4 + 4 * hi);
#pragma unroll
            for (int e = 0; e < 4; ++e) { o0[4 * g4 + e] *= a4[e]; o1[4 * g4 + e] *= a4[e]; } }
        u32x4 pw[4];
        pw[0] = (u32x4){cvtpk(p0[0], p0[1]), cvtpk(p0[2], p0[3]), cvtpk(p0[4], p0[5]), cvtpk(p0[6], p0[7])};
        pw[1] = (u32x4){cvtpk(p0[8], p0[9]), cvtpk(p0[10], p0[11]), cvtpk(p0[12], p0[13]), cvtpk(p0[14], p0[15])};
        pw[2] = (u32x4){cvtpk(p1[0], p1[1]), cvtpk(p1[2], p1[3]), cvtpk(p1[4], p1[5]), cvtpk(p1[6], p1[7])};
        pw[3] = (u32x4){cvtpk(p1[8], p1[9]), cvtpk(p1[10], p1[11]), cvtpk(p1[12], p1[13]), cvtpk(p1[14], p1[15])};
        const LAS unsigned char* vp = Vb + buf * VB + vfo;
#pragma unroll
        for (int ks = 0; ks < 4; ++ks) {
            const bf16x8 pa = __builtin_bit_cast(bf16x8, pw[ks]);
            const s16x4 l0 = __builtin_amdgcn_ds_read_tr16_b64_v4i16((LAS s16x4*)(vp + ks * 1024));
            const s16x4 h0 = __builtin_amdgcn_ds_read_tr16_b64_v4i16((LAS s16x4*)(vp + ks * 1024 + 512));
            const s16x4 l1 = __builtin_amdgcn_ds_read_tr16_b64_v4i16((LAS s16x4*)(vp + 4096 + ks * 1024));
            const s16x4 h1 = __builtin_amdgcn_ds_read_tr16_b64_v4i16((LAS s16x4*)(vp + 4096 + ks * 1024 + 512));
            const bf16x8 v0 = {l0[0], l0[1], l0[2], l0[3], h0[0], h0[1], h0[2], h0[3]};
            const bf16x8 v1 = {l1[0], l1[1], l1[2], l1[3], h1[0], h1[1], h1[2], h1[3]};
            o0 = __builtin_amdgcn_mfma_f32_32x32x16_bf16(pa, v0, o0, 0, 0, 0);
            o1 = __builtin_amdgcn_mfma_f32_32x32x16_bf16(pa, v1, o1, 0, 0, 0);
        }
        if (kt + 1 < NT) store_tile(buf ^ 1);
        __syncthreads();
    }
    lrun += __shfl_xor(lrun, 32);
    if (hi == 0) wsf[32 + r32] = lrun;
    asm volatile("s_waitcnt lgkmcnt(0)" ::: "memory");
    bf16_t* Ow = (bf16_t*)(ws + WS_O) + ((size_t)b * SEQ + qb * 256 + wid * 32) * 1024 + h * 64;
#pragma unroll
    for (int r = 0; r < 16; ++r) { const int orow = crow(r, hi); const float rl = 1.0f / wsf[32 + orow];
        Ow[(size_t)orow * 1024 + r32] = (bf16_t)f2bf(o0[r] * rl); Ow[(size_t)orow * 1024 + 32 + r32] = (bf16_t)f2bf(o1[r] * rl); }
    __syncthreads();
}
__device__ __forceinline__ void phase_attn(const Ctx& p, LAS unsigned char* lds) {
    const int c = p.bid, bq = c >> 1, b = bq >> 3, qb = bq & 7;
    for (int i = 0; i < 8; ++i) { const int h = 2 * i + (c & 1);
        if (h < 8) attn_unit<96>(p, b, h, qb, lds); else attn_unit<64>(p, b, h, qb, lds); }
}

__device__ __forceinline__ void hyena_taps(const Ctx& p, int c, LAS unsigned char* scratch, float (&taps)[4][2][2]) {
    const int tid = p.tid, lane = tid & 63, wave = __builtin_amdgcn_readfirstlane(tid >> 6);
    LAS float* w4s = (LAS float*)scratch;
    LAS float* red = (LAS float*)(scratch + 1024);
    const float* w4 = p.in[I_FW4]; const float* H3 = (const float*)(p.ws + WS_H3);
    if (tid < 256) { const int cc = tid >> 6, k = tid & 63; w4s[cc * 64 + k] = w4[(size_t)k * 4096 + (cc >> 1) * 2048 + (cc & 1) * 1024 + c]; }
    __syncthreads();
    const float dmin = -3.0701134573253940f, dmax = -15.350567286626970f;
    const float delta = fabsf(dmin + (float)c * ((dmax - dmin) / 1023.0f));
    float ss0 = 0.f, ss1 = 0.f;
    float a[4][4];
#pragma unroll
    for (int i = 0; i < 4; ++i)
#pragma unroll
        for (int cc = 0; cc < 4; ++cc) a[i][cc] = 0.f;
#pragma unroll 2
    for (int k4 = 0; k4 < 16; ++k4) {
        f32x4 wv[4];
#pragma unroll
        for (int cc = 0; cc < 4; ++cc) wv[cc] = *(const LAS f32x4*)(w4s + cc * 64 + 4 * k4);
#pragma unroll
        for (int i = 0; i < 4; ++i) { const f32x4 hv = *((const f32x4*)(H3 + (size_t)(tid + 512 * i) * 64) + k4);
#pragma unroll
            for (int cc = 0; cc < 4; ++cc) a[i][cc] += (hv[0] * wv[cc][0] + hv[1] * wv[cc][1]) + (hv[2] * wv[cc][2] + hv[3] * wv[cc][3]); }
    }
#pragma unroll
    for (int i = 0; i < 4; ++i) {
        const int t = tid + 512 * i;
        const float win = expf(-((float)t / 2048.0f) * delta);
#pragma unroll
        for (int cc = 0; cc < 4; ++cc) a[i][cc] *= win;
        taps[i][0][0] = a[i][0]; taps[i][0][1] = a[i][1]; taps[i][1][0] = a[i][2]; taps[i][1][1] = a[i][3];
        ss0 += a[i][0] * a[i][0] + a[i][2] * a[i][2]; ss1 += a[i][1] * a[i][1] + a[i][3] * a[i][3];
    }
    ss0 = wave_sum(ss0); ss1 = wave_sum(ss1);
    if (lane == 0) { red[wave * 2] = ss0; red[wave * 2 + 1] = ss1; }
    __syncthreads();
    float t0 = 0.f, t1 = 0.f;
#pragma unroll
    for (int w = 0; w < 8; ++w) { t0 += red[w * 2]; t1 += red[w * 2 + 1]; }
    const float n0 = rsqrtf(t0 + EPS), n1 = rsqrtf(t1 + EPS);
#pragma unroll
    for (int i = 0; i < 4; ++i) { taps[i][0][0] *= n0; taps[i][1][0] *= n0; taps[i][0][1] *= n1; taps[i][1][1] *= n1; }
    __syncthreads();
}
__device__ __forceinline__ float sconv_at(const bf16_t* zr, int b, int n, float w0, float w1, float w2, float cb) {
    const bf16_t* q = zr + b * SEQ + n;
    const float l = n > 0 ? bf2f(q[-1]) : 0.f, m = bf2f(q[0]), r = n < SEQ - 1 ? bf2f(q[1]) : 0.f;
    return cb + w0 * l + w1 * m + w2 * r;
}

__device__ __forceinline__ void phase_nconv_filt(const Ctx& p, LAS unsigned char* lds) {
    bf16_t* F = (bf16_t*)(p.ws + WS_FILT);
    for (int c = p.bid; c < DM; c += p.nblk) {
        float taps[4][2][2];
        hyena_taps(p, c, lds, taps);
#pragma unroll
        for (int i = 0; i < 4; ++i) { const int t = p.tid + 512 * i;
#pragma unroll
            for (int o = 0; o < 2; ++o) { bf16_t* f = F + (size_t)(c * 2 + o) * 4096;
                f[2048 - t] = (bf16_t)f2bf(taps[i][0][o]);
                if (t > 0) f[2048 + t] = (bf16_t)f2bf(taps[i][1][o]); } }
    }
}
__device__ __forceinline__ void phase_nconv_u0(const Ctx& p) {
    const bf16_t* ZT = (const bf16_t*)(p.ws + WS_ZT); bf16_t* U0 = (bf16_t*)(p.ws + WS_U0T);
    const float* cw = p.in[I_HCW]; const float* cb = p.in[I_HCB];
    for (size_t idx = (size_t)p.bid * NTHREADS + p.tid; idx < (size_t)DM * ML; idx += (size_t)p.nblk * NTHREADS) {
        const int c = (int)(idx >> 15), bn = (int)(idx & 32767), b = bn >> 11, n = bn & 2047; const int ch = 2048 + c;
        U0[idx] = (bf16_t)f2bf(sconv_at(ZT + (size_t)ch * ML, b, n, cw[ch], cw[3072 + ch], cw[6144 + ch], cb[ch]));
    }
}
__device__ __forceinline__ void phase_nconv_pass(const Ctx& p, int o) {
    const bf16_t* ZT = (const bf16_t*)(p.ws + WS_ZT); const bf16_t* F = (const bf16_t*)(p.ws + WS_FILT);
    const bf16_t* U = (const bf16_t*)(p.ws + (o == 0 ? WS_U0T : WS_Y1T)); bf16_t* Y = (bf16_t*)(p.ws + (o == 0 ? WS_Y1T : WS_Y2T));
    const float* cw = p.in[I_HCW]; const float* cb = p.in[I_HCB]; const float* skip = p.in[I_HSKIP];
    for (size_t idx = (size_t)p.bid * NTHREADS + p.tid; idx < (size_t)DM * ML; idx += (size_t)p.nblk * NTHREADS) {
        const int c = (int)(idx >> 15), bn = (int)(idx & 32767), b = bn >> 11, n = bn & 2047;
        const bf16_t* u = U + (size_t)c * ML + b * SEQ; const bf16_t* f = F + (size_t)(c * 2 + o) * 4096 + 2048 - n;
        float acc = 0.f;
        for (int m = 0; m < SEQ; ++m) acc += bf2f(f[m]) * bf2f(u[m]);
        acc += skip[o * DM + c] * bf2f(u[n]);
        const int ch = o * 1024 + c;
        const float gate = sconv_at(ZT + (size_t)ch * ML, b, n, cw[ch], cw[3072 + ch], cw[6144 + ch], cb[ch]);
        Y[idx] = (bf16_t)f2bf(gate * acc);
    }
}

constexpr int CV_USTRIDE = 4112;
constexpr int CV_U = 0;
constexpr int CV_CP = 65792, CV_CPSTRIDE = 8208;
static_assert(CV_CP + 8 * CV_CPSTRIDE <= LDS_BYTES, "conv LDS map");

__device__ __forceinline__ void conv_build_copies(const int tid, LAS unsigned char* lds, const bf16_t* rev) {
    const u32x4 cur = *(const u32x4*)(rev + 8 * tid);
    u32x4 prv = {0u, 0u, 0u, 0u};
    if (tid > 0) prv = *(const u32x4*)(rev + 8 * tid - 8);
    const unsigned W[8] = {prv.x, prv.y, prv.z, prv.w, cur.x, cur.y, cur.z, cur.w};
#pragma unroll
    for (int rho = 0; rho < 8; ++rho) {
        unsigned o[4];
#pragma unroll
        for (int d = 0; d < 4; ++d) { const int e0 = 8 - rho + 2 * d;
            o[d] = (e0 & 1) ? __builtin_amdgcn_alignbit(W[(e0 >> 1) + 1], W[e0 >> 1], 16) : W[e0 >> 1]; }
        *(LAS u32x4*)(lds + CV_CP + rho * CV_CPSTRIDE + 16 * tid) = (u32x4){o[0], o[1], o[2], o[3]};
    }
}
__device__ __forceinline__ void sconv4(const bf16_t* zr, int n, float w0, float w1, float w2, float cb, float (&g)[4]) {
    const u32x2 w = *(const u32x2*)(zr + n);
    const float l = n > 0 ? bf2f(zr[n - 1]) : 0.f, r = n + 4 < SEQ ? bf2f(zr[n + 4]) : 0.f;
    const float x[6] = {l, bflo(w.x), bfhi(w.x), bflo(w.y), bfhi(w.y), r};
#pragma unroll
    for (int e = 0; e < 4; ++e) g[e] = cb + w0 * x[e] + w1 * x[e + 1] + w2 * x[e + 2];
}
__device__ __forceinline__ void conv_mma(const int tid, LAS unsigned char* lds, f32x4 (&acc)[16]) {
    const int lane = tid & 63, wave = __builtin_amdgcn_readfirstlane(tid >> 6);
#pragma unroll
    for (int i = 0; i < 16; ++i) acc[i] = (f32x4){0.f, 0.f, 0.f, 0.f};
    const LAS unsigned char* ab = lds + CV_CP + (lane & 7) * CV_CPSTRIDE + 2 * (2048 - 8 * ((lane & 15) >> 3) + 8 * (lane >> 4)) - 32 * (16 * wave);
    const LAS unsigned char* ub = lds + CV_U + (lane & 15) * CV_USTRIDE + 16 * (lane >> 4);
    bf16x8 w0, w1, w2, w3, w4, w5, w6, w7, w8, w9, w10, w11, w12, w13, w14, w15;
#define CV_LD(i) (*(const LAS bf16x8*)(ab - 32 * (i)))
    w0 = CV_LD(0); w1 = CV_LD(1); w2 = CV_LD(2); w3 = CV_LD(3); w4 = CV_LD(4); w5 = CV_LD(5); w6 = CV_LD(6); w7 = CV_LD(7);
    w8 = CV_LD(8); w9 = CV_LD(9); w10 = CV_LD(10); w11 = CV_LD(11); w12 = CV_LD(12); w13 = CV_LD(13); w14 = CV_LD(14); w15 = CV_LD(15);
#undef CV_LD
#define CV_MF(i, W) acc[i] = __builtin_amdgcn_mfma_f32_16x16x32_bf16(W, uf, acc[i], 0, 0, 0)
#define CV_STEP(jj, A0, A1, A2, A3, A4, A5, A6, A7, A8, A9, A10, A11, A12, A13, A14, A15) do { \
        const int j = J * 8 + (jj); const bf16x8 uf = *(const LAS bf16x8*)(ub + 64 * j); \
        const int jn = (j + 1 < 64) ? (j + 1) : j; \
        const bf16x8 n0 = *(const LAS bf16x8*)(ab + 64 * jn), n1 = *(const LAS bf16x8*)(ab + 64 * jn - 32); \
        CV_MF(0, A0); CV_MF(1, A1); CV_MF(2, A2); CV_MF(3, A3); CV_MF(4, A4); CV_MF(5, A5); CV_MF(6, A6); CV_MF(7, A7); \
        CV_MF(8, A8); CV_MF(9, A9); CV_MF(10, A10); CV_MF(11, A11); CV_MF(12, A12); CV_MF(13, A13); CV_MF(14, A14); CV_MF(15, A15); \
        A14 = n0; A15 = n1; } while (0)
    for (int J = 0; J < 8; ++J) {
        CV_STEP(0, w0, w1, w2, w3, w4, w5, w6, w7, w8, w9, w10, w11, w12, w13, w14, w15);
        CV_STEP(1, w14, w15, w0, w1, w2, w3, w4, w5, w6, w7, w8, w9, w10, w11, w12, w13);
        CV_STEP(2, w12, w13, w14, w15, w0, w1, w2, w3, w4, w5, w6, w7, w8, w9, w10, w11);
        CV_STEP(3, w10, w11, w12, w13, w14, w15, w0, w1, w2, w3, w4, w5, w6, w7, w8, w9);
        CV_STEP(4, w8, w9, w10, w11, w12, w13, w14, w15, w0, w1, w2, w3, w4, w5, w6, w7);
        CV_STEP(5, w6, w7, w8, w9, w10, w11, w12, w13, w14, w15, w0, w1, w2, w3, w4, w5);
        CV_STEP(6, w4, w5, w6, w7, w8, w9, w10, w11, w12, w13, w14, w15, w0, w1, w2, w3);
        CV_STEP(7, w2, w3, w4, w5, w6, w7, w8, w9, w10, w11, w12, w13, w14, w15, w0, w1);
    }
#undef CV_STEP
#undef CV_MF
}
__device__ __forceinline__ void phase_conv(const Ctx& p, LAS unsigned char* lds) {
    const bf16_t* ZT = (const bf16_t*)(p.ws + WS_ZT); bf16_t* Y2T = (bf16_t*)(p.ws + WS_Y2T); const bf16_t* F = (const bf16_t*)(p.ws + WS_FILT);
    const float* cw = p.in[I_HCW]; const float* cb = p.in[I_HCB]; const float* skip = p.in[I_HSKIP];
    for (int c = p.bid; c < DM; c += p.nblk) {
        int tid = p.tid; asm volatile("" : "+v"(tid));
        const int lane = tid & 63, wave = __builtin_amdgcn_readfirstlane(tid >> 6);
        {   const int b = tid >> 5, m0 = (tid & 31) * 64, ch = 2048 + c; const bf16_t* zr = ZT + (size_t)ch * ML + b * SEQ;
            const float w0 = cw[ch], w1 = cw[3072 + ch], w2 = cw[6144 + ch], bb = cb[ch];
            float prev = m0 > 0 ? bf2f(zr[m0 - 1]) : 0.f;
#pragma unroll 2
            for (int k8 = 0; k8 < 8; ++k8) {
                const u32x4 w = *(const u32x4*)(zr + m0 + 8 * k8);
                const int mn = m0 + 8 * k8 + 8; const float nxt = mn < SEQ ? bf2f(zr[mn]) : 0.f;
                const float x[10] = {prev, bflo(w.x), bfhi(w.x), bflo(w.y), bfhi(w.y), bflo(w.z), bfhi(w.z), bflo(w.w), bfhi(w.w), nxt};
                float y[8];
#pragma unroll
                for (int e = 0; e < 8; ++e) y[e] = bb + w0 * x[e] + w1 * x[e + 1] + w2 * x[e + 2];
                u32x4 o; o.x = cvtpk(y[0], y[1]); o.y = cvtpk(y[2], y[3]); o.z = cvtpk(y[4], y[5]); o.w = cvtpk(y[6], y[7]);
                *(LAS u32x4*)(lds + CV_U + b * CV_USTRIDE + 2 * (m0 + 8 * k8)) = o;
                prev = x[8];
            }
        }
        conv_build_copies(tid, lds, F + (size_t)(c * 2 + 0) * 4096);
        __syncthreads();
        f32x4 acc[16];
        conv_mma(tid, lds, acc);
        __syncthreads();
        const int b = lane & 15, nq = 256 * wave + 4 * (lane >> 4);
        {   const int ch = c; const bf16_t* zr = ZT + (size_t)ch * ML + b * SEQ; const float w0 = cw[ch], w1 = cw[3072 + ch], w2 = cw[6144 + ch], bb = cb[ch], sk = skip[c];
#pragma unroll
            for (int i = 0; i < 16; ++i) { const int n = nq + 16 * i; LAS u32x2* up = (LAS u32x2*)(lds + CV_U + b * CV_USTRIDE + 2 * n);
                const u32x2 uw = *up; const float u[4] = {bflo(uw.x), bfhi(uw.x), bflo(uw.y), bfhi(uw.y)};
                float g[4]; sconv4(zr, n, w0, w1, w2, bb, g);
                float y[4];
#pragma unroll
                for (int e = 0; e < 4; ++e) y[e] = g[e] * (acc[i][e] + sk * u[e]);
                u32x2 ow; ow.x = cvtpk(y[0], y[1]); ow.y = cvtpk(y[2], y[3]); *up = ow;
                if ((i & 3) == 3) __builtin_amdgcn_sched_barrier(0); }
        }
        conv_build_copies(tid, lds, F + (size_t)(c * 2 + 1) * 4096);
        __syncthreads();
        conv_mma(tid, lds, acc);
        {   const int ch = 1024 + c; const bf16_t* zr = ZT + (size_t)ch * ML + b * SEQ; const float w0 = cw[ch], w1 = cw[3072 + ch], w2 = cw[6144 + ch], bb = cb[ch], sk = skip[DM + c];
#pragma unroll
            for (int i = 0; i < 16; ++i) { const int n = nq + 16 * i; const u32x2 uw = *(const LAS u32x2*)(lds + CV_U + b * CV_USTRIDE + 2 * n);
                const float u[4] = {bflo(uw.x), bfhi(uw.x), bflo(uw.y), bfhi(uw.y)};
                float g[4]; sconv4(zr, n, w0, w1, w2, bb, g);
                float y[4];
#pragma unroll
                for (int e = 0; e < 4; ++e) y[e] = g[e] * (acc[i][e] + sk * u[e]);
                u32x2 ow; ow.x = cvtpk(y[0], y[1]); ow.y = cvtpk(y[2], y[3]);
                *(u32x2*)(Y2T + (size_t)c * ML + b * SEQ + n) = ow;
                if ((i & 3) == 3) __builtin_amdgcn_sched_barrier(0); }
        }
        __syncthreads();
    }
}

__device__ __forceinline__ void phase_transpose(const Ctx& p, LAS unsigned char* lds) {
    const int tid = p.tid, lane = tid & 63, wave = __builtin_amdgcn_readfirstlane(tid >> 6);
    const bf16_t* src = (const bf16_t*)(p.ws + WS_Y2T); bf16_t* dst = (bf16_t*)(p.ws + WS_Y2);
    LAS bf16_t* tile = (LAS bf16_t*)(lds + wave * 16384);
    const int gw = p.bid * NWAVES + wave, ngw = p.nblk * NWAVES;
    for (int it = gw; it < (DM / 64) * (ML / 64); it += ngw) {
        const int cb = it & 15, tb = it >> 4, c0 = cb * 64, t0 = tb * 64;
#pragma unroll
        for (int i = 0; i < 8; ++i) { const int r = 8 * i + (lane >> 3), ch = lane & 7;
            const u32x4 w = *(const u32x4*)(src + (size_t)(c0 + r) * ML + t0 + 8 * ch);
            LAS unsigned* d = (LAS unsigned*)(tile + r * 66 + 8 * ch); d[0] = w.x; d[1] = w.y; d[2] = w.z; d[3] = w.w; }
        asm volatile("s_waitcnt lgkmcnt(0)" ::: "memory");
#pragma unroll
        for (int i = 0; i < 8; ++i) { const int t = 8 * i + (lane >> 3), ch = lane & 7; unsigned short e[8];
#pragma unroll
            for (int k = 0; k < 8; ++k) e[k] = tile[(8 * ch + k) * 66 + t];
            u32x4 w; w.x = e[0] | ((unsigned)e[1] << 16); w.y = e[2] | ((unsigned)e[3] << 16); w.z = e[4] | ((unsigned)e[5] << 16); w.w = e[6] | ((unsigned)e[7] << 16);
            *(u32x4*)(dst + (size_t)(t0 + t) * DM + c0 + 8 * ch) = w; }
        asm volatile("s_waitcnt lgkmcnt(0)" ::: "memory");
    }
}

enum { P_PRO = 0, P_MOD1_0, P_GEMM_IN, P_ZPOST, P_GEMM_QKV, P_ATTN, P_GEMM_OUT0, P_MOD2_0, P_MLP_UP0, P_MLP_DN0,
       P_MOD1_1, P_GEMM_HIN, P_CONV, P_TRANS, P_GEMM_OUT1, P_MOD2_1, P_MLP_UP1, P_MLP_DN1, P_FINAL,
       P_NC_FILT, P_NC_U0, P_NC_A, P_NC_B, P_NA_Q, P_NONE };
__host__ __device__ __forceinline__ int prog(int i) {
    int k = 0;
#define PRG(x) do { if (i == k) return (x); ++k; } while (0)
    PRG(P_PRO); PRG(P_MOD1_0); PRG(P_GEMM_IN); PRG(P_ZPOST); PRG(P_GEMM_QKV);
#if NAIVE_ATTN
    PRG(P_NA_Q);
#endif
    PRG(P_ATTN); PRG(P_GEMM_OUT0); PRG(P_MOD2_0); PRG(P_MLP_UP0); PRG(P_MLP_DN0); PRG(P_MOD1_1); PRG(P_GEMM_HIN);
    PRG(P_NC_FILT);
#if NAIVE_CONV
    PRG(P_NC_U0); PRG(P_NC_A); PRG(P_NC_B);
#else
    PRG(P_CONV);
#endif
    PRG(P_TRANS); PRG(P_GEMM_OUT1); PRG(P_MOD2_1); PRG(P_MLP_UP1); PRG(P_MLP_DN1); PRG(P_FINAL);
#undef PRG
    return P_NONE;
}
constexpr int N_PROG = 20 + (NAIVE_ATTN ? 1 : 0) + (NAIVE_CONV ? 2 : 0);

__device__ __forceinline__ bool gemm_job(const Ctx& p, int ph, int jj, GemmJob& J) {
    unsigned char* ws = p.ws;
    const float* MODL = (const float*)(ws + WS_MODL); float* XW = (float*)(ws + WS_XW);
    size_t a = 0, b = 0, o = 0; int M = 0, N = 0, K = 0, kind = 0, ldc = 0; const float* base = nullptr; const float* gate = nullptr;
    if (jj == 0) {
        if (ph == P_GEMM_IN) { a = WS_HL; b = WS_WIN; o = WS_Z; M = MT; N = ZW; K = DM; ldc = ZW; }
        else if (ph == P_GEMM_QKV) { a = WS_CQN; b = WS_WQB; o = WS_QM; M = ML; N = 768; K = 384; ldc = 768; }
        else if (ph == P_GEMM_OUT0) { a = WS_O; b = WS_WOUT; M = ML; N = DM; K = DM; kind = 2; base = p.in[I_X]; gate = MODL + 2 * DM; }
        else if (ph == P_MLP_UP0) { a = WS_HL; b = WS_W1_0; o = WS_HID; M = ML; N = 4096; K = DM; kind = 1; ldc = 4096; }
        else if (ph == P_MLP_DN0) { a = WS_HID; b = WS_W2_0; M = ML; N = DM; K = 4096; kind = 2; base = XW; gate = MODL + 5 * DM; }
        else if (ph == P_GEMM_HIN) { a = WS_HIN; b = WS_HL; o = WS_ZT; M = 3 * DM; N = ML; K = DM; ldc = ML; }
        else if (ph == P_GEMM_OUT1) { a = WS_Y2; b = WS_HOUT; M = ML; N = DM; K = DM; kind = 2; base = XW; gate = MODL + (size_t)16 * NMOD + 2 * DM; }
        else if (ph == P_MLP_UP1) { a = WS_HL; b = WS_W1_1; o = WS_HID; M = ML; N = 4096; K = DM; kind = 1; ldc = 4096; }
        else if (ph == P_MLP_DN1) { a = WS_HID; b = WS_W2_1; M = ML; N = DM; K = 4096; kind = 2; base = XW; gate = MODL + (size_t)16 * NMOD + 5 * DM; }
        else return false;
    } else {
        if (ph == P_GEMM_QKV) { a = WS_CKVN; b = WS_WKVB; o = WS_KV; M = MT; N = 1024; K = 256; ldc = 1024; }
        else return false;
    }
    J.A = (const bf16_t*)(ws + a); J.Bt = (const bf16_t*)(ws + b); J.M = M; J.N = N; J.K = K;
    J.E.kind = kind; J.E.O = (bf16_t*)(ws + o); J.E.ldc = ldc; J.E.base = base; J.E.out = XW; J.E.gate = gate;
    return true;
}

__global__ void __launch_bounds__(NTHREADS, 2) fwd(Params kp) {
    extern __shared__ __attribute__((aligned(16))) unsigned char lds_raw[];
    LAS unsigned char* lds = (LAS unsigned char*)lds_raw;
    const int wave0 = __builtin_amdgcn_readfirstlane((int)threadIdx.x >> 6);
    for (int pi = kp.ph_lo; pi < kp.ph_hi; ++pi) {
        if (pi > kp.ph_lo) cg::this_grid().sync();
        const int ph = prog(pi);
        Ctx p;
        { int z_ = 0, lane_; asm volatile("v_mbcnt_lo_u32_b32 %0, -1, 0\n\tv_mbcnt_hi_u32_b32 %0, -1, %0" : "=v"(lane_)); asm volatile("" : "+s"(z_));
          const int tid_ = ((wave0 + z_) << 6) + lane_;
          const CAS cfptr_t* in_ = (const CAS cfptr_t*)kp.in + z_; float* out_ = kp.out + z_; unsigned char* ws_ = kp.ws + z_; const int bid_ = (int)blockIdx.x + z_, nb_ = (int)gridDim.x + z_;
          p.in = in_; p.out = out_; p.ws = ws_; p.tid = tid_; p.bid = bid_; p.nblk = nb_; }
        float* XW = (float*)(p.ws + WS_XW);
#ifndef NO_GEMM
        for (int jj = 0; jj < 2; ++jj) { GemmJob J; if (!gemm_job(p, ph, jj, J)) break; run_gemm(p, lds, J); }
#endif
        if (ph == P_PRO && PHON(P_PRO)) phase_prologue(p, lds);
        else if (ph == P_MOD1_0 && PHON(P_MOD1_0)) phase_modulate(p, p.in[I_X], 0, p.in[I_N1G], 0, DM, true);
        else if (ph == P_ZPOST && PHON(P_ZPOST)) phase_zpost(p, lds);
        else if (ph == P_ATTN && PHON(P_ATTN)) {
#if NAIVE_ATTN
            phase_attn_naive(p);
#else
            phase_attn(p, lds);
#endif
        }
        else if (ph == P_NA_Q && PHON(P_NA_Q)) phase_naive_qrope(p);
        else if (ph == P_MOD2_0 && PHON(P_MOD2_0)) phase_modulate(p, XW, 0, p.in[I_N2G], 3 * DM, 4 * DM, false);
        else if (ph == P_MOD1_1 && PHON(P_MOD1_1)) phase_modulate(p, XW, 1, p.in[I_N1G] + DM, 0, DM, false);
        else if (ph == P_CONV && PHON(P_CONV)) phase_conv(p, lds);
        else if (ph == P_NC_FILT && PHON(P_NC_FILT)) phase_nconv_filt(p, lds);
        else if (ph == P_NC_U0 && PHON(P_NC_U0)) phase_nconv_u0(p);
        else if (ph == P_NC_A && PHON(P_NC_A)) phase_nconv_pass(p, 0);
        else if (ph == P_NC_B && PHON(P_NC_B)) phase_nconv_pass(p, 1);
        else if (ph == P_TRANS && PHON(P_TRANS)) phase_transpose(p, lds);
        else if (ph == P_MOD2_1 && PHON(P_MOD2_1)) phase_modulate(p, XW, 1, p.in[I_N2G] + DM, 3 * DM, 4 * DM, false);
        else if (ph == P_FINAL && PHON(P_FINAL)) phase_final(p);
    }
}

extern "C" void kernel_launch(void* const* d_in, const int* in_sizes, int n_in, void* d_out, int out_size, void* d_ws, size_t ws_size, hipStream_t stream) {
    static int ok = 0;
    if (ok == 0) {
        ok = 1;
        if (n_in != 32 || in_sizes[0] != ML * DM || out_size != ML * DM || ws_size < WS_END) { fprintf(stderr, "kernel_launch: unexpected shapes (n_in %d, in0 %d, out %d, ws %zu)\n", n_in, n_in > 0 ? in_sizes[0] : -1, out_size, ws_size); ok = -1; }
        int dev = 0, cus = 0;
        if (hipGetDevice(&dev) != hipSuccess || hipDeviceGetAttribute(&cus, hipDeviceAttributeMultiprocessorCount, dev) != hipSuccess || cus < GRID) { fprintf(stderr, "kernel_launch: needs %d CUs, device reports %d\n", GRID, cus); ok = -1; }
        if (hipFuncSetAttribute((const void*)fwd, hipFuncAttributeMaxDynamicSharedMemorySize, LDS_BYTES) != hipSuccess) { fprintf(stderr, "kernel_launch: hipFuncSetAttribute failed\n"); ok = -1; }
        int per_cu = 0;
        if (hipOccupancyMaxActiveBlocksPerMultiprocessor(&per_cu, (const void*)fwd, NTHREADS, LDS_BYTES) != hipSuccess || per_cu < 1) { fprintf(stderr, "kernel_launch: occupancy query says %d blocks per CU\n", per_cu); }
        (void)hipGetLastError();
    }
    if (ok < 0) return;
    Params p{};
    for (int i = 0; i < 32; ++i) p.in[i] = (const float*)d_in[i];
    p.out = (float*)d_out; p.ws = (unsigned char*)d_ws;
#if ONE_LAUNCH
    p.ph_lo = 0; p.ph_hi = N_PROG;
    void* args[] = {&p};
    hipError_t e = hipLaunchCooperativeKernel((const void*)fwd, dim3(GRID), dim3(NTHREADS), args, LDS_BYTES, stream);
    if (e != hipSuccess) fprintf(stderr, "kernel_launch: cooperative launch failed: %s\n", hipGetErrorString(e));
#else
    for (int i = 0; i < N_PROG; ++i) { p.ph_lo = i; p.ph_hi = i + 1; hipLaunchKernelGGL(fwd, dim3(GRID), dim3(NTHREADS), LDS_BYTES, stream, p); }
#endif
}
```

```cpp
#include <hip/hip_runtime.h>
#include <hip/hip_cooperative_groups.h>
#include <cstdio>
#include <cstdint>
namespace cg = cooperative_groups;

#ifndef ONE_LAUNCH
#define ONE_LAUNCH 1
#endif
#ifndef CG_SYNC
#define CG_SYNC 0
#endif
#ifndef PROBE_A
#define PROBE_A -1
#endif
#ifndef SIMPLE_GEMM
#define SIMPLE_GEMM 0
#endif
#ifndef NAIVE_ATTN
#define NAIVE_ATTN 0
#endif
#ifndef NAIVE_CONV
#define NAIVE_CONV 0
#endif

#ifndef PHASE_MASK
#define PHASE_MASK 0xFFFFFFFFu
#endif
#define PHON(x) (((PHASE_MASK) >> (x)) & 1u)
#define LAS __attribute__((address_space(3)))
typedef unsigned short bf16_t;
typedef short bf16x8 __attribute__((ext_vector_type(8)));
typedef short s16x4 __attribute__((ext_vector_type(4)));
typedef float f32x2 __attribute__((ext_vector_type(2)));
typedef float f32x4 __attribute__((ext_vector_type(4)));
typedef float f32x16 __attribute__((ext_vector_type(16)));
typedef unsigned u32x2 __attribute__((ext_vector_type(2)));
typedef unsigned u32x4 __attribute__((ext_vector_type(4)));
typedef __bf16 bf16x2_t __attribute__((ext_vector_type(2)));

constexpr int NB = 16, SEQ = 2048, DM = 1024, CTXL = 256, TKEYS = CTXL + SEQ;
constexpr int ML = NB * SEQ;
constexpr int MC = NB * CTXL;
constexpr int MT = ML + MC;
constexpr int NMOD = 6 * DM;
constexpr int ZW = 1536;
constexpr float EPS = 1e-6f;
constexpr int NWAVES = 8, NTHREADS = 512, GRID = 256, NGW = GRID * NWAVES;
constexpr int LDS_BYTES = 147456;
constexpr int ZC_CQ = 0, ZC_CKV = 384, ZC_KR = 640, ZC_GQ = 672, ZC_GK = 1184, ZC_GV = 1312;
constexpr float LOG2E = 1.4426950408889634f;
constexpr float QSCALE_MLA = 0.10206207261596577f * LOG2E;
constexpr float QSCALE_GQA = 0.125f * LOG2E;

constexpr size_t MiB = 1ull << 20;
constexpr size_t WS_CTL = 0;
constexpr size_t WS_MODL = 1 * MiB;
constexpr size_t WS_MODC = 1 * MiB + 786432;
constexpr size_t WS_H3 = 2 * MiB;
constexpr size_t WS_WIN = 4 * MiB, WS_WQB = 7 * MiB, WS_WKVB = 8 * MiB, WS_WOUT = 9 * MiB;
constexpr size_t WS_W1_0 = 11 * MiB, WS_W2_0 = 19 * MiB, WS_W1_1 = 27 * MiB, WS_W2_1 = 35 * MiB, WS_HIN = 43 * MiB, WS_HOUT = 49 * MiB;
constexpr size_t WS_XW = 52 * MiB;
constexpr size_t WS_HL = 180 * MiB;
constexpr size_t WS_Z = 252 * MiB, WS_CQN = 360 * MiB, WS_CKVN = 384 * MiB, WS_KROPE = 402 * MiB, WS_QG = 405 * MiB, WS_KG = 437 * MiB, WS_VG = 446 * MiB, WS_QM = 455 * MiB;
constexpr size_t WS_KV = WS_HL, WS_O = 252 * MiB;
constexpr size_t WS_HID = 252 * MiB;
constexpr size_t WS_ZT = 252 * MiB, WS_Y2T = WS_HL, WS_Y2 = 252 * MiB;
constexpr size_t WS_QMR = 316 * MiB;
constexpr size_t WS_FILT = 4 * MiB, WS_U0T = 444 * MiB, WS_Y1T = 380 * MiB;
constexpr size_t WS_END = 508 * MiB;

struct Params { const float* in[32]; float* out; unsigned char* ws; int ph_lo, ph_hi; };
#define CAS __attribute__((address_space(4)))
typedef const float* cfptr_t;
struct Ctx { const CAS cfptr_t* in; float* out; unsigned char* ws; int tid, bid, nblk; };

enum { I_X = 0, I_C, I_CTX, I_CCTX, I_WMOD, I_BMOD, I_N1G, I_N2G, I_W1, I_W2, I_AWIN, I_AQAG, I_AWQB, I_AKVAG, I_AWKVB, I_AQNG, I_AKNG, I_AWOUT,
       I_HWIN, I_HCW, I_HCB, I_FW1, I_FB1, I_FW2, I_FB2, I_FW3, I_FB3, I_FFREQ, I_FW4, I_HSKIP, I_HWOUT, I_FINALG };

__device__ __forceinline__ unsigned f2bf(float f) { unsigned u = __float_as_uint(f); return (u + 0x7fffu + ((u >> 16) & 1u)) >> 16; }
__device__ __forceinline__ float bf2f(unsigned h) { return __uint_as_float(h << 16); }
__device__ __forceinline__ unsigned cvtpk(float lo, float hi) { f32x2 v = {lo, hi}; bf16x2_t b = __builtin_convertvector(v, bf16x2_t); return __builtin_bit_cast(unsigned, b); }
__device__ __forceinline__ float wave_sum(float v) {
#pragma unroll
    for (int o = 1; o < 64; o <<= 1) v += __shfl_xor(v, o);
    return v;
}
__device__ __forceinline__ float fsin(float x) { return __builtin_amdgcn_sinf(__builtin_amdgcn_fractf(x * 0.15915494309189535f)); }
__device__ __forceinline__ float fcos(float x) { return __builtin_amdgcn_cosf(__builtin_amdgcn_fractf(x * 0.15915494309189535f)); }
__device__ __forceinline__ float inv_theta(float x) { return exp2f(-x * 13.287712379549449f); }
__device__ __forceinline__ float bflo(unsigned w) { return __uint_as_float(w << 16); }
__device__ __forceinline__ float bfhi(unsigned w) { return __uint_as_float(w & 0xffff0000u); }

namespace pg8 {
constexpr int BM = 256, BK = 64, HALF = 128, HTB = HALF * BK * 2, STAGE_BYTES = 8 * HTB, NXCD = 8, WGM = 8;
__host__ __device__ __forceinline__ int lds_byte(int r, int c) { const int st = (r >> 4) * 2 + (c >> 5), rr = r & 15, cc = c & 31, ob = rr * 64 + cc * 2; return st * 1024 + (ob ^ (((ob >> 9) & 1) << 5)); }
__host__ __device__ __forceinline__ void stage_rc(int b, int& R, int& C) { const int st = b / 1024, sb = b % 1024, swz = sb ^ (((sb >> 9) & 1) << 5); R = (st >> 1) * 16 + swz / 64; C = (st & 1) * 32 + (swz % 64) / 2; }
__host__ __device__ __forceinline__ int perm32(int rho) { const int n = rho >> 4, i = rho & 15; return 8 * (i >> 2) + 4 * n + (i & 3); }

struct Unit { int pm, pn; };
struct Gemm { const bf16_t* A; const bf16_t* Bt; int M, N, K; };

struct StaticOrder {
    int nM, nN, nwg, G, c;
    __host__ __device__ void init(int M, int N, int G_, int c_) { nM = M / BM; nN = N / BM; nwg = nM * nN; G = G_; c = c_; }
    __host__ __device__ bool next(int i, Unit& u) const {
        const long L = (long)i * G + c; if (L >= nwg) return false;
        int wgid = (int)L; { const int q = nwg / NXCD, r = nwg % NXCD, xcd = wgid % NXCD, off = wgid / NXCD; wgid = (xcd < r ? xcd * (q + 1) : r * (q + 1) + (xcd - r) * q) + off; }
        const int nig = WGM * nN, gid = wgid / nig, fm = gid * WGM, gsz = (nM - fm) < WGM ? (nM - fm) : WGM;
        u.pm = fm + ((wgid % nig) % gsz); u.pn = (wgid % nig) / gsz; return true;
    }
    __device__ __forceinline__ void a_ready(const Unit&) const {}
    __device__ __forceinline__ void done(const Unit&) const {}
};

struct EpiAny {
    static constexpr bool AFTER_DRAIN = false;
    int kind; bf16_t* O; int ldc; const float* base; float* out; const float* gate;
    __device__ __forceinline__ bool perm() const { return kind != 2; }
    __device__ __forceinline__ void operator()(const f32x4 (&acc)[2][2][4][2], const Unit& u, int wr, int wc, int fr, int fq) const {
        const int row0 = u.pm * BM + wr * 64 + fr;
        if (kind != 2) {
            const int col0 = u.pn * BM + wc * 32 + 8 * fq; const bool act = kind == 1;
#pragma unroll
            for (int ai = 0; ai < 2; ++ai)
#pragma unroll
                for (int m = 0; m < 4; ++m) { bf16_t* rowp = O + (size_t)(row0 + ai * HALF + m * 16) * ldc + col0;
#pragma unroll
                    for (int bj = 0; bj < 2; ++bj) { f32x4 v0 = acc[ai][bj][m][0], v1 = acc[ai][bj][m][1];
                        if (act) {
#pragma unroll
                            for (int e = 0; e < 4; ++e) { const float a = fmaxf(v0[e], 0.f), b = fmaxf(v1[e], 0.f); v0[e] = a * a; v1[e] = b * b; } }
                        u32x4 w; w.x = cvtpk(v0[0], v0[1]); w.y = cvtpk(v0[2], v0[3]); w.z = cvtpk(v1[0], v1[1]); w.w = cvtpk(v1[2], v1[3]);
                        *(u32x4*)(rowp + bj * HALF) = w; } }
        } else {
            const int col0 = u.pn * BM + wc * 32 + 4 * fq;
            const float* gp = gate + (size_t)((u.pm * BM) / SEQ) * NMOD + col0;
            f32x4 gv[2][2];
#pragma unroll
            for (int bj = 0; bj < 2; ++bj)
#pragma unroll
                for (int n = 0; n < 2; ++n) gv[bj][n] = *(const f32x4*)(gp + bj * HALF + n * 16);
#pragma unroll
            for (int ai = 0; ai < 2; ++ai)
#pragma unroll
                for (int m = 0; m < 4; ++m) { const size_t off = (size_t)(row0 + ai * HALF + m * 16) * DM + col0;
#pragma unroll
                    for (int bj = 0; bj < 2; ++bj)
#pragma unroll
                        for (int n = 0; n < 2; ++n) { const f32x4 x = *(const f32x4*)(base + off + bj * HALF + n * 16);
                            *(f32x4*)(out + off + bj * HALF + n * 16) = x + gv[bj][n] * acc[ai][bj][m][n]; } }
        }
    }
};

template <class Epi, class Sched>
__device__ __forceinline__ void gemm_simple(const int tid, const Gemm g, const Sched& S, const Epi& E) {
    const int  wid = __builtin_amdgcn_readfirstlane(tid >> 6), lane = tid & 63, wr = wid >> 2, wc = wid & 3, fr = lane & 15, fq = lane >> 4;
    const int K = g.K;
    Unit u;
    for (int ui = 0; S.next(ui, u); ++ui) {
        f32x4 acc[2][2][4][2];
#pragma unroll
        for (int a = 0; a < 2; ++a)
#pragma unroll
            for (int b = 0; b < 2; ++b)
#pragma unroll
                for (int m = 0; m < 4; ++m)
#pragma unroll
                    for (int n = 0; n < 2; ++n) acc[a][b][m][n] = (f32x4){0.f, 0.f, 0.f, 0.f};
        const bf16_t* Ab = g.A + (size_t)(u.pm * BM + wr * 64 + fr) * K + fq * 8;
        const bf16_t* Bb = g.Bt + (size_t)(u.pn * BM + wc * 32) * K + fq * 8;
        for (int k0 = 0; k0 < K; k0 += 32) {
            bf16x8 At[2][4], Bf[2][2];
#pragma unroll
            for (int ai = 0; ai < 2; ++ai)
#pragma unroll
                for (int m = 0; m < 4; ++m) At[ai][m] = *(const bf16x8*)(Ab + (size_t)(ai * HALF + m * 16) * K + k0);
#pragma unroll
            for (int bj = 0; bj < 2; ++bj)
#pragma unroll
                for (int n = 0; n < 2; ++n) { const int rr = E.perm() ? perm32(16 * n + fr) : (16 * n + fr);
                    Bf[bj][n] = *(const bf16x8*)(Bb + (size_t)(bj * HALF + rr) * K + k0); }
#pragma unroll
            for (int ai = 0; ai < 2; ++ai)
#pragma unroll
                for (int bj = 0; bj < 2; ++bj)
#pragma unroll
                    for (int m = 0; m < 4; ++m)
#pragma unroll
                        for (int n = 0; n < 2; ++n) acc[ai][bj][m][n] = __builtin_amdgcn_mfma_f32_16x16x32_bf16(Bf[bj][n], At[ai][m], acc[ai][bj][m][n], 0, 0, 0);
        }
        E(acc, u, wr, wc, fr, fq);
    }
}

template <class Epi, class Sched, bool ALIGN_EPI = true>
__device__ __forceinline__ void gemm_phase(const int tid, LAS unsigned char* lds, const Gemm g, const Sched& S, const Epi& E) {
    const int  wid = __builtin_amdgcn_readfirstlane(tid >> 6), lane = tid & 63, wr = wid >> 2, wc = wid & 3, fr = lane & 15, fq = lane >> 4;
    const int K = g.K, nt = K / BK;
    unsigned voffA[2], voffB[2];
#pragma unroll
    for (int i = 0; i < 2; ++i) { int R, C; stage_rc(tid * 16 + i * 8192, R, C); const int Rb = E.perm() ? ((R & ~31) + perm32(R & 31)) : R;
        voffA[i] = (unsigned)(R * K + C) * 2u; voffB[i] = (unsigned)(Rb * K + C) * 2u; }
    const size_t kstep = (size_t)(BK * 2);
    const size_t hstep = (size_t)HALF * K * 2;
    const size_t tstep = 2 * hstep;
    const unsigned ldsw = (unsigned)wid * 1024u;
    const int aoff = lds_byte(wr * 64 + fr, fq * 8), boff = lds_byte(wc * 32 + fr, fq * 8);
#define PG8_SA(b, h) (((b) * 2 + (h)) * HTB)
#define PG8_SB(b, h) ((4 + (b) * 2 + (h)) * HTB)
#define PG8_STAGE(bufoff, gbase, voff) do { _Pragma("unroll") for (int _i = 0; _i < 2; ++_i) \
        __builtin_amdgcn_global_load_lds((const unsigned*)((const char*)(gbase) + (voff)[_i]), (LAS unsigned*)(lds + (bufoff) + ldsw + _i * 8192), 16, 0, 0); } while (0)
#define PG8_LDA(dst, b, h) do { _Pragma("unroll") for (int m = 0; m < 4; ++m) _Pragma("unroll") for (int k = 0; k < 2; ++k) dst[m][k] = *(const LAS bf16x8*)(lds + PG8_SA(b, h) + aoff + m * 2048 + k * 1024); } while (0)
#define PG8_LDB(dst, b, h) do { _Pragma("unroll") for (int n = 0; n < 2; ++n) _Pragma("unroll") for (int k = 0; k < 2; ++k) dst[n][k] = *(const LAS bf16x8*)(lds + PG8_SB(b, h) + boff + n * 2048 + k * 1024); } while (0)
#define PG8_MMA(ai, bj, At, Bt) do { __builtin_amdgcn_s_setprio(1); _Pragma("unroll") for (int m = 0; m < 4; ++m) _Pragma("unroll") for (int n = 0; n < 2; ++n) _Pragma("unroll") for (int k = 0; k < 2; ++k) \
        acc[ai][bj][m][n] = __builtin_amdgcn_mfma_f32_16x16x32_bf16(Bt[n][k], At[m][k], acc[ai][bj][m][n], 0, 0, 0); __builtin_amdgcn_s_setprio(0); } while (0)
#define PG8_WAIT_V(n) asm volatile("s_waitcnt vmcnt(" #n ")" ::: "memory")
#define PG8_WAIT_L(n) asm volatile("s_waitcnt lgkmcnt(" #n ")" ::: "memory")
#define PG8_BAR __builtin_amdgcn_s_barrier()
#define PG8_SCHED __builtin_amdgcn_sched_barrier(0)
    Unit cur, nxt; int ui = 0;
    if (!S.next(0, cur)) return;
    f32x4 acc[2][2][4][2];
#pragma unroll
    for (int a = 0; a < 2; ++a)
#pragma unroll
        for (int b = 0; b < 2; ++b)
#pragma unroll
            for (int m = 0; m < 4; ++m)
#pragma unroll
                for (int n = 0; n < 2; ++n) acc[a][b][m][n] = (f32x4){0.f, 0.f, 0.f, 0.f};
    bf16x8 At[4][2], B0[2][2], B1[2][2];
    const char* cA = (const char*)g.A + (size_t)cur.pm * tstep; const char* cB = (const char*)g.Bt + (size_t)cur.pn * tstep;
    S.a_ready(cur);
    PG8_STAGE(PG8_SB(0, 0), cB, voffB); PG8_STAGE(PG8_SB(0, 1), cB + hstep, voffB); PG8_STAGE(PG8_SA(0, 0), cA, voffA); PG8_STAGE(PG8_SA(0, 1), cA + hstep, voffA);
    if (wr == 1) PG8_BAR;
    PG8_WAIT_V(2); PG8_BAR;
    PG8_STAGE(PG8_SB(1, 0), cB + kstep, voffB); PG8_STAGE(PG8_SA(1, 0), cA + kstep, voffA); PG8_STAGE(PG8_SB(1, 1), cB + hstep + kstep, voffB);
    PG8_WAIT_V(6); PG8_BAR;
    for (;;) {
        const bool has_next = S.next(ui + 1, nxt);
        const char* nA = has_next ? (const char*)g.A + (size_t)nxt.pm * tstep : cA; const char* nB = has_next ? (const char*)g.Bt + (size_t)nxt.pn * tstep : cB;
        for (int t = 0; t < nt; t += 2) {
            const bool last = (t == nt - 2);
            const char* a1 = cA + (size_t)(t + 1) * kstep;
            const char* a2 = last ? nA : cA + (size_t)(t + 2) * kstep; const char* b2 = last ? nB : cB + (size_t)(t + 2) * kstep;
            const char* a3 = a2 + kstep; const char* b3 = b2 + kstep;
            if (last && has_next) S.a_ready(nxt);
            PG8_LDB(B0, 0, 0); PG8_LDB(B1, 0, 1); PG8_SCHED; PG8_LDA(At, 0, 0); PG8_STAGE(PG8_SA(1, 1), a1 + hstep, voffA);
            PG8_WAIT_V(8); PG8_WAIT_L(0); PG8_BAR; PG8_MMA(0, 0, At, B0); PG8_MMA(0, 1, At, B1); PG8_BAR; PG8_SCHED;
            PG8_LDA(At, 0, 1); PG8_STAGE(PG8_SB(0, 0), b2, voffB); PG8_STAGE(PG8_SB(0, 1), b2 + hstep, voffB); PG8_STAGE(PG8_SA(0, 0), a2, voffA);
            PG8_WAIT_V(8); PG8_WAIT_L(0); PG8_BAR; PG8_MMA(1, 0, At, B0); PG8_MMA(1, 1, At, B1); PG8_BAR; PG8_SCHED;
            PG8_LDB(B0, 1, 0); PG8_LDB(B1, 1, 1); PG8_SCHED; PG8_LDA(At, 1, 0); PG8_STAGE(PG8_SA(0, 1), a2 + hstep, voffA);
            PG8_WAIT_V(8); PG8_WAIT_L(0); PG8_BAR; PG8_MMA(0, 0, At, B0); PG8_MMA(0, 1, At, B1); PG8_BAR; PG8_SCHED;
            PG8_LDA(At, 1, 1); PG8_STAGE(PG8_SB(1, 0), b3, voffB); PG8_STAGE(PG8_SB(1, 1), b3 + hstep, voffB); PG8_STAGE(PG8_SA(1, 0), a3, voffA);
            PG8_WAIT_V(8); PG8_WAIT_L(0); PG8_BAR; PG8_MMA(1, 0, At, B0); PG8_MMA(1, 1, At, B1); PG8_BAR; PG8_SCHED;
        }
        if constexpr (ALIGN_EPI) { if (wr == 0) PG8_BAR; }
        E(acc, cur, wr, wc, fr, fq); S.done(cur);
        if (!has_next) break;
#pragma unroll
        for (int a = 0; a < 2; ++a)
#pragma unroll
            for (int b = 0; b < 2; ++b)
#pragma unroll
                for (int m = 0; m < 4; ++m)
#pragma unroll
                    for (int n = 0; n < 2; ++n) acc[a][b][m][n] = (f32x4){0.f, 0.f, 0.f, 0.f};
        cur = nxt; cA = nA; cB = nB; ++ui;
        if constexpr (ALIGN_EPI) { if (wr == 1) PG8_BAR; }
    }
    PG8_WAIT_V(0);
    if constexpr (!ALIGN_EPI) { if (wr == 0) PG8_BAR; }
    PG8_BAR;
#undef PG8_SA
#undef PG8_SB
#undef PG8_STAGE
#undef PG8_LDA
#undef PG8_LDB
#undef PG8_MMA
#undef PG8_WAIT_V
#undef PG8_WAIT_L
#undef PG8_BAR
#undef PG8_SCHED
}
}

struct GemmJob { const bf16_t* A; const bf16_t* Bt; int M, N, K; pg8::EpiAny E; };
__device__ __forceinline__ void run_gemm(const Ctx& p, LAS unsigned char* lds, const GemmJob& J) {
    pg8::Gemm g{J.A, J.Bt, J.M, J.N, J.K}; pg8::StaticOrder S; S.init(J.M, J.N, p.nblk, p.bid);
#if SIMPLE_GEMM
    pg8::gemm_simple<pg8::EpiAny, pg8::StaticOrder>(p.tid, g, S, J.E);
#else
    pg8::gemm_phase<pg8::EpiAny, pg8::StaticOrder, true>(p.tid, lds, g, S, J.E);
#endif
    __syncthreads();
}

__device__ __forceinline__ void transpose_item(const float* W, int K, int N, bf16_t* WT, LAS float* scr, int item, int lane) {
    const int nblk = N / 32, kb = item / nblk, nb = item % nblk, k0 = 64 * kb, n0 = 32 * nb;
#pragma unroll 4
    for (int i = 0; i < 32; ++i) { const int kk = 2 * i + (lane >> 5); scr[kk * 33 + (lane & 31)] = W[(size_t)(k0 + kk) * N + n0 + (lane & 31)]; }
    asm volatile("s_waitcnt lgkmcnt(0)" ::: "memory");
    const int c = lane & 7;
#pragma unroll
    for (int j = 0; j < 4; ++j) { const int n = (lane >> 3) + 8 * j; const LAS float* s = scr + (8 * c) * 33 + n;
        u32x4 o; o.x = cvtpk(s[0 * 33], s[1 * 33]); o.y = cvtpk(s[2 * 33], s[3 * 33]); o.z = cvtpk(s[4 * 33], s[5 * 33]); o.w = cvtpk(s[6 * 33], s[7 * 33]);
        *(u32x4*)(WT + (size_t)(n0 + n) * K + k0 + 8 * c) = o; }
    asm volatile("s_waitcnt lgkmcnt(0)" ::: "memory");
}

__device__ __forceinline__ float silu_f(float v) { return v / (1.0f + expf(-v)); }

__device__ __forceinline__ void phase_prologue(const Ctx& p, LAS unsigned char* lds) {
    const int tid = p.tid, lane = tid & 63, wave = __builtin_amdgcn_readfirstlane(tid >> 6);
    unsigned char* ws = p.ws;
#ifndef PRO_SKIP1
    {
        LAS float* S = (LAS float*)lds;
        LAS float* red = (LAS float*)(lds + 69632);
        float* MODL = (float*)(ws + WS_MODL); float* MODC = (float*)(ws + WS_MODC);
        if (p.bid < 192) {
            for (int i = tid; i < 17 * 1024; i += NTHREADS) { const float v = (i < 16 * 1024) ? p.in[I_C][i] : p.in[I_CCTX][i - 16 * 1024]; S[i] = silu_f(v); }
            __syncthreads();
            for (int it = p.bid; it < 192; it += p.nblk) {
                const int layer = it / 96, n0 = (it % 96) * 64;
                const float* W = p.in[I_WMOD] + (size_t)layer * DM * NMOD + n0 + lane;
                float acc[17];
#pragma unroll
                for (int b = 0; b < 17; ++b) acc[b] = 0.f;
#pragma unroll 2
                for (int kk = 0; kk < 128; ++kk) { const int k = wave * 128 + kk; const float w = W[(size_t)k * NMOD];
#pragma unroll
                    for (int b = 0; b < 17; ++b) acc[b] += S[b * 1024 + k] * w; }
#pragma unroll
                for (int b = 0; b < 17; ++b) red[(wave * 17 + b) * 64 + lane] = acc[b];
                __syncthreads();
                for (int idx = tid; idx < 17 * 64; idx += NTHREADS) { const int b = idx >> 6, l = idx & 63; float s = p.in[I_BMOD][layer * NMOD + n0 + l];
#pragma unroll
                    for (int w = 0; w < 8; ++w) s += red[(w * 17 + b) * 64 + l];
                    if (b < 16) MODL[(size_t)(layer * 16 + b) * NMOD + n0 + l] = s; else if (layer == 0) MODC[n0 + l] = s; }
                __syncthreads();
            }
        }
        __syncthreads();
    }
#endif
    const int gw = p.bid * NWAVES + wave, ngw = p.nblk * NWAVES;
#ifndef PRO_SKIP2
    {
        float* H3 = (float*)(ws + WS_H3);
        const float* w1 = p.in[I_FW1]; const float* b1 = p.in[I_FB1]; const float* w2 = p.in[I_FW2]; const float* b2 = p.in[I_FB2];
        const float* w3 = p.in[I_FW3]; const float* b3 = p.in[I_FB3]; const float* fr = p.in[I_FFREQ];
        for (int t = gw; t < SEQ; t += ngw) {
            const float tf = (float)t, tn = tf / 2048.0f, w = 6.283185307179586f * tf / 2048.0f;
            float feat = 0.f;
            if (lane == 0) feat = tn;
            else if (lane < 17) { const int bi = (lane - 1) & 7; const float band = 1e-4f + (float)bi * ((7.0f - 1e-4f) / 7.0f); const float fw = w * band; feat = (lane < 9) ? fcos(fw) : -fsin(fw); }
            float a = b1[lane];
#pragma unroll
            for (int i = 0; i < 17; ++i) a += __shfl(feat, i) * w1[i * 64 + lane];
            float h = fsin(fr[lane] * a);
            a = b2[lane];
#pragma unroll 4
            for (int k = 0; k < 64; ++k) a += __shfl(h, k) * w2[k * 64 + lane];
            h = fsin(fr[64 + lane] * a);
            a = b3[lane];
#pragma unroll 4
            for (int k = 0; k < 64; ++k) a += __shfl(h, k) * w3[k * 64 + lane];
            h = fsin(fr[128 + lane] * a);
            H3[t * 64 + lane] = h;
        }
    }
#endif
#ifndef PRO_SKIP3
    {
        LAS float* scr = (LAS float*)(lds + wave * 16384);
        struct TJob { int in_idx; size_t in_off; int K, N; size_t ws_off; };
        const TJob jobs[10] = {
            {I_AWIN, 0, 1024, 1440, WS_WIN}, {I_AWQB, 0, 384, 768, WS_WQB}, {I_AWKVB, 0, 256, 1024, WS_WKVB}, {I_AWOUT, 0, 1024, 1024, WS_WOUT},
            {I_W1, 0, 1024, 4096, WS_W1_0}, {I_W2, 0, 4096, 1024, WS_W2_0}, {I_W1, (size_t)1024 * 4096, 1024, 4096, WS_W1_1}, {I_W2, (size_t)4096 * 1024, 4096, 1024, WS_W2_1},
            {I_HWIN, 0, 1024, 3072, WS_HIN}, {I_HWOUT, 0, 1024, 1024, WS_HOUT}};
        int base = 0;
#pragma unroll
        for (int j = 0; j < 10; ++j) {
            const int K = jobs[j].K, N = jobs[j].N, nitems = (K / 64) * (N / 32);
            const float* W = p.in[jobs[j].in_idx] + jobs[j].in_off; bf16_t* WT = (bf16_t*)(ws + jobs[j].ws_off);
            int first = gw - (base % ngw); if (first < 0) first += ngw;
            for (int it = first; it < nitems; it += ngw) transpose_item(W, K, N, WT, scr, it, lane);
            base += nitems;
        }
        u32x4* z = (u32x4*)((bf16_t*)(ws + WS_WIN) + (size_t)1440 * 1024);
        for (int i = p.bid * NTHREADS + tid; i < 96 * 1024 / 8; i += p.nblk * NTHREADS) z[i] = (u32x4){0u, 0u, 0u, 0u};
    }
#endif
}

__device__ __forceinline__ void modulate_chunk(const float* src, int row0, int nrows, const float* g, const float* sc, const float* sh, bf16_t* dst, int lane) {
    f32x4 gs[4], sv[4];
#pragma unroll
    for (int j = 0; j < 4; ++j) { const int c4 = lane + 64 * j; const f32x4 gg = ((const f32x4*)g)[c4], ss = ((const f32x4*)sc)[c4]; gs[j] = gg * (ss + 1.0f); sv[j] = ((const f32x4*)sh)[c4]; }
    for (int r = row0; r < row0 + nrows; ++r) {
        const f32x4* xr = (const f32x4*)(src + (size_t)r * DM) + lane;
        f32x4 v[4]; float s = 0.f;
#pragma unroll
        for (int j = 0; j < 4; ++j) { v[j] = xr[64 * j]; s += (v[j].x * v[j].x + v[j].y * v[j].y) + (v[j].z * v[j].z + v[j].w * v[j].w); }
        const float rstd = rsqrtf(wave_sum(s) * (1.0f / DM) + EPS);
        u32x2* o8 = (u32x2*)(dst + (size_t)r * DM) + lane;
#pragma unroll
        for (int j = 0; j < 4; ++j) { const f32x4 y = v[j] * rstd * gs[j] + sv[j]; u32x2 w; w.x = cvtpk(y.x, y.y); w.y = cvtpk(y.z, y.w); o8[64 * j] = w; }
    }
}
__device__ __forceinline__ void phase_modulate(const Ctx& p, const float* src, int layer, const float* g, int shoff, int scoff, bool with_ctx) {
    const int lane = p.tid & 63, wave = __builtin_amdgcn_readfirstlane(p.tid >> 6);
    const int gw = p.bid * NWAVES + wave;
    const float* MODL = (const float*)(p.ws + WS_MODL); const float* MODC = (const float*)(p.ws + WS_MODC);
    bf16_t* HL = (bf16_t*)(p.ws + WS_HL);
    {   const int per = ML / NGW, row0 = gw * per, b = row0 / SEQ; const float* mv = MODL + (size_t)(layer * 16 + b) * NMOD;
        modulate_chunk(src, row0, per, g, mv + scoff, mv + shoff, HL, lane); }
    if (with_ctx) { const int per = MC / NGW, row0 = gw * per;
        modulate_chunk(p.in[I_CTX], row0, per, g, MODC + scoff, MODC + shoff, HL + (size_t)ML * DM, lane); }
}
__device__ __forceinline__ void phase_final(const Ctx& p) {
    const int lane = p.tid & 63, wave = __builtin_amdgcn_readfirstlane(p.tid >> 6);
    const int gw = p.bid * NWAVES + wave, per = ML / NGW;
    const float* X = (const float*)(p.ws + WS_XW); const float* g = p.in[I_FINALG];
    f32x4 gs[4];
#pragma unroll
    for (int j = 0; j < 4; ++j) gs[j] = ((const f32x4*)g)[lane + 64 * j];
    for (int r = gw * per; r < (gw + 1) * per; ++r) {
        const f32x4* xr = (const f32x4*)(X + (size_t)r * DM) + lane; f32x4 v[4]; float s = 0.f;
#pragma unroll
        for (int j = 0; j < 4; ++j) { v[j] = xr[64 * j]; s += (v[j].x * v[j].x + v[j].y * v[j].y) + (v[j].z * v[j].z + v[j].w * v[j].w); }
        const float rstd = rsqrtf(wave_sum(s) * (1.0f / DM) + EPS);
        f32x4* o = (f32x4*)(p.out + (size_t)r * DM) + lane;
#pragma unroll
        for (int j = 0; j < 4; ++j) o[64 * j] = v[j] * rstd * gs[j];
    }
}

__device__ __forceinline__ void zpost_row(const Ctx& p, int row, bool latent, int lane, const LAS f32x2* tabM, const LAS f32x2* tabG) {
    unsigned char* ws = p.ws;
    const bf16_t* z = (const bf16_t*)(ws + WS_Z) + (size_t)row * ZW;
    int prow = 0, pcol = 0;
    if (latent) { const int s = row & (SEQ - 1); prow = s >> 6; pcol = s & 63; }
    if (latent) {
        float v[6], ss = 0.f;
#pragma unroll
        for (int i = 0; i < 6; ++i) { v[i] = bf2f(z[ZC_CQ + lane + 64 * i]); ss += v[i] * v[i]; }
        const float rstd = rsqrtf(wave_sum(ss) * (1.0f / 384.0f) + EPS);
        bf16_t* o = (bf16_t*)(ws + WS_CQN) + (size_t)row * 384;
#pragma unroll
        for (int i = 0; i < 6; ++i) o[lane + 64 * i] = (bf16_t)f2bf(v[i] * rstd * p.in[I_AQAG][lane + 64 * i]);
    }
    {
        float v[4], ss = 0.f;
#pragma unroll
        for (int i = 0; i < 4; ++i) { v[i] = bf2f(z[ZC_CKV + lane + 64 * i]); ss += v[i] * v[i]; }
        const float rstd = rsqrtf(wave_sum(ss) * (1.0f / 256.0f) + EPS);
        bf16_t* o = (bf16_t*)(ws + WS_CKVN) + (size_t)row * 256;
#pragma unroll
        for (int i = 0; i < 4; ++i) o[lane + 64 * i] = (bf16_t)f2bf(v[i] * rstd * p.in[I_AKVAG][lane + 64 * i]);
    }
    {
        const int d = lane & 31; const float y = bf2f(z[ZC_KR + d]);
        const float pr = __shfl_xor(y, 8);
        float o = y;
        if (latent) { const int pos = (d & 16) ? pcol : prow; const f32x2 cs = tabM[pos * 8 + (d & 7)];
            o = (d & 8) ? (pr * cs.y + y * cs.x) : (y * cs.x - pr * cs.y); }
        if (lane < 32) ((bf16_t*)(ws + WS_KROPE))[(size_t)row * 32 + d] = (bf16_t)f2bf(o);
    }
    if (latent) {
        const float gq = p.in[I_AQNG][lane];
        const int pos = (lane & 32) ? pcol : prow; const f32x2 cs = tabG[pos * 16 + (lane & 15)];
        bf16_t* o = (bf16_t*)(ws + WS_QG) + (size_t)row * 512;
#pragma unroll
        for (int hh = 0; hh < 8; ++hh) {
            const float v = bf2f(z[ZC_GQ + 64 * hh + lane]);
            const float rstd = rsqrtf(wave_sum(v * v) * (1.0f / 64.0f) + EPS);
            const float y = v * rstd * gq, pr = __shfl_xor(y, 16);
            const float r = (lane & 16) ? (pr * cs.y + y * cs.x) : (y * cs.x - pr * cs.y);
            o[64 * hh + lane] = (bf16_t)f2bf(r * QSCALE_GQA);
        }
    }
    {
        const float gk = p.in[I_AKNG][lane];
        f32x2 cs = {1.f, 0.f};
        if (latent) { const int pos = (lane & 32) ? pcol : prow; cs = tabG[pos * 16 + (lane & 15)]; }
        bf16_t* o = (bf16_t*)(ws + WS_KG) + (size_t)row * 128;
#pragma unroll
        for (int hh = 0; hh < 2; ++hh) {
            const float v = bf2f(z[ZC_GK + 64 * hh + lane]);
            const float rstd = rsqrtf(wave_sum(v * v) * (1.0f / 64.0f) + EPS);
            const float y = v * rstd * gk, pr = __shfl_xor(y, 16);
            const float r = (lane & 16) ? (pr * cs.y + y * cs.x) : (y * cs.x - pr * cs.y);
            o[64 * hh + lane] = (bf16_t)f2bf(r);
        }
    }
    {
        bf16_t* o = (bf16_t*)(ws + WS_VG) + (size_t)row * 128;
        o[lane] = z[ZC_GV + lane]; o[64 + lane] = z[ZC_GV + 64 + lane];
    }
}
__device__ __forceinline__ void phase_zpost(const Ctx& p, LAS unsigned char* lds) {
    const int tid = p.tid, lane = tid & 63, wave = __builtin_amdgcn_readfirstlane(tid >> 6);
    LAS f32x2* tabM = (LAS f32x2*)lds;
    LAS f32x2* tabG = (LAS f32x2*)(lds + 4096);
    for (int i = tid; i < 512; i += NTHREADS) { const int pos = i >> 3, f = i & 7; const float inv = inv_theta((float)f / 8.0f); const float a = (float)pos * inv; tabM[i] = (f32x2){fcos(a), fsin(a)}; }
    for (int i = tid; i < 1024; i += NTHREADS) { const int pos = i >> 4, f = i & 15; const float inv = inv_theta((float)f / 16.0f); const float a = (float)pos * inv; tabG[i] = (f32x2){fcos(a), fsin(a)}; }
    __syncthreads();
    const int gw = p.bid * NWAVES + wave;
    { const int per = ML / NGW; for (int r = gw * per; r < (gw + 1) * per; ++r) zpost_row(p, r, true, lane, tabM, tabG); }
    { const int per = MC / NGW; for (int r = gw * per; r < (gw + 1) * per; ++r) zpost_row(p, ML + r, false, lane, tabM, tabG); }
    __syncthreads();
}

__device__ __forceinline__ int crow(int r, int hi) { return (r & 3) + 8 * (r >> 2) + 4 * hi; }
__device__ __forceinline__ size_t key_row(int b, int t) { return t < CTXL ? (size_t)(ML + b * CTXL + t) : (size_t)(b * SEQ + (t - CTXL)); }

template <int DK>
__device__ __forceinline__ void attn_naive_one(const Ctx& p, int b, int h, int q) {
    unsigned char* ws = p.ws;
    const bf16_t* KV = (const bf16_t*)(ws + WS_KV); const bf16_t* KR = (const bf16_t*)(ws + WS_KROPE);
    const bf16_t* KG = (const bf16_t*)(ws + WS_KG); const bf16_t* VG = (const bf16_t*)(ws + WS_VG);
    const size_t row = (size_t)b * SEQ + q;
    float qv[DK];
    {
        const bf16_t* qp = (DK == 96) ? (const bf16_t*)(ws + WS_QMR) + row * 768 + h * 96 : (const bf16_t*)(ws + WS_QG) + row * 512 + (h - 8) * 64;
#pragma unroll
        for (int d8 = 0; d8 < DK / 8; ++d8) { const u32x4 w = *(const u32x4*)(qp + 8 * d8);
            qv[8 * d8 + 0] = bflo(w.x); qv[8 * d8 + 1] = bfhi(w.x); qv[8 * d8 + 2] = bflo(w.y); qv[8 * d8 + 3] = bfhi(w.y);
            qv[8 * d8 + 4] = bflo(w.z); qv[8 * d8 + 5] = bfhi(w.z); qv[8 * d8 + 6] = bflo(w.w); qv[8 * d8 + 7] = bfhi(w.w); }
    }
    float o[64];
#pragma unroll
    for (int d = 0; d < 64; ++d) o[d] = 0.f;
    float m = -1e30f, l = 0.f;
    for (int t = 0; t < TKEYS; ++t) {
        const size_t kr = key_row(b, t);
        float s = 0.f;
        const bf16_t* vp;
        if (DK == 96) {
            const bf16_t* kp = KV + kr * 1024 + h * 128; const bf16_t* rp = KR + kr * 32;
#pragma unroll
            for (int d = 0; d < 64; ++d) s += qv[d] * bf2f(kp[d]);
#pragma unroll
            for (int d = 0; d < 32; ++d) s += qv[64 + d] * bf2f(rp[d]);
            vp = kp + 64;
        } else {
            const int kvh = (h - 8) >> 2; const bf16_t* kp = KG + kr * 128 + kvh * 64;
#pragma unroll
            for (int d = 0; d < 64; ++d) s += qv[d] * bf2f(kp[d]);
            vp = VG + kr * 128 + kvh * 64;
        }
        const float mn = fmaxf(m, s), al = exp2f(m - mn), pe = exp2f(s - mn);
        l = l * al + pe; m = mn;
#pragma unroll
        for (int d = 0; d < 64; ++d) o[d] = o[d] * al + pe * bf2f(vp[d]);
    }
    const float rl = 1.0f / l;
    bf16_t* op = (bf16_t*)(ws + WS_O) + row * 1024 + h * 64;
#pragma unroll
    for (int d = 0; d < 64; ++d) op[d] = (bf16_t)f2bf(o[d] * rl);
}
__device__ __forceinline__ void phase_naive_qrope(const Ctx& p) {
    const bf16_t* QM = (const bf16_t*)(p.ws + WS_QM); bf16_t* QMR = (bf16_t*)(p.ws + WS_QMR);
    for (size_t idx = (size_t)p.bid * NTHREADS + p.tid; idx < (size_t)ML * 768; idx += (size_t)p.nblk * NTHREADS) {
        const int col = (int)(idx % 768), d = col % 96; const size_t row = idx / 768; const int q = (int)(row & (SEQ - 1));
        float v = bf2f(QM[idx]);
        if (d >= 64) {
            const int e = d - 64, prow = q >> 6, pcol = q & 63;
            const int pos = (e & 16) ? pcol : prow; const float inv = inv_theta((float)(e & 7) / 8.0f); const float ang = (float)pos * inv;
            const float cs = fcos(ang), sn = fsin(ang);
            const float a = bf2f(QM[idx - e + (e & ~8)]), bb = bf2f(QM[idx - e + (e | 8)]);
            v = (e & 8) ? (a * sn + bb * cs) : (a * cs - bb * sn);
        }
        QMR[idx] = (bf16_t)f2bf(v * QSCALE_MLA);
    }
}
__device__ __forceinline__ void phase_attn_naive(const Ctx& p) {
    for (int idx = p.bid * NTHREADS + p.tid; idx < NB * 16 * SEQ; idx += p.nblk * NTHREADS) {
        const int q = idx & (SEQ - 1), h = (idx >> 11) & 15, b = idx >> 15;
        if (h < 8) attn_naive_one<96>(p, b, h, q); else attn_naive_one<64>(p, b, h, q);
    }
}

template <int DK>
__device__ __forceinline__ void attn_unit(const Ctx& p, int b, int h, int qb, LAS unsigned char* lds) {
    constexpr int NC = DK / 8;
    constexpr int ND = DK / 16;
    constexpr int KB = 12288, VB = 8192;
    unsigned char* ws = p.ws;
    const int tid = p.tid, lane = tid & 63, r32 = lane & 31, hi = lane >> 5; const int wid = __builtin_amdgcn_readfirstlane(tid >> 6);
    const bf16_t* KV = (const bf16_t*)(ws + WS_KV); const bf16_t* KR = (const bf16_t*)(ws + WS_KROPE);
    const bf16_t* KG = (const bf16_t*)(ws + WS_KG); const bf16_t* VG = (const bf16_t*)(ws + WS_VG);
    const int kvh = (h - 8) >> 2;
    LAS unsigned char* Kb = lds; LAS unsigned char* Vb = lds + 2 * KB; LAS float* wsf = (LAS float*)(lds + 2 * KB + 2 * VB) + wid * 64;
    const int qs = qb * 256 + wid * 32 + r32;
    const size_t qrow = (size_t)b * SEQ + qs;
    bf16x8 qr[ND];
    if (DK == 96) {
        const bf16_t* qp = (const bf16_t*)(ws + WS_QM) + qrow * 768 + h * 96;
#pragma unroll
        for (int d0 = 0; d0 < 4; ++d0) { const u32x4 w = *(const u32x4*)(qp + 16 * d0 + 8 * hi); u32x4 o;
            o.x = cvtpk(bflo(w.x) * QSCALE_MLA, bfhi(w.x) * QSCALE_MLA); o.y = cvtpk(bflo(w.y) * QSCALE_MLA, bfhi(w.y) * QSCALE_MLA);
            o.z = cvtpk(bflo(w.z) * QSCALE_MLA, bfhi(w.z) * QSCALE_MLA); o.w = cvtpk(bflo(w.w) * QSCALE_MLA, bfhi(w.w) * QSCALE_MLA);
            qr[d0] = __builtin_bit_cast(bf16x8, o); }
        const int prow = qs >> 6, pcol = qs & 63;
#pragma unroll
        for (int c = 0; c < 2; ++c) {
            const u32x4 wa = *(const u32x4*)(qp + 64 + 16 * c);
            const u32x4 wb = *(const u32x4*)(qp + 64 + 16 * c + 8);
            const float pos = (float)(c == 0 ? prow : pcol);
            float av[8] = {bflo(wa.x), bfhi(wa.x), bflo(wa.y), bfhi(wa.y), bflo(wa.z), bfhi(wa.z), bflo(wa.w), bfhi(wa.w)};
            float bv[8] = {bflo(wb.x), bfhi(wb.x), bflo(wb.y), bfhi(wb.y), bflo(wb.z), bfhi(wb.z), bflo(wb.w), bfhi(wb.w)};
            float ov[8];
#pragma unroll
            for (int j = 0; j < 8; ++j) { const float inv = inv_theta((float)j / 8.0f); const float ang = pos * inv; const float cs = fcos(ang), sn = fsin(ang);
                const float lo = av[j] * cs - bv[j] * sn, hv = av[j] * sn + bv[j] * cs; ov[j] = (hi ? hv : lo) * QSCALE_MLA; }
            u32x4 o; o.x = cvtpk(ov[0], ov[1]); o.y = cvtpk(ov[2], ov[3]); o.z = cvtpk(ov[4], ov[5]); o.w = cvtpk(ov[6], ov[7]);
            qr[4 + c] = __builtin_bit_cast(bf16x8, o);
        }
    } else {
        const bf16_t* qp = (const bf16_t*)(ws + WS_QG) + qrow * 512 + (h - 8) * 64;
#pragma unroll
        for (int d0 = 0; d0 < ND; ++d0) qr[d0] = *(const bf16x8*)(qp + 16 * d0 + 8 * hi);
    }
    const int kkey = tid & 63, kc0 = tid >> 6;
    const int vkv = tid >> 3, vdc = tid & 7;
    const unsigned kdst0 = kc0 * 1024 + kkey * 16, kdst1 = (kc0 + 8) * 1024 + kkey * 16;
    const unsigned vdst = (vdc >> 2) * 4096 + (vkv >> 4) * 1024 + (vkv & 15) * 64 + (vdc & 3) * 16;
    u32x4 kreg0, kreg1 = {0u, 0u, 0u, 0u}, vreg;
    auto load_tile = [&](int kt) {
        const size_t rk = key_row(b, kt * 64 + kkey), rv = key_row(b, kt * 64 + vkv);
        if (DK == 96) {
            kreg0 = *(const u32x4*)(KV + rk * 1024 + h * 128 + 8 * kc0);
            if (wid < 4) kreg1 = *(const u32x4*)(KR + rk * 32 + 8 * kc0);
            vreg = *(const u32x4*)(KV + rv * 1024 + h * 128 + 64 + 8 * vdc);
        } else {
            kreg0 = *(const u32x4*)(KG + rk * 128 + kvh * 64 + 8 * kc0);
            vreg = *(const u32x4*)(VG + rv * 128 + kvh * 64 + 8 * vdc);
        }
    };
    auto store_tile = [&](int buf) {
        *(LAS u32x4*)(Kb + buf * KB + kdst0) = kreg0;
        if (DK == 96) { if (wid < 4) *(LAS u32x4*)(Kb + buf * KB + kdst1) = kreg1; }
        *(LAS u32x4*)(Vb + buf * VB + vdst) = vreg;
    };
    f32x16 o0 = {}, o1 = {};
    float mrun = -1e30f, lrun = 0.f;
    const unsigned kfo = hi * 1024 + r32 * 16;
    const unsigned vfo = ((lane >> 4) & 1) * 32 + (lane & 3) * 8 + (4 * hi + ((lane & 15) >> 2)) * 64;
    load_tile(0); store_tile(0);
    __syncthreads();
    constexpr int NT = TKEYS / 64;
    for (int kt = 0; kt < NT; ++kt) {
        const int buf = kt & 1;
        if (kt + 1 < NT) load_tile(kt + 1);
        f32x16 p0 = {}, p1 = {};
        const LAS unsigned char* kp = Kb + buf * KB + kfo;
#pragma unroll
        for (int d0 = 0; d0 < ND; ++d0) {
            const bf16x8 k0 = *(const LAS bf16x8*)(kp + d0 * 2048), k1 = *(const LAS bf16x8*)(kp + d0 * 2048 + 512);
            p0 = __builtin_amdgcn_mfma_f32_32x32x16_bf16(k0, qr[d0], p0, 0, 0, 0);
            p1 = __builtin_amdgcn_mfma_f32_32x32x16_bf16(k1, qr[d0], p1, 0, 0, 0);
        }
        float mx = fmaxf(p0[0], p1[0]);
#pragma unroll
        for (int r = 1; r < 16; ++r) mx = fmaxf(mx, fmaxf(p0[r], p1[r]));
        mx = fmaxf(mx, __shfl_xor(mx, 32));
        const float mnew = fmaxf(mrun, mx), alpha = __builtin_amdgcn_exp2f(mrun - mnew);
        mrun = mnew;
        float rs = 0.f;
#pragma unroll
        for (int r = 0; r < 16; ++r) { p0[r] = __builtin_amdgcn_exp2f(p0[r] - mnew); p1[r] = __builtin_amdgcn_exp2f(p1[r] - mnew); rs += p0[r] + p1[r]; }
        lrun = lrun * alpha + rs;
        if (hi == 0) wsf[r32] = alpha;
        asm volatile("s_waitcnt lgkmcnt(0)" ::: "memory");
#pragma unroll
        for (int g4 = 0; g4 < 4; ++g4) { const f32x4 a4 = *(const LAS f32x4*)(wsf + 8 * g4 + 4 * hi);
#pragma unroll
            for (int e = 0; e < 4; ++e) { o0[4 * g4 + e] *= a4[e]; o1[4 * g4 + e] *= a4[e]; } }
        u32x4 pw[4];
        pw[0] = (u32x4){cvtpk(p0[0], p0[1]), cvtpk(p0[2], p0[3]), cvtpk(p0[4], p0[5]), cvtpk(p0[6], p0[7])};
        pw[1] = (u32x4){cvtpk(p0[8], p0[9]), cvtpk(p0[10], p0[11]), cvtpk(p0[12], p0[13]), cvtpk(p0[14], p0[15])};
        pw[2] = (u32x4){cvtpk(p1[0], p1[1]), cvtpk(p1[2], p1[3]), cvtpk(p1[4], p1[5]), cvtpk(p1[6], p1[7])};
        pw[3] = (u32x4){cvtpk(p1[8], p1[9]), cvtpk(p1[10], p1[11]), cvtpk(p1[12], p1[13]), cvtpk(p1[14], p1[15])};
        const LAS unsigned char* vp = Vb + buf * VB + vfo;
#pragma unroll
        for (int ks = 0; ks < 4; ++ks) {
            const bf16x8 pa = __builtin_bit_cast(bf16x8, pw[ks]);
            const s16x4 l0 = __builtin_amdgcn_ds_read_tr16_b64_v4i16((LAS s16x4*)(vp + ks * 1024));
            const s16x4 h0 = __builtin_amdgcn_ds_read_tr16_b64_v4i16((LAS s16x4*)(vp + ks * 1024 + 512));
            const s16x4 l1 = __builtin_amdgcn_ds_read_tr16_b64_v4i16((LAS s16x4*)(vp + 4096 + ks * 1024));
            const s16x4 h1 = __builtin_amdgcn_ds_read_tr16_b64_v4i16((LAS s16x4*)(vp + 4096 + ks * 1024 + 512));
            const bf16x8 v0 = {l0[0], l0[1], l0[2], l0[3], h0[0], h0[1], h0[2], h0[3]};
            const bf16x8 v1 = {l1[0], l1[1], l1[2], l1[3], h1[0], h1[1], h1[2], h1[3]};
            o0 = __builtin_amdgcn_mfma_f32_32x32x16_bf16(pa, v0, o0, 0, 0, 0);
            o1 = __builtin_amdgcn_mfma_f32_32x32x16_bf16(pa, v1, o1, 0, 0, 0);
        }
        if (kt + 1 < NT) store_tile(buf ^ 1);
        __syncthreads();
    }
    lrun += __shfl_xor(lrun, 32);
    if (hi == 0) wsf[32 + r32] = lrun;
    asm volatile("s_waitcnt lgkmcnt(0)" ::: "memory");
    bf16_t* Ow = (bf16_t*)(ws + WS_O) + ((size_t)b * SEQ + qb * 256 + wid * 32) * 1024 + h * 64;
#pragma unroll
    for (int r = 0; r < 16; ++r) { const int orow = crow(r, hi); const float rl = 1.0f / wsf[32 + orow];
        Ow[(size_t)orow * 1024 + r32] = (bf16_t)f2bf(o0[r] * rl); Ow[(size_t)orow * 1024 + 32 + r32] = (bf16_t)f2bf(o1[r] * rl); }
    __syncthreads();
}
__device__ __forceinline__ void phase_attn(const Ctx& p, LAS unsigned char* lds) {
    const int c = p.bid, bq = c >> 1, b = bq >> 3, qb = bq & 7;
    for (int i = 0; i < 8; ++i) { const int h = 2 * i + (c & 1);
        if (h < 8) attn_unit<96>(p, b, h, qb, lds); else attn_unit<64>(p, b, h, qb, lds); }
}

__device__ __forceinline__ void hyena_taps(const Ctx& p, int c, LAS unsigned char* scratch, float (&taps)[4][2][2]) {
    const int tid = p.tid, lane = tid & 63, wave = __builtin_amdgcn_readfirstlane(tid >> 6);
    LAS float* w4s = (LAS float*)scratch;
    LAS float* red = (LAS float*)(scratch + 1024);
    const float* w4 = p.in[I_FW4]; const float* H3 = (const float*)(p.ws + WS_H3);
    if (tid < 256) { const int cc = tid >> 6, k = tid & 63; w4s[cc * 64 + k] = w4[(size_t)k * 4096 + (cc >> 1) * 2048 + (cc & 1) * 1024 + c]; }
    __syncthreads();
    const float dmin = -3.0701134573253940f, dmax = -15.350567286626970f;
    const float delta = fabsf(dmin + (float)c * ((dmax - dmin) / 1023.0f));
    float ss0 = 0.f, ss1 = 0.f;
    float a[4][4];
#pragma unroll
    for (int i = 0; i < 4; ++i)
#pragma unroll
        for (int cc = 0; cc < 4; ++cc) a[i][cc] = 0.f;
#pragma unroll 2
    for (int k4 = 0; k4 < 16; ++k4) {
        f32x4 wv[4];
#pragma unroll
        for (int cc = 0; cc < 4; ++cc) wv[cc] = *(const LAS f32x4*)(w4s + cc * 64 + 4 * k4);
#pragma unroll
        for (int i = 0; i < 4; ++i) { const f32x4 hv = *((const f32x4*)(H3 + (size_t)(tid + 512 * i) * 64) + k4);
#pragma unroll
            for (int cc = 0; cc < 4; ++cc) a[i][cc] += (hv[0] * wv[cc][0] + hv[1] * wv[cc][1]) + (hv[2] * wv[cc][2] + hv[3] * wv[cc][3]); }
    }
#pragma unroll
    for (int i = 0; i < 4; ++i) {
        const int t = tid + 512 * i;
        const float win = expf(-((float)t / 2048.0f) * delta);
#pragma unroll
        for (int cc = 0; cc < 4; ++cc) a[i][cc] *= win;
        taps[i][0][0] = a[i][0]; taps[i][0][1] = a[i][1]; taps[i][1][0] = a[i][2]; taps[i][1][1] = a[i][3];
        ss0 += a[i][0] * a[i][0] + a[i][2] * a[i][2]; ss1 += a[i][1] * a[i][1] + a[i][3] * a[i][3];
    }
    ss0 = wave_sum(ss0); ss1 = wave_sum(ss1);
    if (lane == 0) { red[wave * 2] = ss0; red[wave * 2 + 1] = ss1; }
    __syncthreads();
    float t0 = 0.f, t1 = 0.f;
#pragma unroll
    for (int w = 0; w < 8; ++w) { t0 += red[w * 2]; t1 += red[w * 2 + 1]; }
    const float n0 = rsqrtf(t0 + EPS), n1 = rsqrtf(t1 + EPS);
#pragma unroll
    for (int i = 0; i < 4; ++i) { taps[i][0][0] *= n0; taps[i][1][0] *= n0; taps[i][0][1] *= n1; taps[i][1][1] *= n1; }
    __syncthreads();
}
__device__ __forceinline__ float sconv_at(const bf16_t* zr, int b, int n, float w0, float w1, float w2, float cb) {
    const bf16_t* q = zr + b * SEQ + n;
    const float l = n > 0 ? bf2f(q[-1]) : 0.f, m = bf2f(q[0]), r = n < SEQ - 1 ? bf2f(q[1]) : 0.f;
    return cb + w0 * l + w1 * m + w2 * r;
}

__device__ __forceinline__ void phase_nconv_filt(const Ctx& p, LAS unsigned char* lds) {
    bf16_t* F = (bf16_t*)(p.ws + WS_FILT);
    for (int c = p.bid; c < DM; c += p.nblk) {
        float taps[4][2][2];
        hyena_taps(p, c, lds, taps);
#pragma unroll
        for (int i = 0; i < 4; ++i) { const int t = p.tid + 512 * i;
#pragma unroll
            for (int o = 0; o < 2; ++o) { bf16_t* f = F + (size_t)(c * 2 + o) * 4096;
                f[2048 - t] = (bf16_t)f2bf(taps[i][0][o]);
                if (t > 0) f[2048 + t] = (bf16_t)f2bf(taps[i][1][o]); } }
    }
}
__device__ __forceinline__ void phase_nconv_u0(const Ctx& p) {
    const bf16_t* ZT = (const bf16_t*)(p.ws + WS_ZT); bf16_t* U0 = (bf16_t*)(p.ws + WS_U0T);
    const float* cw = p.in[I_HCW]; const float* cb = p.in[I_HCB];
    for (size_t idx = (size_t)p.bid * NTHREADS + p.tid; idx < (size_t)DM * ML; idx += (size_t)p.nblk * NTHREADS) {
        const int c = (int)(idx >> 15), bn = (int)(idx & 32767), b = bn >> 11, n = bn & 2047; const int ch = 2048 + c;
        U0[idx] = (bf16_t)f2bf(sconv_at(ZT + (size_t)ch * ML, b, n, cw[ch], cw[3072 + ch], cw[6144 + ch], cb[ch]));
    }
}
__device__ __forceinline__ void phase_nconv_pass(const Ctx& p, int o) {
    const bf16_t* ZT = (const bf16_t*)(p.ws + WS_ZT); const bf16_t* F = (const bf16_t*)(p.ws + WS_FILT);
    const bf16_t* U = (const bf16_t*)(p.ws + (o == 0 ? WS_U0T : WS_Y1T)); bf16_t* Y = (bf16_t*)(p.ws + (o == 0 ? WS_Y1T : WS_Y2T));
    const float* cw = p.in[I_HCW]; const float* cb = p.in[I_HCB]; const float* skip = p.in[I_HSKIP];
    for (size_t idx = (size_t)p.bid * NTHREADS + p.tid; idx < (size_t)DM * ML; idx += (size_t)p.nblk * NTHREADS) {
        const int c = (int)(idx >> 15), bn = (int)(idx & 32767), b = bn >> 11, n = bn & 2047;
        const bf16_t* u = U + (size_t)c * ML + b * SEQ; const bf16_t* f = F + (size_t)(c * 2 + o) * 4096 + 2048 - n;
        float acc = 0.f;
        for (int m = 0; m < SEQ; ++m) acc += bf2f(f[m]) * bf2f(u[m]);
        acc += skip[o * DM + c] * bf2f(u[n]);
        const int ch = o * 1024 + c;
        const float gate = sconv_at(ZT + (size_t)ch * ML, b, n, cw[ch], cw[3072 + ch], cw[6144 + ch], cb[ch]);
        Y[idx] = (bf16_t)f2bf(gate * acc);
    }
}

constexpr int CV_USTRIDE = 4112;
constexpr int CV_U = 0;
constexpr int CV_CP = 65792, CV_CPSTRIDE = 8208;
static_assert(CV_CP + 8 * CV_CPSTRIDE <= LDS_BYTES, "conv LDS map");

__device__ __forceinline__ void conv_build_copies(const int tid, LAS unsigned char* lds, const bf16_t* rev) {
    const u32x4 cur = *(const u32x4*)(rev + 8 * tid);
    u32x4 prv = {0u, 0u, 0u, 0u};
    if (tid > 0) prv = *(const u32x4*)(rev + 8 * tid - 8);
    const unsigned W[8] = {prv.x, prv.y, prv.z, prv.w, cur.x, cur.y, cur.z, cur.w};
#pragma unroll
    for (int rho = 0; rho < 8; ++rho) {
        unsigned o[4];
#pragma unroll
        for (int d = 0; d < 4; ++d) { const int e0 = 8 - rho + 2 * d;
            o[d] = (e0 & 1) ? __builtin_amdgcn_alignbit(W[(e0 >> 1) + 1], W[e0 >> 1], 16) : W[e0 >> 1]; }
        *(LAS u32x4*)(lds + CV_CP + rho * CV_CPSTRIDE + 16 * tid) = (u32x4){o[0], o[1], o[2], o[3]};
    }
}
__device__ __forceinline__ void sconv4(const bf16_t* zr, int n, float w0, float w1, float w2, float cb, float (&g)[4]) {
    const u32x2 w = *(const u32x2*)(zr + n);
    const float l = n > 0 ? bf2f(zr[n - 1]) : 0.f, r = n + 4 < SEQ ? bf2f(zr[n + 4]) : 0.f;
    const float x[6] = {l, bflo(w.x), bfhi(w.x), bflo(w.y), bfhi(w.y), r};
#pragma unroll
    for (int e = 0; e < 4; ++e) g[e] = cb + w0 * x[e] + w1 * x[e + 1] + w2 * x[e + 2];
}
__device__ __forceinline__ void conv_mma(const int tid, LAS unsigned char* lds, f32x4 (&acc)[16]) {
    const int lane = tid & 63, wave = __builtin_amdgcn_readfirstlane(tid >> 6);
#pragma unroll
    for (int i = 0; i < 16; ++i) acc[i] = (f32x4){0.f, 0.f, 0.f, 0.f};
    const LAS unsigned char* ab = lds + CV_CP + (lane & 7) * CV_CPSTRIDE + 2 * (2048 - 8 * ((lane & 15) >> 3) + 8 * (lane >> 4)) - 32 * (16 * wave);
    const LAS unsigned char* ub = lds + CV_U + (lane & 15) * CV_USTRIDE + 16 * (lane >> 4);
    bf16x8 w0, w1, w2, w3, w4, w5, w6, w7, w8, w9, w10, w11, w12, w13, w14, w15;
#define CV_LD(i) (*(const LAS bf16x8*)(ab - 32 * (i)))
    w0 = CV_LD(0); w1 = CV_LD(1); w2 = CV_LD(2); w3 = CV_LD(3); w4 = CV_LD(4); w5 = CV_LD(5); w6 = CV_LD(6); w7 = CV_LD(7);
    w8 = CV_LD(8); w9 = CV_LD(9); w10 = CV_LD(10); w11 = CV_LD(11); w12 = CV_LD(12); w13 = CV_LD(13); w14 = CV_LD(14); w15 = CV_LD(15);
#undef CV_LD
#define CV_MF(i, W) acc[i] = __builtin_amdgcn_mfma_f32_16x16x32_bf16(W, uf, acc[i], 0, 0, 0)
#define CV_STEP(jj, A0, A1, A2, A3, A4, A5, A6, A7, A8, A9, A10, A11, A12, A13, A14, A15) do { \
        const int j = J * 8 + (jj); const bf16x8 uf = *(const LAS bf16x8*)(ub + 64 * j); \
        const int jn = (j + 1 < 64) ? (j + 1) : j; \
        const bf16x8 n0 = *(const LAS bf16x8*)(ab + 64 * jn), n1 = *(const LAS bf16x8*)(ab + 64 * jn - 32); \
        CV_MF(0, A0); CV_MF(1, A1); CV_MF(2, A2); CV_MF(3, A3); CV_MF(4, A4); CV_MF(5, A5); CV_MF(6, A6); CV_MF(7, A7); \
        CV_MF(8, A8); CV_MF(9, A9); CV_MF(10, A10); CV_MF(11, A11); CV_MF(12, A12); CV_MF(13, A13); CV_MF(14, A14); CV_MF(15, A15); \
        A14 = n0; A15 = n1; } while (0)
    for (int J = 0; J < 8; ++J) {
        CV_STEP(0, w0, w1, w2, w3, w4, w5, w6, w7, w8, w9, w10, w11, w12, w13, w14, w15);
        CV_STEP(1, w14, w15, w0, w1, w2, w3, w4, w5, w6, w7, w8, w9, w10, w11, w12, w13);
        CV_STEP(2, w12, w13, w14, w15, w0, w1, w2, w3, w4, w5, w6, w7, w8, w9, w10, w11);
        CV_STEP(3, w10, w11, w12, w13, w14, w15, w0, w1, w2, w3, w4, w5, w6, w7, w8, w9);
        CV_STEP(4, w8, w9, w10, w11, w12, w13, w14, w15, w0, w1, w2, w3, w4, w5, w6, w7);
        CV_STEP(5, w6, w7, w8, w9, w10, w11, w12, w13, w14, w15, w0, w1, w2, w3, w4, w5);
        CV_STEP(6, w4, w5, w6, w7, w8, w9, w10, w11, w12, w13, w14, w15, w0, w1, w2, w3);
        CV_STEP(7, w2, w3, w4, w5, w6, w7, w8, w9, w10, w11, w12, w13, w14, w15, w0, w1);
    }
#undef CV_STEP
#undef CV_MF
}
__device__ __forceinline__ void phase_conv(const Ctx& p, LAS unsigned char* lds) {
    const bf16_t* ZT = (const bf16_t*)(p.ws + WS_ZT); bf16_t* Y2T = (bf16_t*)(p.ws + WS_Y2T); const bf16_t* F = (const bf16_t*)(p.ws + WS_FILT);
    const float* cw = p.in[I_HCW]; const float* cb = p.in[I_HCB]; const float* skip = p.in[I_HSKIP];
    for (int c = p.bid; c < DM; c += p.nblk) {
        int tid = p.tid; asm volatile("" : "+v"(tid));
        const int lane = tid & 63, wave = __builtin_amdgcn_readfirstlane(tid >> 6);
        {   const int b = tid >> 5, m0 = (tid & 31) * 64, ch = 2048 + c; const bf16_t* zr = ZT + (size_t)ch * ML + b * SEQ;
            const float w0 = cw[ch], w1 = cw[3072 + ch], w2 = cw[6144 + ch], bb = cb[ch];
            float prev = m0 > 0 ? bf2f(zr[m0 - 1]) : 0.f;
#pragma unroll 2
            for (int k8 = 0; k8 < 8; ++k8) {
                const u32x4 w = *(const u32x4*)(zr + m0 + 8 * k8);
                const int mn = m0 + 8 * k8 + 8; const float nxt = mn < SEQ ? bf2f(zr[mn]) : 0.f;
                const float x[10] = {prev, bflo(w.x), bfhi(w.x), bflo(w.y), bfhi(w.y), bflo(w.z), bfhi(w.z), bflo(w.w), bfhi(w.w), nxt};
                float y[8];
#pragma unroll
                for (int e = 0; e < 8; ++e) y[e] = bb + w0 * x[e] + w1 * x[e + 1] + w2 * x[e + 2];
                u32x4 o; o.x = cvtpk(y[0], y[1]); o.y = cvtpk(y[2], y[3]); o.z = cvtpk(y[4], y[5]); o.w = cvtpk(y[6], y[7]);
                *(LAS u32x4*)(lds + CV_U + b * CV_USTRIDE + 2 * (m0 + 8 * k8)) = o;
                prev = x[8];
            }
        }
        conv_build_copies(tid, lds, F + (size_t)(c * 2 + 0) * 4096);
        __syncthreads();
        f32x4 acc[16];
        conv_mma(tid, lds, acc);
        __syncthreads();
        const int b = lane & 15, nq = 256 * wave + 4 * (lane >> 4);
        {   const int ch = c; const bf16_t* zr = ZT + (size_t)ch * ML + b * SEQ; const float w0 = cw[ch], w1 = cw[3072 + ch], w2 = cw[6144 + ch], bb = cb[ch], sk = skip[c];
#pragma unroll
            for (int i = 0; i < 16; ++i) { const int n = nq + 16 * i; LAS u32x2* up = (LAS u32x2*)(lds + CV_U + b * CV_USTRIDE + 2 * n);
                const u32x2 uw = *up; const float u[4] = {bflo(uw.x), bfhi(uw.x), bflo(uw.y), bfhi(uw.y)};
                float g[4]; sconv4(zr, n, w0, w1, w2, bb, g);
                float y[4];
#pragma unroll
                for (int e = 0; e < 4; ++e) y[e] = g[e] * (acc[i][e] + sk * u[e]);
                u32x2 ow; ow.x = cvtpk(y[0], y[1]); ow.y = cvtpk(y[2], y[3]); *up = ow;
                if ((i & 3) == 3) __builtin_amdgcn_sched_barrier(0); }
        }
        conv_build_copies(tid, lds, F + (size_t)(c * 2 + 1) * 4096);
        __syncthreads();
        conv_mma(tid, lds, acc);
        {   const int ch = 1024 + c; const bf16_t* zr = ZT + (size_t)ch * ML + b * SEQ; const float w0 = cw[ch], w1 = cw[3072 + ch], w2 = cw[6144 + ch], bb = cb[ch], sk = skip[DM + c];
#pragma unroll
            for (int i = 0; i < 16; ++i) { const int n = nq + 16 * i; const u32x2 uw = *(const LAS u32x2*)(lds + CV_U + b * CV_USTRIDE + 2 * n);
                const float u[4] = {bflo(uw.x), bfhi(uw.x), bflo(uw.y), bfhi(uw.y)};
                float g[4]; sconv4(zr, n, w0, w1, w2, bb, g);
                float y[4];
#pragma unroll
                for (int e = 0; e < 4; ++e) y[e] = g[e] * (acc[i][e] + sk * u[e]);
                u32x2 ow; ow.x = cvtpk(y[0], y[1]); ow.y = cvtpk(y[2], y[3]);
                *(u32x2*)(Y2T + (size_t)c * ML + b * SEQ + n) = ow;
                if ((i & 3) == 3) __builtin_amdgcn_sched_barrier(0); }
        }
        __syncthreads();
    }
}

__device__ __forceinline__ void phase_transpose(const Ctx& p, LAS unsigned char* lds) {
    const int tid = p.tid, lane = tid & 63, wave = __builtin_amdgcn_readfirstlane(tid >> 6);
    const bf16_t* src = (const bf16_t*)(p.ws + WS_Y2T); bf16_t* dst = (bf16_t*)(p.ws + WS_Y2);
    LAS bf16_t* tile = (LAS bf16_t*)(lds + wave * 16384);
    const int gw = p.bid * NWAVES + wave, ngw = p.nblk * NWAVES;
    for (int it = gw; it < (DM / 64) * (ML / 64); it += ngw) {
        const int cb = it & 15, tb = it >> 4, c0 = cb * 64, t0 = tb * 64;
#pragma unroll
        for (int i = 0; i < 8; ++i) { const int r = 8 * i + (lane >> 3), ch = lane & 7;
            const u32x4 w = *(const u32x4*)(src + (size_t)(c0 + r) * ML + t0 + 8 * ch);
            LAS unsigned* d = (LAS unsigned*)(tile + r * 66 + 8 * ch); d[0] = w.x; d[1] = w.y; d[2] = w.z; d[3] = w.w; }
        asm volatile("s_waitcnt lgkmcnt(0)" ::: "memory");
#pragma unroll
        for (int i = 0; i < 8; ++i) { const int t = 8 * i + (lane >> 3), ch = lane & 7; unsigned short e[8];
#pragma unroll
            for (int k = 0; k < 8; ++k) e[k] = tile[(8 * ch + k) * 66 + t];
            u32x4 w; w.x = e[0] | ((unsigned)e[1] << 16); w.y = e[2] | ((unsigned)e[3] << 16); w.z = e[4] | ((unsigned)e[5] << 16); w.w = e[6] | ((unsigned)e[7] << 16);
            *(u32x4*)(dst + (size_t)(t0 + t) * DM + c0 + 8 * ch) = w; }
        asm volatile("s_waitcnt lgkmcnt(0)" ::: "memory");
    }
}

#define XB_TMO      128
#define XB_XCNT(j)  (256  + 64 * (j))
#define XB_XSUB(j)  (1280 + 64 * (j))
#define XB_XGEN(j)  (2304 + 64 * (j))
#define XB_TOP      3328
#define XB_TOPGEN   3392
#define XCD_BAR_WORDS 3456
#define XB_SPIN_CAP (1u << 18)
__device__ __forceinline__ unsigned xb_ld(unsigned* p)              { return __hip_atomic_load(p, __ATOMIC_RELAXED, __HIP_MEMORY_SCOPE_AGENT); }
__device__ __forceinline__ unsigned xb_add(unsigned* p, unsigned v) { return __hip_atomic_fetch_add(p, v, __ATOMIC_RELAXED, __HIP_MEMORY_SCOPE_AGENT); }
__device__ __forceinline__ unsigned xb_xcc_id() { return (unsigned)__builtin_amdgcn_s_getreg((3 << 11) | 20) & 0xFu; }
#define XB_SPIN(cond, bar) do { unsigned _sp = 0; while (cond) { __builtin_amdgcn_s_sleep(1); \
    if ((++_sp & 255u) == 0u) { if (xb_ld(&(bar)[XB_TMO])) break; if (_sp > XB_SPIN_CAP) { atomicAdd(&(bar)[XB_TMO], 1u); break; } } } } while (0)
struct XcdBarrier { unsigned* bar; unsigned x; volatile LAS unsigned* st; };
__device__ __forceinline__ XcdBarrier xcd_barrier_post(unsigned* bar, volatile LAS unsigned* st) {
    XcdBarrier b; b.bar = bar; b.x = xb_xcc_id(); b.st = st;
    if (threadIdx.x == 0) (void)xb_add(&bar[XB_XCNT(b.x)], 1u);
    return b;
}
__device__ __forceinline__ void xcd_barrier_complete(unsigned* bar, unsigned x, unsigned& nloc, unsigned& nx) {
    const unsigned G = gridDim.x * gridDim.y * gridDim.z;
    unsigned sum, cnt, mine, sp = 0u;
    for (;;) {
        sum = 0u; cnt = 0u; mine = 0u;
#pragma unroll
        for (unsigned j = 0; j < 16; ++j) { const unsigned c = xb_ld(&bar[XB_XCNT(j)]); sum += c; cnt += (c > 0u) ? 1u : 0u; mine = (j == x) ? c : mine; }
        if (sum == G) break;
        __builtin_amdgcn_s_sleep(1);
        if ((++sp & 255u) == 0u) { if (xb_ld(&bar[XB_TMO])) break; if (sp > XB_SPIN_CAP) { atomicAdd(&bar[XB_TMO], 1u); break; } }
    }
    nloc = mine > 0u ? mine : 1u; nx = cnt > 0u ? cnt : 1u;
}
__device__ __forceinline__ void xcd_barrier(const XcdBarrier& b) {
    asm volatile("s_waitcnt vmcnt(0)" ::: "memory");
    __syncthreads();
    if (threadIdx.x == 0) {
        unsigned* bar = b.bar;
        __builtin_amdgcn_s_waitcnt(0);
        unsigned nloc = b.st[0], nx = b.st[1];
        if (nloc == 0u) { xcd_barrier_complete(bar, b.x, nloc, nx); b.st[0] = nloc; b.st[1] = nx; }
        const unsigned old = xb_add(&bar[XB_XSUB(b.x)], 1u);
        const unsigned gen = old / nloc;
        if (old + 1u == (gen + 1u) * nloc) {
            __builtin_amdgcn_fence(__ATOMIC_RELEASE, "agent");
            asm volatile("s_waitcnt vmcnt(0)" ::: "memory");
            const unsigned og = xb_add(&bar[XB_TOP], 1u);
            const unsigned tg = og / nx;
            if (og + 1u == (tg + 1u) * nx) xb_add(&bar[XB_TOPGEN], 1u);
            else XB_SPIN(xb_ld(&bar[XB_TOPGEN]) == tg, bar);
            __builtin_amdgcn_fence(__ATOMIC_ACQUIRE, "agent");
            xb_add(&bar[XB_XGEN(b.x)], 1u);
            asm volatile("s_waitcnt vmcnt(0)" ::: "memory");
        } else {
            XB_SPIN(xb_ld(&bar[XB_XGEN(b.x)]) == gen, bar);
            __builtin_amdgcn_fence(__ATOMIC_ACQUIRE, "agent");
            asm volatile("s_waitcnt vmcnt(0)" ::: "memory");
        }
    }
    __syncthreads();
}
constexpr int LDS_CTL_OFF = LDS_BYTES - 64;
constexpr size_t CTL_BAR_OFF = 16384;
constexpr size_t CTL_STAMP_OFF = 65536;
constexpr size_t CTL_ZERO_BYTES = 131072;

enum { P_PRO = 0, P_MOD1_0, P_GEMM_IN, P_ZPOST, P_GEMM_QKV, P_ATTN, P_GEMM_OUT0, P_MOD2_0, P_MLP_UP0, P_MLP_DN0,
       P_MOD1_1, P_GEMM_HIN, P_CONV, P_TRANS, P_GEMM_OUT1, P_MOD2_1, P_MLP_UP1, P_MLP_DN1, P_FINAL,
       P_NC_FILT, P_NC_U0, P_NC_A, P_NC_B, P_NA_Q, P_NONE };
__host__ __device__ __forceinline__ int prog(int i) {
    int k = 0;
#define PRG(x) do { if (i == k) return (x); ++k; } while (0)
    PRG(P_PRO); PRG(P_MOD1_0); PRG(P_GEMM_IN); PRG(P_ZPOST); PRG(P_GEMM_QKV);
#if NAIVE_ATTN
    PRG(P_NA_Q);
#endif
    PRG(P_ATTN); PRG(P_GEMM_OUT0); PRG(P_MOD2_0); PRG(P_MLP_UP0); PRG(P_MLP_DN0); PRG(P_MOD1_1); PRG(P_GEMM_HIN);
    PRG(P_NC_FILT);
#if NAIVE_CONV
    PRG(P_NC_U0); PRG(P_NC_A); PRG(P_NC_B);
#else
    PRG(P_CONV);
#endif
    PRG(P_TRANS); PRG(P_GEMM_OUT1); PRG(P_MOD2_1); PRG(P_MLP_UP1); PRG(P_MLP_DN1); PRG(P_FINAL);
#undef PRG
    return P_NONE;
}
constexpr int N_PROG = 20 + (NAIVE_ATTN ? 1 : 0) + (NAIVE_CONV ? 2 : 0);

__device__ __forceinline__ bool gemm_job(const Ctx& p, int ph, int jj, GemmJob& J) {
    unsigned char* ws = p.ws;
    const float* MODL = (const float*)(ws + WS_MODL); float* XW = (float*)(ws + WS_XW);
    size_t a = 0, b = 0, o = 0; int M = 0, N = 0, K = 0, kind = 0, ldc = 0; const float* base = nullptr; const float* gate = nullptr;
    if (jj == 0) {
        if (ph == P_GEMM_IN) { a = WS_HL; b = WS_WIN; o = WS_Z; M = MT; N = ZW; K = DM; ldc = ZW; }
        else if (ph == P_GEMM_QKV) { a = WS_CQN; b = WS_WQB; o = WS_QM; M = ML; N = 768; K = 384; ldc = 768; }
        else if (ph == P_GEMM_OUT0) { a = WS_O; b = WS_WOUT; M = ML; N = DM; K = DM; kind = 2; base = p.in[I_X]; gate = MODL + 2 * DM; }
        else if (ph == P_MLP_UP0) { a = WS_HL; b = WS_W1_0; o = WS_HID; M = ML; N = 4096; K = DM; kind = 1; ldc = 4096; }
        else if (ph == P_MLP_DN0) { a = WS_HID; b = WS_W2_0; M = ML; N = DM; K = 4096; kind = 2; base = XW; gate = MODL + 5 * DM; }
        else if (ph == P_GEMM_HIN) { a = WS_HIN; b = WS_HL; o = WS_ZT; M = 3 * DM; N = ML; K = DM; ldc = ML; }
        else if (ph == P_GEMM_OUT1) { a = WS_Y2; b = WS_HOUT; M = ML; N = DM; K = DM; kind = 2; base = XW; gate = MODL + (size_t)16 * NMOD + 2 * DM; }
        else if (ph == P_MLP_UP1) { a = WS_HL; b = WS_W1_1; o = WS_HID; M = ML; N = 4096; K = DM; kind = 1; ldc = 4096; }
        else if (ph == P_MLP_DN1) { a = WS_HID; b = WS_W2_1; M = ML; N = DM; K = 4096; kind = 2; base = XW; gate = MODL + (size_t)16 * NMOD + 5 * DM; }
        else return false;
    } else {
        if (ph == P_GEMM_QKV) { a = WS_CKVN; b = WS_WKVB; o = WS_KV; M = MT; N = 1024; K = 256; ldc = 1024; }
        else return false;
    }
    J.A = (const bf16_t*)(ws + a); J.Bt = (const bf16_t*)(ws + b); J.M = M; J.N = N; J.K = K;
    J.E.kind = kind; J.E.O = (bf16_t*)(ws + o); J.E.ldc = ldc; J.E.base = base; J.E.out = XW; J.E.gate = gate;
    return true;
}

__global__ void __launch_bounds__(NTHREADS, 2) fwd(Params kp) {
    extern __shared__ __attribute__((aligned(16))) unsigned char lds_raw[];
    LAS unsigned char* lds = (LAS unsigned char*)lds_raw;
    const int wave0 = __builtin_amdgcn_readfirstlane((int)threadIdx.x >> 6);
#if !CG_SYNC
    if (threadIdx.x < 16) ((volatile LAS unsigned*)(lds + LDS_CTL_OFF))[threadIdx.x] = 0u;
    __syncthreads();
    const XcdBarrier xbar = xcd_barrier_post((unsigned*)(kp.ws + WS_CTL + CTL_BAR_OFF), (volatile LAS unsigned*)(lds + LDS_CTL_OFF));
#endif
#if PROBE_A >= 0
#define STAMP(k) do { if (blockIdx.x == 0 && threadIdx.x == 0) ((unsigned long long*)(kp.ws + WS_CTL + CTL_STAMP_OFF))[(k)] = __builtin_amdgcn_s_memrealtime(); } while (0)
#else
#define STAMP(k) do { } while (0)
#endif
    for (int pi = kp.ph_lo; pi < kp.ph_hi; ++pi) {
        if (pi > kp.ph_lo) {
            STAMP(2 * pi - 1);
#if CG_SYNC
            cg::this_grid().sync();
#else
            xcd_barrier(xbar);
#endif
        }
        STAMP(2 * pi);
        const int ph = prog(pi);
        Ctx p;
        { int z_ = 0, lane_; asm volatile("v_mbcnt_lo_u32_b32 %0, -1, 0\n\tv_mbcnt_hi_u32_b32 %0, -1, %0" : "=v"(lane_)); asm volatile("" : "+s"(z_));
          const int tid_ = ((wave0 + z_) << 6) + lane_;
          const CAS cfptr_t* in_ = (const CAS cfptr_t*)kp.in + z_; float* out_ = kp.out + z_; unsigned char* ws_ = kp.ws + z_; const int bid_ = (int)blockIdx.x + z_, nb_ = (int)gridDim.x + z_;
          p.in = in_; p.out = out_; p.ws = ws_; p.tid = tid_; p.bid = bid_; p.nblk = nb_; }
        float* XW = (float*)(p.ws + WS_XW);
#ifndef NO_GEMM
        for (int jj = 0; jj < 2; ++jj) { GemmJob J; if (!gemm_job(p, ph, jj, J)) break; run_gemm(p, lds, J); }
#endif
        if (ph == P_PRO && PHON(P_PRO)) phase_prologue(p, lds);
        else if (ph == P_MOD1_0 && PHON(P_MOD1_0)) phase_modulate(p, p.in[I_X], 0, p.in[I_N1G], 0, DM, true);
        else if (ph == P_ZPOST && PHON(P_ZPOST)) phase_zpost(p, lds);
        else if (ph == P_ATTN && PHON(P_ATTN)) {
#if NAIVE_ATTN
            phase_attn_naive(p);
#else
            phase_attn(p, lds);
#endif
        }
        else if (ph == P_NA_Q && PHON(P_NA_Q)) phase_naive_qrope(p);
        else if (ph == P_MOD2_0 && PHON(P_MOD2_0)) phase_modulate(p, XW, 0, p.in[I_N2G], 3 * DM, 4 * DM, false);
        else if (ph == P_MOD1_1 && PHON(P_MOD1_1)) phase_modulate(p, XW, 1, p.in[I_N1G] + DM, 0, DM, false);
        else if (ph == P_CONV && PHON(P_CONV)) phase_conv(p, lds);
        else if (ph == P_NC_FILT && PHON(P_NC_FILT)) phase_nconv_filt(p, lds);
        else if (ph == P_NC_U0 && PHON(P_NC_U0)) phase_nconv_u0(p);
        else if (ph == P_NC_A && PHON(P_NC_A)) phase_nconv_pass(p, 0);
        else if (ph == P_NC_B && PHON(P_NC_B)) phase_nconv_pass(p, 1);
        else if (ph == P_TRANS && PHON(P_TRANS)) phase_transpose(p, lds);
        else if (ph == P_MOD2_1 && PHON(P_MOD2_1)) phase_modulate(p, XW, 1, p.in[I_N2G] + DM, 3 * DM, 4 * DM, false);
        else if (ph == P_FINAL && PHON(P_FINAL)) phase_final(p);
    }
#if PROBE_A >= 0
    STAMP(2 * kp.ph_hi - 1);
    __syncthreads();
    if (blockIdx.x == 0) {
        asm volatile("s_waitcnt vmcnt(0)" ::: "memory");
        const unsigned long long* st = (const unsigned long long*)(kp.ws + WS_CTL + CTL_STAMP_OFF);
        const float dta = (float)(st[PROBE_A_TO] - st[PROBE_A]) * 0.01f, dtb = (float)(st[PROBE_B_TO] - st[PROBE_B]) * 0.01f;
        const int nb = (int)(dtb * 100.0f);
        for (int i = threadIdx.x + 1024; i < 1024 + nb && i < 128 * 1024; i += NTHREADS) kp.out[i] += 2.0f;
        if (threadIdx.x == 0) kp.out[0] += 0.01f * dta;
    }
#endif
}

extern "C" void kernel_launch(void* const* d_in, const int* in_sizes, int n_in, void* d_out, int out_size, void* d_ws, size_t ws_size, hipStream_t stream) {
    static int ok = 0;
    if (ok == 0) {
        ok = 1;
        if (n_in != 32 || in_sizes[0] != ML * DM || out_size != ML * DM || ws_size < WS_END) { fprintf(stderr, "kernel_launch: unexpected shapes (n_in %d, in0 %d, out %d, ws %zu)\n", n_in, n_in > 0 ? in_sizes[0] : -1, out_size, ws_size); ok = -1; }
        int dev = 0, cus = 0;
        if (hipGetDevice(&dev) != hipSuccess || hipDeviceGetAttribute(&cus, hipDeviceAttributeMultiprocessorCount, dev) != hipSuccess || cus < GRID) { fprintf(stderr, "kernel_launch: needs %d CUs, device reports %d\n", GRID, cus); ok = -1; }
        if (hipFuncSetAttribute((const void*)fwd, hipFuncAttributeMaxDynamicSharedMemorySize, LDS_BYTES) != hipSuccess) { fprintf(stderr, "kernel_launch: hipFuncSetAttribute failed\n"); ok = -1; }
        int per_cu = 0;
        if (hipOccupancyMaxActiveBlocksPerMultiprocessor(&per_cu, (const void*)fwd, NTHREADS, LDS_BYTES) != hipSuccess || per_cu < 1) { fprintf(stderr, "kernel_launch: occupancy query says %d blocks per CU\n", per_cu); }
        (void)hipGetLastError();
    }
    if (ok < 0) return;
    Params p{};
    for (int i = 0; i < 32; ++i) p.in[i] = (const float*)d_in[i];
    p.out = (float*)d_out; p.ws = (unsigned char*)d_ws;
#if !CG_SYNC || PROBE_A >= 0
    if (hipMemsetAsync((char*)d_ws + WS_CTL, 0, CTL_ZERO_BYTES, stream) != hipSuccess) { fprintf(stderr, "kernel_launch: memset of the control words failed\n"); return; }
#endif
#if ONE_LAUNCH
    p.ph_lo = 0; p.ph_hi = N_PROG;
    void* args[] = {&p};
    hipError_t e = hipLaunchCooperativeKernel((const void*)fwd, dim3(GRID), dim3(NTHREADS), args, LDS_BYTES, stream);
    if (e != hipSuccess) fprintf(stderr, "kernel_launch: cooperative launch failed: %s\n", hipGetErrorString(e));
#else
    for (int i = 0; i < N_PROG; ++i) { p.ph_lo = i; p.ph_hi = i + 1; hipLaunchKernelGGL(fwd, dim3(GRID), dim3(NTHREADS), LDS_BYTES, stream, p); }
#endif
}
```

```cpp
#include <hip/hip_runtime.h>
#include <hip/hip_cooperative_groups.h>
#include <cstdio>
#include <cstdint>
namespace cg = cooperative_groups;

#ifndef ONE_LAUNCH
#define ONE_LAUNCH 1
#endif
#ifndef CG_SYNC
#define CG_SYNC 0
#endif
#ifndef REPEAT_PI
#define REPEAT_PI -1
#endif
#ifndef PROBE_A
#define PROBE_A -1
#endif
#ifndef SIMPLE_GEMM
#define SIMPLE_GEMM 0
#endif
#ifndef NAIVE_ATTN
#define NAIVE_ATTN 0
#endif
#ifndef NAIVE_CONV
#define NAIVE_CONV 0
#endif

#ifndef PHASE_MASK
#define PHASE_MASK 0xFFFFFFFFu
#endif
#define PHON(x) (((PHASE_MASK) >> (x)) & 1u)
#define LAS __attribute__((address_space(3)))
typedef unsigned short bf16_t;
typedef short bf16x8 __attribute__((ext_vector_type(8)));
typedef short s16x4 __attribute__((ext_vector_type(4)));
typedef float f32x2 __attribute__((ext_vector_type(2)));
typedef float f32x4 __attribute__((ext_vector_type(4)));
typedef float f32x16 __attribute__((ext_vector_type(16)));
typedef unsigned u32x2 __attribute__((ext_vector_type(2)));
typedef unsigned u32x4 __attribute__((ext_vector_type(4)));
typedef __bf16 bf16x2_t __attribute__((ext_vector_type(2)));

constexpr int NB = 16, SEQ = 2048, DM = 1024, CTXL = 256, TKEYS = CTXL + SEQ;
constexpr int ML = NB * SEQ;
constexpr int MC = NB * CTXL;
constexpr int MT = ML + MC;
constexpr int NMOD = 6 * DM;
constexpr int ZW = 1536;
constexpr float EPS = 1e-6f;
constexpr int NWAVES = 8, NTHREADS = 512, GRID = 256, NGW = GRID * NWAVES;
constexpr int LDS_BYTES = 155648;
constexpr int ZC_CQ = 0, ZC_CKV = 384, ZC_KR = 640, ZC_GQ = 672, ZC_GK = 1184, ZC_GV = 1312;
constexpr float LOG2E = 1.4426950408889634f;
constexpr float QSCALE_MLA = 0.10206207261596577f * LOG2E;
constexpr float QSCALE_GQA = 0.125f * LOG2E;

constexpr size_t MiB = 1ull << 20;
constexpr size_t WS_CTL = 0;
constexpr size_t WS_MODL = 1 * MiB;
constexpr size_t WS_MODC = 1 * MiB + 786432;
constexpr size_t WS_H3 = 2 * MiB;
constexpr size_t WS_SHW_UP0 = 3 * MiB, WS_SHW_HIN = 3 * MiB + 262144, WS_SHW_UP1 = 3 * MiB + 262144 + 196608;
constexpr size_t WS_SQA = 244 * MiB, WS_SQB = 246 * MiB, WS_SQC = 248 * MiB;
constexpr size_t WS_WIN = 4 * MiB, WS_WQB = 7 * MiB, WS_WKVB = 8 * MiB, WS_WOUT = 9 * MiB;
constexpr size_t WS_W1_0 = 11 * MiB, WS_W2_0 = 19 * MiB, WS_W1_1 = 27 * MiB, WS_W2_1 = 35 * MiB, WS_HIN = 43 * MiB, WS_HOUT = 49 * MiB;
constexpr size_t WS_XW = 52 * MiB;
constexpr size_t WS_HL = 180 * MiB;
constexpr size_t WS_Z = 252 * MiB, WS_CQN = 360 * MiB, WS_CKVN = 384 * MiB, WS_KROPE = 402 * MiB, WS_QG = 405 * MiB, WS_KG = 437 * MiB, WS_VG = 446 * MiB, WS_QM = 455 * MiB;
constexpr size_t WS_KV = WS_HL, WS_O = 252 * MiB;
constexpr size_t WS_HID = 252 * MiB;
constexpr size_t WS_ZT = 252 * MiB, WS_Y2T = WS_HL, WS_Y2 = 252 * MiB;
constexpr size_t WS_QMR = 316 * MiB;
constexpr size_t WS_FILT = 4 * MiB, WS_U0T = 444 * MiB, WS_Y1T = 380 * MiB;
constexpr size_t WS_END = 508 * MiB;

struct Params { const float* in[32]; float* out; unsigned char* ws; int ph_lo, ph_hi; };
#define CAS __attribute__((address_space(4)))
typedef const float* cfptr_t;
struct Ctx { const CAS cfptr_t* in; float* out; unsigned char* ws; int tid, bid, nblk; };

enum { I_X = 0, I_C, I_CTX, I_CCTX, I_WMOD, I_BMOD, I_N1G, I_N2G, I_W1, I_W2, I_AWIN, I_AQAG, I_AWQB, I_AKVAG, I_AWKVB, I_AQNG, I_AKNG, I_AWOUT,
       I_HWIN, I_HCW, I_HCB, I_FW1, I_FB1, I_FW2, I_FB2, I_FW3, I_FB3, I_FFREQ, I_FW4, I_HSKIP, I_HWOUT, I_FINALG };

__device__ __forceinline__ unsigned f2bf(float f) { unsigned u = __float_as_uint(f); return (u + 0x7fffu + ((u >> 16) & 1u)) >> 16; }
__device__ __forceinline__ float bf2f(unsigned h) { return __uint_as_float(h << 16); }
__device__ __forceinline__ unsigned cvtpk(float lo, float hi) { f32x2 v = {lo, hi}; bf16x2_t b = __builtin_convertvector(v, bf16x2_t); return __builtin_bit_cast(unsigned, b); }
__device__ __forceinline__ float wave_sum(float v) {
#pragma unroll
    for (int o = 1; o < 64; o <<= 1) v += __shfl_xor(v, o);
    return v;
}
__device__ __forceinline__ float fsin(float x) { return __builtin_amdgcn_sinf(__builtin_amdgcn_fractf(x * 0.15915494309189535f)); }
__device__ __forceinline__ float fcos(float x) { return __builtin_amdgcn_cosf(__builtin_amdgcn_fractf(x * 0.15915494309189535f)); }
__device__ __forceinline__ float inv_theta(float x) { return exp2f(-x * 13.287712379549449f); }
__device__ __forceinline__ float bflo(unsigned w) { return __uint_as_float(w << 16); }
__device__ __forceinline__ float bfhi(unsigned w) { return __uint_as_float(w & 0xffff0000u); }

namespace pg8 {
constexpr int BM = 256, BK = 64, HALF = 128, HTB = HALF * BK * 2, STAGE_BYTES = 8 * HTB, NXCD = 8, WGM = 8;
__host__ __device__ __forceinline__ int lds_byte(int r, int c) { const int st = (r >> 4) * 2 + (c >> 5), rr = r & 15, cc = c & 31, ob = rr * 64 + cc * 2; return st * 1024 + (ob ^ (((ob >> 9) & 1) << 5)); }
__host__ __device__ __forceinline__ void stage_rc(int b, int& R, int& C) { const int st = b / 1024, sb = b % 1024, swz = sb ^ (((sb >> 9) & 1) << 5); R = (st >> 1) * 16 + swz / 64; C = (st & 1) * 32 + (swz % 64) / 2; }
__host__ __device__ __forceinline__ int perm32(int rho) { const int n = rho >> 4, i = rho & 15; return 8 * (i >> 2) + 4 * n + (i & 3); }

struct Unit { int pm, pn; };
struct Gemm { const bf16_t* A; const bf16_t* Bt; int M, N, K; };

struct StaticOrder {
    int nM, nN, nwg, G, c;
    __host__ __device__ void init(int M, int N, int G_, int c_) { nM = M / BM; nN = N / BM; nwg = nM * nN; G = G_; c = c_; }
    __host__ __device__ bool next(int i, Unit& u) const {
        const long L = (long)i * G + c; if (L >= nwg) return false;
        int wgid = (int)L; { const int q = nwg / NXCD, r = nwg % NXCD, xcd = wgid % NXCD, off = wgid / NXCD; wgid = (xcd < r ? xcd * (q + 1) : r * (q + 1) + (xcd - r) * q) + off; }
        const int nig = WGM * nN, gid = wgid / nig, fm = gid * WGM, gsz = (nM - fm) < WGM ? (nM - fm) : WGM;
        u.pm = fm + ((wgid % nig) % gsz); u.pn = (wgid % nig) / gsz; return true;
    }
    __device__ __forceinline__ void a_ready(const Unit&) const {}
    __device__ __forceinline__ void done(const Unit&) const {}
};

struct EpiAny {
    static constexpr bool AFTER_DRAIN = false;
    int kind; bf16_t* O; int ldc; const float* base; float* out; const float* gate; const float* ng; const float* nsc; float* sqp; const float* shw; int shw_ld; LAS float* tab;
    __device__ __forceinline__ bool perm() const { return true; }
    __device__ __forceinline__ void operator()(const f32x4 (&acc)[2][2][4][2], const Unit& u, int ui, int wr, int wc, int fr, int fq) const {
        const int rt = wr * 64 + fr, ct = wc * 32 + 8 * fq;
        const int row0 = u.pm * BM + rt, col0 = u.pn * BM + ct;
        if (kind != 2) {
            const LAS float* T0 = tab + ui * 512; const LAS float* T1 = T0 + 256;
            f32x4 cs[2][2], ca[2][2];
#pragma unroll
            for (int bj = 0; bj < 2; ++bj)
#pragma unroll
                for (int h = 0; h < 2; ++h) { cs[bj][h] = (f32x4){1.f, 1.f, 1.f, 1.f}; ca[bj][h] = (f32x4){0.f, 0.f, 0.f, 0.f}; }
            if (kind == 1) {
#pragma unroll
                for (int bj = 0; bj < 2; ++bj) { ca[bj][0] = *(const LAS f32x4*)(T1 + ct + bj * HALF); ca[bj][1] = *(const LAS f32x4*)(T1 + ct + bj * HALF + 4); } }
            if (kind == 3) {
#pragma unroll
                for (int bj = 0; bj < 2; ++bj) { cs[bj][0] = *(const LAS f32x4*)(T0 + ct + bj * HALF); cs[bj][1] = *(const LAS f32x4*)(T0 + ct + bj * HALF + 4); } }
#pragma unroll
            for (int ai = 0; ai < 2; ++ai)
#pragma unroll
                for (int m = 0; m < 4; ++m) { const int rr = rt + ai * HALF + m * 16; bf16_t* rowp = O + (size_t)(u.pm * BM + rr) * ldc + col0;
                    float rs = 1.f, ra = 0.f;
                    if (kind == 1) rs = T0[rr];
                    if (kind == 3) ra = T1[rr];
#pragma unroll
                    for (int bj = 0; bj < 2; ++bj) { f32x4 v0 = acc[ai][bj][m][0], v1 = acc[ai][bj][m][1];
                        if (kind == 1) { v0 = v0 * rs + ca[bj][0]; v1 = v1 * rs + ca[bj][1];
#pragma unroll
                            for (int e = 0; e < 4; ++e) { const float a = fmaxf(v0[e], 0.f), b = fmaxf(v1[e], 0.f); v0[e] = a * a; v1[e] = b * b; } }
                        if (kind == 3) { v0 = v0 * cs[bj][0] + ra; v1 = v1 * cs[bj][1] + ra; }
                        u32x4 w; w.x = cvtpk(v0[0], v0[1]); w.y = cvtpk(v0[2], v0[3]); w.z = cvtpk(v1[0], v1[1]); w.w = cvtpk(v1[2], v1[3]);
                        *(u32x4*)(rowp + bj * HALF) = w; } }
        } else {
            const int b = (u.pm * BM) / SEQ;
            const float* gp = gate + (size_t)b * NMOD + col0;
            f32x4 gv[2][2], gs[2][2];
#pragma unroll
            for (int bj = 0; bj < 2; ++bj)
#pragma unroll
                for (int n = 0; n < 2; ++n) { gv[bj][n] = *(const f32x4*)(gp + bj * HALF + n * 4);
                    gs[bj][n] = (f32x4){0.f, 0.f, 0.f, 0.f};
                    if (O) { const f32x4 g4 = *(const f32x4*)(ng + col0 + bj * HALF + n * 4), s4 = *(const f32x4*)(nsc + (size_t)b * NMOD + col0 + bj * HALF + n * 4); gs[bj][n] = g4 * (s4 + 1.0f); } }
#pragma unroll
            for (int ai = 0; ai < 2; ++ai)
#pragma unroll
                for (int m = 0; m < 4; ++m) { const int r = row0 + ai * HALF + m * 16; const size_t off = (size_t)r * DM + col0; float sq = 0.f;
#pragma unroll
                    for (int bj = 0; bj < 2; ++bj) {
                        const f32x4 x0 = *(const f32x4*)(base + off + bj * HALF), x1 = *(const f32x4*)(base + off + bj * HALF + 4);
                        const f32x4 y0 = x0 + gv[bj][0] * acc[ai][bj][m][0], y1 = x1 + gv[bj][1] * acc[ai][bj][m][1];
                        *(f32x4*)(out + off + bj * HALF) = y0; *(f32x4*)(out + off + bj * HALF + 4) = y1;
                        sq += ((y0[0] * y0[0] + y0[1] * y0[1]) + (y0[2] * y0[2] + y0[3] * y0[3])) + ((y1[0] * y1[0] + y1[1] * y1[1]) + (y1[2] * y1[2] + y1[3] * y1[3]));
                        if (O) { const f32x4 a0 = y0 * gs[bj][0], a1 = y1 * gs[bj][1]; u32x4 w; w.x = cvtpk(a0[0], a0[1]); w.y = cvtpk(a0[2], a0[3]); w.z = cvtpk(a1[0], a1[1]); w.w = cvtpk(a1[2], a1[3]);
                            *(u32x4*)(O + off + bj * HALF) = w; } }
                    if (sqp) { sq += __shfl_xor(sq, 16); sq += __shfl_xor(sq, 32); if (fq == 0) sqp[(size_t)r * 16 + u.pn * 4 + wc] = sq; } }
        }
    }
};

template <class Epi, class Sched>
__device__ __forceinline__ void gemm_simple(const int tid, const Gemm g, const Sched& S, const Epi& E) {
    const int  wid = __builtin_amdgcn_readfirstlane(tid >> 6), lane = tid & 63, wr = wid >> 2, wc = wid & 3, fr = lane & 15, fq = lane >> 4;
    const int K = g.K;
    Unit u;
    for (int ui = 0; S.next(ui, u); ++ui) {
        f32x4 acc[2][2][4][2];
#pragma unroll
        for (int a = 0; a < 2; ++a)
#pragma unroll
            for (int b = 0; b < 2; ++b)
#pragma unroll
                for (int m = 0; m < 4; ++m)
#pragma unroll
                    for (int n = 0; n < 2; ++n) acc[a][b][m][n] = (f32x4){0.f, 0.f, 0.f, 0.f};
        const bf16_t* Ab = g.A + (size_t)(u.pm * BM + wr * 64 + fr) * K + fq * 8;
        const bf16_t* Bb = g.Bt + (size_t)(u.pn * BM + wc * 32) * K + fq * 8;
        for (int k0 = 0; k0 < K; k0 += 32) {
            bf16x8 At[2][4], Bf[2][2];
#pragma unroll
            for (int ai = 0; ai < 2; ++ai)
#pragma unroll
                for (int m = 0; m < 4; ++m) At[ai][m] = *(const bf16x8*)(Ab + (size_t)(ai * HALF + m * 16) * K + k0);
#pragma unroll
            for (int bj = 0; bj < 2; ++bj)
#pragma unroll
                for (int n = 0; n < 2; ++n) { const int rr = E.perm() ? perm32(16 * n + fr) : (16 * n + fr);
                    Bf[bj][n] = *(const bf16x8*)(Bb + (size_t)(bj * HALF + rr) * K + k0); }
#pragma unroll
            for (int ai = 0; ai < 2; ++ai)
#pragma unroll
                for (int bj = 0; bj < 2; ++bj)
#pragma unroll
                    for (int m = 0; m < 4; ++m)
#pragma unroll
                        for (int n = 0; n < 2; ++n) acc[ai][bj][m][n] = __builtin_amdgcn_mfma_f32_16x16x32_bf16(Bf[bj][n], At[ai][m], acc[ai][bj][m][n], 0, 0, 0);
        }
        E(acc, u, ui, wr, wc, fr, fq);
    }
}

template <class Epi, class Sched, bool ALIGN_EPI = true>
__device__ __forceinline__ void gemm_phase(const int tid, LAS unsigned char* lds, const Gemm g, const Sched& S, const Epi& E) {
    const int  wid = __builtin_amdgcn_readfirstlane(tid >> 6), lane = tid & 63, wr = wid >> 2, wc = wid & 3, fr = lane & 15, fq = lane >> 4;
    const int K = g.K, nt = K / BK;
    unsigned voffA[2], voffB[2];
#pragma unroll
    for (int i = 0; i < 2; ++i) { int R, C; stage_rc(tid * 16 + i * 8192, R, C); const int Rb = E.perm() ? ((R & ~31) + perm32(R & 31)) : R;
        voffA[i] = (unsigned)(R * K + C) * 2u; voffB[i] = (unsigned)(Rb * K + C) * 2u; }
    const size_t kstep = (size_t)(BK * 2);
    const size_t hstep = (size_t)HALF * K * 2;
    const size_t tstep = 2 * hstep;
    const unsigned ldsw = (unsigned)wid * 1024u;
    const int aoff = lds_byte(wr * 64 + fr, fq * 8), boff = lds_byte(wc * 32 + fr, fq * 8);
#define PG8_SA(b, h) (((b) * 2 + (h)) * HTB)
#define PG8_SB(b, h) ((4 + (b) * 2 + (h)) * HTB)
#define PG8_STAGE(bufoff, gbase, voff) do { _Pragma("unroll") for (int _i = 0; _i < 2; ++_i) \
        __builtin_amdgcn_global_load_lds((const unsigned*)((const char*)(gbase) + (voff)[_i]), (LAS unsigned*)(lds + (bufoff) + ldsw + _i * 8192), 16, 0, 0); } while (0)
#define PG8_LDA(dst, b, h) do { _Pragma("unroll") for (int m = 0; m < 4; ++m) _Pragma("unroll") for (int k = 0; k < 2; ++k) dst[m][k] = *(const LAS bf16x8*)(lds + PG8_SA(b, h) + aoff + m * 2048 + k * 1024); } while (0)
#define PG8_LDB(dst, b, h) do { _Pragma("unroll") for (int n = 0; n < 2; ++n) _Pragma("unroll") for (int k = 0; k < 2; ++k) dst[n][k] = *(const LAS bf16x8*)(lds + PG8_SB(b, h) + boff + n * 2048 + k * 1024); } while (0)
#define PG8_MMA(ai, bj, At, Bt) do { __builtin_amdgcn_s_setprio(1); _Pragma("unroll") for (int m = 0; m < 4; ++m) _Pragma("unroll") for (int n = 0; n < 2; ++n) _Pragma("unroll") for (int k = 0; k < 2; ++k) \
        acc[ai][bj][m][n] = __builtin_amdgcn_mfma_f32_16x16x32_bf16(Bt[n][k], At[m][k], acc[ai][bj][m][n], 0, 0, 0); __builtin_amdgcn_s_setprio(0); } while (0)
#define PG8_WAIT_V(n) asm volatile("s_waitcnt vmcnt(" #n ")" ::: "memory")
#define PG8_WAIT_L(n) asm volatile("s_waitcnt lgkmcnt(" #n ")" ::: "memory")
#define PG8_BAR __builtin_amdgcn_s_barrier()
#define PG8_SCHED __builtin_amdgcn_sched_barrier(0)
    Unit cur, nxt; int ui = 0;
    if (!S.next(0, cur)) return;
    f32x4 acc[2][2][4][2];
#pragma unroll
    for (int a = 0; a < 2; ++a)
#pragma unroll
        for (int b = 0; b < 2; ++b)
#pragma unroll
            for (int m = 0; m < 4; ++m)
#pragma unroll
                for (int n = 0; n < 2; ++n) acc[a][b][m][n] = (f32x4){0.f, 0.f, 0.f, 0.f};
    bf16x8 At[4][2], B0[2][2], B1[2][2];
    const char* cA = (const char*)g.A + (size_t)cur.pm * tstep; const char* cB = (const char*)g.Bt + (size_t)cur.pn * tstep;
    S.a_ready(cur);
    PG8_STAGE(PG8_SB(0, 0), cB, voffB); PG8_STAGE(PG8_SB(0, 1), cB + hstep, voffB); PG8_STAGE(PG8_SA(0, 0), cA, voffA); PG8_STAGE(PG8_SA(0, 1), cA + hstep, voffA);
    if (wr == 1) PG8_BAR;
    PG8_WAIT_V(2); PG8_BAR;
    PG8_STAGE(PG8_SB(1, 0), cB + kstep, voffB); PG8_STAGE(PG8_SA(1, 0), cA + kstep, voffA); PG8_STAGE(PG8_SB(1, 1), cB + hstep + kstep, voffB);
    PG8_WAIT_V(6); PG8_BAR;
    for (;;) {
        const bool has_next = S.next(ui + 1, nxt);
        const char* nA = has_next ? (const char*)g.A + (size_t)nxt.pm * tstep : cA; const char* nB = has_next ? (const char*)g.Bt + (size_t)nxt.pn * tstep : cB;
        for (int t = 0; t < nt; t += 2) {
            const bool last = (t == nt - 2);
            const char* a1 = cA + (size_t)(t + 1) * kstep;
            const char* a2 = last ? nA : cA + (size_t)(t + 2) * kstep; const char* b2 = last ? nB : cB + (size_t)(t + 2) * kstep;
            const char* a3 = a2 + kstep; const char* b3 = b2 + kstep;
            if (last && has_next) S.a_ready(nxt);
            PG8_LDB(B0, 0, 0); PG8_LDB(B1, 0, 1); PG8_SCHED; PG8_LDA(At, 0, 0); PG8_STAGE(PG8_SA(1, 1), a1 + hstep, voffA);
            PG8_WAIT_V(8); PG8_WAIT_L(0); PG8_BAR; PG8_MMA(0, 0, At, B0); PG8_MMA(0, 1, At, B1); PG8_BAR; PG8_SCHED;
            PG8_LDA(At, 0, 1); PG8_STAGE(PG8_SB(0, 0), b2, voffB); PG8_STAGE(PG8_SB(0, 1), b2 + hstep, voffB); PG8_STAGE(PG8_SA(0, 0), a2, voffA);
            PG8_WAIT_V(8); PG8_WAIT_L(0); PG8_BAR; PG8_MMA(1, 0, At, B0); PG8_MMA(1, 1, At, B1); PG8_BAR; PG8_SCHED;
            PG8_LDB(B0, 1, 0); PG8_LDB(B1, 1, 1); PG8_SCHED; PG8_LDA(At, 1, 0); PG8_STAGE(PG8_SA(0, 1), a2 + hstep, voffA);
            PG8_WAIT_V(8); PG8_WAIT_L(0); PG8_BAR; PG8_MMA(0, 0, At, B0); PG8_MMA(0, 1, At, B1); PG8_BAR; PG8_SCHED;
            PG8_LDA(At, 1, 1); PG8_STAGE(PG8_SB(1, 0), b3, voffB); PG8_STAGE(PG8_SB(1, 1), b3 + hstep, voffB); PG8_STAGE(PG8_SA(1, 0), a3, voffA);
            PG8_WAIT_V(8); PG8_WAIT_L(0); PG8_BAR; PG8_MMA(1, 0, At, B0); PG8_MMA(1, 1, At, B1); PG8_BAR; PG8_SCHED;
        }
        if constexpr (ALIGN_EPI) { if (wr == 0) PG8_BAR; }
        E(acc, cur, ui, wr, wc, fr, fq); S.done(cur);
        if (!has_next) break;
#pragma unroll
        for (int a = 0; a < 2; ++a)
#pragma unroll
            for (int b = 0; b < 2; ++b)
#pragma unroll
                for (int m = 0; m < 4; ++m)
#pragma unroll
                    for (int n = 0; n < 2; ++n) acc[a][b][m][n] = (f32x4){0.f, 0.f, 0.f, 0.f};
        cur = nxt; cA = nA; cB = nB; ++ui;
        if constexpr (ALIGN_EPI) { if (wr == 1) PG8_BAR; }
    }
    PG8_WAIT_V(0);
    if constexpr (!ALIGN_EPI) { if (wr == 0) PG8_BAR; }
    PG8_BAR;
#undef PG8_SA
#undef PG8_SB
#undef PG8_STAGE
#undef PG8_LDA
#undef PG8_LDB
#undef PG8_MMA
#undef PG8_WAIT_V
#undef PG8_WAIT_L
#undef PG8_BAR
#undef PG8_SCHED
}
}

struct GemmJob { const bf16_t* A; const bf16_t* Bt; int M, N, K; pg8::EpiAny E; };
constexpr int GEMM_TAB_OFF = 131072;
__device__ __forceinline__ void gemm_tables(const Ctx& p, const GemmJob& J, const pg8::StaticOrder& S) {
    const int tid = p.tid; pg8::Unit u;
    for (int ui = 0; S.next(ui, u); ++ui) {
        LAS float* T = J.E.tab + ui * 512;
        const int tokt = (J.E.kind == 1) ? u.pm : u.pn, vect = (J.E.kind == 1) ? u.pn : u.pm;
        const int r = tid & 255;
        if (tid < 256) { const f32x4* q = (const f32x4*)(J.E.sqp + (size_t)(tokt * 256 + r) * 16); const f32x4 a = q[0], b = q[1], c = q[2], d = q[3];
            const float sm = ((a[0] + a[1]) + (a[2] + a[3])) + ((b[0] + b[1]) + (b[2] + b[3])) + ((c[0] + c[1]) + (c[2] + c[3])) + ((d[0] + d[1]) + (d[2] + d[3]));
            T[r] = rsqrtf(sm * (1.0f / DM) + EPS); }
        else T[256 + r] = J.E.shw[(size_t)((tokt * 256) / SEQ) * J.E.shw_ld + vect * 256 + r];
    }
    __syncthreads();
}
__device__ __forceinline__ void run_gemm(const Ctx& p, LAS unsigned char* lds, GemmJob& J) {
    J.E.tab = (LAS float*)(lds + GEMM_TAB_OFF);
    pg8::Gemm g{J.A, J.Bt, J.M, J.N, J.K}; pg8::StaticOrder S; S.init(J.M, J.N, p.nblk, p.bid);
    if (J.E.kind == 1 || J.E.kind == 3) gemm_tables(p, J, S);
#if SIMPLE_GEMM
    pg8::gemm_simple<pg8::EpiAny, pg8::StaticOrder>(p.tid, g, S, J.E);
#else
    pg8::gemm_phase<pg8::EpiAny, pg8::StaticOrder, true>(p.tid, lds, g, S, J.E);
#endif
    __syncthreads();
}

__device__ __forceinline__ void transpose_item(const float* W, int K, int N, bf16_t* WT, LAS float* scr, int item, int lane) {
    const int nblk = N / 32, kb = item / nblk, nb = item % nblk, k0 = 64 * kb, n0 = 32 * nb;
    float v[32];
#pragma unroll
    for (int i = 0; i < 32; ++i) { const int kk = 2 * i + (lane >> 5); v[i] = W[(size_t)(k0 + kk) * N + n0 + (lane & 31)]; }
#pragma unroll
    for (int i = 0; i < 32; ++i) { const int kk = 2 * i + (lane >> 5); scr[kk * 33 + (lane & 31)] = v[i]; }
    asm volatile("s_waitcnt lgkmcnt(0)" ::: "memory");
    const int c = lane & 7;
#pragma unroll
    for (int j = 0; j < 4; ++j) { const int n = (lane >> 3) + 8 * j; const LAS float* s = scr + (8 * c) * 33 + n;
        u32x4 o; o.x = cvtpk(s[0 * 33], s[1 * 33]); o.y = cvtpk(s[2 * 33], s[3 * 33]); o.z = cvtpk(s[4 * 33], s[5 * 33]); o.w = cvtpk(s[6 * 33], s[7 * 33]);
        *(u32x4*)(WT + (size_t)(n0 + n) * K + k0 + 8 * c) = o; }
    asm volatile("s_waitcnt lgkmcnt(0)" ::: "memory");
}

__device__ __forceinline__ float silu_f(float v) { return v / (1.0f + expf(-v)); }

__device__ __forceinline__ void phase_prologue(const Ctx& p, LAS unsigned char* lds) {
    const int tid = p.tid, lane = tid & 63, wave = __builtin_amdgcn_readfirstlane(tid >> 6);
    unsigned char* ws = p.ws;
#ifndef PRO_SKIP1
    {
        LAS float* S = (LAS float*)lds;
        LAS float* red = (LAS float*)(lds + 69632);
        float* MODL = (float*)(ws + WS_MODL); float* MODC = (float*)(ws + WS_MODC);
        if (p.bid < 192) {
            for (int i = tid; i < 17 * 1024; i += NTHREADS) { const float v = (i < 16 * 1024) ? p.in[I_C][i] : p.in[I_CCTX][i - 16 * 1024]; S[i] = silu_f(v); }
            __syncthreads();
            for (int it = p.bid; it < 192; it += p.nblk) {
                const int layer = it / 96, n0 = (it % 96) * 64;
                const float* W = p.in[I_WMOD] + (size_t)layer * DM * NMOD + n0 + lane;
                float acc[17];
#pragma unroll
                for (int b = 0; b < 17; ++b) acc[b] = 0.f;
#pragma unroll 2
                for (int kk = 0; kk < 128; ++kk) { const int k = wave * 128 + kk; const float w = W[(size_t)k * NMOD];
#pragma unroll
                    for (int b = 0; b < 17; ++b) acc[b] += S[b * 1024 + k] * w; }
#pragma unroll
                for (int b = 0; b < 17; ++b) red[(wave * 17 + b) * 64 + lane] = acc[b];
                __syncthreads();
                for (int idx = tid; idx < 17 * 64; idx += NTHREADS) { const int b = idx >> 6, l = idx & 63; float s = p.in[I_BMOD][layer * NMOD + n0 + l];
#pragma unroll
                    for (int w = 0; w < 8; ++w) s += red[(w * 17 + b) * 64 + l];
                    if (b < 16) MODL[(size_t)(layer * 16 + b) * NMOD + n0 + l] = s; else if (layer == 0) MODC[n0 + l] = s; }
                __syncthreads();
            }
        }
        __syncthreads();
    }
#endif
    const int gw = p.bid * NWAVES + wave, ngw = p.nblk * NWAVES;
#ifndef PRO_SKIP2
    {
        float* H3 = (float*)(ws + WS_H3);
        const float* w1 = p.in[I_FW1]; const float* b1 = p.in[I_FB1]; const float* w2 = p.in[I_FW2]; const float* b2 = p.in[I_FB2];
        const float* w3 = p.in[I_FW3]; const float* b3 = p.in[I_FB3]; const float* fr = p.in[I_FFREQ];
        for (int t = gw; t < SEQ; t += ngw) {
            const float tf = (float)t, tn = tf / 2048.0f, w = 6.283185307179586f * tf / 2048.0f;
            float feat = 0.f;
            if (lane == 0) feat = tn;
            else if (lane < 17) { const int bi = (lane - 1) & 7; const float band = 1e-4f + (float)bi * ((7.0f - 1e-4f) / 7.0f); const float fw = w * band; feat = (lane < 9) ? fcos(fw) : -fsin(fw); }
            float a = b1[lane];
#pragma unroll
            for (int i = 0; i < 17; ++i) a += __shfl(feat, i) * w1[i * 64 + lane];
            float h = fsin(fr[lane] * a);
            a = b2[lane];
#pragma unroll 4
            for (int k = 0; k < 64; ++k) a += __shfl(h, k) * w2[k * 64 + lane];
            h = fsin(fr[64 + lane] * a);
            a = b3[lane];
#pragma unroll 4
            for (int k = 0; k < 64; ++k) a += __shfl(h, k) * w3[k * 64 + lane];
            h = fsin(fr[128 + lane] * a);
            H3[t * 64 + lane] = h;
        }
    }
#endif
#ifndef PRO_SKIP3
    {
        LAS float* scr = (LAS float*)(lds + wave * 16384);
        struct TJob { int in_idx; size_t in_off; int K, N; size_t ws_off; };
        const TJob jobs[10] = {
            {I_AWIN, 0, 1024, 1440, WS_WIN}, {I_AWQB, 0, 384, 768, WS_WQB}, {I_AWKVB, 0, 256, 1024, WS_WKVB}, {I_AWOUT, 0, 1024, 1024, WS_WOUT},
            {I_W1, 0, 1024, 4096, WS_W1_0}, {I_W2, 0, 4096, 1024, WS_W2_0}, {I_W1, (size_t)1024 * 4096, 1024, 4096, WS_W1_1}, {I_W2, (size_t)4096 * 1024, 4096, 1024, WS_W2_1},
            {I_HWIN, 0, 1024, 3072, WS_HIN}, {I_HWOUT, 0, 1024, 1024, WS_HOUT}};
        int base = 0;
#pragma unroll
        for (int j = 0; j < 10; ++j) {
            const int K = jobs[j].K, N = jobs[j].N, nitems = (K / 64) * (N / 32);
            const float* W = p.in[jobs[j].in_idx] + jobs[j].in_off; bf16_t* WT = (bf16_t*)(ws + jobs[j].ws_off);
            int first = gw - (base % ngw); if (first < 0) first += ngw;
            for (int it = first; it < nitems; it += ngw) transpose_item(W, K, N, WT, scr, it, lane);
            base += nitems;
        }
        u32x4* z = (u32x4*)((bf16_t*)(ws + WS_WIN) + (size_t)1440 * 1024);
        for (int i = p.bid * NTHREADS + tid; i < 96 * 1024 / 8; i += p.nblk * NTHREADS) z[i] = (u32x4){0u, 0u, 0u, 0u};
    }
#endif
}

__device__ __forceinline__ void modulate_chunk(const float* src, int row0, int nrows, const float* g, const float* sc, const float* sh, bf16_t* dst, int lane) {
    f32x4 gs[4], sv[4];
#pragma unroll
    for (int j = 0; j < 4; ++j) { const int c4 = lane + 64 * j; const f32x4 gg = ((const f32x4*)g)[c4], ss = ((const f32x4*)sc)[c4]; gs[j] = gg * (ss + 1.0f); sv[j] = ((const f32x4*)sh)[c4]; }
    for (int r = row0; r < row0 + nrows; ++r) {
        const f32x4* xr = (const f32x4*)(src + (size_t)r * DM) + lane;
        f32x4 v[4]; float s = 0.f;
#pragma unroll
        for (int j = 0; j < 4; ++j) { v[j] = xr[64 * j]; s += (v[j].x * v[j].x + v[j].y * v[j].y) + (v[j].z * v[j].z + v[j].w * v[j].w); }
        const float rstd = rsqrtf(wave_sum(s) * (1.0f / DM) + EPS);
        u32x2* o8 = (u32x2*)(dst + (size_t)r * DM) + lane;
#pragma unroll
        for (int j = 0; j < 4; ++j) { const f32x4 y = v[j] * rstd * gs[j] + sv[j]; u32x2 w; w.x = cvtpk(y.x, y.y); w.y = cvtpk(y.z, y.w); o8[64 * j] = w; }
    }
}
__device__ __forceinline__ void phase_modulate(const Ctx& p, const float* src, int layer, const float* g, int shoff, int scoff, bool with_ctx) {
    const int lane = p.tid & 63, wave = __builtin_amdgcn_readfirstlane(p.tid >> 6);
    const int gw = p.bid * NWAVES + wave;
    const float* MODL = (const float*)(p.ws + WS_MODL); const float* MODC = (const float*)(p.ws + WS_MODC);
    bf16_t* HL = (bf16_t*)(p.ws + WS_HL);
    {   const int per = ML / NGW, row0 = gw * per, b = row0 / SEQ; const float* mv = MODL + (size_t)(layer * 16 + b) * NMOD;
        modulate_chunk(src, row0, per, g, mv + scoff, mv + shoff, HL, lane); }
    if (with_ctx) { const int per = MC / NGW, row0 = gw * per;
        modulate_chunk(p.in[I_CTX], row0, per, g, MODC + scoff, MODC + shoff, HL + (size_t)ML * DM, lane); }
}
__device__ __forceinline__ void shw_job(const bf16_t* WT, int N, const float* sh, float* out, int gw, int ngw, int lane) {
    for (int n = gw; n < N; n += ngw) {
        const u32x4 w0 = *(const u32x4*)(WT + (size_t)n * DM + 16 * lane), w1 = *(const u32x4*)(WT + (size_t)n * DM + 16 * lane + 8);
        const float w[16] = {bflo(w0.x), bfhi(w0.x), bflo(w0.y), bfhi(w0.y), bflo(w0.z), bfhi(w0.z), bflo(w0.w), bfhi(w0.w),
                             bflo(w1.x), bfhi(w1.x), bflo(w1.y), bfhi(w1.y), bflo(w1.z), bfhi(w1.z), bflo(w1.w), bfhi(w1.w)};
        float res = 0.f;
#pragma unroll 2
        for (int b = 0; b < 16; ++b) {
            const f32x4* sp = (const f32x4*)(sh + (size_t)b * NMOD + 16 * lane);
            float d = 0.f;
#pragma unroll
            for (int q = 0; q < 4; ++q) { const f32x4 s4 = sp[q]; d += (w[4 * q] * s4[0] + w[4 * q + 1] * s4[1]) + (w[4 * q + 2] * s4[2] + w[4 * q + 3] * s4[3]); }
            d = wave_sum(d);
            if (lane == b) res = d;
        }
        if (lane < 16) out[(size_t)lane * N + n] = res;
    }
}
__device__ __forceinline__ void phase_shw(const Ctx& p) {
    const int lane = p.tid & 63, wave = __builtin_amdgcn_readfirstlane(p.tid >> 6);
    const int gw = p.bid * NWAVES + wave, ngw = p.nblk * NWAVES;
    const float* MODL = (const float*)(p.ws + WS_MODL);
    shw_job((const bf16_t*)(p.ws + WS_W1_0), 4096, MODL + 3 * DM, (float*)(p.ws + WS_SHW_UP0), gw, ngw, lane);
    shw_job((const bf16_t*)(p.ws + WS_HIN), 3072, MODL + (size_t)16 * NMOD, (float*)(p.ws + WS_SHW_HIN), gw, ngw, lane);
    shw_job((const bf16_t*)(p.ws + WS_W1_1), 4096, MODL + (size_t)16 * NMOD + 3 * DM, (float*)(p.ws + WS_SHW_UP1), gw, ngw, lane);
}
__device__ __forceinline__ void phase_final(const Ctx& p) {
    const int lane = p.tid & 63, wave = __builtin_amdgcn_readfirstlane(p.tid >> 6);
    const int gw = p.bid * NWAVES + wave, per = ML / NGW;
    const float* X = (const float*)(p.ws + WS_XW); const float* g = p.in[I_FINALG];
    f32x4 gs[4];
#pragma unroll
    for (int j = 0; j < 4; ++j) gs[j] = ((const f32x4*)g)[lane + 64 * j];
    for (int r = gw * per; r < (gw + 1) * per; ++r) {
        const f32x4* xr = (const f32x4*)(X + (size_t)r * DM) + lane; f32x4 v[4]; float s = 0.f;
#pragma unroll
        for (int j = 0; j < 4; ++j) { v[j] = xr[64 * j]; s += (v[j].x * v[j].x + v[j].y * v[j].y) + (v[j].z * v[j].z + v[j].w * v[j].w); }
        const float rstd = rsqrtf(wave_sum(s) * (1.0f / DM) + EPS);
        f32x4* o = (f32x4*)(p.out + (size_t)r * DM) + lane;
#pragma unroll
        for (int j = 0; j < 4; ++j) o[64 * j] = v[j] * rstd * gs[j];
    }
}

__device__ __forceinline__ void zpost_row(const Ctx& p, int row, bool latent, int lane, const LAS f32x2* tabM, const LAS f32x2* tabG) {
    unsigned char* ws = p.ws;
    const bf16_t* z = (const bf16_t*)(ws + WS_Z) + (size_t)row * ZW;
    int prow = 0, pcol = 0;
    if (latent) { const int s = row & (SEQ - 1); prow = s >> 6; pcol = s & 63; }
    if (latent) {
        float v[6], ss = 0.f;
#pragma unroll
        for (int i = 0; i < 6; ++i) { v[i] = bf2f(z[ZC_CQ + lane + 64 * i]); ss += v[i] * v[i]; }
        const float rstd = rsqrtf(wave_sum(ss) * (1.0f / 384.0f) + EPS);
        bf16_t* o = (bf16_t*)(ws + WS_CQN) + (size_t)row * 384;
#pragma unroll
        for (int i = 0; i < 6; ++i) o[lane + 64 * i] = (bf16_t)f2bf(v[i] * rstd * p.in[I_AQAG][lane + 64 * i]);
    }
    {
        float v[4], ss = 0.f;
#pragma unroll
        for (int i = 0; i < 4; ++i) { v[i] = bf2f(z[ZC_CKV + lane + 64 * i]); ss += v[i] * v[i]; }
        const float rstd = rsqrtf(wave_sum(ss) * (1.0f / 256.0f) + EPS);
        bf16_t* o = (bf16_t*)(ws + WS_CKVN) + (size_t)row * 256;
#pragma unroll
        for (int i = 0; i < 4; ++i) o[lane + 64 * i] = (bf16_t)f2bf(v[i] * rstd * p.in[I_AKVAG][lane + 64 * i]);
    }
    {
        const int d = lane & 31; const float y = bf2f(z[ZC_KR + d]);
        const float pr = __shfl_xor(y, 8);
        float o = y;
        if (latent) { const int pos = (d & 16) ? pcol : prow; const f32x2 cs = tabM[pos * 8 + (d & 7)];
            o = (d & 8) ? (pr * cs.y + y * cs.x) : (y * cs.x - pr * cs.y); }
        if (lane < 32) ((bf16_t*)(ws + WS_KROPE))[(size_t)row * 32 + d] = (bf16_t)f2bf(o);
    }
    if (latent) {
        const float gq = p.in[I_AQNG][lane];
        const int pos = (lane & 32) ? pcol : prow; const f32x2 cs = tabG[pos * 16 + (lane & 15)];
        bf16_t* o = (bf16_t*)(ws + WS_QG) + (size_t)row * 512;
#pragma unroll
        for (int hh = 0; hh < 8; ++hh) {
            const float v = bf2f(z[ZC_GQ + 64 * hh + lane]);
            const float rstd = rsqrtf(wave_sum(v * v) * (1.0f / 64.0f) + EPS);
            const float y = v * rstd * gq, pr = __shfl_xor(y, 16);
            const float r = (lane & 16) ? (pr * cs.y + y * cs.x) : (y * cs.x - pr * cs.y);
            o[64 * hh + lane] = (bf16_t)f2bf(r * QSCALE_GQA);
        }
    }
    {
        const float gk = p.in[I_AKNG][lane];
        f32x2 cs = {1.f, 0.f};
        if (latent) { const int pos = (lane & 32) ? pcol : prow; cs = tabG[pos * 16 + (lane & 15)]; }
        bf16_t* o = (bf16_t*)(ws + WS_KG) + (size_t)row * 128;
#pragma unroll
        for (int hh = 0; hh < 2; ++hh) {
            const float v = bf2f(z[ZC_GK + 64 * hh + lane]);
            const float rstd = rsqrtf(wave_sum(v * v) * (1.0f / 64.0f) + EPS);
            const float y = v * rstd * gk, pr = __shfl_xor(y, 16);
            const float r = (lane & 16) ? (pr * cs.y + y * cs.x) : (y * cs.x - pr * cs.y);
            o[64 * hh + lane] = (bf16_t)f2bf(r);
        }
    }
    {
        bf16_t* o = (bf16_t*)(ws + WS_VG) + (size_t)row * 128;
        o[lane] = z[ZC_GV + lane]; o[64 + lane] = z[ZC_GV + 64 + lane];
    }
}
__device__ __forceinline__ void phase_zpost(const Ctx& p, LAS unsigned char* lds) {
    const int tid = p.tid, lane = tid & 63, wave = __builtin_amdgcn_readfirstlane(tid >> 6);
    LAS f32x2* tabM = (LAS f32x2*)lds;
    LAS f32x2* tabG = (LAS f32x2*)(lds + 4096);
    for (int i = tid; i < 512; i += NTHREADS) { const int pos = i >> 3, f = i & 7; const float inv = inv_theta((float)f / 8.0f); const float a = (float)pos * inv; tabM[i] = (f32x2){fcos(a), fsin(a)}; }
    for (int i = tid; i < 1024; i += NTHREADS) { const int pos = i >> 4, f = i & 15; const float inv = inv_theta((float)f / 16.0f); const float a = (float)pos * inv; tabG[i] = (f32x2){fcos(a), fsin(a)}; }
    __syncthreads();
    const int gw = p.bid * NWAVES + wave;
    { const int per = ML / NGW; for (int r = gw * per; r < (gw + 1) * per; ++r) zpost_row(p, r, true, lane, tabM, tabG); }
    { const int per = MC / NGW; for (int r = gw * per; r < (gw + 1) * per; ++r) zpost_row(p, ML + r, false, lane, tabM, tabG); }
    __syncthreads();
}

__device__ __forceinline__ int crow(int r, int hi) { return (r & 3) + 8 * (r >> 2) + 4 * hi; }
__device__ __forceinline__ size_t key_row(int b, int t) { return t < CTXL ? (size_t)(ML + b * CTXL + t) : (size_t)(b * SEQ + (t - CTXL)); }

template <int DK>
__device__ __forceinline__ void attn_naive_one(const Ctx& p, int b, int h, int q) {
    unsigned char* ws = p.ws;
    const bf16_t* KV = (const bf16_t*)(ws + WS_KV); const bf16_t* KR = (const bf16_t*)(ws + WS_KROPE);
    const bf16_t* KG = (const bf16_t*)(ws + WS_KG); const bf16_t* VG = (const bf16_t*)(ws + WS_VG);
    const size_t row = (size_t)b * SEQ + q;
    float qv[DK];
    {
        const bf16_t* qp = (DK == 96) ? (const bf16_t*)(ws + WS_QMR) + row * 768 + h * 96 : (const bf16_t*)(ws + WS_QG) + row * 512 + (h - 8) * 64;
#pragma unroll
        for (int d8 = 0; d8 < DK / 8; ++d8) { const u32x4 w = *(const u32x4*)(qp + 8 * d8);
            qv[8 * d8 + 0] = bflo(w.x); qv[8 * d8 + 1] = bfhi(w.x); qv[8 * d8 + 2] = bflo(w.y); qv[8 * d8 + 3] = bfhi(w.y);
            qv[8 * d8 + 4] = bflo(w.z); qv[8 * d8 + 5] = bfhi(w.z); qv[8 * d8 + 6] = bflo(w.w); qv[8 * d8 + 7] = bfhi(w.w); }
    }
    float o[64];
#pragma unroll
    for (int d = 0; d < 64; ++d) o[d] = 0.f;
    float m = -1e30f, l = 0.f;
    for (int t = 0; t < TKEYS; ++t) {
        const size_t kr = key_row(b, t);
        float s = 0.f;
        const bf16_t* vp;
        if (DK == 96) {
            const bf16_t* kp = KV + kr * 1024 + h * 128; const bf16_t* rp = KR + kr * 32;
#pragma unroll
            for (int d = 0; d < 64; ++d) s += qv[d] * bf2f(kp[d]);
#pragma unroll
            for (int d = 0; d < 32; ++d) s += qv[64 + d] * bf2f(rp[d]);
            vp = kp + 64;
        } else {
            const int kvh = (h - 8) >> 2; const bf16_t* kp = KG + kr * 128 + kvh * 64;
#pragma unroll
            for (int d = 0; d < 64; ++d) s += qv[d] * bf2f(kp[d]);
            vp = VG + kr * 128 + kvh * 64;
        }
        const float mn = fmaxf(m, s), al = exp2f(m - mn), pe = exp2f(s - mn);
        l = l * al + pe; m = mn;
#pragma unroll
        for (int d = 0; d < 64; ++d) o[d] = o[d] * al + pe * bf2f(vp[d]);
    }
    const float rl = 1.0f / l;
    bf16_t* op = (bf16_t*)(ws + WS_O) + row * 1024 + h * 64;
#pragma unroll
    for (int d = 0; d < 64; ++d) op[d] = (bf16_t)f2bf(o[d] * rl);
}
__device__ __forceinline__ void phase_naive_qrope(const Ctx& p) {
    const bf16_t* QM = (const bf16_t*)(p.ws + WS_QM); bf16_t* QMR = (bf16_t*)(p.ws + WS_QMR);
    for (size_t idx = (size_t)p.bid * NTHREADS + p.tid; idx < (size_t)ML * 768; idx += (size_t)p.nblk * NTHREADS) {
        const int col = (int)(idx % 768), d = col % 96; const size_t row = idx / 768; const int q = (int)(row & (SEQ - 1));
        float v = bf2f(QM[idx]);
        if (d >= 64) {
            const int e = d - 64, prow = q >> 6, pcol = q & 63;
            const int pos = (e & 16) ? pcol : prow; const float inv = inv_theta((float)(e & 7) / 8.0f); const float ang = (float)pos * inv;
            const float cs = fcos(ang), sn = fsin(ang);
            const float a = bf2f(QM[idx - e + (e & ~8)]), bb = bf2f(QM[idx - e + (e | 8)]);
            v = (e & 8) ? (a * sn + bb * cs) : (a * cs - bb * sn);
        }
        QMR[idx] = (bf16_t)f2bf(v * QSCALE_MLA);
    }
}
__device__ __forceinline__ void phase_attn_naive(const Ctx& p) {
    for (int idx = p.bid * NTHREADS + p.tid; idx < NB * 16 * SEQ; idx += p.nblk * NTHREADS) {
        const int q = idx & (SEQ - 1), h = (idx >> 11) & 15, b = idx >> 15;
        if (h < 8) attn_naive_one<96>(p, b, h, q); else attn_naive_one<64>(p, b, h, q);
    }
}

template <int DK>
__device__ __forceinline__ void attn_unit(const Ctx& p, int b, int h, int qb, LAS unsigned char* lds) {
    constexpr int NC = DK / 8;
    constexpr int ND = DK / 16;
    constexpr int KB = 12288, VB = 8192;
    unsigned char* ws = p.ws;
    const int tid = p.tid, lane = tid & 63, r32 = lane & 31, hi = lane >> 5; const int wid = __builtin_amdgcn_readfirstlane(tid >> 6);
    const bf16_t* KV = (const bf16_t*)(ws + WS_KV); const bf16_t* KR = (const bf16_t*)(ws + WS_KROPE);
    const bf16_t* KG = (const bf16_t*)(ws + WS_KG); const bf16_t* VG = (const bf16_t*)(ws + WS_VG);
    const int kvh = (h - 8) >> 2;
    LAS unsigned char* Kb = lds; LAS unsigned char* Vb = lds + 2 * KB; LAS float* wsf = (LAS float*)(lds + 2 * KB + 2 * VB) + wid * 64;
    const int qs = qb * 256 + wid * 32 + r32;
    const size_t qrow = (size_t)b * SEQ + qs;
    bf16x8 qr[ND];
    if (DK == 96) {
        const bf16_t* qp = (const bf16_t*)(ws + WS_QM) + qrow * 768 + h * 96;
#pragma unroll
        for (int d0 = 0; d0 < 4; ++d0) { const u32x4 w = *(const u32x4*)(qp + 16 * d0 + 8 * hi); u32x4 o;
            o.x = cvtpk(bflo(w.x) * QSCALE_MLA, bfhi(w.x) * QSCALE_MLA); o.y = cvtpk(bflo(w.y) * QSCALE_MLA, bfhi(w.y) * QSCALE_MLA);
            o.z = cvtpk(bflo(w.z) * QSCALE_MLA, bfhi(w.z) * QSCALE_MLA); o.w = cvtpk(bflo(w.w) * QSCALE_MLA, bfhi(w.w) * QSCALE_MLA);
            qr[d0] = __builtin_bit_cast(bf16x8, o); }
        const int prow = qs >> 6, pcol = qs & 63;
#pragma unroll
        for (int c = 0; c < 2; ++c) {
            const u32x4 wa = *(const u32x4*)(qp + 64 + 16 * c);
            const u32x4 wb = *(const u32x4*)(qp + 64 + 16 * c + 8);
            const float pos = (float)(c == 0 ? prow : pcol);
            float av[8] = {bflo(wa.x), bfhi(wa.x), bflo(wa.y), bfhi(wa.y), bflo(wa.z), bfhi(wa.z), bflo(wa.w), bfhi(wa.w)};
            float bv[8] = {bflo(wb.x), bfhi(wb.x), bflo(wb.y), bfhi(wb.y), bflo(wb.z), bfhi(wb.z), bflo(wb.w), bfhi(wb.w)};
            float ov[8];
#pragma unroll
            for (int j = 0; j < 8; ++j) { const float inv = inv_theta((float)j / 8.0f); const float ang = pos * inv; const float cs = fcos(ang), sn = fsin(ang);
                const float lo = av[j] * cs - bv[j] * sn, hv = av[j] * sn + bv[j] * cs; ov[j] = (hi ? hv : lo) * QSCALE_MLA; }
            u32x4 o; o.x = cvtpk(ov[0], ov[1]); o.y = cvtpk(ov[2], ov[3]); o.z = cvtpk(ov[4], ov[5]); o.w = cvtpk(ov[6], ov[7]);
            qr[4 + c] = __builtin_bit_cast(bf16x8, o);
        }
    } else {
        const bf16_t* qp = (const bf16_t*)(ws + WS_QG) + qrow * 512 + (h - 8) * 64;
#pragma unroll
        for (int d0 = 0; d0 < ND; ++d0) qr[d0] = *(const bf16x8*)(qp + 16 * d0 + 8 * hi);
    }
    const int kkey = tid & 63, kc0 = tid >> 6;
    const int vkv = tid >> 3, vdc = tid & 7;
    const unsigned kdst0 = kc0 * 1024 + kkey * 16, kdst1 = (kc0 + 8) * 1024 + kkey * 16;
    const unsigned vdst = (vdc >> 2) * 4096 + (vkv >> 4) * 1024 + (vkv & 15) * 64 + (vdc & 3) * 16;
    u32x4 kreg0, kreg1 = {0u, 0u, 0u, 0u}, vreg;
    auto load_tile = [&](int kt) {
        const size_t rk = key_row(b, kt * 64 + kkey), rv = key_row(b, kt * 64 + vkv);
        if (DK == 96) {
            kreg0 = *(const u32x4*)(KV + rk * 1024 + h * 128 + 8 * kc0);
            if (wid < 4) kreg1 = *(const u32x4*)(KR + rk * 32 + 8 * kc0);
            vreg = *(const u32x4*)(KV + rv * 1024 + h * 128 + 64 + 8 * vdc);
        } else {
            kreg0 = *(const u32x4*)(KG + rk * 128 + kvh * 64 + 8 * kc0);
            vreg = *(const u32x4*)(VG + rv * 128 + kvh * 64 + 8 * vdc);
        }
    };
    auto store_tile = [&](int buf) {
        *(LAS u32x4*)(Kb + buf * KB + kdst0) = kreg0;
        if (DK == 96) { if (wid < 4) *(LAS u32x4*)(Kb + buf * KB + kdst1) = kreg1; }
        *(LAS u32x4*)(Vb + buf * VB + vdst) = vreg;
    };
    f32x16 o0 = {}, o1 = {};
    float mrun = -1e30f, lrun = 0.f;
    const unsigned kfo = hi * 1024 + r32 * 16;
    const unsigned vfo = ((lane >> 4) & 1) * 32 + (lane & 3) * 8 + (4 * hi + ((lane & 15) >> 2)) * 64;
    load_tile(0); store_tile(0);
    __syncthreads();
    constexpr int NT = TKEYS / 64;
    for (int kt = 0; kt < NT; ++kt) {
        const int buf = kt & 1;
        if (kt + 1 < NT) load_tile(kt + 1);
        f32x16 p0 = {}, p1 = {};
        const LAS unsigned char* kp = Kb + buf * KB + kfo;
#pragma unroll
        for (int d0 = 0; d0 < ND; ++d0) {
            const bf16x8 k0 = *(const LAS bf16x8*)(kp + d0 * 2048), k1 = *(const LAS bf16x8*)(kp + d0 * 2048 + 512);
            p0 = __builtin_amdgcn_mfma_f32_32x32x16_bf16(k0, qr[d0], p0, 0, 0, 0);
            p1 = __builtin_amdgcn_mfma_f32_32x32x16_bf16(k1, qr[d0], p1, 0, 0, 0);
        }
        float mx = fmaxf(p0[0], p1[0]);
#pragma unroll
        for (int r = 1; r < 16; ++r) mx = fmaxf(mx, fmaxf(p0[r], p1[r]));
        mx = fmaxf(mx, __shfl_xor(mx, 32));
        const float mnew = fmaxf(mrun, mx), alpha = __builtin_amdgcn_exp2f(mrun - mnew);
        mrun = mnew;
        float rs = 0.f;
#pragma unroll
        for (int r = 0; r < 16; ++r) { p0[r] = __builtin_amdgcn_exp2f(p0[r] - mnew); p1[r] = __builtin_amdgcn_exp2f(p1[r] - mnew); rs += p0[r] + p1[r]; }
        lrun = lrun * alpha + rs;
        if (hi == 0) wsf[r32] = alpha;
        asm volatile("s_waitcnt lgkmcnt(0)" ::: "memory");
#pragma unroll
        for (int g4 = 0; g4 < 4; ++g4) { const f32x4 a4 = *(const LAS f32x4*)(wsf + 8 * g4 + 4 * hi);
#pragma unroll
            for (int e = 0; e < 4; ++e) { o0[4 * g4 + e] *= a4[e]; o1[4 * g4 + e] *= a4[e]; } }
        u32x4 pw[4];
        pw[0] = (u32x4){cvtpk(p0[0], p0[1]), cvtpk(p0[2], p0[3]), cvtpk(p0[4], p0[5]), cvtpk(p0[6], p0[7])};
        pw[1] = (u32x4){cvtpk(p0[8], p0[9]), cvtpk(p0[10], p0[11]), cvtpk(p0[12], p0[13]), cvtpk(p0[14], p0[15])};
        pw[2] = (u32x4){cvtpk(p1[0], p1[1]), cvtpk(p1[2], p1[3]), cvtpk(p1[4], p1[5]), cvtpk(p1[6], p1[7])};
        pw[3] = (u32x4){cvtpk(p1[8], p1[9]), cvtpk(p1[10], p1[11]), cvtpk(p1[12], p1[13]), cvtpk(p1[14], p1[15])};
        const LAS unsigned char* vp = Vb + buf * VB + vfo;
#pragma unroll
        for (int ks = 0; ks < 4; ++ks) {
            const bf16x8 pa = __builtin_bit_cast(bf16x8, pw[ks]);
            const s16x4 l0 = __builtin_amdgcn_ds_read_tr16_b64_v4i16((LAS s16x4*)(vp + ks * 1024));
            const s16x4 h0 = __builtin_amdgcn_ds_read_tr16_b64_v4i16((LAS s16x4*)(vp + ks * 1024 + 512));
            const s16x4 l1 = __builtin_amdgcn_ds_read_tr16_b64_v4i16((LAS s16x4*)(vp + 4096 + ks * 1024));
            const s16x4 h1 = __builtin_amdgcn_ds_read_tr16_b64_v4i16((LAS s16x4*)(vp + 4096 + ks * 1024 + 512));
            const bf16x8 v0 = {l0[0], l0[1], l0[2], l0[3], h0[0], h0[1], h0[2], h0[3]};
            const bf16x8 v1 = {l1[0], l1[1], l1[2], l1[3], h1[0], h1[1], h1[2], h1[3]};
            o0 = __builtin_amdgcn_mfma_f32_32x32x16_bf16(pa, v0, o0, 0, 0, 0);
            o1 = __builtin_amdgcn_mfma_f32_32x32x16_bf16(pa, v1, o1, 0, 0, 0);
        }
        if (kt + 1 < NT) store_tile(buf ^ 1);
        __syncthreads();
    }
    lrun += __shfl_xor(lrun, 32);
    if (hi == 0) wsf[32 + r32] = lrun;
    asm volatile("s_waitcnt lgkmcnt(0)" ::: "memory");
    bf16_t* Ow = (bf16_t*)(ws + WS_O) + ((size_t)b * SEQ + qb * 256 + wid * 32) * 1024 + h * 64;
#pragma unroll
    for (int r = 0; r < 16; ++r) { const int orow = crow(r, hi); const float rl = 1.0f / wsf[32 + orow];
        Ow[(size_t)orow * 1024 + r32] = (bf16_t)f2bf(o0[r] * rl); Ow[(size_t)orow * 1024 + 32 + r32] = (bf16_t)f2bf(o1[r] * rl); }
    __syncthreads();
}
__device__ __forceinline__ void phase_attn(const Ctx& p, LAS unsigned char* lds) {
    const int c = p.bid, bq = c >> 1, b = bq >> 3, qb = bq & 7;
    for (int i = 0; i < 8; ++i) { const int h = 2 * i + (c & 1);
        if (h < 8) attn_unit<96>(p, b, h, qb, lds); else attn_unit<64>(p, b, h, qb, lds); }
}

__device__ __forceinline__ void hyena_taps(const Ctx& p, int c, LAS unsigned char* scratch, float (&taps)[4][2][2]) {
    const int tid = p.tid, lane = tid & 63, wave = __builtin_amdgcn_readfirstlane(tid >> 6);
    LAS float* w4s = (LAS float*)scratch;
    LAS float* red = (LAS float*)(scratch + 1024);
    const float* w4 = p.in[I_FW4]; const float* H3 = (const float*)(p.ws + WS_H3);
    if (tid < 256) { const int cc = tid >> 6, k = tid & 63; w4s[cc * 64 + k] = w4[(size_t)k * 4096 + (cc >> 1) * 2048 + (cc & 1) * 1024 + c]; }
    __syncthreads();
    const float dmin = -3.0701134573253940f, dmax = -15.350567286626970f;
    const float delta = fabsf(dmin + (float)c * ((dmax - dmin) / 1023.0f));
    float ss0 = 0.f, ss1 = 0.f;
    float a[4][4];
#pragma unroll
    for (int i = 0; i < 4; ++i)
#pragma unroll
        for (int cc = 0; cc < 4; ++cc) a[i][cc] = 0.f;
#pragma unroll 2
    for (int k4 = 0; k4 < 16; ++k4) {
        f32x4 wv[4];
#pragma unroll
        for (int cc = 0; cc < 4; ++cc) wv[cc] = *(const LAS f32x4*)(w4s + cc * 64 + 4 * k4);
#pragma unroll
        for (int i = 0; i < 4; ++i) { const f32x4 hv = *((const f32x4*)(H3 + (size_t)(tid + 512 * i) * 64) + k4);
#pragma unroll
            for (int cc = 0; cc < 4; ++cc) a[i][cc] += (hv[0] * wv[cc][0] + hv[1] * wv[cc][1]) + (hv[2] * wv[cc][2] + hv[3] * wv[cc][3]); }
    }
#pragma unroll
    for (int i = 0; i < 4; ++i) {
        const int t = tid + 512 * i;
        const float win = expf(-((float)t / 2048.0f) * delta);
#pragma unroll
        for (int cc = 0; cc < 4; ++cc) a[i][cc] *= win;
        taps[i][0][0] = a[i][0]; taps[i][0][1] = a[i][1]; taps[i][1][0] = a[i][2]; taps[i][1][1] = a[i][3];
        ss0 += a[i][0] * a[i][0] + a[i][2] * a[i][2]; ss1 += a[i][1] * a[i][1] + a[i][3] * a[i][3];
    }
    ss0 = wave_sum(ss0); ss1 = wave_sum(ss1);
    if (lane == 0) { red[wave * 2] = ss0; red[wave * 2 + 1] = ss1; }
    __syncthreads();
    float t0 = 0.f, t1 = 0.f;
#pragma unroll
    for (int w = 0; w < 8; ++w) { t0 += red[w * 2]; t1 += red[w * 2 + 1]; }
    const float n0 = rsqrtf(t0 + EPS), n1 = rsqrtf(t1 + EPS);
#pragma unroll
    for (int i = 0; i < 4; ++i) { taps[i][0][0] *= n0; taps[i][1][0] *= n0; taps[i][0][1] *= n1; taps[i][1][1] *= n1; }
    __syncthreads();
}
__device__ __forceinline__ void hyena_taps_block(const Ctx& p, LAS unsigned char* lds) {
    const int tid = p.tid, lane = tid & 63, wave = __builtin_amdgcn_readfirstlane(tid >> 6), fr = lane & 15, fq = lane >> 4;
    LAS float* w4s = (LAS float*)lds;
    LAS float* red = (LAS float*)(lds + 4096);
    const float* w4 = p.in[I_FW4]; const float* H3 = (const float*)(p.ws + WS_H3); bf16_t* F = (bf16_t*)(p.ws + WS_FILT);
    for (int i = tid; i < 1024; i += NTHREADS) { const int col = i >> 6, k = i & 63, q = col >> 2, cc = col & 3; const int c = p.bid + p.nblk * q;
        w4s[i] = (c < DM) ? w4[(size_t)k * 4096 + (cc >> 1) * 2048 + (cc & 1) * 1024 + c] : 0.f; }
    __syncthreads();
    bf16x8 bfr[2];
#pragma unroll
    for (int ks = 0; ks < 2; ++ks) { const f32x4 b0 = *(const LAS f32x4*)(w4s + fr * 64 + 32 * ks + 8 * fq), b1 = *(const LAS f32x4*)(w4s + fr * 64 + 32 * ks + 8 * fq + 4);
        const u32x4 w = {cvtpk(b0[0], b0[1]), cvtpk(b0[2], b0[3]), cvtpk(b1[0], b1[1]), cvtpk(b1[2], b1[3])}; bfr[ks] = __builtin_bit_cast(bf16x8, w); }
    f32x4 acc[16];
#pragma unroll
    for (int g = 0; g < 4; ++g) {
        f32x4 hv[4][2][2];
#pragma unroll
        for (int j = 0; j < 4; ++j)
#pragma unroll
            for (int ks = 0; ks < 2; ++ks) { const float* hp = H3 + (size_t)(16 * (wave * 16 + 4 * g + j) + fr) * 64 + 32 * ks + 8 * fq; hv[j][ks][0] = *(const f32x4*)hp; hv[j][ks][1] = *(const f32x4*)(hp + 4); }
#pragma unroll
        for (int j = 0; j < 4; ++j) { f32x4 a = {0.f, 0.f, 0.f, 0.f};
#pragma unroll
            for (int ks = 0; ks < 2; ++ks) { const f32x4 h0 = hv[j][ks][0], h1 = hv[j][ks][1];
                const u32x4 w = {cvtpk(h0[0], h0[1]), cvtpk(h0[2], h0[3]), cvtpk(h1[0], h1[1]), cvtpk(h1[2], h1[3])};
                a = __builtin_amdgcn_mfma_f32_16x16x32_bf16(__builtin_bit_cast(bf16x8, w), bfr[ks], a, 0, 0, 0); }
            acc[4 * g + j] = a; }
        __builtin_amdgcn_sched_barrier(0);
    }
    const int q = fr >> 2, o = fr & 1, dir = (fr >> 1) & 1, c = p.bid + p.nblk * q;
    const float dmin = -3.0701134573253940f, dmax = -15.350567286626970f;
    const float delta = fabsf(dmin + (float)c * ((dmax - dmin) / 1023.0f));
    const float r1 = expf(-delta / 2048.0f);
    float ssq = 0.f;
#pragma unroll
    for (int tt = 0; tt < 16; ++tt) { const int tb = 16 * (16 * wave + tt) + 4 * fq; float win = expf(-((float)tb / 2048.0f) * delta);
#pragma unroll
        for (int e = 0; e < 4; ++e) { const float v = acc[tt][e] * win; acc[tt][e] = v; ssq += v * v; win *= r1; } }
    ssq += __shfl_xor(ssq, 16); ssq += __shfl_xor(ssq, 32); ssq += __shfl_xor(ssq, 2);
    if (fq == 0 && dir == 0) red[wave * 8 + q * 2 + o] = ssq;
    __syncthreads();
    float tot = 0.f;
#pragma unroll
    for (int w = 0; w < 8; ++w) tot += red[w * 8 + q * 2 + o];
    const float nrm = rsqrtf(tot + EPS);
    LAS bf16_t* st = (LAS bf16_t*)(lds + 8192) + (q * 2 + o) * 4096 + 2048;
#pragma unroll
    for (int tt = 0; tt < 16; ++tt)
#pragma unroll
        for (int e = 0; e < 4; ++e) { const int t = 16 * (16 * wave + tt) + 4 * fq + e; const bf16_t v = (bf16_t)f2bf(acc[tt][e] * nrm);
            if (dir == 0) st[-t] = v; else if (t > 0) st[t] = v; }
    __syncthreads();
#pragma unroll
    for (int j = 0; j < 8; ++j) { const int idx = tid + 512 * j, arr = idx >> 9, off = idx & 511; const int cq = p.bid + p.nblk * (arr >> 1);
        const u32x4 w = *(const LAS u32x4*)(lds + 8192 + arr * 8192 + off * 16);
        if (cq < DM) *(u32x4*)(F + (size_t)(cq * 2 + (arr & 1)) * 4096 + 8 * off) = w; }
    __builtin_amdgcn_fence(__ATOMIC_RELEASE, "workgroup");
    asm volatile("s_waitcnt vmcnt(0)" ::: "memory");
    __syncthreads();
    __builtin_amdgcn_fence(__ATOMIC_ACQUIRE, "workgroup");
}
__device__ __forceinline__ float sconv_at(const bf16_t* zr, int b, int n, float w0, float w1, float w2, float cb) {
    const bf16_t* q = zr + b * SEQ + n;
    const float l = n > 0 ? bf2f(q[-1]) : 0.f, m = bf2f(q[0]), r = n < SEQ - 1 ? bf2f(q[1]) : 0.f;
    return cb + w0 * l + w1 * m + w2 * r;
}

__device__ __forceinline__ void phase_nconv_filt(const Ctx& p, LAS unsigned char* lds) {
    bf16_t* F = (bf16_t*)(p.ws + WS_FILT);
    for (int c = p.bid; c < DM; c += p.nblk) {
        float taps[4][2][2];
        hyena_taps(p, c, lds, taps);
#pragma unroll
        for (int i = 0; i < 4; ++i) { const int t = p.tid + 512 * i;
#pragma unroll
            for (int o = 0; o < 2; ++o) { bf16_t* f = F + (size_t)(c * 2 + o) * 4096;
                f[2048 - t] = (bf16_t)f2bf(taps[i][0][o]);
                if (t > 0) f[2048 + t] = (bf16_t)f2bf(taps[i][1][o]); } }
    }
}
__device__ __forceinline__ void phase_nconv_u0(const Ctx& p) {
    const bf16_t* ZT = (const bf16_t*)(p.ws + WS_ZT); bf16_t* U0 = (bf16_t*)(p.ws + WS_U0T);
    const float* cw = p.in[I_HCW]; const float* cb = p.in[I_HCB];
    for (size_t idx = (size_t)p.bid * NTHREADS + p.tid; idx < (size_t)DM * ML; idx += (size_t)p.nblk * NTHREADS) {
        const int c = (int)(idx >> 15), bn = (int)(idx & 32767), b = bn >> 11, n = bn & 2047; const int ch = 2048 + c;
        U0[idx] = (bf16_t)f2bf(sconv_at(ZT + (size_t)ch * ML, b, n, cw[ch], cw[3072 + ch], cw[6144 + ch], cb[ch]));
    }
}
__device__ __forceinline__ void phase_nconv_pass(const Ctx& p, int o) {
    const bf16_t* ZT = (const bf16_t*)(p.ws + WS_ZT); const bf16_t* F = (const bf16_t*)(p.ws + WS_FILT);
    const bf16_t* U = (const bf16_t*)(p.ws + (o == 0 ? WS_U0T : WS_Y1T)); bf16_t* Y = (bf16_t*)(p.ws + (o == 0 ? WS_Y1T : WS_Y2T));
    const float* cw = p.in[I_HCW]; const float* cb = p.in[I_HCB]; const float* skip = p.in[I_HSKIP];
    for (size_t idx = (size_t)p.bid * NTHREADS + p.tid; idx < (size_t)DM * ML; idx += (size_t)p.nblk * NTHREADS) {
        const int c = (int)(idx >> 15), bn = (int)(idx & 32767), b = bn >> 11, n = bn & 2047;
        const bf16_t* u = U + (size_t)c * ML + b * SEQ; const bf16_t* f = F + (size_t)(c * 2 + o) * 4096 + 2048 - n;
        float acc = 0.f;
        for (int m = 0; m < SEQ; ++m) acc += bf2f(f[m]) * bf2f(u[m]);
        acc += skip[o * DM + c] * bf2f(u[n]);
        const int ch = o * 1024 + c;
        const float gate = sconv_at(ZT + (size_t)ch * ML, b, n, cw[ch], cw[3072 + ch], cw[6144 + ch], cb[ch]);
        Y[idx] = (bf16_t)f2bf(gate * acc);
    }
}

constexpr int CV_USTRIDE = 4112;
constexpr int CV_U = 0;
constexpr int CV_CP = 65792, CV_CPSTRIDE = 8208;
static_assert(CV_CP + 8 * CV_CPSTRIDE <= LDS_BYTES, "conv LDS map");

__device__ __forceinline__ void conv_build_copies(const int tid, LAS unsigned char* lds, const bf16_t* rev) {
    const u32x4 cur = *(const u32x4*)(rev + 8 * tid);
    u32x4 prv = {0u, 0u, 0u, 0u};
    if (tid > 0) prv = *(const u32x4*)(rev + 8 * tid - 8);
    const unsigned W[8] = {prv.x, prv.y, prv.z, prv.w, cur.x, cur.y, cur.z, cur.w};
#pragma unroll
    for (int rho = 0; rho < 8; ++rho) {
        unsigned o[4];
#pragma unroll
        for (int d = 0; d < 4; ++d) { const int e0 = 8 - rho + 2 * d;
            o[d] = (e0 & 1) ? __builtin_amdgcn_alignbit(W[(e0 >> 1) + 1], W[e0 >> 1], 16) : W[e0 >> 1]; }
        *(LAS u32x4*)(lds + CV_CP + rho * CV_CPSTRIDE + 16 * tid) = (u32x4){o[0], o[1], o[2], o[3]};
    }
}
__device__ __forceinline__ void sconv4(const bf16_t* zr, int n, float w0, float w1, float w2, float cb, float (&g)[4]) {
    const u32x2 w = *(const u32x2*)(zr + n);
    const float l = n > 0 ? bf2f(zr[n - 1]) : 0.f, r = n + 4 < SEQ ? bf2f(zr[n + 4]) : 0.f;
    const float x[6] = {l, bflo(w.x), bfhi(w.x), bflo(w.y), bfhi(w.y), r};
#pragma unroll
    for (int e = 0; e < 4; ++e) g[e] = cb + w0 * x[e] + w1 * x[e + 1] + w2 * x[e + 2];
}
__device__ __forceinline__ void conv_mma(const int tid, LAS unsigned char* lds, f32x4 (&acc)[16]) {
    const int lane = tid & 63, wave = __builtin_amdgcn_readfirstlane(tid >> 6);
#pragma unroll
    for (int i = 0; i < 16; ++i) acc[i] = (f32x4){0.f, 0.f, 0.f, 0.f};
    const LAS unsigned char* ab = lds + CV_CP + (lane & 7) * CV_CPSTRIDE + 2 * (2048 - 8 * ((lane & 15) >> 3) + 8 * (lane >> 4)) - 32 * (16 * wave);
    const LAS unsigned char* ub = lds + CV_U + (lane & 15) * CV_USTRIDE + 16 * (lane >> 4);
    bf16x8 w0, w1, w2, w3, w4, w5, w6, w7, w8, w9, w10, w11, w12, w13, w14, w15;
#define CV_LD(i) (*(const LAS bf16x8*)(ab - 32 * (i)))
    w0 = CV_LD(0); w1 = CV_LD(1); w2 = CV_LD(2); w3 = CV_LD(3); w4 = CV_LD(4); w5 = CV_LD(5); w6 = CV_LD(6); w7 = CV_LD(7);
    w8 = CV_LD(8); w9 = CV_LD(9); w10 = CV_LD(10); w11 = CV_LD(11); w12 = CV_LD(12); w13 = CV_LD(13); w14 = CV_LD(14); w15 = CV_LD(15);
#undef CV_LD
#define CV_MF(i, W) acc[i] = __builtin_amdgcn_mfma_f32_16x16x32_bf16(W, uf, acc[i], 0, 0, 0)
#define CV_STEP(jj, A0, A1, A2, A3, A4, A5, A6, A7, A8, A9, A10, A11, A12, A13, A14, A15) do { \
        const int j = J * 8 + (jj); const bf16x8 uf = *(const LAS bf16x8*)(ub + 64 * j); \
        const int jn = (j + 1 < 64) ? (j + 1) : j; \
        const bf16x8 n0 = *(const LAS bf16x8*)(ab + 64 * jn), n1 = *(const LAS bf16x8*)(ab + 64 * jn - 32); \
        CV_MF(0, A0); CV_MF(1, A1); CV_MF(2, A2); CV_MF(3, A3); CV_MF(4, A4); CV_MF(5, A5); CV_MF(6, A6); CV_MF(7, A7); \
        CV_MF(8, A8); CV_MF(9, A9); CV_MF(10, A10); CV_MF(11, A11); CV_MF(12, A12); CV_MF(13, A13); CV_MF(14, A14); CV_MF(15, A15); \
        A14 = n0; A15 = n1; } while (0)
    for (int J = 0; J < 8; ++J) {
        CV_STEP(0, w0, w1, w2, w3, w4, w5, w6, w7, w8, w9, w10, w11, w12, w13, w14, w15);
        CV_STEP(1, w14, w15, w0, w1, w2, w3, w4, w5, w6, w7, w8, w9, w10, w11, w12, w13);
        CV_STEP(2, w12, w13, w14, w15, w0, w1, w2, w3, w4, w5, w6, w7, w8, w9, w10, w11);
        CV_STEP(3, w10, w11, w12, w13, w14, w15, w0, w1, w2, w3, w4, w5, w6, w7, w8, w9);
        CV_STEP(4, w8, w9, w10, w11, w12, w13, w14, w15, w0, w1, w2, w3, w4, w5, w6, w7);
        CV_STEP(5, w6, w7, w8, w9, w10, w11, w12, w13, w14, w15, w0, w1, w2, w3, w4, w5);
        CV_STEP(6, w4, w5, w6, w7, w8, w9, w10, w11, w12, w13, w14, w15, w0, w1, w2, w3);
        CV_STEP(7, w2, w3, w4, w5, w6, w7, w8, w9, w10, w11, w12, w13, w14, w15, w0, w1);
    }
#undef CV_STEP
#undef CV_MF
}
__device__ __forceinline__ void phase_conv(const Ctx& p, LAS unsigned char* lds) {
    const bf16_t* ZT = (const bf16_t*)(p.ws + WS_ZT); bf16_t* Y2T = (bf16_t*)(p.ws + WS_Y2T); const bf16_t* F = (const bf16_t*)(p.ws + WS_FILT);
    const float* cw = p.in[I_HCW]; const float* cb = p.in[I_HCB]; const float* skip = p.in[I_HSKIP];
    hyena_taps_block(p, lds);
    for (int c = p.bid; c < DM; c += p.nblk) {
        int tid = p.tid; asm volatile("" : "+v"(tid));
        const int lane = tid & 63, wave = __builtin_amdgcn_readfirstlane(tid >> 6);
        {   const int b = tid >> 5, m0 = (tid & 31) * 64, ch = 2048 + c; const bf16_t* zr = ZT + (size_t)ch * ML + b * SEQ;
            const float w0 = cw[ch], w1 = cw[3072 + ch], w2 = cw[6144 + ch], bb = cb[ch];
            float prev = m0 > 0 ? bf2f(zr[m0 - 1]) : 0.f;
#pragma unroll 2
            for (int k8 = 0; k8 < 8; ++k8) {
                const u32x4 w = *(const u32x4*)(zr + m0 + 8 * k8);
                const int mn = m0 + 8 * k8 + 8; const float nxt = mn < SEQ ? bf2f(zr[mn]) : 0.f;
                const float x[10] = {prev, bflo(w.x), bfhi(w.x), bflo(w.y), bfhi(w.y), bflo(w.z), bfhi(w.z), bflo(w.w), bfhi(w.w), nxt};
                float y[8];
#pragma unroll
                for (int e = 0; e < 8; ++e) y[e] = bb + w0 * x[e] + w1 * x[e + 1] + w2 * x[e + 2];
                u32x4 o; o.x = cvtpk(y[0], y[1]); o.y = cvtpk(y[2], y[3]); o.z = cvtpk(y[4], y[5]); o.w = cvtpk(y[6], y[7]);
                *(LAS u32x4*)(lds + CV_U + b * CV_USTRIDE + 2 * (m0 + 8 * k8)) = o;
                prev = x[8];
            }
        }
        conv_build_copies(tid, lds, F + (size_t)(c * 2 + 0) * 4096);
        __syncthreads();
        f32x4 acc[16];
        conv_mma(tid, lds, acc);
        __syncthreads();
        const int b = lane & 15, nq = 256 * wave + 4 * (lane >> 4);
        {   const int ch = c; const bf16_t* zr = ZT + (size_t)ch * ML + b * SEQ; const float w0 = cw[ch], w1 = cw[3072 + ch], w2 = cw[6144 + ch], bb = cb[ch], sk = skip[c];
#pragma unroll
            for (int i = 0; i < 16; ++i) { const int n = nq + 16 * i; LAS u32x2* up = (LAS u32x2*)(lds + CV_U + b * CV_USTRIDE + 2 * n);
                const u32x2 uw = *up; const float u[4] = {bflo(uw.x), bfhi(uw.x), bflo(uw.y), bfhi(uw.y)};
                float g[4]; sconv4(zr, n, w0, w1, w2, bb, g);
                float y[4];
#pragma unroll
                for (int e = 0; e < 4; ++e) y[e] = g[e] * (acc[i][e] + sk * u[e]);
                u32x2 ow; ow.x = cvtpk(y[0], y[1]); ow.y = cvtpk(y[2], y[3]); *up = ow;
                if ((i & 3) == 3) __builtin_amdgcn_sched_barrier(0); }
        }
        conv_build_copies(tid, lds, F + (size_t)(c * 2 + 1) * 4096);
        __syncthreads();
        conv_mma(tid, lds, acc);
        {   const int ch = 1024 + c; const bf16_t* zr = ZT + (size_t)ch * ML + b * SEQ; const float w0 = cw[ch], w1 = cw[3072 + ch], w2 = cw[6144 + ch], bb = cb[ch], sk = skip[DM + c];
#pragma unroll
            for (int i = 0; i < 16; ++i) { const int n = nq + 16 * i; const u32x2 uw = *(const LAS u32x2*)(lds + CV_U + b * CV_USTRIDE + 2 * n);
                const float u[4] = {bflo(uw.x), bfhi(uw.x), bflo(uw.y), bfhi(uw.y)};
                float g[4]; sconv4(zr, n, w0, w1, w2, bb, g);
                float y[4];
#pragma unroll
                for (int e = 0; e < 4; ++e) y[e] = g[e] * (acc[i][e] + sk * u[e]);
                u32x2 ow; ow.x = cvtpk(y[0], y[1]); ow.y = cvtpk(y[2], y[3]);
                *(u32x2*)(Y2T + (size_t)c * ML + b * SEQ + n) = ow;
                if ((i & 3) == 3) __builtin_amdgcn_sched_barrier(0); }
        }
        __syncthreads();
    }
}

__device__ __forceinline__ void phase_transpose(const Ctx& p, LAS unsigned char* lds) {
    const int tid = p.tid, lane = tid & 63, wave = __builtin_amdgcn_readfirstlane(tid >> 6);
    const bf16_t* src = (const bf16_t*)(p.ws + WS_Y2T); bf16_t* dst = (bf16_t*)(p.ws + WS_Y2);
    LAS bf16_t* tile = (LAS bf16_t*)(lds + wave * 16384);
    const int gw = p.bid * NWAVES + wave, ngw = p.nblk * NWAVES;
    for (int it = gw; it < (DM / 64) * (ML / 64); it += ngw) {
        const int cb = it & 15, tb = it >> 4, c0 = cb * 64, t0 = tb * 64;
#pragma unroll
        for (int i = 0; i < 8; ++i) { const int r = 8 * i + (lane >> 3), ch = lane & 7;
            const u32x4 w = *(const u32x4*)(src + (size_t)(c0 + r) * ML + t0 + 8 * ch);
            LAS unsigned* d = (LAS unsigned*)(tile + r * 66 + 8 * ch); d[0] = w.x; d[1] = w.y; d[2] = w.z; d[3] = w.w; }
        asm volatile("s_waitcnt lgkmcnt(0)" ::: "memory");
#pragma unroll
        for (int i = 0; i < 8; ++i) { const int t = 8 * i + (lane >> 3), ch = lane & 7; unsigned short e[8];
#pragma unroll
            for (int k = 0; k < 8; ++k) e[k] = tile[(8 * ch + k) * 66 + t];
            u32x4 w; w.x = e[0] | ((unsigned)e[1] << 16); w.y = e[2] | ((unsigned)e[3] << 16); w.z = e[4] | ((unsigned)e[5] << 16); w.w = e[6] | ((unsigned)e[7] << 16);
            *(u32x4*)(dst + (size_t)(t0 + t) * DM + c0 + 8 * ch) = w; }
        asm volatile("s_waitcnt lgkmcnt(0)" ::: "memory");
    }
}

#define XB_TMO      128
#define XB_XCNT(j)  (256  + 64 * (j))
#define XB_XSUB(j)  (1280 + 64 * (j))
#define XB_XGEN(j)  (2304 + 64 * (j))
#define XB_TOP      3328
#define XB_TOPGEN   3392
#define XCD_BAR_WORDS 3456
#define XB_SPIN_CAP (1u << 18)
__device__ __forceinline__ unsigned xb_ld(unsigned* p)              { return __hip_atomic_load(p, __ATOMIC_RELAXED, __HIP_MEMORY_SCOPE_AGENT); }
__device__ __forceinline__ unsigned xb_add(unsigned* p, unsigned v) { return __hip_atomic_fetch_add(p, v, __ATOMIC_RELAXED, __HIP_MEMORY_SCOPE_AGENT); }
__device__ __forceinline__ unsigned xb_xcc_id() { return (unsigned)__builtin_amdgcn_s_getreg((3 << 11) | 20) & 0xFu; }
#define XB_SPIN(cond, bar) do { unsigned _sp = 0; while (cond) { __builtin_amdgcn_s_sleep(1); \
    if ((++_sp & 255u) == 0u) { if (xb_ld(&(bar)[XB_TMO])) break; if (_sp > XB_SPIN_CAP) { atomicAdd(&(bar)[XB_TMO], 1u); break; } } } } while (0)
struct XcdBarrier { unsigned* bar; unsigned x; volatile LAS unsigned* st; };
__device__ __forceinline__ XcdBarrier xcd_barrier_post(unsigned* bar, volatile LAS unsigned* st) {
    XcdBarrier b; b.bar = bar; b.x = xb_xcc_id(); b.st = st;
    if (threadIdx.x == 0) (void)xb_add(&bar[XB_XCNT(b.x)], 1u);
    return b;
}
__device__ __forceinline__ void xcd_barrier_complete(unsigned* bar, unsigned x, unsigned& nloc, unsigned& nx) {
    const unsigned G = gridDim.x * gridDim.y * gridDim.z;
    unsigned sum, cnt, mine, sp = 0u;
    for (;;) {
        sum = 0u; cnt = 0u; mine = 0u;
#pragma unroll
        for (unsigned j = 0; j < 16; ++j) { const unsigned c = xb_ld(&bar[XB_XCNT(j)]); sum += c; cnt += (c > 0u) ? 1u : 0u; mine = (j == x) ? c : mine; }
        if (sum == G) break;
        __builtin_amdgcn_s_sleep(1);
        if ((++sp & 255u) == 0u) { if (xb_ld(&bar[XB_TMO])) break; if (sp > XB_SPIN_CAP) { atomicAdd(&bar[XB_TMO], 1u); break; } }
    }
    nloc = mine > 0u ? mine : 1u; nx = cnt > 0u ? cnt : 1u;
}
__device__ __forceinline__ void xcd_barrier(const XcdBarrier& b) {
    asm volatile("s_waitcnt vmcnt(0)" ::: "memory");
    __syncthreads();
    if (threadIdx.x == 0) {
        unsigned* bar = b.bar;
        __builtin_amdgcn_s_waitcnt(0);
        unsigned nloc = b.st[0], nx = b.st[1];
        if (nloc == 0u) { xcd_barrier_complete(bar, b.x, nloc, nx); b.st[0] = nloc; b.st[1] = nx; }
        const unsigned old = xb_add(&bar[XB_XSUB(b.x)], 1u);
        const unsigned gen = old / nloc;
        if (old + 1u == (gen + 1u) * nloc) {
            __builtin_amdgcn_fence(__ATOMIC_RELEASE, "agent");
            asm volatile("s_waitcnt vmcnt(0)" ::: "memory");
            const unsigned og = xb_add(&bar[XB_TOP], 1u);
            const unsigned tg = og / nx;
            if (og + 1u == (tg + 1u) * nx) xb_add(&bar[XB_TOPGEN], 1u);
            else XB_SPIN(xb_ld(&bar[XB_TOPGEN]) == tg, bar);
            __builtin_amdgcn_fence(__ATOMIC_ACQUIRE, "agent");
            xb_add(&bar[XB_XGEN(b.x)], 1u);
            asm volatile("s_waitcnt vmcnt(0)" ::: "memory");
        } else {
            XB_SPIN(xb_ld(&bar[XB_XGEN(b.x)]) == gen, bar);
            __builtin_amdgcn_fence(__ATOMIC_ACQUIRE, "agent");
            asm volatile("s_waitcnt vmcnt(0)" ::: "memory");
        }
    }
    __syncthreads();
}
constexpr int LDS_CTL_OFF = LDS_BYTES - 64;
constexpr size_t CTL_BAR_OFF = 16384;
constexpr size_t CTL_STAMP_OFF = 65536;
constexpr size_t CTL_ZERO_BYTES = 131072;

enum { P_PRO = 0, P_MOD1_0, P_GEMM_IN, P_ZPOST, P_GEMM_QKV, P_ATTN, P_GEMM_OUT0, P_MOD2_0, P_MLP_UP0, P_MLP_DN0,
       P_MOD1_1, P_GEMM_HIN, P_CONV, P_TRANS, P_GEMM_OUT1, P_MOD2_1, P_MLP_UP1, P_MLP_DN1, P_FINAL,
       P_NC_FILT, P_NC_U0, P_NC_A, P_NC_B, P_NA_Q, P_NONE };
__host__ __device__ __forceinline__ int prog(int i) {
    int k = 0;
#define PRG(x) do { if (i == k) return (x); ++k; } while (0)
    PRG(P_PRO); PRG(P_MOD1_0); PRG(P_GEMM_IN); PRG(P_ZPOST); PRG(P_GEMM_QKV);
#if NAIVE_ATTN
    PRG(P_NA_Q);
#endif
    PRG(P_ATTN); PRG(P_GEMM_OUT0); PRG(P_MLP_UP0); PRG(P_MLP_DN0); PRG(P_GEMM_HIN);
#if NAIVE_CONV
    PRG(P_NC_FILT); PRG(P_NC_U0); PRG(P_NC_A); PRG(P_NC_B);
#else
    PRG(P_CONV);
#endif
    PRG(P_TRANS); PRG(P_GEMM_OUT1); PRG(P_MLP_UP1); PRG(P_MLP_DN1); PRG(P_FINAL);
#undef PRG
    return P_NONE;
}
constexpr int N_PROG = 16 + (NAIVE_ATTN ? 1 : 0) + (NAIVE_CONV ? 3 : 0);

__device__ __forceinline__ bool gemm_job(const Ctx& p, int ph, int jj, GemmJob& J) {
    unsigned char* ws = p.ws;
    const float* MODL = (const float*)(ws + WS_MODL); float* XW = (float*)(ws + WS_XW);
    size_t a = 0, b = 0, o = 0, sq = 0, shw = 0; int M = 0, N = 0, K = 0, kind = 0, ldc = 0, shw_ld = 0; bool has_o = true, has_sq = false;
    const float* base = nullptr; const float* gate = nullptr; const float* ng = nullptr; const float* nsc = nullptr;
    if (jj == 0) {
        if (ph == P_GEMM_IN) { a = WS_HL; b = WS_WIN; o = WS_Z; M = MT; N = ZW; K = DM; ldc = ZW; }
        else if (ph == P_GEMM_QKV) { a = WS_CQN; b = WS_WQB; o = WS_QM; M = ML; N = 768; K = 384; ldc = 768; }
        else if (ph == P_GEMM_OUT0) { a = WS_O; b = WS_WOUT; M = ML; N = DM; K = DM; kind = 2; base = p.in[I_X]; gate = MODL + 2 * DM;
            o = WS_HL; ng = p.in[I_N2G]; nsc = MODL + 4 * DM; sq = WS_SQA; has_sq = true; }
        else if (ph == P_MLP_UP0) { a = WS_HL; b = WS_W1_0; o = WS_HID; M = ML; N = 4096; K = DM; kind = 1; ldc = 4096; sq = WS_SQA; has_sq = true; shw = WS_SHW_UP0; shw_ld = 4096; }
        else if (ph == P_MLP_DN0) { a = WS_HID; b = WS_W2_0; M = ML; N = DM; K = 4096; kind = 2; base = XW; gate = MODL + 5 * DM;
            o = WS_HL; ng = p.in[I_N1G] + DM; nsc = MODL + (size_t)16 * NMOD + DM; sq = WS_SQB; has_sq = true; }
        else if (ph == P_GEMM_HIN) { a = WS_HIN; b = WS_HL; o = WS_ZT; M = 3 * DM; N = ML; K = DM; ldc = ML; kind = 3; sq = WS_SQB; has_sq = true; shw = WS_SHW_HIN; shw_ld = 3 * DM; }
        else if (ph == P_GEMM_OUT1) { a = WS_Y2; b = WS_HOUT; M = ML; N = DM; K = DM; kind = 2; base = XW; gate = MODL + (size_t)16 * NMOD + 2 * DM;
            o = WS_HL; ng = p.in[I_N2G] + DM; nsc = MODL + (size_t)16 * NMOD + 4 * DM; sq = WS_SQC; has_sq = true; }
        else if (ph == P_MLP_UP1) { a = WS_HL; b = WS_W1_1; o = WS_HID; M = ML; N = 4096; K = DM; kind = 1; ldc = 4096; sq = WS_SQC; has_sq = true; shw = WS_SHW_UP1; shw_ld = 4096; }
        else if (ph == P_MLP_DN1) { a = WS_HID; b = WS_W2_1; M = ML; N = DM; K = 4096; kind = 2; base = XW; gate = MODL + (size_t)16 * NMOD + 5 * DM; has_o = false; }
        else return false;
    } else {
        if (ph == P_GEMM_QKV) { a = WS_CKVN; b = WS_WKVB; o = WS_KV; M = MT; N = 1024; K = 256; ldc = 1024; }
        else return false;
    }
    J.A = (const bf16_t*)(ws + a); J.Bt = (const bf16_t*)(ws + b); J.M = M; J.N = N; J.K = K;
    J.E.kind = kind; J.E.O = has_o ? (bf16_t*)(ws + o) : nullptr; J.E.ldc = ldc; J.E.base = base; J.E.out = XW; J.E.gate = gate; J.E.ng = ng; J.E.nsc = nsc;
    J.E.sqp = has_sq ? (float*)(ws + sq) : nullptr; J.E.shw = (const float*)(ws + shw); J.E.shw_ld = shw_ld;
    return true;
}

__global__ void __launch_bounds__(NTHREADS, 2) fwd(Params kp) {
    extern __shared__ __attribute__((aligned(16))) unsigned char lds_raw[];
    LAS unsigned char* lds = (LAS unsigned char*)lds_raw;
    const int wave0 = __builtin_amdgcn_readfirstlane((int)threadIdx.x >> 6);
#if !CG_SYNC
    if (threadIdx.x < 16) ((volatile LAS unsigned*)(lds + LDS_CTL_OFF))[threadIdx.x] = 0u;
    __syncthreads();
    const XcdBarrier xbar = xcd_barrier_post((unsigned*)(kp.ws + WS_CTL + CTL_BAR_OFF), (volatile LAS unsigned*)(lds + LDS_CTL_OFF));
#endif
#if PROBE_A >= 0
#define STAMP(k) do { if (blockIdx.x == 0 && threadIdx.x == 0) ((unsigned long long*)(kp.ws + WS_CTL + CTL_STAMP_OFF))[(k)] = __builtin_amdgcn_s_memrealtime(); } while (0)
#else
#define STAMP(k) do { } while (0)
#endif
    for (int pi = kp.ph_lo; pi < kp.ph_hi; ++pi) {
        if (pi > kp.ph_lo) {
            STAMP(2 * pi - 1);
#if CG_SYNC
            cg::this_grid().sync();
#else
            xcd_barrier(xbar);
#endif
        }
        STAMP(2 * pi);
        const int ph = prog(pi);
        for (int rep = 0; rep < ((pi == REPEAT_PI) ? 2 : 1); ++rep) {
        if (rep) {
#if CG_SYNC
            cg::this_grid().sync();
#else
            xcd_barrier(xbar);
#endif
        }
        Ctx p;
        { int z_ = 0, lane_; asm volatile("v_mbcnt_lo_u32_b32 %0, -1, 0\n\tv_mbcnt_hi_u32_b32 %0, -1, %0" : "=v"(lane_)); asm volatile("" : "+s"(z_));
          const int tid_ = ((wave0 + z_) << 6) + lane_;
          const CAS cfptr_t* in_ = (const CAS cfptr_t*)kp.in + z_; float* out_ = kp.out + z_; unsigned char* ws_ = kp.ws + z_; const int bid_ = (int)blockIdx.x + z_, nb_ = (int)gridDim.x + z_;
          p.in = in_; p.out = out_; p.ws = ws_; p.tid = tid_; p.bid = bid_; p.nblk = nb_; }
        float* XW = (float*)(p.ws + WS_XW);
#ifndef NO_GEMM
        for (int jj = 0; jj < 2; ++jj) { GemmJob J; if (!gemm_job(p, ph, jj, J)) break; run_gemm(p, lds, J); }
#endif
        if (ph == P_PRO && PHON(P_PRO)) phase_prologue(p, lds);
        else if (ph == P_MOD1_0 && PHON(P_MOD1_0)) { phase_modulate(p, p.in[I_X], 0, p.in[I_N1G], 0, DM, true); phase_shw(p); }
        else if (ph == P_ZPOST && PHON(P_ZPOST)) phase_zpost(p, lds);
        else if (ph == P_ATTN && PHON(P_ATTN)) {
#if NAIVE_ATTN
            phase_attn_naive(p);
#else
            phase_attn(p, lds);
#endif
        }
        else if (ph == P_NA_Q && PHON(P_NA_Q)) phase_naive_qrope(p);
        else if (ph == P_CONV && PHON(P_CONV)) phase_conv(p, lds);
        else if (ph == P_NC_FILT && PHON(P_NC_FILT)) phase_nconv_filt(p, lds);
        else if (ph == P_NC_U0 && PHON(P_NC_U0)) phase_nconv_u0(p);
        else if (ph == P_NC_A && PHON(P_NC_A)) phase_nconv_pass(p, 0);
        else if (ph == P_NC_B && PHON(P_NC_B)) phase_nconv_pass(p, 1);
        else if (ph == P_TRANS && PHON(P_TRANS)) phase_transpose(p, lds);
        else if (ph == P_FINAL && PHON(P_FINAL)) phase_final(p);
        }
    }
#if PROBE_A >= 0
    STAMP(2 * kp.ph_hi - 1);
    __syncthreads();
    if (blockIdx.x == 0) {
        asm volatile("s_waitcnt vmcnt(0)" ::: "memory");
        const unsigned long long* st = (const unsigned long long*)(kp.ws + WS_CTL + CTL_STAMP_OFF);
        const float dta = (float)(st[PROBE_A_TO] - st[PROBE_A]) * 0.01f, dtb = (float)(st[PROBE_B_TO] - st[PROBE_B]) * 0.01f;
        for (int i = threadIdx.x + 1024; i < 1024 + 100000; i += NTHREADS) kp.out[i] += 0.001f * dtb;
        if (threadIdx.x == 0) kp.out[0] += 0.004f * dta;
    }
#endif
}

extern "C" void kernel_launch(void* const* d_in, const int* in_sizes, int n_in, void* d_out, int out_size, void* d_ws, size_t ws_size, hipStream_t stream) {
    static int ok = 0;
    if (ok == 0) {
        ok = 1;
        if (n_in != 32 || in_sizes[0] != ML * DM || out_size != ML * DM || ws_size < WS_END) { fprintf(stderr, "kernel_launch: unexpected shapes (n_in %d, in0 %d, out %d, ws %zu)\n", n_in, n_in > 0 ? in_sizes[0] : -1, out_size, ws_size); ok = -1; }
        int dev = 0, cus = 0;
        if (hipGetDevice(&dev) != hipSuccess || hipDeviceGetAttribute(&cus, hipDeviceAttributeMultiprocessorCount, dev) != hipSuccess || cus < GRID) { fprintf(stderr, "kernel_launch: needs %d CUs, device reports %d\n", GRID, cus); ok = -1; }
        if (hipFuncSetAttribute((const void*)fwd, hipFuncAttributeMaxDynamicSharedMemorySize, LDS_BYTES) != hipSuccess) { fprintf(stderr, "kernel_launch: hipFuncSetAttribute failed\n"); ok = -1; }
        int per_cu = 0;
        if (hipOccupancyMaxActiveBlocksPerMultiprocessor(&per_cu, (const void*)fwd, NTHREADS, LDS_BYTES) != hipSuccess || per_cu < 1) { fprintf(stderr, "kernel_launch: occupancy query says %d blocks per CU\n", per_cu); }
        (void)hipGetLastError();
    }
    if (ok < 0) return;
    Params p{};
    for (int i = 0; i < 32; ++i) p.in[i] = (const float*)d_in[i];
    p.out = (float*)d_out; p.ws = (unsigned char*)d_ws;
#if !CG_SYNC || PROBE_A >= 0
    if (hipMemsetAsync((char*)d_ws + WS_CTL, 0, CTL_ZERO_BYTES, stream) != hipSuccess) { fprintf(stderr, "kernel_launch: memset of the control words failed\n"); return; }
#endif
#if ONE_LAUNCH
    p.ph_lo = 0; p.ph_hi = N_PROG;
    void* args[] = {&p};
    hipError_t e = hipLaunchCooperativeKernel((const void*)fwd, dim3(GRID), dim3(NTHREADS), args, LDS_BYTES, stream);
    if (e != hipSuccess) fprintf(stderr, "kernel_launch: cooperative launch failed: %s\n", hipGetErrorString(e));
#else
    for (int i = 0; i < N_PROG; ++i) { p.ph_lo = i; p.ph_hi = i + 1; hipLaunchKernelGGL(fwd, dim3(GRID), dim3(NTHREADS), LDS_BYTES, stream, p); }
#endif
}
```

```cpp
#include <hip/hip_runtime.h>
#include <hip/hip_cooperative_groups.h>
#include <cstdio>
#include <cstdint>
namespace cg = cooperative_groups;

#ifndef ONE_LAUNCH
#define ONE_LAUNCH 1
#endif
#ifndef CG_SYNC
#define CG_SYNC 0
#endif
#ifndef REPEAT_PI
#define REPEAT_PI -1
#endif
#ifndef PROBE_A
#define PROBE_A -1
#endif
#ifndef ATTN_V1
#define ATTN_V1 0
#endif
#ifndef ZPOST_REF
#define ZPOST_REF 0
#endif
#ifndef SIMPLE_GEMM
#define SIMPLE_GEMM 0
#endif
#ifndef NAIVE_ATTN
#define NAIVE_ATTN 0
#endif
#ifndef NAIVE_CONV
#define NAIVE_CONV 0
#endif

#ifndef PHASE_MASK
#define PHASE_MASK 0xFFFFFFFFu
#endif
#define PHON(x) (((PHASE_MASK) >> (x)) & 1u)
#define LAS __attribute__((address_space(3)))
typedef unsigned short bf16_t;
typedef short bf16x8 __attribute__((ext_vector_type(8)));
typedef short s16x4 __attribute__((ext_vector_type(4)));
typedef float f32x2 __attribute__((ext_vector_type(2)));
typedef float f32x4 __attribute__((ext_vector_type(4)));
typedef float f32x16 __attribute__((ext_vector_type(16)));
typedef unsigned u32x2 __attribute__((ext_vector_type(2)));
typedef unsigned u32x4 __attribute__((ext_vector_type(4)));
typedef __bf16 bf16x2_t __attribute__((ext_vector_type(2)));

constexpr int NB = 16, SEQ = 2048, DM = 1024, CTXL = 256, TKEYS = CTXL + SEQ;
constexpr int ML = NB * SEQ;
constexpr int MC = NB * CTXL;
constexpr int MT = ML + MC;
constexpr int NMOD = 6 * DM;
constexpr int ZW = 1536;
constexpr float EPS = 1e-6f;
constexpr int NWAVES = 8, NTHREADS = 512, GRID = 256, NGW = GRID * NWAVES;
constexpr int LDS_BYTES = 155648;
constexpr int ZC_CQ = 0, ZC_CKV = 384, ZC_KR = 640, ZC_GQ = 672, ZC_GK = 1184, ZC_GV = 1312;
constexpr float LOG2E = 1.4426950408889634f;
constexpr float QSCALE_MLA = 0.10206207261596577f * LOG2E;
constexpr float QSCALE_GQA = 0.125f * LOG2E;

constexpr size_t MiB = 1ull << 20;
constexpr size_t WS_CTL = 0;
constexpr size_t WS_MODL = 1 * MiB;
constexpr size_t WS_MODC = 1 * MiB + 786432;
constexpr size_t WS_H3 = 2 * MiB;
constexpr size_t WS_SHW_UP0 = 3 * MiB, WS_SHW_HIN = 3 * MiB + 262144, WS_SHW_UP1 = 3 * MiB + 262144 + 196608;
constexpr size_t WS_SQA = 244 * MiB, WS_SQB = 246 * MiB, WS_SQC = 248 * MiB;
constexpr size_t WS_WIN = 4 * MiB, WS_WQB = 7 * MiB, WS_WKVB = 8 * MiB, WS_WOUT = 9 * MiB;
constexpr size_t WS_W1_0 = 11 * MiB, WS_W2_0 = 19 * MiB, WS_W1_1 = 27 * MiB, WS_W2_1 = 35 * MiB, WS_HIN = 43 * MiB, WS_HOUT = 49 * MiB;
constexpr size_t WS_XW = 52 * MiB;
constexpr size_t WS_HL = 180 * MiB;
constexpr size_t WS_Z = 252 * MiB, WS_CQN = 360 * MiB, WS_CKVN = 384 * MiB, WS_KROPE = 402 * MiB, WS_QG = 405 * MiB, WS_KG = 437 * MiB, WS_VG = 446 * MiB, WS_QM = 455 * MiB;
constexpr size_t WS_KV = WS_HL, WS_O = 252 * MiB;
constexpr size_t WS_HID = 252 * MiB;
constexpr size_t WS_ZT = 252 * MiB, WS_Y2T = WS_HL, WS_Y2 = 252 * MiB;
constexpr size_t WS_QMR = 316 * MiB;
constexpr size_t WS_FILT = 4 * MiB, WS_U0T = 444 * MiB, WS_Y1T = 380 * MiB;
constexpr size_t WS_END = 508 * MiB;

struct Params { const float* in[32]; float* out; unsigned char* ws; int ph_lo, ph_hi; };
#define CAS __attribute__((address_space(4)))
typedef const float* cfptr_t;
struct Ctx { const CAS cfptr_t* in; float* out; unsigned char* ws; int tid, bid, nblk; };

enum { I_X = 0, I_C, I_CTX, I_CCTX, I_WMOD, I_BMOD, I_N1G, I_N2G, I_W1, I_W2, I_AWIN, I_AQAG, I_AWQB, I_AKVAG, I_AWKVB, I_AQNG, I_AKNG, I_AWOUT,
       I_HWIN, I_HCW, I_HCB, I_FW1, I_FB1, I_FW2, I_FB2, I_FW3, I_FB3, I_FFREQ, I_FW4, I_HSKIP, I_HWOUT, I_FINALG };

__device__ __forceinline__ unsigned f2bf(float f) { unsigned u = __float_as_uint(f); return (u + 0x7fffu + ((u >> 16) & 1u)) >> 16; }
__device__ __forceinline__ float bf2f(unsigned h) { return __uint_as_float(h << 16); }
__device__ __forceinline__ unsigned cvtpk(float lo, float hi) { f32x2 v = {lo, hi}; bf16x2_t b = __builtin_convertvector(v, bf16x2_t); return __builtin_bit_cast(unsigned, b); }
__device__ __forceinline__ float wave_sum(float v) {
#pragma unroll
    for (int o = 1; o < 64; o <<= 1) v += __shfl_xor(v, o);
    return v;
}
__device__ __forceinline__ float fsin(float x) { return __builtin_amdgcn_sinf(__builtin_amdgcn_fractf(x * 0.15915494309189535f)); }
__device__ __forceinline__ float fcos(float x) { return __builtin_amdgcn_cosf(__builtin_amdgcn_fractf(x * 0.15915494309189535f)); }
__device__ __forceinline__ float inv_theta(float x) { return exp2f(-x * 13.287712379549449f); }
__device__ __forceinline__ float bflo(unsigned w) { return __uint_as_float(w << 16); }
__device__ __forceinline__ float bfhi(unsigned w) { return __uint_as_float(w & 0xffff0000u); }

namespace pg8 {
constexpr int BM = 256, BK = 64, HALF = 128, HTB = HALF * BK * 2, STAGE_BYTES = 8 * HTB, NXCD = 8, WGM = 8;
__host__ __device__ __forceinline__ int lds_byte(int r, int c) { const int st = (r >> 4) * 2 + (c >> 5), rr = r & 15, cc = c & 31, ob = rr * 64 + cc * 2; return st * 1024 + (ob ^ (((ob >> 9) & 1) << 5)); }
__host__ __device__ __forceinline__ void stage_rc(int b, int& R, int& C) { const int st = b / 1024, sb = b % 1024, swz = sb ^ (((sb >> 9) & 1) << 5); R = (st >> 1) * 16 + swz / 64; C = (st & 1) * 32 + (swz % 64) / 2; }
__host__ __device__ __forceinline__ int perm32(int rho) { const int n = rho >> 4, i = rho & 15; return 8 * (i >> 2) + 4 * n + (i & 3); }

struct Unit { int pm, pn; };
struct Gemm { const bf16_t* A; const bf16_t* Bt; int M, N, K; };

struct StaticOrder {
    int nM, nN, nwg, G, c;
    __host__ __device__ void init(int M, int N, int G_, int c_) { nM = M / BM; nN = N / BM; nwg = nM * nN; G = G_; c = c_; }
    __host__ __device__ bool next(int i, Unit& u) const {
        const long L = (long)i * G + c; if (L >= nwg) return false;
        int wgid = (int)L; { const int q = nwg / NXCD, r = nwg % NXCD, xcd = wgid % NXCD, off = wgid / NXCD; wgid = (xcd < r ? xcd * (q + 1) : r * (q + 1) + (xcd - r) * q) + off; }
        const int nig = WGM * nN, gid = wgid / nig, fm = gid * WGM, gsz = (nM - fm) < WGM ? (nM - fm) : WGM;
        u.pm = fm + ((wgid % nig) % gsz); u.pn = (wgid % nig) / gsz; return true;
    }
    __device__ __forceinline__ void a_ready(const Unit&) const {}
    __device__ __forceinline__ void done(const Unit&) const {}
};

struct EpiAny {
    static constexpr bool AFTER_DRAIN = false;
    int kind; bf16_t* O; int ldc; const float* base; bf16_t* xres; const float* gate; const float* ng; const float* nsc; float* sqp; const float* shw; int shw_ld; LAS float* tab;
    __device__ __forceinline__ bool perm() const { return true; }
    __device__ __forceinline__ void operator()(const f32x4 (&acc)[2][2][4][2], const Unit& u, int ui, int wr, int wc, int fr, int fq) const {
        const int rt = wr * 64 + fr, ct = wc * 32 + 8 * fq;
        const int row0 = u.pm * BM + rt, col0 = u.pn * BM + ct;
        if (kind != 2) {
            const LAS float* T0 = tab + ui * 512; const LAS float* T1 = T0 + 256;
            f32x4 cs[2][2], ca[2][2];
#pragma unroll
            for (int bj = 0; bj < 2; ++bj)
#pragma unroll
                for (int h = 0; h < 2; ++h) { cs[bj][h] = (f32x4){1.f, 1.f, 1.f, 1.f}; ca[bj][h] = (f32x4){0.f, 0.f, 0.f, 0.f}; }
            if (kind == 1) {
#pragma unroll
                for (int bj = 0; bj < 2; ++bj) { ca[bj][0] = *(const LAS f32x4*)(T1 + ct + bj * HALF); ca[bj][1] = *(const LAS f32x4*)(T1 + ct + bj * HALF + 4); } }
            if (kind == 3) {
#pragma unroll
                for (int bj = 0; bj < 2; ++bj) { cs[bj][0] = *(const LAS f32x4*)(T0 + ct + bj * HALF); cs[bj][1] = *(const LAS f32x4*)(T0 + ct + bj * HALF + 4); } }
#pragma unroll
            for (int ai = 0; ai < 2; ++ai)
#pragma unroll
                for (int m = 0; m < 4; ++m) { const int rr = rt + ai * HALF + m * 16; bf16_t* rowp = O + (size_t)(u.pm * BM + rr) * ldc + col0;
                    float rs = 1.f, ra = 0.f;
                    if (kind == 1) rs = T0[rr];
                    if (kind == 3) ra = T1[rr];
#pragma unroll
                    for (int bj = 0; bj < 2; ++bj) { f32x4 v0 = acc[ai][bj][m][0], v1 = acc[ai][bj][m][1];
                        if (kind == 1) { v0 = v0 * rs + ca[bj][0]; v1 = v1 * rs + ca[bj][1];
#pragma unroll
                            for (int e = 0; e < 4; ++e) { const float a = fmaxf(v0[e], 0.f), b = fmaxf(v1[e], 0.f); v0[e] = a * a; v1[e] = b * b; } }
                        if (kind == 3) { v0 = v0 * cs[bj][0] + ra; v1 = v1 * cs[bj][1] + ra; }
                        u32x4 w; w.x = cvtpk(v0[0], v0[1]); w.y = cvtpk(v0[2], v0[3]); w.z = cvtpk(v1[0], v1[1]); w.w = cvtpk(v1[2], v1[3]);
                        *(u32x4*)(rowp + bj * HALF) = w; } }
        } else {
            const int b = (u.pm * BM) / SEQ;
            const float* gp = gate + (size_t)b * NMOD + col0;
            f32x4 gv[2][2], gs[2][2];
#pragma unroll
            for (int bj = 0; bj < 2; ++bj)
#pragma unroll
                for (int n = 0; n < 2; ++n) { gv[bj][n] = *(const f32x4*)(gp + bj * HALF + n * 4);
                    gs[bj][n] = (f32x4){0.f, 0.f, 0.f, 0.f};
                    if (O) { const f32x4 g4 = *(const f32x4*)(ng + col0 + bj * HALF + n * 4), s4 = *(const f32x4*)(nsc + (size_t)b * NMOD + col0 + bj * HALF + n * 4); gs[bj][n] = g4 * (s4 + 1.0f); } }
#pragma unroll
            for (int ai = 0; ai < 2; ++ai)
#pragma unroll
                for (int m = 0; m < 4; ++m) { const int r = row0 + ai * HALF + m * 16; const size_t off = (size_t)r * DM + col0; float sq = 0.f;
#pragma unroll
                    for (int bj = 0; bj < 2; ++bj) {
                        f32x4 x0, x1;
                        if (base) { x0 = *(const f32x4*)(base + off + bj * HALF); x1 = *(const f32x4*)(base + off + bj * HALF + 4); }
                        else { const u32x4 xb = *(const u32x4*)(xres + off + bj * HALF); x0 = (f32x4){bflo(xb.x), bfhi(xb.x), bflo(xb.y), bfhi(xb.y)}; x1 = (f32x4){bflo(xb.z), bfhi(xb.z), bflo(xb.w), bfhi(xb.w)}; }
                        const f32x4 y0 = x0 + gv[bj][0] * acc[ai][bj][m][0], y1 = x1 + gv[bj][1] * acc[ai][bj][m][1];
                        { u32x4 w; w.x = cvtpk(y0[0], y0[1]); w.y = cvtpk(y0[2], y0[3]); w.z = cvtpk(y1[0], y1[1]); w.w = cvtpk(y1[2], y1[3]); *(u32x4*)(xres + off + bj * HALF) = w; }
                        sq += ((y0[0] * y0[0] + y0[1] * y0[1]) + (y0[2] * y0[2] + y0[3] * y0[3])) + ((y1[0] * y1[0] + y1[1] * y1[1]) + (y1[2] * y1[2] + y1[3] * y1[3]));
                        if (O) { const f32x4 a0 = y0 * gs[bj][0], a1 = y1 * gs[bj][1]; u32x4 w; w.x = cvtpk(a0[0], a0[1]); w.y = cvtpk(a0[2], a0[3]); w.z = cvtpk(a1[0], a1[1]); w.w = cvtpk(a1[2], a1[3]);
                            *(u32x4*)(O + off + bj * HALF) = w; } }
                    if (sqp) { sq += __shfl_xor(sq, 16); sq += __shfl_xor(sq, 32); if (fq == 0) sqp[(size_t)r * 16 + u.pn * 4 + wc] = sq; } }
        }
    }
};

template <class Epi, class Sched>
__device__ __forceinline__ void gemm_simple(const int tid, const Gemm g, const Sched& S, const Epi& E) {
    const int  wid = __builtin_amdgcn_readfirstlane(tid >> 6), lane = tid & 63, wr = wid >> 2, wc = wid & 3, fr = lane & 15, fq = lane >> 4;
    const int K = g.K;
    Unit u;
    for (int ui = 0; S.next(ui, u); ++ui) {
        f32x4 acc[2][2][4][2];
#pragma unroll
        for (int a = 0; a < 2; ++a)
#pragma unroll
            for (int b = 0; b < 2; ++b)
#pragma unroll
                for (int m = 0; m < 4; ++m)
#pragma unroll
                    for (int n = 0; n < 2; ++n) acc[a][b][m][n] = (f32x4){0.f, 0.f, 0.f, 0.f};
        const bf16_t* Ab = g.A + (size_t)(u.pm * BM + wr * 64 + fr) * K + fq * 8;
        const bf16_t* Bb = g.Bt + (size_t)(u.pn * BM + wc * 32) * K + fq * 8;
        for (int k0 = 0; k0 < K; k0 += 32) {
            bf16x8 At[2][4], Bf[2][2];
#pragma unroll
            for (int ai = 0; ai < 2; ++ai)
#pragma unroll
                for (int m = 0; m < 4; ++m) At[ai][m] = *(const bf16x8*)(Ab + (size_t)(ai * HALF + m * 16) * K + k0);
#pragma unroll
            for (int bj = 0; bj < 2; ++bj)
#pragma unroll
                for (int n = 0; n < 2; ++n) { const int rr = E.perm() ? perm32(16 * n + fr) : (16 * n + fr);
                    Bf[bj][n] = *(const bf16x8*)(Bb + (size_t)(bj * HALF + rr) * K + k0); }
#pragma unroll
            for (int ai = 0; ai < 2; ++ai)
#pragma unroll
                for (int bj = 0; bj < 2; ++bj)
#pragma unroll
                    for (int m = 0; m < 4; ++m)
#pragma unroll
                        for (int n = 0; n < 2; ++n) acc[ai][bj][m][n] = __builtin_amdgcn_mfma_f32_16x16x32_bf16(Bf[bj][n], At[ai][m], acc[ai][bj][m][n], 0, 0, 0);
        }
        E(acc, u, ui, wr, wc, fr, fq);
    }
}

template <class Epi, class Sched, bool ALIGN_EPI = true>
__device__ __forceinline__ void gemm_phase(const int tid, LAS unsigned char* lds, const Gemm g, const Sched& S, const Epi& E) {
    const int  wid = __builtin_amdgcn_readfirstlane(tid >> 6), lane = tid & 63, wr = wid >> 2, wc = wid & 3, fr = lane & 15, fq = lane >> 4;
    const int K = g.K, nt = K / BK;
    unsigned voffA[2], voffB[2];
#pragma unroll
    for (int i = 0; i < 2; ++i) { int R, C; stage_rc(tid * 16 + i * 8192, R, C); const int Rb = E.perm() ? ((R & ~31) + perm32(R & 31)) : R;
        voffA[i] = (unsigned)(R * K + C) * 2u; voffB[i] = (unsigned)(Rb * K + C) * 2u; }
    const size_t kstep = (size_t)(BK * 2);
    const size_t hstep = (size_t)HALF * K * 2;
    const size_t tstep = 2 * hstep;
    const unsigned ldsw = (unsigned)wid * 1024u;
    const int aoff = lds_byte(wr * 64 + fr, fq * 8), boff = lds_byte(wc * 32 + fr, fq * 8);
#define PG8_SA(b, h) (((b) * 2 + (h)) * HTB)
#define PG8_SB(b, h) ((4 + (b) * 2 + (h)) * HTB)
#define PG8_STAGE(bufoff, gbase, voff) do { _Pragma("unroll") for (int _i = 0; _i < 2; ++_i) \
        __builtin_amdgcn_global_load_lds((const unsigned*)((const char*)(gbase) + (voff)[_i]), (LAS unsigned*)(lds + (bufoff) + ldsw + _i * 8192), 16, 0, 0); } while (0)
#define PG8_LDA(dst, b, h) do { _Pragma("unroll") for (int m = 0; m < 4; ++m) _Pragma("unroll") for (int k = 0; k < 2; ++k) dst[m][k] = *(const LAS bf16x8*)(lds + PG8_SA(b, h) + aoff + m * 2048 + k * 1024); } while (0)
#define PG8_LDB(dst, b, h) do { _Pragma("unroll") for (int n = 0; n < 2; ++n) _Pragma("unroll") for (int k = 0; k < 2; ++k) dst[n][k] = *(const LAS bf16x8*)(lds + PG8_SB(b, h) + boff + n * 2048 + k * 1024); } while (0)
#define PG8_MMA(ai, bj, At, Bt) do { __builtin_amdgcn_s_setprio(1); _Pragma("unroll") for (int m = 0; m < 4; ++m) _Pragma("unroll") for (int n = 0; n < 2; ++n) _Pragma("unroll") for (int k = 0; k < 2; ++k) \
        acc[ai][bj][m][n] = __builtin_amdgcn_mfma_f32_16x16x32_bf16(Bt[n][k], At[m][k], acc[ai][bj][m][n], 0, 0, 0); __builtin_amdgcn_s_setprio(0); } while (0)
#define PG8_WAIT_V(n) asm volatile("s_waitcnt vmcnt(" #n ")" ::: "memory")
#define PG8_WAIT_L(n) asm volatile("s_waitcnt lgkmcnt(" #n ")" ::: "memory")
#define PG8_BAR __builtin_amdgcn_s_barrier()
#define PG8_SCHED __builtin_amdgcn_sched_barrier(0)
    Unit cur, nxt; int ui = 0;
    if (!S.next(0, cur)) return;
    f32x4 acc[2][2][4][2];
#pragma unroll
    for (int a = 0; a < 2; ++a)
#pragma unroll
        for (int b = 0; b < 2; ++b)
#pragma unroll
            for (int m = 0; m < 4; ++m)
#pragma unroll
                for (int n = 0; n < 2; ++n) acc[a][b][m][n] = (f32x4){0.f, 0.f, 0.f, 0.f};
    bf16x8 At[4][2], B0[2][2], B1[2][2];
    const char* cA = (const char*)g.A + (size_t)cur.pm * tstep; const char* cB = (const char*)g.Bt + (size_t)cur.pn * tstep;
    S.a_ready(cur);
    PG8_STAGE(PG8_SB(0, 0), cB, voffB); PG8_STAGE(PG8_SB(0, 1), cB + hstep, voffB); PG8_STAGE(PG8_SA(0, 0), cA, voffA); PG8_STAGE(PG8_SA(0, 1), cA + hstep, voffA);
    if (wr == 1) PG8_BAR;
    PG8_WAIT_V(2); PG8_BAR;
    PG8_STAGE(PG8_SB(1, 0), cB + kstep, voffB); PG8_STAGE(PG8_SA(1, 0), cA + kstep, voffA); PG8_STAGE(PG8_SB(1, 1), cB + hstep + kstep, voffB);
    PG8_WAIT_V(6); PG8_BAR;
    for (;;) {
        const bool has_next = S.next(ui + 1, nxt);
        const char* nA = has_next ? (const char*)g.A + (size_t)nxt.pm * tstep : cA; const char* nB = has_next ? (const char*)g.Bt + (size_t)nxt.pn * tstep : cB;
        for (int t = 0; t < nt; t += 2) {
            const bool last = (t == nt - 2);
            const char* a1 = cA + (size_t)(t + 1) * kstep;
            const char* a2 = last ? nA : cA + (size_t)(t + 2) * kstep; const char* b2 = last ? nB : cB + (size_t)(t + 2) * kstep;
            const char* a3 = a2 + kstep; const char* b3 = b2 + kstep;
            if (last && has_next) S.a_ready(nxt);
            PG8_LDB(B0, 0, 0); PG8_LDB(B1, 0, 1); PG8_SCHED; PG8_LDA(At, 0, 0); PG8_STAGE(PG8_SA(1, 1), a1 + hstep, voffA);
            PG8_WAIT_V(8); PG8_WAIT_L(0); PG8_BAR; PG8_MMA(0, 0, At, B0); PG8_MMA(0, 1, At, B1); PG8_BAR; PG8_SCHED;
            PG8_LDA(At, 0, 1); PG8_STAGE(PG8_SB(0, 0), b2, voffB); PG8_STAGE(PG8_SB(0, 1), b2 + hstep, voffB); PG8_STAGE(PG8_SA(0, 0), a2, voffA);
            PG8_WAIT_V(8); PG8_WAIT_L(0); PG8_BAR; PG8_MMA(1, 0, At, B0); PG8_MMA(1, 1, At, B1); PG8_BAR; PG8_SCHED;
            PG8_LDB(B0, 1, 0); PG8_LDB(B1, 1, 1); PG8_SCHED; PG8_LDA(At, 1, 0); PG8_STAGE(PG8_SA(0, 1), a2 + hstep, voffA);
            PG8_WAIT_V(8); PG8_WAIT_L(0); PG8_BAR; PG8_MMA(0, 0, At, B0); PG8_MMA(0, 1, At, B1); PG8_BAR; PG8_SCHED;
            PG8_LDA(At, 1, 1); PG8_STAGE(PG8_SB(1, 0), b3, voffB); PG8_STAGE(PG8_SB(1, 1), b3 + hstep, voffB); PG8_STAGE(PG8_SA(1, 0), a3, voffA);
            PG8_WAIT_V(8); PG8_WAIT_L(0); PG8_BAR; PG8_MMA(1, 0, At, B0); PG8_MMA(1, 1, At, B1); PG8_BAR; PG8_SCHED;
        }
        if constexpr (ALIGN_EPI) { if (wr == 0) PG8_BAR; }
        E(acc, cur, ui, wr, wc, fr, fq); S.done(cur);
        if (!has_next) break;
#pragma unroll
        for (int a = 0; a < 2; ++a)
#pragma unroll
            for (int b = 0; b < 2; ++b)
#pragma unroll
                for (int m = 0; m < 4; ++m)
#pragma unroll
                    for (int n = 0; n < 2; ++n) acc[a][b][m][n] = (f32x4){0.f, 0.f, 0.f, 0.f};
        cur = nxt; cA = nA; cB = nB; ++ui;
        if constexpr (ALIGN_EPI) { if (wr == 1) PG8_BAR; }
    }
    PG8_WAIT_V(0);
    if constexpr (!ALIGN_EPI) { if (wr == 0) PG8_BAR; }
    PG8_BAR;
#undef PG8_SA
#undef PG8_SB
#undef PG8_STAGE
#undef PG8_LDA
#undef PG8_LDB
#undef PG8_MMA
#undef PG8_WAIT_V
#undef PG8_WAIT_L
#undef PG8_BAR
#undef PG8_SCHED
}
}

struct GemmJob { const bf16_t* A; const bf16_t* Bt; int M, N, K; pg8::EpiAny E; };
constexpr int GEMM_TAB_OFF = 131072;
__device__ __forceinline__ void gemm_tables(const Ctx& p, const GemmJob& J, const pg8::StaticOrder& S) {
    const int tid = p.tid; pg8::Unit u;
    for (int ui = 0; S.next(ui, u); ++ui) {
        LAS float* T = J.E.tab + ui * 512;
        const int tokt = (J.E.kind == 1) ? u.pm : u.pn, vect = (J.E.kind == 1) ? u.pn : u.pm;
        const int r = tid & 255;
        if (tid < 256) { const f32x4* q = (const f32x4*)(J.E.sqp + (size_t)(tokt * 256 + r) * 16); const f32x4 a = q[0], b = q[1], c = q[2], d = q[3];
            const float sm = ((a[0] + a[1]) + (a[2] + a[3])) + ((b[0] + b[1]) + (b[2] + b[3])) + ((c[0] + c[1]) + (c[2] + c[3])) + ((d[0] + d[1]) + (d[2] + d[3]));
            T[r] = rsqrtf(sm * (1.0f / DM) + EPS); }
        else T[256 + r] = J.E.shw[(size_t)((tokt * 256) / SEQ) * J.E.shw_ld + vect * 256 + r];
    }
    __syncthreads();
}
__device__ __forceinline__ void run_gemm(const Ctx& p, LAS unsigned char* lds, GemmJob& J) {
    J.E.tab = (LAS float*)(lds + GEMM_TAB_OFF);
    pg8::Gemm g{J.A, J.Bt, J.M, J.N, J.K}; pg8::StaticOrder S; S.init(J.M, J.N, p.nblk, p.bid);
    if (J.E.kind == 1 || J.E.kind == 3) gemm_tables(p, J, S);
#if SIMPLE_GEMM
    pg8::gemm_simple<pg8::EpiAny, pg8::StaticOrder>(p.tid, g, S, J.E);
#else
    pg8::gemm_phase<pg8::EpiAny, pg8::StaticOrder, true>(p.tid, lds, g, S, J.E);
#endif
    __syncthreads();
}

__device__ __forceinline__ void transpose_item(const float* W, int K, int N, bf16_t* WT, LAS float* scr, int item, int lane) {
    const int nblk = N / 32, kb = item / nblk, nb = item % nblk, k0 = 64 * kb, n0 = 32 * nb;
    float v[32];
#pragma unroll
    for (int i = 0; i < 32; ++i) { const int kk = 2 * i + (lane >> 5); v[i] = W[(size_t)(k0 + kk) * N + n0 + (lane & 31)]; }
#pragma unroll
    for (int i = 0; i < 32; ++i) { const int kk = 2 * i + (lane >> 5); scr[kk * 33 + (lane & 31)] = v[i]; }
    asm volatile("s_waitcnt lgkmcnt(0)" ::: "memory");
    const int c = lane & 7;
#pragma unroll
    for (int j = 0; j < 4; ++j) { const int n = (lane >> 3) + 8 * j; const LAS float* s = scr + (8 * c) * 33 + n;
        u32x4 o; o.x = cvtpk(s[0 * 33], s[1 * 33]); o.y = cvtpk(s[2 * 33], s[3 * 33]); o.z = cvtpk(s[4 * 33], s[5 * 33]); o.w = cvtpk(s[6 * 33], s[7 * 33]);
        *(u32x4*)(WT + (size_t)(n0 + n) * K + k0 + 8 * c) = o; }
    asm volatile("s_waitcnt lgkmcnt(0)" ::: "memory");
}

__device__ __forceinline__ float silu_f(float v) { return v / (1.0f + expf(-v)); }

__device__ __forceinline__ void phase_prologue(const Ctx& p, LAS unsigned char* lds, const bool partA, const bool partB) {
    const int tid = p.tid, lane = tid & 63, wave = __builtin_amdgcn_readfirstlane(tid >> 6);
    unsigned char* ws = p.ws;
#ifndef PRO_SKIP1
    if (partA) {
        LAS float* S = (LAS float*)lds;
        LAS float* red = (LAS float*)(lds + 69632);
        float* MODL = (float*)(ws + WS_MODL); float* MODC = (float*)(ws + WS_MODC);
        if (p.bid < 192) {
            for (int i = tid; i < 17 * 1024; i += NTHREADS) { const float v = (i < 16 * 1024) ? p.in[I_C][i] : p.in[I_CCTX][i - 16 * 1024]; S[i] = silu_f(v); }
            __syncthreads();
            for (int it = p.bid; it < 192; it += p.nblk) {
                const int layer = it / 96, n0 = (it % 96) * 64;
                const float* W = p.in[I_WMOD] + (size_t)layer * DM * NMOD + n0 + lane;
                float acc[17];
#pragma unroll
                for (int b = 0; b < 17; ++b) acc[b] = 0.f;
#pragma unroll 1
                for (int k0 = 0; k0 < 128; k0 += 32) {
                    float wv[32];
#pragma unroll
                    for (int j = 0; j < 32; ++j) wv[j] = W[(size_t)(wave * 128 + k0 + j) * NMOD];
#pragma unroll
                    for (int j = 0; j < 32; ++j) { const int k = wave * 128 + k0 + j;
#pragma unroll
                        for (int b = 0; b < 17; ++b) acc[b] += S[b * 1024 + k] * wv[j]; }
                }
#pragma unroll
                for (int b = 0; b < 17; ++b) red[(wave * 17 + b) * 64 + lane] = acc[b];
                __syncthreads();
                for (int idx = tid; idx < 17 * 64; idx += NTHREADS) { const int b = idx >> 6, l = idx & 63; float s = p.in[I_BMOD][layer * NMOD + n0 + l];
#pragma unroll
                    for (int w = 0; w < 8; ++w) s += red[(w * 17 + b) * 64 + l];
                    if (b < 16) MODL[(size_t)(layer * 16 + b) * NMOD + n0 + l] = s; else if (layer == 0) MODC[n0 + l] = s; }
                __syncthreads();
            }
        }
        __syncthreads();
    }
#endif
    const int gw = p.bid * NWAVES + wave, ngw = p.nblk * NWAVES;
#ifndef PRO_SKIP2
    if (partA) {
        float* H3 = (float*)(ws + WS_H3);
        const float* w1 = p.in[I_FW1]; const float* b1 = p.in[I_FB1]; const float* w2 = p.in[I_FW2]; const float* b2 = p.in[I_FB2];
        const float* w3 = p.in[I_FW3]; const float* b3 = p.in[I_FB3]; const float* fr = p.in[I_FFREQ];
        LAS float* w2s = (LAS float*)lds; LAS float* w3s = (LAS float*)(lds + 16384); LAS float* w1s = (LAS float*)(lds + 32768);
        for (int i = tid; i < 4096; i += NTHREADS) { w2s[i] = w2[i]; w3s[i] = w3[i]; if (i < 17 * 64) w1s[i] = w1[i]; }
        __syncthreads();
        for (int t = gw; t < SEQ; t += ngw) {
            const float tf = (float)t, tn = tf / 2048.0f, w = 6.283185307179586f * tf / 2048.0f;
            float feat = 0.f;
            if (lane == 0) feat = tn;
            else if (lane < 17) { const int bi = (lane - 1) & 7; const float band = 1e-4f + (float)bi * ((7.0f - 1e-4f) / 7.0f); const float fw = w * band; feat = (lane < 9) ? fcos(fw) : -fsin(fw); }
            float a = b1[lane];
#pragma unroll
            for (int i = 0; i < 17; ++i) a += __shfl(feat, i) * w1s[i * 64 + lane];
            float h = fsin(fr[lane] * a);
            a = b2[lane];
#pragma unroll 16
            for (int k = 0; k < 64; ++k) a += __shfl(h, k) * w2s[k * 64 + lane];
            h = fsin(fr[64 + lane] * a);
            a = b3[lane];
#pragma unroll 16
            for (int k = 0; k < 64; ++k) a += __shfl(h, k) * w3s[k * 64 + lane];
            h = fsin(fr[128 + lane] * a);
            H3[t * 64 + lane] = h;
        }
    }
#endif
#ifndef PRO_SKIP3
    if (partB) {
        LAS float* scr = (LAS float*)(lds + wave * 16384);
        struct TJob { int in_idx; size_t in_off; int K, N; size_t ws_off; };
        const TJob jobs[10] = {
            {I_AWIN, 0, 1024, 1440, WS_WIN}, {I_AWQB, 0, 384, 768, WS_WQB}, {I_AWKVB, 0, 256, 1024, WS_WKVB}, {I_AWOUT, 0, 1024, 1024, WS_WOUT},
            {I_W1, 0, 1024, 4096, WS_W1_0}, {I_W2, 0, 4096, 1024, WS_W2_0}, {I_W1, (size_t)1024 * 4096, 1024, 4096, WS_W1_1}, {I_W2, (size_t)4096 * 1024, 4096, 1024, WS_W2_1},
            {I_HWIN, 0, 1024, 3072, WS_HIN}, {I_HWOUT, 0, 1024, 1024, WS_HOUT}};
        int base = 0;
#pragma unroll
        for (int j = 0; j < 10; ++j) {
            const int K = jobs[j].K, N = jobs[j].N, nitems = (K / 64) * (N / 32);
            const float* W = p.in[jobs[j].in_idx] + jobs[j].in_off; bf16_t* WT = (bf16_t*)(ws + jobs[j].ws_off);
            int first = gw - (base % ngw); if (first < 0) first += ngw;
            for (int it = first; it < nitems; it += ngw) transpose_item(W, K, N, WT, scr, it, lane);
            base += nitems;
        }
        u32x4* z = (u32x4*)((bf16_t*)(ws + WS_WIN) + (size_t)1440 * 1024);
        for (int i = p.bid * NTHREADS + tid; i < 96 * 1024 / 8; i += p.nblk * NTHREADS) z[i] = (u32x4){0u, 0u, 0u, 0u};
    }
#endif
}

__device__ __forceinline__ void modulate_chunk(const float* src, int row0, int nrows, const float* g, const float* sc, const float* sh, bf16_t* dst, int lane) {
    f32x4 gs[4], sv[4];
#pragma unroll
    for (int j = 0; j < 4; ++j) { const int c4 = lane + 64 * j; const f32x4 gg = ((const f32x4*)g)[c4], ss = ((const f32x4*)sc)[c4]; gs[j] = gg * (ss + 1.0f); sv[j] = ((const f32x4*)sh)[c4]; }
    for (int r = row0; r < row0 + nrows; ++r) {
        const f32x4* xr = (const f32x4*)(src + (size_t)r * DM) + lane;
        f32x4 v[4]; float s = 0.f;
#pragma unroll
        for (int j = 0; j < 4; ++j) { v[j] = xr[64 * j]; s += (v[j].x * v[j].x + v[j].y * v[j].y) + (v[j].z * v[j].z + v[j].w * v[j].w); }
        const float rstd = rsqrtf(wave_sum(s) * (1.0f / DM) + EPS);
        u32x2* o8 = (u32x2*)(dst + (size_t)r * DM) + lane;
#pragma unroll
        for (int j = 0; j < 4; ++j) { const f32x4 y = v[j] * rstd * gs[j] + sv[j]; u32x2 w; w.x = cvtpk(y.x, y.y); w.y = cvtpk(y.z, y.w); o8[64 * j] = w; }
    }
}
__device__ __forceinline__ void phase_modulate(const Ctx& p, const float* src, int layer, const float* g, int shoff, int scoff, bool with_ctx) {
    const int lane = p.tid & 63, wave = __builtin_amdgcn_readfirstlane(p.tid >> 6);
    const int gw = p.bid * NWAVES + wave;
    const float* MODL = (const float*)(p.ws + WS_MODL); const float* MODC = (const float*)(p.ws + WS_MODC);
    bf16_t* HL = (bf16_t*)(p.ws + WS_HL);
    {   const int per = ML / NGW, row0 = gw * per, b = row0 / SEQ; const float* mv = MODL + (size_t)(layer * 16 + b) * NMOD;
        modulate_chunk(src, row0, per, g, mv + scoff, mv + shoff, HL, lane); }
    if (with_ctx) { const int per = MC / NGW, row0 = gw * per;
        modulate_chunk(p.in[I_CTX], row0, per, g, MODC + scoff, MODC + shoff, HL + (size_t)ML * DM, lane); }
}
__device__ __forceinline__ void shw_job(const bf16_t* WT, int N, const float* sh, float* out, int gw, int ngw, int lane) {
    const int fr = lane & 15, fq = lane >> 4;
    for (int g = gw; g < N / 16; g += ngw) {
        f32x4 acc = {0.f, 0.f, 0.f, 0.f};
#pragma unroll 8
        for (int ks = 0; ks < 32; ++ks) {
            const float* sp = sh + (size_t)fr * NMOD + 32 * ks + 8 * fq;
            const f32x4 s0 = *(const f32x4*)sp, s1 = *(const f32x4*)(sp + 4);
            const u32x4 aw = {cvtpk(s0[0], s0[1]), cvtpk(s0[2], s0[3]), cvtpk(s1[0], s1[1]), cvtpk(s1[2], s1[3])};
            const bf16x8 bw = *(const bf16x8*)(WT + (size_t)(16 * g + fr) * DM + 32 * ks + 8 * fq);
            acc = __builtin_amdgcn_mfma_f32_16x16x32_bf16(__builtin_bit_cast(bf16x8, aw), bw, acc, 0, 0, 0);
        }
#pragma unroll
        for (int e = 0; e < 4; ++e) out[(size_t)(4 * fq + e) * N + 16 * g + fr] = acc[e];
    }
}
__device__ __forceinline__ void phase_shw(const Ctx& p) {
    const int lane = p.tid & 63, wave = __builtin_amdgcn_readfirstlane(p.tid >> 6);
    const int gw = p.bid * NWAVES + wave, ngw = p.nblk * NWAVES;
    const float* MODL = (const float*)(p.ws + WS_MODL);
    shw_job((const bf16_t*)(p.ws + WS_W1_0), 4096, MODL + 3 * DM, (float*)(p.ws + WS_SHW_UP0), gw, ngw, lane);
    shw_job((const bf16_t*)(p.ws + WS_HIN), 3072, MODL + (size_t)16 * NMOD, (float*)(p.ws + WS_SHW_HIN), gw, ngw, lane);
    shw_job((const bf16_t*)(p.ws + WS_W1_1), 4096, MODL + (size_t)16 * NMOD + 3 * DM, (float*)(p.ws + WS_SHW_UP1), gw, ngw, lane);
}
__device__ __forceinline__ void phase_final(const Ctx& p) {
    const int lane = p.tid & 63, wave = __builtin_amdgcn_readfirstlane(p.tid >> 6);
    const int gw = p.bid * NWAVES + wave, per = ML / NGW;
    const bf16_t* X = (const bf16_t*)(p.ws + WS_XW); const float* g = p.in[I_FINALG]; const float* sqp = (const float*)(p.ws + WS_SQA);
    f32x4 gs[4];
#pragma unroll
    for (int j = 0; j < 2; ++j) { gs[2 * j] = *(const f32x4*)(g + 512 * j + 8 * lane); gs[2 * j + 1] = *(const f32x4*)(g + 512 * j + 8 * lane + 4); }
    for (int r = gw * per; r < (gw + 1) * per; ++r) {
        const float part = (lane < 16) ? sqp[(size_t)r * 16 + lane] : 0.f;
        const float rstd = rsqrtf(wave_sum(part) * (1.0f / DM) + EPS);
#pragma unroll
        for (int j = 0; j < 2; ++j) { const u32x4 xb = *(const u32x4*)(X + (size_t)r * DM + 512 * j + 8 * lane);
            const f32x4 v0 = {bflo(xb.x), bfhi(xb.x), bflo(xb.y), bfhi(xb.y)}, v1 = {bflo(xb.z), bfhi(xb.z), bflo(xb.w), bfhi(xb.w)};
            f32x4* o = (f32x4*)(p.out + (size_t)r * DM + 512 * j + 8 * lane);
            o[0] = v0 * rstd * gs[2 * j]; o[1] = v1 * rstd * gs[2 * j + 1]; }
    }
}

__device__ __forceinline__ void zpost_row(const Ctx& p, int row, bool latent, int lane, const LAS f32x2* tabM, const LAS f32x2* tabG) {
    unsigned char* ws = p.ws;
    const bf16_t* z = (const bf16_t*)(ws + WS_Z) + (size_t)row * ZW;
    int prow = 0, pcol = 0;
    if (latent) { const int s = row & (SEQ - 1); prow = s >> 6; pcol = s & 63; }
    if (latent) {
        float v[6], ss = 0.f;
#pragma unroll
        for (int i = 0; i < 6; ++i) { v[i] = bf2f(z[ZC_CQ + lane + 64 * i]); ss += v[i] * v[i]; }
        const float rstd = rsqrtf(wave_sum(ss) * (1.0f / 384.0f) + EPS);
        bf16_t* o = (bf16_t*)(ws + WS_CQN) + (size_t)row * 384;
#pragma unroll
        for (int i = 0; i < 6; ++i) o[lane + 64 * i] = (bf16_t)f2bf(v[i] * rstd * p.in[I_AQAG][lane + 64 * i]);
    }
    {
        float v[4], ss = 0.f;
#pragma unroll
        for (int i = 0; i < 4; ++i) { v[i] = bf2f(z[ZC_CKV + lane + 64 * i]); ss += v[i] * v[i]; }
        const float rstd = rsqrtf(wave_sum(ss) * (1.0f / 256.0f) + EPS);
        bf16_t* o = (bf16_t*)(ws + WS_CKVN) + (size_t)row * 256;
#pragma unroll
        for (int i = 0; i < 4; ++i) o[lane + 64 * i] = (bf16_t)f2bf(v[i] * rstd * p.in[I_AKVAG][lane + 64 * i]);
    }
    {
        const int d = lane & 31; const float y = bf2f(z[ZC_KR + d]);
        const float pr = __shfl_xor(y, 8);
        float o = y;
        if (latent) { const int pos = (d & 16) ? pcol : prow; const f32x2 cs = tabM[pos * 8 + (d & 7)];
            o = (d & 8) ? (pr * cs.y + y * cs.x) : (y * cs.x - pr * cs.y); }
        if (lane < 32) ((bf16_t*)(ws + WS_KROPE))[(size_t)row * 32 + d] = (bf16_t)f2bf(o);
    }
    if (latent) {
        const float gq = p.in[I_AQNG][lane];
        const int pos = (lane & 32) ? pcol : prow; const f32x2 cs = tabG[pos * 16 + (lane & 15)];
        bf16_t* o = (bf16_t*)(ws + WS_QG) + (size_t)row * 512;
#pragma unroll
        for (int hh = 0; hh < 8; ++hh) {
            const float v = bf2f(z[ZC_GQ + 64 * hh + lane]);
            const float rstd = rsqrtf(wave_sum(v * v) * (1.0f / 64.0f) + EPS);
            const float y = v * rstd * gq, pr = __shfl_xor(y, 16);
            const float r = (lane & 16) ? (pr * cs.y + y * cs.x) : (y * cs.x - pr * cs.y);
            o[64 * hh + lane] = (bf16_t)f2bf(r * QSCALE_GQA);
        }
    }
    {
        const float gk = p.in[I_AKNG][lane];
        f32x2 cs = {1.f, 0.f};
        if (latent) { const int pos = (lane & 32) ? pcol : prow; cs = tabG[pos * 16 + (lane & 15)]; }
        bf16_t* o = (bf16_t*)(ws + WS_KG) + (size_t)row * 128;
#pragma unroll
        for (int hh = 0; hh < 2; ++hh) {
            const float v = bf2f(z[ZC_GK + 64 * hh + lane]);
            const float rstd = rsqrtf(wave_sum(v * v) * (1.0f / 64.0f) + EPS);
            const float y = v * rstd * gk, pr = __shfl_xor(y, 16);
            const float r = (lane & 16) ? (pr * cs.y + y * cs.x) : (y * cs.x - pr * cs.y);
            o[64 * hh + lane] = (bf16_t)f2bf(r);
        }
    }
    {
        bf16_t* o = (bf16_t*)(ws + WS_VG) + (size_t)row * 128;
        o[lane] = z[ZC_GV + lane]; o[64 + lane] = z[ZC_GV + 64 + lane];
    }
}
struct ZGains { f32x4 qa[2], kva0[2], kva1[2], qn[2], kn[2]; };
__device__ __forceinline__ void unpack8(const u32x4 w, float (&v)[8]) { v[0] = bflo(w.x); v[1] = bfhi(w.x); v[2] = bflo(w.y); v[3] = bfhi(w.y); v[4] = bflo(w.z); v[5] = bfhi(w.z); v[6] = bflo(w.w); v[7] = bfhi(w.w); }
__device__ __forceinline__ u32x4 pack8(const float (&v)[8]) { u32x4 w; w.x = cvtpk(v[0], v[1]); w.y = cvtpk(v[2], v[3]); w.z = cvtpk(v[4], v[5]); w.w = cvtpk(v[6], v[7]); return w; }
__device__ __forceinline__ float sumsq8(const float (&v)[8]) { return ((v[0] * v[0] + v[1] * v[1]) + (v[2] * v[2] + v[3] * v[3])) + ((v[4] * v[4] + v[5] * v[5]) + (v[6] * v[6] + v[7] * v[7])); }
__device__ __forceinline__ void rope8(float (&y)[8], const float (&pr)[8], bool second, const LAS f32x2* cs) {
#pragma unroll
    for (int e = 0; e < 8; ++e) { const f32x2 c = cs[e]; y[e] = second ? (pr[e] * c.y + y[e] * c.x) : (y[e] * c.x - pr[e] * c.y); }
}
__device__ __forceinline__ void zpost_row_vec(const Ctx& p, int row, bool latent, int lane, const LAS f32x2* tabM, const LAS f32x2* tabG, const ZGains& G) {
    unsigned char* ws = p.ws;
    const bf16_t* z = (const bf16_t*)(ws + WS_Z) + (size_t)row * ZW;
    int prow = 0, pcol = 0;
    if (latent) { const int s_ = row & (SEQ - 1); prow = s_ >> 6; pcol = s_ & 63; }
    const int cB = 84 + lane, cC = lane < 16 ? 148 + lane : (lane < 32 ? 164 + (lane - 16) : 80 + (lane & 3));
    const u32x4 wA0 = *(const u32x4*)(z + 8 * lane);
    const u32x4 wA1 = *(const u32x4*)(z + 8 * (64 + (lane & 15)));
    const u32x4 wB = *(const u32x4*)(z + 8 * cB);
    const u32x4 wC = *(const u32x4*)(z + 8 * cC);
    float a0[8], a1[8], vb[8], vc[8];
    unpack8(wA0, a0); unpack8(wA1, a1); unpack8(wB, vb); unpack8(wC, vc);
    {
        const float s0 = sumsq8(a0), s1 = sumsq8(a1);
        const float sq_cq = wave_sum(lane < 48 ? s0 : 0.f), sq_ckv = wave_sum((lane >= 48 ? s0 : 0.f) + (lane < 16 ? s1 : 0.f));
        const float rq = rsqrtf(sq_cq * (1.0f / 384.0f) + EPS), rk = rsqrtf(sq_ckv * (1.0f / 256.0f) + EPS);
        float o[8];
        if (lane < 48) { if (latent) {
#pragma unroll
                for (int e = 0; e < 8; ++e) o[e] = a0[e] * rq * G.qa[e >> 2][e & 3];
                *(u32x4*)((bf16_t*)(ws + WS_CQN) + (size_t)row * 384 + 8 * lane) = pack8(o); } }
        else {
#pragma unroll
            for (int e = 0; e < 8; ++e) o[e] = a0[e] * rk * G.kva0[e >> 2][e & 3];
            *(u32x4*)((bf16_t*)(ws + WS_CKVN) + (size_t)row * 256 + 8 * (lane - 48)) = pack8(o); }
        if (lane < 16) {
#pragma unroll
            for (int e = 0; e < 8; ++e) o[e] = a1[e] * rk * G.kva1[e >> 2][e & 3];
            *(u32x4*)((bf16_t*)(ws + WS_CKVN) + (size_t)row * 256 + 128 + 8 * lane) = pack8(o); }
    }
    if (latent) {
        float sq = sumsq8(vb); sq += __shfl_xor(sq, 1); sq += __shfl_xor(sq, 2); sq += __shfl_xor(sq, 4);
        const float rs = rsqrtf(sq * (1.0f / 64.0f) + EPS);
        float y[8], pr[8];
#pragma unroll
        for (int e = 0; e < 8; ++e) y[e] = vb[e] * rs * G.qn[e >> 2][e & 3];
#pragma unroll
        for (int e = 0; e < 8; ++e) pr[e] = __shfl_xor(y[e], 2);
        const int pos = (lane & 4) ? pcol : prow;
        rope8(y, pr, (lane & 2) != 0, tabG + pos * 16 + 8 * (lane & 1));
#pragma unroll
        for (int e = 0; e < 8; ++e) y[e] *= QSCALE_GQA;
        *(u32x4*)((bf16_t*)(ws + WS_QG) + (size_t)row * 512 + 8 * lane) = pack8(y);
    }
    {
        float sq = sumsq8(vc); sq += __shfl_xor(sq, 1); sq += __shfl_xor(sq, 2); sq += __shfl_xor(sq, 4);
        const float rs = rsqrtf(sq * (1.0f / 64.0f) + EPS);
        float y[8], pr2[8], pr1[8];
#pragma unroll
        for (int e = 0; e < 8; ++e) y[e] = (lane < 16) ? vc[e] * rs * G.kn[e >> 2][e & 3] : vc[e];
#pragma unroll
        for (int e = 0; e < 8; ++e) { pr2[e] = __shfl_xor(y[e], 2); pr1[e] = __shfl_xor(y[e], 1); }
        if (lane < 16) {
            if (latent) { const int pos = (lane & 4) ? pcol : prow; rope8(y, pr2, (lane & 2) != 0, tabG + pos * 16 + 8 * (lane & 1)); }
            *(u32x4*)((bf16_t*)(ws + WS_KG) + (size_t)row * 128 + 8 * lane) = pack8(y);
        } else if (lane < 32) {
            *(u32x4*)((bf16_t*)(ws + WS_VG) + (size_t)row * 128 + 8 * (lane - 16)) = wC;
        } else if (lane < 36) {
            if (latent) { const int pos = (lane & 2) ? pcol : prow; rope8(y, pr1, (lane & 1) != 0, tabM + pos * 8); }
            *(u32x4*)((bf16_t*)(ws + WS_KROPE) + (size_t)row * 32 + 8 * (lane - 32)) = pack8(y);
        }
    }
}
__device__ __forceinline__ void phase_zpost(const Ctx& p, LAS unsigned char* lds) {
    const int tid = p.tid, lane = tid & 63, wave = __builtin_amdgcn_readfirstlane(tid >> 6);
    LAS f32x2* tabM = (LAS f32x2*)lds;
    LAS f32x2* tabG = (LAS f32x2*)(lds + 4096);
    for (int i = tid; i < 512; i += NTHREADS) { const int pos = i >> 3, f = i & 7; const float inv = inv_theta((float)f / 8.0f); const float a = (float)pos * inv; tabM[i] = (f32x2){fcos(a), fsin(a)}; }
    for (int i = tid; i < 1024; i += NTHREADS) { const int pos = i >> 4, f = i & 15; const float inv = inv_theta((float)f / 16.0f); const float a = (float)pos * inv; tabG[i] = (f32x2){fcos(a), fsin(a)}; }
    __syncthreads();
    const int gw = p.bid * NWAVES + wave;
#if ZPOST_REF
    { const int per = ML / NGW; for (int r = gw * per; r < (gw + 1) * per; ++r) zpost_row(p, r, true, lane, tabM, tabG); }
    { const int per = MC / NGW; for (int r = gw * per; r < (gw + 1) * per; ++r) zpost_row(p, ML + r, false, lane, tabM, tabG); }
#else
    ZGains G;
    { const float* qa = p.in[I_AQAG] + 8 * (lane < 48 ? lane : 0); const float* k0 = p.in[I_AKVAG] + 8 * (lane >= 48 ? lane - 48 : 0); const float* k1 = p.in[I_AKVAG] + 128 + 8 * (lane & 15);
      const float* qn = p.in[I_AQNG] + 8 * (lane & 7); const float* kn = p.in[I_AKNG] + 8 * (lane & 7);
#pragma unroll
      for (int h = 0; h < 2; ++h) { G.qa[h] = *(const f32x4*)(qa + 4 * h); G.kva0[h] = *(const f32x4*)(k0 + 4 * h); G.kva1[h] = *(const f32x4*)(k1 + 4 * h); G.qn[h] = *(const f32x4*)(qn + 4 * h); G.kn[h] = *(const f32x4*)(kn + 4 * h); } }
    { const int per = ML / NGW;
#pragma unroll 2
      for (int r = gw * per; r < (gw + 1) * per; ++r) zpost_row_vec(p, r, true, lane, tabM, tabG, G); }
    { const int per = MC / NGW; for (int r = gw * per; r < (gw + 1) * per; ++r) zpost_row_vec(p, ML + r, false, lane, tabM, tabG, G); }
#endif
    __syncthreads();
}

__device__ __forceinline__ float max3f(float a, float b, float c) { float r; asm("v_max3_f32 %0, %1, %2, %3" : "=v"(r) : "v"(a), "v"(b), "v"(c)); return r; }
__device__ __forceinline__ int crow(int r, int hi) { return (r & 3) + 8 * (r >> 2) + 4 * hi; }
__device__ __forceinline__ size_t key_row(int b, int t) { return t < CTXL ? (size_t)(ML + b * CTXL + t) : (size_t)(b * SEQ + (t - CTXL)); }

template <int DK>
__device__ __forceinline__ void attn_naive_one(const Ctx& p, int b, int h, int q) {
    unsigned char* ws = p.ws;
    const bf16_t* KV = (const bf16_t*)(ws + WS_KV); const bf16_t* KR = (const bf16_t*)(ws + WS_KROPE);
    const bf16_t* KG = (const bf16_t*)(ws + WS_KG); const bf16_t* VG = (const bf16_t*)(ws + WS_VG);
    const size_t row = (size_t)b * SEQ + q;
    float qv[DK];
    {
        const bf16_t* qp = (DK == 96) ? (const bf16_t*)(ws + WS_QMR) + row * 768 + h * 96 : (const bf16_t*)(ws + WS_QG) + row * 512 + (h - 8) * 64;
#pragma unroll
        for (int d8 = 0; d8 < DK / 8; ++d8) { const u32x4 w = *(const u32x4*)(qp + 8 * d8);
            qv[8 * d8 + 0] = bflo(w.x); qv[8 * d8 + 1] = bfhi(w.x); qv[8 * d8 + 2] = bflo(w.y); qv[8 * d8 + 3] = bfhi(w.y);
            qv[8 * d8 + 4] = bflo(w.z); qv[8 * d8 + 5] = bfhi(w.z); qv[8 * d8 + 6] = bflo(w.w); qv[8 * d8 + 7] = bfhi(w.w); }
    }
    float o[64];
#pragma unroll
    for (int d = 0; d < 64; ++d) o[d] = 0.f;
    float m = -1e30f, l = 0.f;
    for (int t = 0; t < TKEYS; ++t) {
        const size_t kr = key_row(b, t);
        float s = 0.f;
        const bf16_t* vp;
        if (DK == 96) {
            const bf16_t* kp = KV + kr * 1024 + h * 128; const bf16_t* rp = KR + kr * 32;
#pragma unroll
            for (int d = 0; d < 64; ++d) s += qv[d] * bf2f(kp[d]);
#pragma unroll
            for (int d = 0; d < 32; ++d) s += qv[64 + d] * bf2f(rp[d]);
            vp = kp + 64;
        } else {
            const int kvh = (h - 8) >> 2; const bf16_t* kp = KG + kr * 128 + kvh * 64;
#pragma unroll
            for (int d = 0; d < 64; ++d) s += qv[d] * bf2f(kp[d]);
            vp = VG + kr * 128 + kvh * 64;
        }
        const float mn = fmaxf(m, s), al = exp2f(m - mn), pe = exp2f(s - mn);
        l = l * al + pe; m = mn;
#pragma unroll
        for (int d = 0; d < 64; ++d) o[d] = o[d] * al + pe * bf2f(vp[d]);
    }
    const float rl = 1.0f / l;
    bf16_t* op = (bf16_t*)(ws + WS_O) + row * 1024 + h * 64;
#pragma unroll
    for (int d = 0; d < 64; ++d) op[d] = (bf16_t)f2bf(o[d] * rl);
}
__device__ __forceinline__ void phase_naive_qrope(const Ctx& p) {
    const bf16_t* QM = (const bf16_t*)(p.ws + WS_QM); bf16_t* QMR = (bf16_t*)(p.ws + WS_QMR);
    for (size_t idx = (size_t)p.bid * NTHREADS + p.tid; idx < (size_t)ML * 768; idx += (size_t)p.nblk * NTHREADS) {
        const int col = (int)(idx % 768), d = col % 96; const size_t row = idx / 768; const int q = (int)(row & (SEQ - 1));
        float v = bf2f(QM[idx]);
        if (d >= 64) {
            const int e = d - 64, prow = q >> 6, pcol = q & 63;
            const int pos = (e & 16) ? pcol : prow; const float inv = inv_theta((float)(e & 7) / 8.0f); const float ang = (float)pos * inv;
            const float cs = fcos(ang), sn = fsin(ang);
            const float a = bf2f(QM[idx - e + (e & ~8)]), bb = bf2f(QM[idx - e + (e | 8)]);
            v = (e & 8) ? (a * sn + bb * cs) : (a * cs - bb * sn);
        }
        QMR[idx] = (bf16_t)f2bf(v * QSCALE_MLA);
    }
}
__device__ __forceinline__ void phase_attn_naive(const Ctx& p) {
    for (int idx = p.bid * NTHREADS + p.tid; idx < NB * 16 * SEQ; idx += p.nblk * NTHREADS) {
        const int q = idx & (SEQ - 1), h = (idx >> 11) & 15, b = idx >> 15;
        if (h < 8) attn_naive_one<96>(p, b, h, q); else attn_naive_one<64>(p, b, h, q);
    }
}

template <int DK>
__device__ __forceinline__ void attn_unit(const Ctx& p, int b, int h, int qb, LAS unsigned char* lds) {
    constexpr int NC = DK / 8;
    constexpr int ND = DK / 16;
    constexpr int KB = 12288, VB = 8192;
    unsigned char* ws = p.ws;
    const int tid = p.tid, lane = tid & 63, r32 = lane & 31, hi = lane >> 5; const int wid = __builtin_amdgcn_readfirstlane(tid >> 6);
    const bf16_t* KV = (const bf16_t*)(ws + WS_KV); const bf16_t* KR = (const bf16_t*)(ws + WS_KROPE);
    const bf16_t* KG = (const bf16_t*)(ws + WS_KG); const bf16_t* VG = (const bf16_t*)(ws + WS_VG);
    const int kvh = (h - 8) >> 2;
    LAS unsigned char* Kb = lds; LAS unsigned char* Vb = lds + 2 * KB; LAS float* wsf = (LAS float*)(lds + 2 * KB + 2 * VB) + wid * 64;
    const int qs = qb * 256 + wid * 32 + r32;
    const size_t qrow = (size_t)b * SEQ + qs;
    bf16x8 qr[ND];
    if (DK == 96) {
        const bf16_t* qp = (const bf16_t*)(ws + WS_QM) + qrow * 768 + h * 96;
#pragma unroll
        for (int d0 = 0; d0 < 4; ++d0) { const u32x4 w = *(const u32x4*)(qp + 16 * d0 + 8 * hi); u32x4 o;
            o.x = cvtpk(bflo(w.x) * QSCALE_MLA, bfhi(w.x) * QSCALE_MLA); o.y = cvtpk(bflo(w.y) * QSCALE_MLA, bfhi(w.y) * QSCALE_MLA);
            o.z = cvtpk(bflo(w.z) * QSCALE_MLA, bfhi(w.z) * QSCALE_MLA); o.w = cvtpk(bflo(w.w) * QSCALE_MLA, bfhi(w.w) * QSCALE_MLA);
            qr[d0] = __builtin_bit_cast(bf16x8, o); }
        const int prow = qs >> 6, pcol = qs & 63;
#pragma unroll
        for (int c = 0; c < 2; ++c) {
            const u32x4 wa = *(const u32x4*)(qp + 64 + 16 * c);
            const u32x4 wb = *(const u32x4*)(qp + 64 + 16 * c + 8);
            const float pos = (float)(c == 0 ? prow : pcol);
            float av[8] = {bflo(wa.x), bfhi(wa.x), bflo(wa.y), bfhi(wa.y), bflo(wa.z), bfhi(wa.z), bflo(wa.w), bfhi(wa.w)};
            float bv[8] = {bflo(wb.x), bfhi(wb.x), bflo(wb.y), bfhi(wb.y), bflo(wb.z), bfhi(wb.z), bflo(wb.w), bfhi(wb.w)};
            float ov[8];
#pragma unroll
            for (int j = 0; j < 8; ++j) { const float inv = inv_theta((float)j / 8.0f); const float ang = pos * inv; const float cs = fcos(ang), sn = fsin(ang);
                const float lo = av[j] * cs - bv[j] * sn, hv = av[j] * sn + bv[j] * cs; ov[j] = (hi ? hv : lo) * QSCALE_MLA; }
            u32x4 o; o.x = cvtpk(ov[0], ov[1]); o.y = cvtpk(ov[2], ov[3]); o.z = cvtpk(ov[4], ov[5]); o.w = cvtpk(ov[6], ov[7]);
            qr[4 + c] = __builtin_bit_cast(bf16x8, o);
        }
    } else {
        const bf16_t* qp = (const bf16_t*)(ws + WS_QG) + qrow * 512 + (h - 8) * 64;
#pragma unroll
        for (int d0 = 0; d0 < ND; ++d0) qr[d0] = *(const bf16x8*)(qp + 16 * d0 + 8 * hi);
    }
    const int kkey = tid & 63, kc0 = tid >> 6;
    const int vkv = tid >> 3, vdc = tid & 7;
    const unsigned kdst0 = kc0 * 1024 + kkey * 16, kdst1 = (kc0 + 8) * 1024 + kkey * 16;
    const unsigned vdst = (vdc >> 2) * 4096 + (vkv >> 4) * 1024 + (vkv & 15) * 64 + (vdc & 3) * 16;
    u32x4 kreg0, kreg1, vreg;
    auto load_tile = [&](int kt) {
        const size_t rk = key_row(b, kt * 64 + kkey), rv = key_row(b, kt * 64 + vkv);
        if (DK == 96) {
            kreg0 = *(const u32x4*)(KV + rk * 1024 + h * 128 + 8 * kc0);
            if (wid < 4) kreg1 = *(const u32x4*)(KR + rk * 32 + 8 * kc0);
            vreg = *(const u32x4*)(KV + rv * 1024 + h * 128 + 64 + 8 * vdc);
        } else {
            kreg0 = *(const u32x4*)(KG + rk * 128 + kvh * 64 + 8 * kc0);
            vreg = *(const u32x4*)(VG + rv * 128 + kvh * 64 + 8 * vdc);
        }
    };
    auto store_tile = [&](int buf) {
        *(LAS u32x4*)(Kb + buf * KB + kdst0) = kreg0;
        if (DK == 96) { if (wid < 4) *(LAS u32x4*)(Kb + buf * KB + kdst1) = kreg1; }
        *(LAS u32x4*)(Vb + buf * VB + vdst) = vreg;
    };
    f32x16 o0 = {}, o1 = {};
    float mrun = -1e30f, lrun = 0.f;
    const unsigned kfo = hi * 1024 + r32 * 16;
    const unsigned vfo = ((lane >> 4) & 1) * 32 + (lane & 3) * 8 + (4 * hi + ((lane & 15) >> 2)) * 64;
    load_tile(0); store_tile(0);
    __syncthreads();
    constexpr int NT = TKEYS / 64;
    for (int kt = 0; kt < NT; ++kt) {
        const int buf = kt & 1;
        if (kt + 1 < NT) load_tile(kt + 1);
        f32x16 p0 = {}, p1 = {};
        const LAS unsigned char* kp = Kb + buf * KB + kfo;
#pragma unroll
        for (int d0 = 0; d0 < ND; ++d0) {
            const bf16x8 k0 = *(const LAS bf16x8*)(kp + d0 * 2048), k1 = *(const LAS bf16x8*)(kp + d0 * 2048 + 512);
            p0 = __builtin_amdgcn_mfma_f32_32x32x16_bf16(k0, qr[d0], p0, 0, 0, 0);
            p1 = __builtin_amdgcn_mfma_f32_32x32x16_bf16(k1, qr[d0], p1, 0, 0, 0);
        }
        float mx = fmaxf(p0[0], p1[0]);
#pragma unroll
        for (int r = 1; r < 16; ++r) mx = fmaxf(mx, fmaxf(p0[r], p1[r]));
        mx = fmaxf(mx, __shfl_xor(mx, 32));
        const float mnew = fmaxf(mrun, mx), alpha = __builtin_amdgcn_exp2f(mrun - mnew);
        mrun = mnew;
        float rs = 0.f;
#pragma unroll
        for (int r = 0; r < 16; ++r) { p0[r] = __builtin_amdgcn_exp2f(p0[r] - mnew); p1[r] = __builtin_amdgcn_exp2f(p1[r] - mnew); rs += p0[r] + p1[r]; }
        lrun = lrun * alpha + rs;
        if (hi == 0) wsf[r32] = alpha;
        asm volatile("s_waitcnt lgkmcnt(0)" ::: "memory");
#pragma unroll
        for (int g4 = 0; g4 < 4; ++g4) { const f32x4 a4 = *(const LAS f32x4*)(wsf + 8 * g4 + 4 * hi);
#pragma unroll
            for (int e = 0; e < 4; ++e) { o0[4 * g4 + e] *= a4[e]; o1[4 * g4 + e] *= a4[e]; } }
        u32x4 pw[4];
        pw[0] = (u32x4){cvtpk(p0[0], p0[1]), cvtpk(p0[2], p0[3]), cvtpk(p0[4], p0[5]), cvtpk(p0[6], p0[7])};
        pw[1] = (u32x4){cvtpk(p0[8], p0[9]), cvtpk(p0[10], p0[11]), cvtpk(p0[12], p0[13]), cvtpk(p0[14], p0[15])};
        pw[2] = (u32x4){cvtpk(p1[0], p1[1]), cvtpk(p1[2], p1[3]), cvtpk(p1[4], p1[5]), cvtpk(p1[6], p1[7])};
        pw[3] = (u32x4){cvtpk(p1[8], p1[9]), cvtpk(p1[10], p1[11]), cvtpk(p1[12], p1[13]), cvtpk(p1[14], p1[15])};
        const LAS unsigned char* vp = Vb + buf * VB + vfo;
#pragma unroll
        for (int ks = 0; ks < 4; ++ks) {
            const bf16x8 pa = __builtin_bit_cast(bf16x8, pw[ks]);
            const s16x4 l0 = __builtin_amdgcn_ds_read_tr16_b64_v4i16((LAS s16x4*)(vp + ks * 1024));
            const s16x4 h0 = __builtin_amdgcn_ds_read_tr16_b64_v4i16((LAS s16x4*)(vp + ks * 1024 + 512));
            const s16x4 l1 = __builtin_amdgcn_ds_read_tr16_b64_v4i16((LAS s16x4*)(vp + 4096 + ks * 1024));
            const s16x4 h1 = __builtin_amdgcn_ds_read_tr16_b64_v4i16((LAS s16x4*)(vp + 4096 + ks * 1024 + 512));
            const bf16x8 v0 = {l0[0], l0[1], l0[2], l0[3], h0[0], h0[1], h0[2], h0[3]};
            const bf16x8 v1 = {l1[0], l1[1], l1[2], l1[3], h1[0], h1[1], h1[2], h1[3]};
            o0 = __builtin_amdgcn_mfma_f32_32x32x16_bf16(pa, v0, o0, 0, 0, 0);
            o1 = __builtin_amdgcn_mfma_f32_32x32x16_bf16(pa, v1, o1, 0, 0, 0);
        }
        if (kt + 1 < NT) store_tile(buf ^ 1);
        __syncthreads();
    }
    lrun += __shfl_xor(lrun, 32);
    if (hi == 0) wsf[32 + r32] = lrun;
    asm volatile("s_waitcnt lgkmcnt(0)" ::: "memory");
    bf16_t* Ow = (bf16_t*)(ws + WS_O) + ((size_t)b * SEQ + qb * 256 + wid * 32) * 1024 + h * 64;
#pragma unroll
    for (int r = 0; r < 16; ++r) { const int orow = crow(r, hi); const float rl = __builtin_amdgcn_rcpf(wsf[32 + orow]);
        Ow[(size_t)orow * 1024 + r32] = (bf16_t)f2bf(o0[r] * rl); Ow[(size_t)orow * 1024 + 32 + r32] = (bf16_t)f2bf(o1[r] * rl); }
    __syncthreads();
}
template <int DK>
__device__ __forceinline__ void attn_unit2(const Ctx& p, const int tid, int b, int h, int qb, LAS unsigned char* lds) {
    constexpr int ND = DK / 16;
    constexpr int KB = 12288, VB = 8192, NT = TKEYS / 64;
    constexpr float THR = 8.0f;
    unsigned char* ws = p.ws;
    const int lane = tid & 63, r32 = lane & 31, hi = lane >> 5; const int wid = __builtin_amdgcn_readfirstlane(tid >> 6);
    const bf16_t* KV = (const bf16_t*)(ws + WS_KV); const bf16_t* KR = (const bf16_t*)(ws + WS_KROPE);
    const bf16_t* KG = (const bf16_t*)(ws + WS_KG); const bf16_t* VG = (const bf16_t*)(ws + WS_VG);
    const int kvh = (h - 8) >> 2;
    LAS unsigned char* Kb = lds; LAS unsigned char* Vb = lds + 2 * KB; LAS float* wsf = (LAS float*)(lds + 2 * KB + 2 * VB) + wid * 64;
    const int qs = qb * 256 + wid * 32 + r32;
    const size_t qrow = (size_t)b * SEQ + qs;
    bf16x8 qr[ND];
    if (DK == 96) {
        const bf16_t* qp = (const bf16_t*)(ws + WS_QM) + qrow * 768 + h * 96;
#pragma unroll
        for (int d0 = 0; d0 < 4; ++d0) { const u32x4 w = *(const u32x4*)(qp + 16 * d0 + 8 * hi); u32x4 o;
            o.x = cvtpk(bflo(w.x) * QSCALE_MLA, bfhi(w.x) * QSCALE_MLA); o.y = cvtpk(bflo(w.y) * QSCALE_MLA, bfhi(w.y) * QSCALE_MLA);
            o.z = cvtpk(bflo(w.z) * QSCALE_MLA, bfhi(w.z) * QSCALE_MLA); o.w = cvtpk(bflo(w.w) * QSCALE_MLA, bfhi(w.w) * QSCALE_MLA);
            qr[d0] = __builtin_bit_cast(bf16x8, o); }
        const int prow = qs >> 6, pcol = qs & 63;
#pragma unroll
        for (int c = 0; c < 2; ++c) {
            const u32x4 wa = *(const u32x4*)(qp + 64 + 16 * c);
            const u32x4 wb = *(const u32x4*)(qp + 64 + 16 * c + 8);
            const float pos = (float)(c == 0 ? prow : pcol);
            float av[8], bv[8], ov[8]; unpack8(wa, av); unpack8(wb, bv);
#pragma unroll
            for (int j = 0; j < 8; ++j) { const float inv = inv_theta((float)j / 8.0f); const float ang = pos * inv; const float cs = fcos(ang), sn = fsin(ang);
                const float lo = av[j] * cs - bv[j] * sn, hv = av[j] * sn + bv[j] * cs; ov[j] = (hi ? hv : lo) * QSCALE_MLA; }
            qr[4 + c] = __builtin_bit_cast(bf16x8, pack8(ov));
        }
    } else {
        const bf16_t* qp = (const bf16_t*)(ws + WS_QG) + qrow * 512 + (h - 8) * 64;
#pragma unroll
        for (int d0 = 0; d0 < ND; ++d0) qr[d0] = *(const bf16x8*)(qp + 16 * d0 + 8 * hi);
    }
    const int kkey = tid & 63, kc0 = tid >> 6, vkv = tid >> 3, vdc = tid & 7;
    const unsigned kdst0 = kc0 * 1024 + kkey * 16, kdst1 = (kc0 + 8) * 1024 + kkey * 16;
    const unsigned vdst = (vdc >> 2) * 4096 + (vkv >> 4) * 1024 + (vkv & 15) * 64 + (vdc & 3) * 16;
    u32x4 kreg0, kreg1, vreg;
    auto load_k = [&](int kt) { const size_t rk = key_row(b, kt * 64 + kkey);
        if (DK == 96) { kreg0 = *(const u32x4*)(KV + rk * 1024 + h * 128 + 8 * kc0); if (wid < 4) kreg1 = *(const u32x4*)(KR + rk * 32 + 8 * kc0); }
        else kreg0 = *(const u32x4*)(KG + rk * 128 + kvh * 64 + 8 * kc0); };
    auto load_v = [&](int kt) { const size_t rv = key_row(b, kt * 64 + vkv);
        if (DK == 96) vreg = *(const u32x4*)(KV + rv * 1024 + h * 128 + 64 + 8 * vdc); else vreg = *(const u32x4*)(VG + rv * 128 + kvh * 64 + 8 * vdc); };
    auto store_k = [&](int buf) { *(LAS u32x4*)(Kb + buf * KB + kdst0) = kreg0; if (DK == 96) { if (wid < 4) *(LAS u32x4*)(Kb + buf * KB + kdst1) = kreg1; } };
    auto store_v = [&](int buf) { *(LAS u32x4*)(Vb + buf * VB + vdst) = vreg; };
    f32x16 o0 = {}, o1 = {};
    float mhat = -1e30f, lrun = 0.f;
    const unsigned kfo = hi * 1024 + r32 * 16;
    const unsigned vfo = ((lane >> 4) & 1) * 32 + (lane & 3) * 8 + (4 * hi + ((lane & 15) >> 2)) * 64;
#define A2_SBAR() __builtin_amdgcn_sched_barrier(0)
#define A2_EL(X0, X1, i) ((i) < 16 ? X0[(i) & 15] : X1[(i) & 15])
#define A2_STEP(C0, C1, P0, P1, T, HASPREV, HASK) do { const int t_ = (T); \
        if (HASK) load_k(t_ + 1); \
        load_v(t_); \
        const LAS unsigned char* kp_ = Kb + (t_ & 1) * KB + kfo; const LAS unsigned char* vp_ = Vb + ((t_ + 1) & 1) * VB + vfo; \
        float sacc_ = 0.f; unsigned pw_[16]; s16x4 vl_[8], vh_[8]; bf16x8 kf_[2 * ND]; \
        kf_[0] = *(const LAS bf16x8*)(kp_); kf_[1] = *(const LAS bf16x8*)(kp_ + 512); \
        A2_SBAR(); \
        _Pragma("unroll") for (int g = 0; g < 2 * ND; ++g) { \
            if (g + 2 < 2 * ND) kf_[g + 2] = *(const LAS bf16x8*)(kp_ + ((g + 2) >> 1) * 2048 + ((g + 2) & 1) * 512); \
            if (HASPREV && g < 8) { vl_[g] = __builtin_amdgcn_ds_read_tr16_b64_v4i16((LAS s16x4*)(vp_ + (g >> 2) * 4096 + (g & 3) * 1024)); \
                                    vh_[g] = __builtin_amdgcn_ds_read_tr16_b64_v4i16((LAS s16x4*)(vp_ + (g >> 2) * 4096 + (g & 3) * 1024 + 512)); } \
            if ((g & 1) == 0) { if (g == 0) C0 = __builtin_amdgcn_mfma_f32_32x32x16_bf16(kf_[g], qr[g >> 1], (f32x16){}, 0, 0, 0); else C0 = __builtin_amdgcn_mfma_f32_32x32x16_bf16(kf_[g], qr[g >> 1], C0, 0, 0, 0); } \
            else { if (g == 1) C1 = __builtin_amdgcn_mfma_f32_32x32x16_bf16(kf_[g], qr[g >> 1], (f32x16){}, 0, 0, 0); else C1 = __builtin_amdgcn_mfma_f32_32x32x16_bf16(kf_[g], qr[g >> 1], C1, 0, 0, 0); } \
            if (HASPREV) { constexpr int NA = (ND == 6) ? 3 : 4; \
                _Pragma("unroll") for (int i = 0; i < NA; ++i) { const int e = NA * g + i; if (e < 32) sacc_ += A2_EL(P0, P1, e); } \
                if (g < 8) { pw_[2 * g] = cvtpk(A2_EL(P0, P1, 4 * g), A2_EL(P0, P1, 4 * g + 1)); pw_[2 * g + 1] = cvtpk(A2_EL(P0, P1, 4 * g + 2), A2_EL(P0, P1, 4 * g + 3)); asm volatile("" : "+v"(pw_[2 * g]), "+v"(pw_[2 * g + 1])); } \
                asm volatile("" : "+v"(sacc_)); } \
            A2_SBAR(); } \
        lrun += sacc_; \
        float rm_ = __builtin_fmaxf(C0[0], C1[0]), rn_ = __builtin_fmaxf(C0[1], C1[1]);            \
        _Pragma("unroll") for (int r = 2; r < 16; r += 2) { rm_ = __builtin_fmaxf(__builtin_fmaxf(rm_, C0[r]), C1[r]); rn_ = __builtin_fmaxf(__builtin_fmaxf(rn_, C0[r + 1]), C1[r + 1]); } \
        rm_ = __builtin_fmaxf(rm_, rn_); \
        { auto rr_ = __builtin_amdgcn_permlane32_swap(__float_as_uint(rm_), __float_as_uint(rm_), false, false); rm_ = fmaxf(__uint_as_float(rr_[0]), __uint_as_float(rr_[1])); } \
        bool resc_ = false; \
        if (__any(rm_ - mhat > THR)) { const float mn_ = fmaxf(mhat, rm_); const float f_ = __builtin_amdgcn_exp2f(mhat - mn_); mhat = mn_; lrun *= f_; if (hi == 0) wsf[r32] = f_; resc_ = true; } \
        A2_SBAR(); \
        _Pragma("unroll") for (int g = 0; g < 8; ++g) { \
            if (HASPREV) { const int ks = g >> 1, dv = g & 1; const u32x4 pa_ = {pw_[4 * ks], pw_[4 * ks + 1], pw_[4 * ks + 2], pw_[4 * ks + 3]}; \
                const s16x4 l_ = vl_[dv * 4 + ks], h_ = vh_[dv * 4 + ks]; const bf16x8 vf_ = {l_[0], l_[1], l_[2], l_[3], h_[0], h_[1], h_[2], h_[3]}; \
                if (dv == 0) o0 = __builtin_amdgcn_mfma_f32_32x32x16_bf16(__builtin_bit_cast(bf16x8, pa_), vf_, o0, 0, 0, 0); \
                else o1 = __builtin_amdgcn_mfma_f32_32x32x16_bf16(__builtin_bit_cast(bf16x8, pa_), vf_, o1, 0, 0, 0); } \
            _Pragma("unroll") for (int i = 0; i < 4; ++i) { const int e = 4 * g + i; if (e < 16) C0[e & 15] = __builtin_amdgcn_exp2f(C0[e & 15] - mhat); else C1[e & 15] = __builtin_amdgcn_exp2f(C1[e & 15] - mhat); } \
            if (g < 4) asm volatile("" : "+v"(C0)); else asm volatile("" : "+v"(C1)); \
            A2_SBAR(); } \
        if (resc_) { asm volatile("s_waitcnt lgkmcnt(0)" ::: "memory"); \
            _Pragma("unroll") for (int g4 = 0; g4 < 4; ++g4) { const f32x4 a4 = *(const LAS f32x4*)(wsf + 8 * g4 + 4 * hi); \
                _Pragma("unroll") for (int e = 0; e < 4; ++e) { o0[4 * g4 + e] *= a4[e]; o1[4 * g4 + e] *= a4[e]; } } } \
        if (HASK) store_k((t_ + 1) & 1); \
        store_v(t_ & 1); \
        __syncthreads(); } while (0)
    load_k(0); store_k(0);
    __syncthreads();
    f32x16 sA0, sA1, sB0, sB1;
    A2_STEP(sA0, sA1, sB0, sB1, 0, false, true);
    for (int t = 1; t + 1 < NT; t += 2) {
        A2_STEP(sB0, sB1, sA0, sA1, t, true, true);
        A2_STEP(sA0, sA1, sB0, sB1, t + 1, true, true);
    }
    A2_STEP(sB0, sB1, sA0, sA1, NT - 1, true, false);
    {
        float sacc = 0.f;
#pragma unroll
        for (int r = 0; r < 16; ++r) sacc += sB0[r] + sB1[r];
        lrun += sacc;
        const LAS unsigned char* vp = Vb + ((NT - 1) & 1) * VB + vfo;
#pragma unroll
        for (int ks = 0; ks < 4; ++ks) {
            const f32x16& P = (ks < 2) ? sB0 : sB1; const int bse = 8 * (ks & 1);
            const u32x4 pa = {cvtpk(P[bse], P[bse + 1]), cvtpk(P[bse + 2], P[bse + 3]), cvtpk(P[bse + 4], P[bse + 5]), cvtpk(P[bse + 6], P[bse + 7])};
            const s16x4 l0 = __builtin_amdgcn_ds_read_tr16_b64_v4i16((LAS s16x4*)(vp + ks * 1024)), h0 = __builtin_amdgcn_ds_read_tr16_b64_v4i16((LAS s16x4*)(vp + ks * 1024 + 512));
            const s16x4 l1 = __builtin_amdgcn_ds_read_tr16_b64_v4i16((LAS s16x4*)(vp + 4096 + ks * 1024)), h1 = __builtin_amdgcn_ds_read_tr16_b64_v4i16((LAS s16x4*)(vp + 4096 + ks * 1024 + 512));
            const bf16x8 v0 = {l0[0], l0[1], l0[2], l0[3], h0[0], h0[1], h0[2], h0[3]}, v1 = {l1[0], l1[1], l1[2], l1[3], h1[0], h1[1], h1[2], h1[3]};
            o0 = __builtin_amdgcn_mfma_f32_32x32x16_bf16(__builtin_bit_cast(bf16x8, pa), v0, o0, 0, 0, 0);
            o1 = __builtin_amdgcn_mfma_f32_32x32x16_bf16(__builtin_bit_cast(bf16x8, pa), v1, o1, 0, 0, 0);
        }
    }
#undef A2_STEP
#undef A2_EL
#undef A2_SBAR
    lrun += __shfl_xor(lrun, 32);
    if (hi == 0) wsf[32 + r32] = lrun;
    asm volatile("s_waitcnt lgkmcnt(0)" ::: "memory");
    bf16_t* Ow = (bf16_t*)(ws + WS_O) + ((size_t)b * SEQ + qb * 256 + wid * 32) * 1024 + h * 64;
#pragma unroll
    for (int r = 0; r < 16; ++r) { const int orow = crow(r, hi); const float rl = __builtin_amdgcn_rcpf(wsf[32 + orow]);
        Ow[(size_t)orow * 1024 + r32] = (bf16_t)f2bf(o0[r] * rl); Ow[(size_t)orow * 1024 + 32 + r32] = (bf16_t)f2bf(o1[r] * rl); }
    __syncthreads();
}
__device__ __forceinline__ void phase_attn(const Ctx& p, LAS unsigned char* lds) {
    const int c = p.bid, bq = c >> 1, b = bq >> 3, qb = bq & 7;
    for (int i = 0; i < 8; ++i) { const int h = 2 * i + (c & 1);
#if ATTN_V1
        if (h < 8) attn_unit<96>(p, b, h, qb, lds); else attn_unit<64>(p, b, h, qb, lds); }
#else
        int tid = p.tid; asm volatile("" : "+v"(tid));
        if (h < 8) attn_unit2<96>(p, tid, b, h, qb, lds); else attn_unit2<64>(p, tid, b, h, qb, lds); }
#endif
}

__device__ __forceinline__ void hyena_taps(const Ctx& p, int c, LAS unsigned char* scratch, float (&taps)[4][2][2]) {
    const int tid = p.tid, lane = tid & 63, wave = __builtin_amdgcn_readfirstlane(tid >> 6);
    LAS float* w4s = (LAS float*)scratch;
    LAS float* red = (LAS float*)(scratch + 1024);
    const float* w4 = p.in[I_FW4]; const float* H3 = (const float*)(p.ws + WS_H3);
    if (tid < 256) { const int cc = tid >> 6, k = tid & 63; w4s[cc * 64 + k] = w4[(size_t)k * 4096 + (cc >> 1) * 2048 + (cc & 1) * 1024 + c]; }
    __syncthreads();
    const float dmin = -3.0701134573253940f, dmax = -15.350567286626970f;
    const float delta = fabsf(dmin + (float)c * ((dmax - dmin) / 1023.0f));
    float ss0 = 0.f, ss1 = 0.f;
    float a[4][4];
#pragma unroll
    for (int i = 0; i < 4; ++i)
#pragma unroll
        for (int cc = 0; cc < 4; ++cc) a[i][cc] = 0.f;
#pragma unroll 2
    for (int k4 = 0; k4 < 16; ++k4) {
        f32x4 wv[4];
#pragma unroll
        for (int cc = 0; cc < 4; ++cc) wv[cc] = *(const LAS f32x4*)(w4s + cc * 64 + 4 * k4);
#pragma unroll
        for (int i = 0; i < 4; ++i) { const f32x4 hv = *((const f32x4*)(H3 + (size_t)(tid + 512 * i) * 64) + k4);
#pragma unroll
            for (int cc = 0; cc < 4; ++cc) a[i][cc] += (hv[0] * wv[cc][0] + hv[1] * wv[cc][1]) + (hv[2] * wv[cc][2] + hv[3] * wv[cc][3]); }
    }
#pragma unroll
    for (int i = 0; i < 4; ++i) {
        const int t = tid + 512 * i;
        const float win = expf(-((float)t / 2048.0f) * delta);
#pragma unroll
        for (int cc = 0; cc < 4; ++cc) a[i][cc] *= win;
        taps[i][0][0] = a[i][0]; taps[i][0][1] = a[i][1]; taps[i][1][0] = a[i][2]; taps[i][1][1] = a[i][3];
        ss0 += a[i][0] * a[i][0] + a[i][2] * a[i][2]; ss1 += a[i][1] * a[i][1] + a[i][3] * a[i][3];
    }
    ss0 = wave_sum(ss0); ss1 = wave_sum(ss1);
    if (lane == 0) { red[wave * 2] = ss0; red[wave * 2 + 1] = ss1; }
    __syncthreads();
    float t0 = 0.f, t1 = 0.f;
#pragma unroll
    for (int w = 0; w < 8; ++w) { t0 += red[w * 2]; t1 += red[w * 2 + 1]; }
    const float n0 = rsqrtf(t0 + EPS), n1 = rsqrtf(t1 + EPS);
#pragma unroll
    for (int i = 0; i < 4; ++i) { taps[i][0][0] *= n0; taps[i][1][0] *= n0; taps[i][0][1] *= n1; taps[i][1][1] *= n1; }
    __syncthreads();
}
__device__ __forceinline__ void hyena_taps_block(const Ctx& p, LAS unsigned char* lds) {
    const int tid = p.tid, lane = tid & 63, wave = __builtin_amdgcn_readfirstlane(tid >> 6), fr = lane & 15, fq = lane >> 4;
    LAS float* w4s = (LAS float*)lds;
    LAS float* red = (LAS float*)(lds + 4096);
    const float* w4 = p.in[I_FW4]; const float* H3 = (const float*)(p.ws + WS_H3); bf16_t* F = (bf16_t*)(p.ws + WS_FILT);
    for (int i = tid; i < 1024; i += NTHREADS) { const int col = i >> 6, k = i & 63, q = col >> 2, cc = col & 3; const int c = p.bid + p.nblk * q;
        w4s[i] = (c < DM) ? w4[(size_t)k * 4096 + (cc >> 1) * 2048 + (cc & 1) * 1024 + c] : 0.f; }
    __syncthreads();
    bf16x8 bfr[2];
#pragma unroll
    for (int ks = 0; ks < 2; ++ks) { const f32x4 b0 = *(const LAS f32x4*)(w4s + fr * 64 + 32 * ks + 8 * fq), b1 = *(const LAS f32x4*)(w4s + fr * 64 + 32 * ks + 8 * fq + 4);
        const u32x4 w = {cvtpk(b0[0], b0[1]), cvtpk(b0[2], b0[3]), cvtpk(b1[0], b1[1]), cvtpk(b1[2], b1[3])}; bfr[ks] = __builtin_bit_cast(bf16x8, w); }
    f32x4 acc[16];
#pragma unroll
    for (int g = 0; g < 4; ++g) {
        f32x4 hv[4][2][2];
#pragma unroll
        for (int j = 0; j < 4; ++j)
#pragma unroll
            for (int ks = 0; ks < 2; ++ks) { const float* hp = H3 + (size_t)(16 * (wave * 16 + 4 * g + j) + fr) * 64 + 32 * ks + 8 * fq; hv[j][ks][0] = *(const f32x4*)hp; hv[j][ks][1] = *(const f32x4*)(hp + 4); }
#pragma unroll
        for (int j = 0; j < 4; ++j) { f32x4 a = {0.f, 0.f, 0.f, 0.f};
#pragma unroll
            for (int ks = 0; ks < 2; ++ks) { const f32x4 h0 = hv[j][ks][0], h1 = hv[j][ks][1];
                const u32x4 w = {cvtpk(h0[0], h0[1]), cvtpk(h0[2], h0[3]), cvtpk(h1[0], h1[1]), cvtpk(h1[2], h1[3])};
                a = __builtin_amdgcn_mfma_f32_16x16x32_bf16(__builtin_bit_cast(bf16x8, w), bfr[ks], a, 0, 0, 0); }
            acc[4 * g + j] = a; }
        __builtin_amdgcn_sched_barrier(0);
    }
    const int q = fr >> 2, o = fr & 1, dir = (fr >> 1) & 1, c = p.bid + p.nblk * q;
    const float dmin = -3.0701134573253940f, dmax = -15.350567286626970f;
    const float delta = fabsf(dmin + (float)c * ((dmax - dmin) / 1023.0f));
    const float r1 = expf(-delta / 2048.0f);
    float ssq = 0.f;
#pragma unroll
    for (int tt = 0; tt < 16; ++tt) { const int tb = 16 * (16 * wave + tt) + 4 * fq; float win = expf(-((float)tb / 2048.0f) * delta);
#pragma unroll
        for (int e = 0; e < 4; ++e) { const float v = acc[tt][e] * win; acc[tt][e] = v; ssq += v * v; win *= r1; } }
    ssq += __shfl_xor(ssq, 16); ssq += __shfl_xor(ssq, 32); ssq += __shfl_xor(ssq, 2);
    if (fq == 0 && dir == 0) red[wave * 8 + q * 2 + o] = ssq;
    __syncthreads();
    float tot = 0.f;
#pragma unroll
    for (int w = 0; w < 8; ++w) tot += red[w * 8 + q * 2 + o];
    const float nrm = rsqrtf(tot + EPS);
    LAS bf16_t* st = (LAS bf16_t*)(lds + 8192) + (q * 2 + o) * 4096 + 2048;
#pragma unroll
    for (int tt = 0; tt < 16; ++tt)
#pragma unroll
        for (int e = 0; e < 4; ++e) { const int t = 16 * (16 * wave + tt) + 4 * fq + e; const bf16_t v = (bf16_t)f2bf(acc[tt][e] * nrm);
            if (dir == 0) st[-t] = v; else if (t > 0) st[t] = v; }
    __syncthreads();
#pragma unroll
    for (int j = 0; j < 8; ++j) { const int idx = tid + 512 * j, arr = idx >> 9, off = idx & 511; const int cq = p.bid + p.nblk * (arr >> 1);
        const u32x4 w = *(const LAS u32x4*)(lds + 8192 + arr * 8192 + off * 16);
        if (cq < DM) *(u32x4*)(F + (size_t)(cq * 2 + (arr & 1)) * 4096 + 8 * off) = w; }
    __builtin_amdgcn_fence(__ATOMIC_RELEASE, "workgroup");
    asm volatile("s_waitcnt vmcnt(0)" ::: "memory");
    __syncthreads();
    __builtin_amdgcn_fence(__ATOMIC_ACQUIRE, "workgroup");
}
__device__ __forceinline__ float sconv_at(const bf16_t* zr, int b, int n, float w0, float w1, float w2, float cb) {
    const bf16_t* q = zr + b * SEQ + n;
    const float l = n > 0 ? bf2f(q[-1]) : 0.f, m = bf2f(q[0]), r = n < SEQ - 1 ? bf2f(q[1]) : 0.f;
    return cb + w0 * l + w1 * m + w2 * r;
}

__device__ __forceinline__ void phase_nconv_filt(const Ctx& p, LAS unsigned char* lds) {
    bf16_t* F = (bf16_t*)(p.ws + WS_FILT);
    for (int c = p.bid; c < DM; c += p.nblk) {
        float taps[4][2][2];
        hyena_taps(p, c, lds, taps);
#pragma unroll
        for (int i = 0; i < 4; ++i) { const int t = p.tid + 512 * i;
#pragma unroll
            for (int o = 0; o < 2; ++o) { bf16_t* f = F + (size_t)(c * 2 + o) * 4096;
                f[2048 - t] = (bf16_t)f2bf(taps[i][0][o]);
                if (t > 0) f[2048 + t] = (bf16_t)f2bf(taps[i][1][o]); } }
    }
}
__device__ __forceinline__ void phase_nconv_u0(const Ctx& p) {
    const bf16_t* ZT = (const bf16_t*)(p.ws + WS_ZT); bf16_t* U0 = (bf16_t*)(p.ws + WS_U0T);
    const float* cw = p.in[I_HCW]; const float* cb = p.in[I_HCB];
    for (size_t idx = (size_t)p.bid * NTHREADS + p.tid; idx < (size_t)DM * ML; idx += (size_t)p.nblk * NTHREADS) {
        const int c = (int)(idx >> 15), bn = (int)(idx & 32767), b = bn >> 11, n = bn & 2047; const int ch = 2048 + c;
        U0[idx] = (bf16_t)f2bf(sconv_at(ZT + (size_t)ch * ML, b, n, cw[ch], cw[3072 + ch], cw[6144 + ch], cb[ch]));
    }
}
__device__ __forceinline__ void phase_nconv_pass(const Ctx& p, int o) {
    const bf16_t* ZT = (const bf16_t*)(p.ws + WS_ZT); const bf16_t* F = (const bf16_t*)(p.ws + WS_FILT);
    const bf16_t* U = (const bf16_t*)(p.ws + (o == 0 ? WS_U0T : WS_Y1T)); bf16_t* Y = (bf16_t*)(p.ws + (o == 0 ? WS_Y1T : WS_Y2T));
    const float* cw = p.in[I_HCW]; const float* cb = p.in[I_HCB]; const float* skip = p.in[I_HSKIP];
    for (size_t idx = (size_t)p.bid * NTHREADS + p.tid; idx < (size_t)DM * ML; idx += (size_t)p.nblk * NTHREADS) {
        const int c = (int)(idx >> 15), bn = (int)(idx & 32767), b = bn >> 11, n = bn & 2047;
        const bf16_t* u = U + (size_t)c * ML + b * SEQ; const bf16_t* f = F + (size_t)(c * 2 + o) * 4096 + 2048 - n;
        float acc = 0.f;
        for (int m = 0; m < SEQ; ++m) acc += bf2f(f[m]) * bf2f(u[m]);
        acc += skip[o * DM + c] * bf2f(u[n]);
        const int ch = o * 1024 + c;
        const float gate = sconv_at(ZT + (size_t)ch * ML, b, n, cw[ch], cw[3072 + ch], cw[6144 + ch], cb[ch]);
        Y[idx] = (bf16_t)f2bf(gate * acc);
    }
}

constexpr int CV_USTRIDE = 4112;
constexpr int CV_U = 0;
constexpr int CV_CP = 65792, CV_CPSTRIDE = 8208;
static_assert(CV_CP + 8 * CV_CPSTRIDE <= LDS_BYTES, "conv LDS map");

__device__ __forceinline__ void conv_build_copies(const int tid, LAS unsigned char* lds, const bf16_t* rev) {
    const u32x4 cur = *(const u32x4*)(rev + 8 * tid);
    u32x4 prv = {0u, 0u, 0u, 0u};
    if (tid > 0) prv = *(const u32x4*)(rev + 8 * tid - 8);
    const unsigned W[8] = {prv.x, prv.y, prv.z, prv.w, cur.x, cur.y, cur.z, cur.w};
#pragma unroll
    for (int rho = 0; rho < 8; ++rho) {
        unsigned o[4];
#pragma unroll
        for (int d = 0; d < 4; ++d) { const int e0 = 8 - rho + 2 * d;
            o[d] = (e0 & 1) ? __builtin_amdgcn_alignbit(W[(e0 >> 1) + 1], W[e0 >> 1], 16) : W[e0 >> 1]; }
        *(LAS u32x4*)(lds + CV_CP + rho * CV_CPSTRIDE + 16 * tid) = (u32x4){o[0], o[1], o[2], o[3]};
    }
}
__device__ __forceinline__ void sconv4(const bf16_t* zr, int n, float w0, float w1, float w2, float cb, float (&g)[4]) {
    const u32x2 w = *(const u32x2*)(zr + n);
    const float l = n > 0 ? bf2f(zr[n - 1]) : 0.f, r = n + 4 < SEQ ? bf2f(zr[n + 4]) : 0.f;
    const float x[6] = {l, bflo(w.x), bfhi(w.x), bflo(w.y), bfhi(w.y), r};
#pragma unroll
    for (int e = 0; e < 4; ++e) g[e] = cb + w0 * x[e] + w1 * x[e + 1] + w2 * x[e + 2];
}
__device__ __forceinline__ void conv_mma(const int tid, LAS unsigned char* lds, f32x4 (&acc)[16]) {
    const int lane = tid & 63, wave = __builtin_amdgcn_readfirstlane(tid >> 6);
#pragma unroll
    for (int i = 0; i < 16; ++i) acc[i] = (f32x4){0.f, 0.f, 0.f, 0.f};
    const LAS unsigned char* ab = lds + CV_CP + (lane & 7) * CV_CPSTRIDE + 2 * (2048 - 8 * ((lane & 15) >> 3) + 8 * (lane >> 4)) - 32 * (16 * wave);
    const LAS unsigned char* ub = lds + CV_U + (lane & 15) * CV_USTRIDE + 16 * (lane >> 4);
    bf16x8 w0, w1, w2, w3, w4, w5, w6, w7, w8, w9, w10, w11, w12, w13, w14, w15;
#define CV_LD(i) (*(const LAS bf16x8*)(ab - 32 * (i)))
    w0 = CV_LD(0); w1 = CV_LD(1); w2 = CV_LD(2); w3 = CV_LD(3); w4 = CV_LD(4); w5 = CV_LD(5); w6 = CV_LD(6); w7 = CV_LD(7);
    w8 = CV_LD(8); w9 = CV_LD(9); w10 = CV_LD(10); w11 = CV_LD(11); w12 = CV_LD(12); w13 = CV_LD(13); w14 = CV_LD(14); w15 = CV_LD(15);
#undef CV_LD
#define CV_MF(i, W) acc[i] = __builtin_amdgcn_mfma_f32_16x16x32_bf16(W, uf, acc[i], 0, 0, 0)
#define CV_STEP(jj, A0, A1, A2, A3, A4, A5, A6, A7, A8, A9, A10, A11, A12, A13, A14, A15) do { \
        const int j = J * 8 + (jj); \
        const int jn = (j + 1 < 64) ? (j + 1) : j; \
        const bf16x8 ufn = *(const LAS bf16x8*)(ub + 64 * jn); \
        const bf16x8 n0 = *(const LAS bf16x8*)(ab + 64 * jn), n1 = *(const LAS bf16x8*)(ab + 64 * jn - 32); \
        CV_MF(0, A0); CV_MF(1, A1); CV_MF(2, A2); CV_MF(3, A3); CV_MF(4, A4); CV_MF(5, A5); CV_MF(6, A6); CV_MF(7, A7); \
        CV_MF(8, A8); CV_MF(9, A9); CV_MF(10, A10); CV_MF(11, A11); CV_MF(12, A12); CV_MF(13, A13); CV_MF(14, A14); CV_MF(15, A15); \
        A14 = n0; A15 = n1; uf = ufn; } while (0)
    bf16x8 uf = *(const LAS bf16x8*)ub;
    for (int J = 0; J < 8; ++J) {
        CV_STEP(0, w0, w1, w2, w3, w4, w5, w6, w7, w8, w9, w10, w11, w12, w13, w14, w15);
        CV_STEP(1, w14, w15, w0, w1, w2, w3, w4, w5, w6, w7, w8, w9, w10, w11, w12, w13);
        CV_STEP(2, w12, w13, w14, w15, w0, w1, w2, w3, w4, w5, w6, w7, w8, w9, w10, w11);
        CV_STEP(3, w10, w11, w12, w13, w14, w15, w0, w1, w2, w3, w4, w5, w6, w7, w8, w9);
        CV_STEP(4, w8, w9, w10, w11, w12, w13, w14, w15, w0, w1, w2, w3, w4, w5, w6, w7);
        CV_STEP(5, w6, w7, w8, w9, w10, w11, w12, w13, w14, w15, w0, w1, w2, w3, w4, w5);
        CV_STEP(6, w4, w5, w6, w7, w8, w9, w10, w11, w12, w13, w14, w15, w0, w1, w2, w3);
        CV_STEP(7, w2, w3, w4, w5, w6, w7, w8, w9, w10, w11, w12, w13, w14, w15, w0, w1);
    }
#undef CV_STEP
#undef CV_MF
}
template <int STRIDE, bool W16>
__device__ __forceinline__ void sconv_row_to_lds(const int tid, const bf16_t* zrow, float w0, float w1, float w2, float bb, LAS unsigned char* dst) {
    const int b = tid >> 5, m0 = (tid & 31) * 64; const bf16_t* zr = zrow + b * SEQ;
    u32x4 w[8];
#pragma unroll
    for (int k8 = 0; k8 < 8; ++k8) w[k8] = *(const u32x4*)(zr + m0 + 8 * k8);
    float prev = m0 > 0 ? bf2f(zr[m0 - 1]) : 0.f;
    const float last = m0 + 64 < SEQ ? bf2f(zr[m0 + 64]) : 0.f;
#pragma unroll
    for (int k8 = 0; k8 < 8; ++k8) {
        const float nxt = k8 < 7 ? bflo(w[k8 < 7 ? k8 + 1 : 7].x) : last;
        const float x[10] = {prev, bflo(w[k8].x), bfhi(w[k8].x), bflo(w[k8].y), bfhi(w[k8].y), bflo(w[k8].z), bfhi(w[k8].z), bflo(w[k8].w), bfhi(w[k8].w), nxt};
        float y[8];
#pragma unroll
        for (int e = 0; e < 8; ++e) y[e] = bb + w0 * x[e] + w1 * x[e + 1] + w2 * x[e + 2];
        const u32x4 o = {cvtpk(y[0], y[1]), cvtpk(y[2], y[3]), cvtpk(y[4], y[5]), cvtpk(y[6], y[7])};
        LAS unsigned char* d = dst + b * STRIDE + 2 * (m0 + 8 * k8);
        if (W16) *(LAS u32x4*)d = o; else { *(LAS u32x2*)d = (u32x2){o.x, o.y}; *(LAS u32x2*)(d + 8) = (u32x2){o.z, o.w}; }
        prev = x[8];
    }
}
constexpr int CV_GSTRIDE = 4104;
static_assert(16 * CV_GSTRIDE <= 8 * CV_CPSTRIDE, "gate image fits the copies region");
__device__ __forceinline__ void phase_conv(const Ctx& p, LAS unsigned char* lds) {
    const bf16_t* ZT = (const bf16_t*)(p.ws + WS_ZT); bf16_t* Y2T = (bf16_t*)(p.ws + WS_Y2T); const bf16_t* F = (const bf16_t*)(p.ws + WS_FILT);
    const float* cw = p.in[I_HCW]; const float* cb = p.in[I_HCB]; const float* skip = p.in[I_HSKIP];
    hyena_taps_block(p, lds);
    for (int c = p.bid; c < DM; c += p.nblk) {
        int tid = p.tid; asm volatile("" : "+v"(tid));
        const int lane = tid & 63, wave = __builtin_amdgcn_readfirstlane(tid >> 6);
        const int b = lane & 15, nq = 256 * wave + 4 * (lane >> 4);
        LAS unsigned char* Ul = lds + CV_U; LAS unsigned char* Gl = lds + CV_CP;
        { const int ch = 2048 + c; sconv_row_to_lds<CV_USTRIDE, true>(tid, ZT + (size_t)ch * ML, cw[ch], cw[3072 + ch], cw[6144 + ch], cb[ch], Ul); }
        conv_build_copies(tid, lds, F + (size_t)(c * 2 + 0) * 4096);
        __syncthreads();
        f32x4 acc[16];
#pragma unroll 1
        for (int o = 0; o < 2; ++o) {
            conv_mma(tid, lds, acc);
            __syncthreads();
            { const int ch = o * 1024 + c; sconv_row_to_lds<CV_GSTRIDE, false>(tid, ZT + (size_t)ch * ML, cw[ch], cw[3072 + ch], cw[6144 + ch], cb[ch], Gl); }
            __syncthreads();
            { const float sk = skip[o * DM + c];
#pragma unroll
              for (int i = 0; i < 16; ++i) { const int n = nq + 16 * i; LAS u32x2* up = (LAS u32x2*)(Ul + b * CV_USTRIDE + 2 * n);
                  const u32x2 uw = *up, gw = *(const LAS u32x2*)(Gl + b * CV_GSTRIDE + 2 * n);
                  const float u[4] = {bflo(uw.x), bfhi(uw.x), bflo(uw.y), bfhi(uw.y)}, g[4] = {bflo(gw.x), bfhi(gw.x), bflo(gw.y), bfhi(gw.y)};
                  float y[4];
#pragma unroll
                  for (int e = 0; e < 4; ++e) y[e] = g[e] * (acc[i][e] + sk * u[e]);
                  *up = (u32x2){cvtpk(y[0], y[1]), cvtpk(y[2], y[3])}; } }
            __syncthreads();
            if (o == 0) { conv_build_copies(tid, lds, F + (size_t)(c * 2 + 1) * 4096); __syncthreads(); }
        }
        { const int bb_ = tid >> 5, m0 = (tid & 31) * 64; bf16_t* dst = Y2T + (size_t)c * ML + bb_ * SEQ + m0;
#pragma unroll
          for (int k8 = 0; k8 < 8; ++k8) *(u32x4*)(dst + 8 * k8) = *(const LAS u32x4*)(Ul + bb_ * CV_USTRIDE + 2 * (m0 + 8 * k8)); }
        __syncthreads();
    }
}

__device__ __forceinline__ void phase_transpose(const Ctx& p, LAS unsigned char* lds) {
    const int tid = p.tid, lane = tid & 63, wave = __builtin_amdgcn_readfirstlane(tid >> 6);
    const bf16_t* src = (const bf16_t*)(p.ws + WS_Y2T); bf16_t* dst = (bf16_t*)(p.ws + WS_Y2);
    LAS bf16_t* tile = (LAS bf16_t*)(lds + wave * 16384);
    const int gw = p.bid * NWAVES + wave, ngw = p.nblk * NWAVES;
    for (int it = gw; it < (DM / 64) * (ML / 64); it += ngw) {
        const int cb = it & 15, tb = it >> 4, c0 = cb * 64, t0 = tb * 64;
#pragma unroll
        for (int i = 0; i < 8; ++i) { const int r = 8 * i + (lane >> 3), ch = lane & 7;
            const u32x4 w = *(const u32x4*)(src + (size_t)(c0 + r) * ML + t0 + 8 * ch);
            LAS unsigned* d = (LAS unsigned*)(tile + r * 66 + 8 * ch); d[0] = w.x; d[1] = w.y; d[2] = w.z; d[3] = w.w; }
        asm volatile("s_waitcnt lgkmcnt(0)" ::: "memory");
#pragma unroll
        for (int i = 0; i < 8; ++i) { const int t = 8 * i + (lane >> 3), ch = lane & 7; unsigned short e[8];
#pragma unroll
            for (int k = 0; k < 8; ++k) e[k] = tile[(8 * ch + k) * 66 + t];
            u32x4 w; w.x = e[0] | ((unsigned)e[1] << 16); w.y = e[2] | ((unsigned)e[3] << 16); w.z = e[4] | ((unsigned)e[5] << 16); w.w = e[6] | ((unsigned)e[7] << 16);
            *(u32x4*)(dst + (size_t)(t0 + t) * DM + c0 + 8 * ch) = w; }
        asm volatile("s_waitcnt lgkmcnt(0)" ::: "memory");
    }
}

#define XB_TMO      128
#define XB_XCNT(j)  (256  + 64 * (j))
#define XB_XSUB(j)  (1280 + 64 * (j))
#define XB_XGEN(j)  (2304 + 64 * (j))
#define XB_TOP      3328
#define XB_TOPGEN   3392
#define XCD_BAR_WORDS 3456
#define XB_SPIN_CAP (1u << 18)
__device__ __forceinline__ unsigned xb_ld(unsigned* p)              { return __hip_atomic_load(p, __ATOMIC_RELAXED, __HIP_MEMORY_SCOPE_AGENT); }
__device__ __forceinline__ unsigned xb_add(unsigned* p, unsigned v) { return __hip_atomic_fetch_add(p, v, __ATOMIC_RELAXED, __HIP_MEMORY_SCOPE_AGENT); }
__device__ __forceinline__ unsigned xb_xcc_id() { return (unsigned)__builtin_amdgcn_s_getreg((3 << 11) | 20) & 0xFu; }
#define XB_SPIN(cond, bar) do { unsigned _sp = 0; while (cond) { __builtin_amdgcn_s_sleep(1); \
    if ((++_sp & 255u) == 0u) { if (xb_ld(&(bar)[XB_TMO])) break; if (_sp > XB_SPIN_CAP) { atomicAdd(&(bar)[XB_TMO], 1u); break; } } } } while (0)
struct XcdBarrier { unsigned* bar; unsigned x; volatile LAS unsigned* st; };
__device__ __forceinline__ XcdBarrier xcd_barrier_post(unsigned* bar, volatile LAS unsigned* st) {
    XcdBarrier b; b.bar = bar; b.x = xb_xcc_id(); b.st = st;
    if (threadIdx.x == 0) (void)xb_add(&bar[XB_XCNT(b.x)], 1u);
    return b;
}
__device__ __forceinline__ void xcd_barrier_complete(unsigned* bar, unsigned x, unsigned& nloc, unsigned& nx) {
    const unsigned G = gridDim.x * gridDim.y * gridDim.z;
    unsigned sum, cnt, mine, sp = 0u;
    for (;;) {
        sum = 0u; cnt = 0u; mine = 0u;
#pragma unroll
        for (unsigned j = 0; j < 16; ++j) { const unsigned c = xb_ld(&bar[XB_XCNT(j)]); sum += c; cnt += (c > 0u) ? 1u : 0u; mine = (j == x) ? c : mine; }
        if (sum == G) break;
        __builtin_amdgcn_s_sleep(1);
        if ((++sp & 255u) == 0u) { if (xb_ld(&bar[XB_TMO])) break; if (sp > XB_SPIN_CAP) { atomicAdd(&bar[XB_TMO], 1u); break; } }
    }
    nloc = mine > 0u ? mine : 1u; nx = cnt > 0u ? cnt : 1u;
}
__device__ __forceinline__ void xcd_barrier(const XcdBarrier& b) {
    asm volatile("s_waitcnt vmcnt(0)" ::: "memory");
    __syncthreads();
    if (threadIdx.x == 0) {
        unsigned* bar = b.bar;
        __builtin_amdgcn_s_waitcnt(0);
        unsigned nloc = b.st[0], nx = b.st[1];
        if (nloc == 0u) { xcd_barrier_complete(bar, b.x, nloc, nx); b.st[0] = nloc; b.st[1] = nx; }
        const unsigned old = xb_add(&bar[XB_XSUB(b.x)], 1u);
        const unsigned gen = old / nloc;
        if (old + 1u == (gen + 1u) * nloc) {
            __builtin_amdgcn_fence(__ATOMIC_RELEASE, "agent");
            asm volatile("s_waitcnt vmcnt(0)" ::: "memory");
            const unsigned og = xb_add(&bar[XB_TOP], 1u);
            const unsigned tg = og / nx;
            if (og + 1u == (tg + 1u) * nx) xb_add(&bar[XB_TOPGEN], 1u);
            else XB_SPIN(xb_ld(&bar[XB_TOPGEN]) == tg, bar);
            __builtin_amdgcn_fence(__ATOMIC_ACQUIRE, "agent");
            xb_add(&bar[XB_XGEN(b.x)], 1u);
            asm volatile("s_waitcnt vmcnt(0)" ::: "memory");
        } else {
            XB_SPIN(xb_ld(&bar[XB_XGEN(b.x)]) == gen, bar);
            __builtin_amdgcn_fence(__ATOMIC_ACQUIRE, "agent");
            asm volatile("s_waitcnt vmcnt(0)" ::: "memory");
        }
    }
    __syncthreads();
}
constexpr int LDS_CTL_OFF = LDS_BYTES - 64;
constexpr size_t CTL_BAR_OFF = 16384;
constexpr size_t CTL_STAMP_OFF = 65536;
constexpr size_t CTL_ZERO_BYTES = 131072;

enum { P_PRO = 0, P_MOD1_0, P_GEMM_IN, P_ZPOST, P_GEMM_QKV, P_ATTN, P_GEMM_OUT0, P_MOD2_0, P_MLP_UP0, P_MLP_DN0,
       P_MOD1_1, P_GEMM_HIN, P_CONV, P_TRANS, P_GEMM_OUT1, P_MOD2_1, P_MLP_UP1, P_MLP_DN1, P_FINAL,
       P_NC_FILT, P_NC_U0, P_NC_A, P_NC_B, P_NA_Q, P_NONE };
__host__ __device__ __forceinline__ int prog(int i) {
    int k = 0;
#define PRG(x) do { if (i == k) return (x); ++k; } while (0)
    PRG(P_PRO); PRG(P_MOD1_0); PRG(P_GEMM_IN); PRG(P_ZPOST); PRG(P_GEMM_QKV);
#if NAIVE_ATTN
    PRG(P_NA_Q);
#endif
    PRG(P_ATTN); PRG(P_GEMM_OUT0); PRG(P_MLP_UP0); PRG(P_MLP_DN0); PRG(P_GEMM_HIN);
#if NAIVE_CONV
    PRG(P_NC_FILT); PRG(P_NC_U0); PRG(P_NC_A); PRG(P_NC_B);
#else
    PRG(P_CONV);
#endif
    PRG(P_TRANS); PRG(P_GEMM_OUT1); PRG(P_MLP_UP1); PRG(P_MLP_DN1); PRG(P_FINAL);
#undef PRG
    return P_NONE;
}
constexpr int N_PROG = 16 + (NAIVE_ATTN ? 1 : 0) + (NAIVE_CONV ? 3 : 0);

__device__ __forceinline__ bool gemm_job(const Ctx& p, int ph, int jj, GemmJob& J) {
    unsigned char* ws = p.ws;
    const float* MODL = (const float*)(ws + WS_MODL);
    size_t a = 0, b = 0, o = 0, sq = 0, shw = 0; int M = 0, N = 0, K = 0, kind = 0, ldc = 0, shw_ld = 0; bool has_o = true, has_sq = false;
    const float* base = nullptr; const float* gate = nullptr; const float* ng = nullptr; const float* nsc = nullptr;
    if (jj == 0) {
        if (ph == P_GEMM_IN) { a = WS_HL; b = WS_WIN; o = WS_Z; M = MT; N = ZW; K = DM; ldc = ZW; }
        else if (ph == P_GEMM_QKV) { a = WS_CQN; b = WS_WQB; o = WS_QM; M = ML; N = 768; K = 384; ldc = 768; }
        else if (ph == P_GEMM_OUT0) { a = WS_O; b = WS_WOUT; M = ML; N = DM; K = DM; kind = 2; base = p.in[I_X]; gate = MODL + 2 * DM;
            o = WS_HL; ng = p.in[I_N2G]; nsc = MODL + 4 * DM; sq = WS_SQA; has_sq = true; }
        else if (ph == P_MLP_UP0) { a = WS_HL; b = WS_W1_0; o = WS_HID; M = ML; N = 4096; K = DM; kind = 1; ldc = 4096; sq = WS_SQA; has_sq = true; shw = WS_SHW_UP0; shw_ld = 4096; }
        else if (ph == P_MLP_DN0) { a = WS_HID; b = WS_W2_0; M = ML; N = DM; K = 4096; kind = 2; gate = MODL + 5 * DM;
            o = WS_HL; ng = p.in[I_N1G] + DM; nsc = MODL + (size_t)16 * NMOD + DM; sq = WS_SQB; has_sq = true; }
        else if (ph == P_GEMM_HIN) { a = WS_HIN; b = WS_HL; o = WS_ZT; M = 3 * DM; N = ML; K = DM; ldc = ML; kind = 3; sq = WS_SQB; has_sq = true; shw = WS_SHW_HIN; shw_ld = 3 * DM; }
        else if (ph == P_GEMM_OUT1) { a = WS_Y2; b = WS_HOUT; M = ML; N = DM; K = DM; kind = 2; gate = MODL + (size_t)16 * NMOD + 2 * DM;
            o = WS_HL; ng = p.in[I_N2G] + DM; nsc = MODL + (size_t)16 * NMOD + 4 * DM; sq = WS_SQC; has_sq = true; }
        else if (ph == P_MLP_UP1) { a = WS_HL; b = WS_W1_1; o = WS_HID; M = ML; N = 4096; K = DM; kind = 1; ldc = 4096; sq = WS_SQC; has_sq = true; shw = WS_SHW_UP1; shw_ld = 4096; }
        else if (ph == P_MLP_DN1) { a = WS_HID; b = WS_W2_1; M = ML; N = DM; K = 4096; kind = 2; gate = MODL + (size_t)16 * NMOD + 5 * DM; has_o = false; sq = WS_SQA; has_sq = true; }
        else return false;
    } else {
        if (ph == P_GEMM_QKV) { a = WS_CKVN; b = WS_WKVB; o = WS_KV; M = MT; N = 1024; K = 256; ldc = 1024; }
        else return false;
    }
    J.A = (const bf16_t*)(ws + a); J.Bt = (const bf16_t*)(ws + b); J.M = M; J.N = N; J.K = K;
    J.E.kind = kind; J.E.O = has_o ? (bf16_t*)(ws + o) : nullptr; J.E.ldc = ldc; J.E.base = base; J.E.xres = (bf16_t*)(ws + WS_XW); J.E.gate = gate; J.E.ng = ng; J.E.nsc = nsc;
    J.E.sqp = has_sq ? (float*)(ws + sq) : nullptr; J.E.shw = (const float*)(ws + shw); J.E.shw_ld = shw_ld;
    return true;
}

__global__ void __launch_bounds__(NTHREADS, 2) fwd(Params kp) {
    extern __shared__ __attribute__((aligned(16))) unsigned char lds_raw[];
    LAS unsigned char* lds = (LAS unsigned char*)lds_raw;
    const int wave0 = __builtin_amdgcn_readfirstlane((int)threadIdx.x >> 6);
#if !CG_SYNC
    if (threadIdx.x < 16) ((volatile LAS unsigned*)(lds + LDS_CTL_OFF))[threadIdx.x] = 0u;
    __syncthreads();
    const XcdBarrier xbar = xcd_barrier_post((unsigned*)(kp.ws + WS_CTL + CTL_BAR_OFF), (volatile LAS unsigned*)(lds + LDS_CTL_OFF));
#endif
#if PROBE_A >= 0
#define STAMP(k) do { if (blockIdx.x == 0 && threadIdx.x == 0) ((unsigned long long*)(kp.ws + WS_CTL + CTL_STAMP_OFF))[(k)] = __builtin_amdgcn_s_memrealtime(); } while (0)
#else
#define STAMP(k) do { } while (0)
#endif
    for (int pi = kp.ph_lo; pi < kp.ph_hi; ++pi) {
        if (pi > kp.ph_lo) {
            STAMP(2 * pi - 1);
#if CG_SYNC
            cg::this_grid().sync();
#else
            xcd_barrier(xbar);
#endif
        }
        STAMP(2 * pi);
        const int ph = prog(pi);
        for (int rep = 0; rep < ((pi == REPEAT_PI) ? 2 : 1); ++rep) {
        if (rep) {
#if CG_SYNC
            cg::this_grid().sync();
#else
            xcd_barrier(xbar);
#endif
        }
        Ctx p;
        { int z_ = 0, lane_; asm volatile("v_mbcnt_lo_u32_b32 %0, -1, 0\n\tv_mbcnt_hi_u32_b32 %0, -1, %0" : "=v"(lane_)); asm volatile("" : "+s"(z_));
          const int tid_ = ((wave0 + z_) << 6) + lane_;
          const CAS cfptr_t* in_ = (const CAS cfptr_t*)kp.in + z_; float* out_ = kp.out + z_; unsigned char* ws_ = kp.ws + z_; const int bid_ = (int)blockIdx.x + z_, nb_ = (int)gridDim.x + z_;
          p.in = in_; p.out = out_; p.ws = ws_; p.tid = tid_; p.bid = bid_; p.nblk = nb_; }
        float* XW = (float*)(p.ws + WS_XW);
#ifndef NO_GEMM
        for (int jj = 0; jj < 2; ++jj) { GemmJob J; if (!gemm_job(p, ph, jj, J)) break; run_gemm(p, lds, J); }
#endif
        if (ph == P_PRO && PHON(P_PRO)) phase_prologue(p, lds, true, false);
        else if (ph == P_MOD1_0 && PHON(P_MOD1_0)) { phase_prologue(p, lds, false, true); phase_modulate(p, p.in[I_X], 0, p.in[I_N1G], 0, DM, true); }
        else if (ph == P_ZPOST && PHON(P_ZPOST)) { phase_zpost(p, lds); phase_shw(p); }
        else if (ph == P_ATTN && PHON(P_ATTN)) {
#if NAIVE_ATTN
            phase_attn_naive(p);
#else
            phase_attn(p, lds);
#endif
        }
        else if (ph == P_NA_Q && PHON(P_NA_Q)) phase_naive_qrope(p);
        else if (ph == P_CONV && PHON(P_CONV)) phase_conv(p, lds);
        else if (ph == P_NC_FILT && PHON(P_NC_FILT)) phase_nconv_filt(p, lds);
        else if (ph == P_NC_U0 && PHON(P_NC_U0)) phase_nconv_u0(p);
        else if (ph == P_NC_A && PHON(P_NC_A)) phase_nconv_pass(p, 0);
        else if (ph == P_NC_B && PHON(P_NC_B)) phase_nconv_pass(p, 1);
        else if (ph == P_TRANS && PHON(P_TRANS)) phase_transpose(p, lds);
        else if (ph == P_FINAL && PHON(P_FINAL)) phase_final(p);
        }
    }
#if PROBE_A >= 0
    STAMP(2 * kp.ph_hi - 1);
    __syncthreads();
    if (blockIdx.x == 0) {
        asm volatile("s_waitcnt vmcnt(0)" ::: "memory");
        const unsigned long long* st = (const unsigned long long*)(kp.ws + WS_CTL + CTL_STAMP_OFF);
        const float dta = (float)(st[PROBE_A_TO] - st[PROBE_A]) * 0.01f, dtb = (float)(st[PROBE_B_TO] - st[PROBE_B]) * 0.01f;
        for (int i = threadIdx.x + 1024; i < 1024 + 100000; i += NTHREADS) kp.out[i] += 0.001f * dtb;
        if (threadIdx.x == 0) kp.out[0] += 0.004f * dta;
    }
#endif
}

extern "C" void kernel_launch(void* const* d_in, const int* in_sizes, int n_in, void* d_out, int out_size, void* d_ws, size_t ws_size, hipStream_t stream) {
    static int ok = 0;
    if (ok == 0) {
        ok = 1;
        if (n_in != 32 || in_sizes[0] != ML * DM || out_size != ML * DM || ws_size < WS_END) { fprintf(stderr, "kernel_launch: unexpected shapes (n_in %d, in0 %d, out %d, ws %zu)\n", n_in, n_in > 0 ? in_sizes[0] : -1, out_size, ws_size); ok = -1; }
        int dev = 0, cus = 0;
        if (hipGetDevice(&dev) != hipSuccess || hipDeviceGetAttribute(&cus, hipDeviceAttributeMultiprocessorCount, dev) != hipSuccess || cus < GRID) { fprintf(stderr, "kernel_launch: needs %d CUs, device reports %d\n", GRID, cus); ok = -1; }
        if (hipFuncSetAttribute((const void*)fwd, hipFuncAttributeMaxDynamicSharedMemorySize, LDS_BYTES) != hipSuccess) { fprintf(stderr, "kernel_launch: hipFuncSetAttribute failed\n"); ok = -1; }
        int per_cu = 0;
        if (hipOccupancyMaxActiveBlocksPerMultiprocessor(&per_cu, (const void*)fwd, NTHREADS, LDS_BYTES) != hipSuccess || per_cu < 1) { fprintf(stderr, "kernel_launch: occupancy query says %d blocks per CU\n", per_cu); }
        (void)hipGetLastError();
    }
    if (ok < 0) return;
    Params p{};
    for (int i = 0; i < 32; ++i) p.in[i] = (const float*)d_in[i];
    p.out = (float*)d_out; p.ws = (unsigned char*)d_ws;
#if !CG_SYNC || PROBE_A >= 0
    if (hipMemsetAsync((char*)d_ws + WS_CTL, 0, CTL_ZERO_BYTES, stream) != hipSuccess) { fprintf(stderr, "kernel_launch: memset of the control words failed\n"); return; }
#endif
#if ONE_LAUNCH
    p.ph_lo = 0; p.ph_hi = N_PROG;
    void* args[] = {&p};
    hipError_t e = hipLaunchCooperativeKernel((const void*)fwd, dim3(GRID), dim3(NTHREADS), args, LDS_BYTES, stream);
    if (e != hipSuccess) fprintf(stderr, "kernel_launch: cooperative launch failed: %s\n", hipGetErrorString(e));
#else
    for (int i = 0; i < N_PROG; ++i) { p.ph_lo = i; p.ph_hi = i + 1; hipLaunchKernelGGL(fwd, dim3(GRID), dim3(NTHREADS), LDS_BYTES, stream, p); }
#endif
}
```

```cpp
#include <hip/hip_runtime.h>
#include <hip/hip_cooperative_groups.h>
#include <cstdio>
#include <cstdint>
namespace cg = cooperative_groups;

#ifndef ONE_LAUNCH
#define ONE_LAUNCH 1
#endif
#ifndef CG_SYNC
#define CG_SYNC 0
#endif
#ifndef REPEAT_PI
#define REPEAT_PI -1
#endif
#ifndef PROBE_A
#define PROBE_A -1
#endif
#ifndef ATTN_V1
#define ATTN_V1 0
#endif
#ifndef ZPOST_REF
#define ZPOST_REF 0
#endif
#ifndef SIMPLE_GEMM
#define SIMPLE_GEMM 0
#endif
#ifndef NAIVE_ATTN
#define NAIVE_ATTN 0
#endif
#ifndef NAIVE_CONV
#define NAIVE_CONV 0
#endif

#ifndef PHASE_MASK
#define PHASE_MASK 0xFFFFFFFFu
#endif
#define PHON(x) (((PHASE_MASK) >> (x)) & 1u)
#define LAS __attribute__((address_space(3)))
typedef unsigned short bf16_t;
typedef short bf16x8 __attribute__((ext_vector_type(8)));
typedef short s16x4 __attribute__((ext_vector_type(4)));
typedef float f32x2 __attribute__((ext_vector_type(2)));
typedef float f32x4 __attribute__((ext_vector_type(4)));
typedef float f32x16 __attribute__((ext_vector_type(16)));
typedef unsigned u32x2 __attribute__((ext_vector_type(2)));
typedef unsigned u32x4 __attribute__((ext_vector_type(4)));
typedef __bf16 bf16x2_t __attribute__((ext_vector_type(2)));

constexpr int NB = 16, SEQ = 2048, DM = 1024, CTXL = 256, TKEYS = CTXL + SEQ;
constexpr int ML = NB * SEQ;
constexpr int MC = NB * CTXL;
constexpr int MT = ML + MC;
constexpr int NMOD = 6 * DM;
constexpr int ZW = 1536;
constexpr float EPS = 1e-6f;
constexpr int NWAVES = 8, NTHREADS = 512, GRID = 256, NGW = GRID * NWAVES;
constexpr int LDS_BYTES = 155648;
constexpr int ZC_CQ = 0, ZC_CKV = 384, ZC_KR = 640, ZC_GQ = 672, ZC_GK = 1184, ZC_GV = 1312;
constexpr float LOG2E = 1.4426950408889634f;
constexpr float QSCALE_MLA = 0.10206207261596577f * LOG2E;
constexpr float QSCALE_GQA = 0.125f * LOG2E;

constexpr size_t MiB = 1ull << 20;
constexpr size_t WS_CTL = 0;
constexpr size_t WS_MODL = 1 * MiB;
constexpr size_t WS_MODC = 1 * MiB + 786432;
constexpr size_t WS_H3 = 2 * MiB;
constexpr size_t WS_SHW_UP0 = 3 * MiB, WS_SHW_HIN = 3 * MiB + 262144, WS_SHW_UP1 = 3 * MiB + 262144 + 196608;
constexpr size_t WS_SQA = 244 * MiB, WS_SQB = 246 * MiB, WS_SQC = 248 * MiB;
constexpr size_t WS_WIN = 4 * MiB, WS_WQB = 7 * MiB, WS_WKVB = 8 * MiB, WS_WOUT = 9 * MiB;
constexpr size_t WS_W1_0 = 11 * MiB, WS_W2_0 = 19 * MiB, WS_W1_1 = 27 * MiB, WS_W2_1 = 35 * MiB, WS_HIN = 43 * MiB, WS_HOUT = 49 * MiB;
constexpr size_t WS_XW = 52 * MiB;
constexpr size_t WS_HL = 180 * MiB;
constexpr size_t WS_Z = 252 * MiB, WS_CQN = 360 * MiB, WS_CKVN = 384 * MiB, WS_KROPE = 402 * MiB, WS_QG = 405 * MiB, WS_KG = 437 * MiB, WS_VG = 446 * MiB, WS_QM = 455 * MiB;
constexpr size_t WS_KV = WS_HL, WS_O = 252 * MiB;
constexpr size_t WS_HID = 252 * MiB;
constexpr size_t WS_ZT = 252 * MiB, WS_Y2T = WS_HL, WS_Y2 = 252 * MiB;
constexpr size_t WS_QMR = 316 * MiB;
constexpr size_t WS_FILT = 4 * MiB, WS_U0T = 444 * MiB, WS_Y1T = 380 * MiB;
constexpr size_t WS_END = 508 * MiB;

struct Params { const float* in[32]; float* out; unsigned char* ws; int ph_lo, ph_hi; };
#define CAS __attribute__((address_space(4)))
typedef const float* cfptr_t;
struct Ctx { const CAS cfptr_t* in; float* out; unsigned char* ws; int tid, bid, nblk; };

enum { I_X = 0, I_C, I_CTX, I_CCTX, I_WMOD, I_BMOD, I_N1G, I_N2G, I_W1, I_W2, I_AWIN, I_AQAG, I_AWQB, I_AKVAG, I_AWKVB, I_AQNG, I_AKNG, I_AWOUT,
       I_HWIN, I_HCW, I_HCB, I_FW1, I_FB1, I_FW2, I_FB2, I_FW3, I_FB3, I_FFREQ, I_FW4, I_HSKIP, I_HWOUT, I_FINALG };

__device__ __forceinline__ unsigned f2bf(float f) { unsigned u = __float_as_uint(f); return (u + 0x7fffu + ((u >> 16) & 1u)) >> 16; }
__device__ __forceinline__ float bf2f(unsigned h) { return __uint_as_float(h << 16); }
__device__ __forceinline__ unsigned cvtpk(float lo, float hi) { f32x2 v = {lo, hi}; bf16x2_t b = __builtin_convertvector(v, bf16x2_t); return __builtin_bit_cast(unsigned, b); }
__device__ __forceinline__ float wave_sum(float v) {
#pragma unroll
    for (int o = 1; o < 64; o <<= 1) v += __shfl_xor(v, o);
    return v;
}
__device__ __forceinline__ float fsin(float x) { return __builtin_amdgcn_sinf(__builtin_amdgcn_fractf(x * 0.15915494309189535f)); }
__device__ __forceinline__ float fcos(float x) { return __builtin_amdgcn_cosf(__builtin_amdgcn_fractf(x * 0.15915494309189535f)); }
__device__ __forceinline__ float inv_theta(float x) { return exp2f(-x * 13.287712379549449f); }
__device__ __forceinline__ float dpp_xor1(float v) { return __builtin_bit_cast(float, __builtin_amdgcn_update_dpp(0, __builtin_bit_cast(int, v), 0xB1, 0xF, 0xF, true)); }
__device__ __forceinline__ float dpp_xor2(float v) { return __builtin_bit_cast(float, __builtin_amdgcn_update_dpp(0, __builtin_bit_cast(int, v), 0x4E, 0xF, 0xF, true)); }
__device__ __forceinline__ float dpp_hmirror(float v) { return __builtin_bit_cast(float, __builtin_amdgcn_update_dpp(0, __builtin_bit_cast(int, v), 0x141, 0xF, 0xF, true)); }
__device__ __forceinline__ float sum8(float v) { v += dpp_xor1(v); v += dpp_xor2(v); v += dpp_hmirror(v); return v; }
__device__ __forceinline__ float bflo(unsigned w) { return __uint_as_float(w << 16); }
__device__ __forceinline__ float bfhi(unsigned w) { return __uint_as_float(w & 0xffff0000u); }

namespace pg8 {
constexpr int BM = 256, BK = 64, HALF = 128, HTB = HALF * BK * 2, STAGE_BYTES = 8 * HTB, NXCD = 8, WGM = 8;
__host__ __device__ __forceinline__ int lds_byte(int r, int c) { const int st = (r >> 4) * 2 + (c >> 5), rr = r & 15, cc = c & 31, ob = rr * 64 + cc * 2; return st * 1024 + (ob ^ (((ob >> 9) & 1) << 5)); }
__host__ __device__ __forceinline__ void stage_rc(int b, int& R, int& C) { const int st = b / 1024, sb = b % 1024, swz = sb ^ (((sb >> 9) & 1) << 5); R = (st >> 1) * 16 + swz / 64; C = (st & 1) * 32 + (swz % 64) / 2; }
__host__ __device__ __forceinline__ int perm32(int rho) { const int n = rho >> 4, i = rho & 15; return 8 * (i >> 2) + 4 * n + (i & 3); }

struct Unit { int pm, pn; };
struct Gemm { const bf16_t* A; const bf16_t* Bt; int M, N, K; };

struct StaticOrder {
    int nM, nN, nwg, G, c;
    __host__ __device__ void init(int M, int N, int G_, int c_) { nM = M / BM; nN = N / BM; nwg = nM * nN; G = G_; c = c_; }
    __host__ __device__ bool next(int i, Unit& u) const {
        const long L = (long)i * G + c; if (L >= nwg) return false;
        int wgid = (int)L; { const int q = nwg / NXCD, r = nwg % NXCD, xcd = wgid % NXCD, off = wgid / NXCD; wgid = (xcd < r ? xcd * (q + 1) : r * (q + 1) + (xcd - r) * q) + off; }
        const int nig = WGM * nN, gid = wgid / nig, fm = gid * WGM, gsz = (nM - fm) < WGM ? (nM - fm) : WGM;
        u.pm = fm + ((wgid % nig) % gsz); u.pn = (wgid % nig) / gsz; return true;
    }
    __device__ __forceinline__ void a_ready(const Unit&) const {}
    __device__ __forceinline__ void done(const Unit&) const {}
};

struct EpiAny {
    static constexpr bool AFTER_DRAIN = false;
    int kind; bf16_t* O; int ldc; const float* base; bf16_t* xres; const float* gate; const float* ng; const float* nsc; float* sqp; const float* shw; int shw_ld; LAS float* tab;
    __device__ __forceinline__ bool perm() const { return true; }
    __device__ __forceinline__ void operator()(const f32x4 (&acc)[2][2][4][2], const Unit& u, int ui, int wr, int wc, int fr, int fq) const {
        const int rt = wr * 64 + fr, ct = wc * 32 + 8 * fq;
        const int row0 = u.pm * BM + rt, col0 = u.pn * BM + ct;
        if (kind != 2) {
            const LAS float* T0 = tab + ui * 512; const LAS float* T1 = T0 + 256;
            f32x4 cs[2][2], ca[2][2];
#pragma unroll
            for (int bj = 0; bj < 2; ++bj)
#pragma unroll
                for (int h = 0; h < 2; ++h) { cs[bj][h] = (f32x4){1.f, 1.f, 1.f, 1.f}; ca[bj][h] = (f32x4){0.f, 0.f, 0.f, 0.f}; }
            if (kind == 1) {
#pragma unroll
                for (int bj = 0; bj < 2; ++bj) { ca[bj][0] = *(const LAS f32x4*)(T1 + ct + bj * HALF); ca[bj][1] = *(const LAS f32x4*)(T1 + ct + bj * HALF + 4); } }
            if (kind == 3) {
#pragma unroll
                for (int bj = 0; bj < 2; ++bj) { cs[bj][0] = *(const LAS f32x4*)(T0 + ct + bj * HALF); cs[bj][1] = *(const LAS f32x4*)(T0 + ct + bj * HALF + 4); } }
#pragma unroll
            for (int ai = 0; ai < 2; ++ai)
#pragma unroll
                for (int m = 0; m < 4; ++m) { const int rr = rt + ai * HALF + m * 16; bf16_t* rowp = O + (size_t)(u.pm * BM + rr) * ldc + col0;
                    float rs = 1.f, ra = 0.f;
                    if (kind == 1) rs = T0[rr];
                    if (kind == 3) ra = T1[rr];
#pragma unroll
                    for (int bj = 0; bj < 2; ++bj) { f32x4 v0 = acc[ai][bj][m][0], v1 = acc[ai][bj][m][1];
                        if (kind == 1) { v0 = v0 * rs + ca[bj][0]; v1 = v1 * rs + ca[bj][1];
#pragma unroll
                            for (int e = 0; e < 4; ++e) { const float a = fmaxf(v0[e], 0.f), b = fmaxf(v1[e], 0.f); v0[e] = a * a; v1[e] = b * b; } }
                        if (kind == 3) { v0 = v0 * cs[bj][0] + ra; v1 = v1 * cs[bj][1] + ra; }
                        u32x4 w; w.x = cvtpk(v0[0], v0[1]); w.y = cvtpk(v0[2], v0[3]); w.z = cvtpk(v1[0], v1[1]); w.w = cvtpk(v1[2], v1[3]);
                        *(u32x4*)(rowp + bj * HALF) = w; } }
        } else {
            const int b = (u.pm * BM) / SEQ;
            const float* gp = gate + (size_t)b * NMOD + col0;
            f32x4 gv[2][2], gs[2][2];
#pragma unroll
            for (int bj = 0; bj < 2; ++bj)
#pragma unroll
                for (int n = 0; n < 2; ++n) { gv[bj][n] = *(const f32x4*)(gp + bj * HALF + n * 4);
                    gs[bj][n] = (f32x4){0.f, 0.f, 0.f, 0.f};
                    if (O) { const f32x4 g4 = *(const f32x4*)(ng + col0 + bj * HALF + n * 4), s4 = *(const f32x4*)(nsc + (size_t)b * NMOD + col0 + bj * HALF + n * 4); gs[bj][n] = g4 * (s4 + 1.0f); } }
#pragma unroll
            for (int ai = 0; ai < 2; ++ai)
#pragma unroll
                for (int m = 0; m < 4; ++m) { const int r = row0 + ai * HALF + m * 16; const size_t off = (size_t)r * DM + col0; float sq = 0.f;
#pragma unroll
                    for (int bj = 0; bj < 2; ++bj) {
                        f32x4 x0, x1;
                        if (base) { x0 = *(const f32x4*)(base + off + bj * HALF); x1 = *(const f32x4*)(base + off + bj * HALF + 4); }
                        else { const u32x4 xb = *(const u32x4*)(xres + off + bj * HALF); x0 = (f32x4){bflo(xb.x), bfhi(xb.x), bflo(xb.y), bfhi(xb.y)}; x1 = (f32x4){bflo(xb.z), bfhi(xb.z), bflo(xb.w), bfhi(xb.w)}; }
                        const f32x4 y0 = x0 + gv[bj][0] * acc[ai][bj][m][0], y1 = x1 + gv[bj][1] * acc[ai][bj][m][1];
                        { u32x4 w; w.x = cvtpk(y0[0], y0[1]); w.y = cvtpk(y0[2], y0[3]); w.z = cvtpk(y1[0], y1[1]); w.w = cvtpk(y1[2], y1[3]); *(u32x4*)(xres + off + bj * HALF) = w; }
                        sq += ((y0[0] * y0[0] + y0[1] * y0[1]) + (y0[2] * y0[2] + y0[3] * y0[3])) + ((y1[0] * y1[0] + y1[1] * y1[1]) + (y1[2] * y1[2] + y1[3] * y1[3]));
                        if (O) { const f32x4 a0 = y0 * gs[bj][0], a1 = y1 * gs[bj][1]; u32x4 w; w.x = cvtpk(a0[0], a0[1]); w.y = cvtpk(a0[2], a0[3]); w.z = cvtpk(a1[0], a1[1]); w.w = cvtpk(a1[2], a1[3]);
                            *(u32x4*)(O + off + bj * HALF) = w; } }
                    if (sqp) { sq += __shfl_xor(sq, 16); sq += __shfl_xor(sq, 32); if (fq == 0) sqp[(size_t)r * 16 + u.pn * 4 + wc] = sq; } }
        }
    }
};

template <class Epi, class Sched>
__device__ __forceinline__ void gemm_simple(const int tid, const Gemm g, const Sched& S, const Epi& E) {
    const int  wid = __builtin_amdgcn_readfirstlane(tid >> 6), lane = tid & 63, wr = wid >> 2, wc = wid & 3, fr = lane & 15, fq = lane >> 4;
    const int K = g.K;
    Unit u;
    for (int ui = 0; S.next(ui, u); ++ui) {
        f32x4 acc[2][2][4][2];
#pragma unroll
        for (int a = 0; a < 2; ++a)
#pragma unroll
            for (int b = 0; b < 2; ++b)
#pragma unroll
                for (int m = 0; m < 4; ++m)
#pragma unroll
                    for (int n = 0; n < 2; ++n) acc[a][b][m][n] = (f32x4){0.f, 0.f, 0.f, 0.f};
        const bf16_t* Ab = g.A + (size_t)(u.pm * BM + wr * 64 + fr) * K + fq * 8;
        const bf16_t* Bb = g.Bt + (size_t)(u.pn * BM + wc * 32) * K + fq * 8;
        for (int k0 = 0; k0 < K; k0 += 32) {
            bf16x8 At[2][4], Bf[2][2];
#pragma unroll
            for (int ai = 0; ai < 2; ++ai)
#pragma unroll
                for (int m = 0; m < 4; ++m) At[ai][m] = *(const bf16x8*)(Ab + (size_t)(ai * HALF + m * 16) * K + k0);
#pragma unroll
            for (int bj = 0; bj < 2; ++bj)
#pragma unroll
                for (int n = 0; n < 2; ++n) { const int rr = E.perm() ? perm32(16 * n + fr) : (16 * n + fr);
                    Bf[bj][n] = *(const bf16x8*)(Bb + (size_t)(bj * HALF + rr) * K + k0); }
#pragma unroll
            for (int ai = 0; ai < 2; ++ai)
#pragma unroll
                for (int bj = 0; bj < 2; ++bj)
#pragma unroll
                    for (int m = 0; m < 4; ++m)
#pragma unroll
                        for (int n = 0; n < 2; ++n) acc[ai][bj][m][n] = __builtin_amdgcn_mfma_f32_16x16x32_bf16(Bf[bj][n], At[ai][m], acc[ai][bj][m][n], 0, 0, 0);
        }
        E(acc, u, ui, wr, wc, fr, fq);
    }
}

template <class Epi, class Sched, bool ALIGN_EPI = true>
__device__ __forceinline__ void gemm_phase(const int tid, LAS unsigned char* lds, const Gemm g, const Sched& S, const Epi& E) {
    const int  wid = __builtin_amdgcn_readfirstlane(tid >> 6), lane = tid & 63, wr = wid >> 2, wc = wid & 3, fr = lane & 15, fq = lane >> 4;
    const int K = g.K, nt = K / BK;
    unsigned voffA[2], voffB[2];
#pragma unroll
    for (int i = 0; i < 2; ++i) { int R, C; stage_rc(tid * 16 + i * 8192, R, C); const int Rb = E.perm() ? ((R & ~31) + perm32(R & 31)) : R;
        voffA[i] = (unsigned)(R * K + C) * 2u; voffB[i] = (unsigned)(Rb * K + C) * 2u; }
    const size_t kstep = (size_t)(BK * 2);
    const size_t hstep = (size_t)HALF * K * 2;
    const size_t tstep = 2 * hstep;
    const unsigned ldsw = (unsigned)wid * 1024u;
    const int aoff = lds_byte(wr * 64 + fr, fq * 8), boff = lds_byte(wc * 32 + fr, fq * 8);
#define PG8_SA(b, h) (((b) * 2 + (h)) * HTB)
#define PG8_SB(b, h) ((4 + (b) * 2 + (h)) * HTB)
#define PG8_STAGE(bufoff, gbase, voff) do { _Pragma("unroll") for (int _i = 0; _i < 2; ++_i) \
        __builtin_amdgcn_global_load_lds((const unsigned*)((const char*)(gbase) + (voff)[_i]), (LAS unsigned*)(lds + (bufoff) + ldsw + _i * 8192), 16, 0, 0); } while (0)
#define PG8_LDA(dst, b, h) do { _Pragma("unroll") for (int m = 0; m < 4; ++m) _Pragma("unroll") for (int k = 0; k < 2; ++k) dst[m][k] = *(const LAS bf16x8*)(lds + PG8_SA(b, h) + aoff + m * 2048 + k * 1024); } while (0)
#define PG8_LDB(dst, b, h) do { _Pragma("unroll") for (int n = 0; n < 2; ++n) _Pragma("unroll") for (int k = 0; k < 2; ++k) dst[n][k] = *(const LAS bf16x8*)(lds + PG8_SB(b, h) + boff + n * 2048 + k * 1024); } while (0)
#define PG8_MMA(ai, bj, At, Bt) do { __builtin_amdgcn_s_setprio(1); _Pragma("unroll") for (int m = 0; m < 4; ++m) _Pragma("unroll") for (int n = 0; n < 2; ++n) _Pragma("unroll") for (int k = 0; k < 2; ++k) \
        acc[ai][bj][m][n] = __builtin_amdgcn_mfma_f32_16x16x32_bf16(Bt[n][k], At[m][k], acc[ai][bj][m][n], 0, 0, 0); __builtin_amdgcn_s_setprio(0); } while (0)
#define PG8_WAIT_V(n) asm volatile("s_waitcnt vmcnt(" #n ")" ::: "memory")
#define PG8_WAIT_L(n) asm volatile("s_waitcnt lgkmcnt(" #n ")" ::: "memory")
#define PG8_BAR __builtin_amdgcn_s_barrier()
#define PG8_SCHED __builtin_amdgcn_sched_barrier(0)
    Unit cur, nxt; int ui = 0;
    if (!S.next(0, cur)) return;
    f32x4 acc[2][2][4][2];
#pragma unroll
    for (int a = 0; a < 2; ++a)
#pragma unroll
        for (int b = 0; b < 2; ++b)
#pragma unroll
            for (int m = 0; m < 4; ++m)
#pragma unroll
                for (int n = 0; n < 2; ++n) acc[a][b][m][n] = (f32x4){0.f, 0.f, 0.f, 0.f};
    bf16x8 At[4][2], B0[2][2], B1[2][2];
    const char* cA = (const char*)g.A + (size_t)cur.pm * tstep; const char* cB = (const char*)g.Bt + (size_t)cur.pn * tstep;
    S.a_ready(cur);
    PG8_STAGE(PG8_SB(0, 0), cB, voffB); PG8_STAGE(PG8_SB(0, 1), cB + hstep, voffB); PG8_STAGE(PG8_SA(0, 0), cA, voffA); PG8_STAGE(PG8_SA(0, 1), cA + hstep, voffA);
    if (wr == 1) PG8_BAR;
    PG8_WAIT_V(2); PG8_BAR;
    PG8_STAGE(PG8_SB(1, 0), cB + kstep, voffB); PG8_STAGE(PG8_SA(1, 0), cA + kstep, voffA); PG8_STAGE(PG8_SB(1, 1), cB + hstep + kstep, voffB);
    PG8_WAIT_V(6); PG8_BAR;
    for (;;) {
        const bool has_next = S.next(ui + 1, nxt);
        const char* nA = has_next ? (const char*)g.A + (size_t)nxt.pm * tstep : cA; const char* nB = has_next ? (const char*)g.Bt + (size_t)nxt.pn * tstep : cB;
        for (int t = 0; t < nt; t += 2) {
            const bool last = (t == nt - 2);
            const char* a1 = cA + (size_t)(t + 1) * kstep;
            const char* a2 = last ? nA : cA + (size_t)(t + 2) * kstep; const char* b2 = last ? nB : cB + (size_t)(t + 2) * kstep;
            const char* a3 = a2 + kstep; const char* b3 = b2 + kstep;
            if (last && has_next) S.a_ready(nxt);
            PG8_LDB(B0, 0, 0); PG8_LDB(B1, 0, 1); PG8_SCHED; PG8_LDA(At, 0, 0); PG8_STAGE(PG8_SA(1, 1), a1 + hstep, voffA);
            PG8_WAIT_V(8); PG8_WAIT_L(0); PG8_BAR; PG8_MMA(0, 0, At, B0); PG8_MMA(0, 1, At, B1); PG8_BAR; PG8_SCHED;
            PG8_LDA(At, 0, 1); PG8_STAGE(PG8_SB(0, 0), b2, voffB); PG8_STAGE(PG8_SB(0, 1), b2 + hstep, voffB); PG8_STAGE(PG8_SA(0, 0), a2, voffA);
            PG8_WAIT_V(8); PG8_WAIT_L(0); PG8_BAR; PG8_MMA(1, 0, At, B0); PG8_MMA(1, 1, At, B1); PG8_BAR; PG8_SCHED;
            PG8_LDB(B0, 1, 0); PG8_LDB(B1, 1, 1); PG8_SCHED; PG8_LDA(At, 1, 0); PG8_STAGE(PG8_SA(0, 1), a2 + hstep, voffA);
            PG8_WAIT_V(8); PG8_WAIT_L(0); PG8_BAR; PG8_MMA(0, 0, At, B0); PG8_MMA(0, 1, At, B1); PG8_BAR; PG8_SCHED;
            PG8_LDA(At, 1, 1); PG8_STAGE(PG8_SB(1, 0), b3, voffB); PG8_STAGE(PG8_SB(1, 1), b3 + hstep, voffB); PG8_STAGE(PG8_SA(1, 0), a3, voffA);
            PG8_WAIT_V(8); PG8_WAIT_L(0); PG8_BAR; PG8_MMA(1, 0, At, B0); PG8_MMA(1, 1, At, B1); PG8_BAR; PG8_SCHED;
        }
        if constexpr (ALIGN_EPI) { if (wr == 0) PG8_BAR; }
        E(acc, cur, ui, wr, wc, fr, fq); S.done(cur);
        if (!has_next) break;
#pragma unroll
        for (int a = 0; a < 2; ++a)
#pragma unroll
            for (int b = 0; b < 2; ++b)
#pragma unroll
                for (int m = 0; m < 4; ++m)
#pragma unroll
                    for (int n = 0; n < 2; ++n) acc[a][b][m][n] = (f32x4){0.f, 0.f, 0.f, 0.f};
        cur = nxt; cA = nA; cB = nB; ++ui;
        if constexpr (ALIGN_EPI) { if (wr == 1) PG8_BAR; }
    }
    PG8_WAIT_V(0);
    if constexpr (!ALIGN_EPI) { if (wr == 0) PG8_BAR; }
    PG8_BAR;
#undef PG8_SA
#undef PG8_SB
#undef PG8_STAGE
#undef PG8_LDA
#undef PG8_LDB
#undef PG8_MMA
#undef PG8_WAIT_V
#undef PG8_WAIT_L
#undef PG8_BAR
#undef PG8_SCHED
}
}

struct GemmJob { const bf16_t* A; const bf16_t* Bt; int M, N, K; pg8::EpiAny E; };
constexpr int GEMM_TAB_OFF = 131072;
__device__ __forceinline__ void gemm_tables(const Ctx& p, const GemmJob& J, const pg8::StaticOrder& S) {
    const int tid = p.tid; pg8::Unit u;
    for (int ui = 0; S.next(ui, u); ++ui) {
        LAS float* T = J.E.tab + ui * 512;
        const int tokt = (J.E.kind == 1) ? u.pm : u.pn, vect = (J.E.kind == 1) ? u.pn : u.pm;
        const int r = tid & 255;
        if (tid < 256) { const f32x4* q = (const f32x4*)(J.E.sqp + (size_t)(tokt * 256 + r) * 16); const f32x4 a = q[0], b = q[1], c = q[2], d = q[3];
            const float sm = ((a[0] + a[1]) + (a[2] + a[3])) + ((b[0] + b[1]) + (b[2] + b[3])) + ((c[0] + c[1]) + (c[2] + c[3])) + ((d[0] + d[1]) + (d[2] + d[3]));
            T[r] = rsqrtf(sm * (1.0f / DM) + EPS); }
        else T[256 + r] = J.E.shw[(size_t)((tokt * 256) / SEQ) * J.E.shw_ld + vect * 256 + r];
    }
    __syncthreads();
}
__device__ __forceinline__ void run_gemm(const Ctx& p, LAS unsigned char* lds, GemmJob& J) {
    J.E.tab = (LAS float*)(lds + GEMM_TAB_OFF);
    pg8::Gemm g{J.A, J.Bt, J.M, J.N, J.K}; pg8::StaticOrder S; S.init(J.M, J.N, p.nblk, p.bid);
    if (J.E.kind == 1 || J.E.kind == 3) gemm_tables(p, J, S);
#if SIMPLE_GEMM
    pg8::gemm_simple<pg8::EpiAny, pg8::StaticOrder>(p.tid, g, S, J.E);
#else
    pg8::gemm_phase<pg8::EpiAny, pg8::StaticOrder, true>(p.tid, lds, g, S, J.E);
#endif
    __syncthreads();
}

__device__ __forceinline__ void transpose_item(const float* W, int K, int N, bf16_t* WT, LAS float* scr, int item, int lane) {
    const int nblk = N / 32, kb = item / nblk, nb = item % nblk, k0 = 64 * kb, n0 = 32 * nb;
    float v[32];
#pragma unroll
    for (int i = 0; i < 32; ++i) { const int kk = 2 * i + (lane >> 5); v[i] = W[(size_t)(k0 + kk) * N + n0 + (lane & 31)]; }
#pragma unroll
    for (int i = 0; i < 32; ++i) { const int kk = 2 * i + (lane >> 5); scr[kk * 33 + (lane & 31)] = v[i]; }
    asm volatile("s_waitcnt lgkmcnt(0)" ::: "memory");
    const int c = lane & 7;
#pragma unroll
    for (int j = 0; j < 4; ++j) { const int n = (lane >> 3) + 8 * j; const LAS float* s = scr + (8 * c) * 33 + n;
        u32x4 o; o.x = cvtpk(s[0 * 33], s[1 * 33]); o.y = cvtpk(s[2 * 33], s[3 * 33]); o.z = cvtpk(s[4 * 33], s[5 * 33]); o.w = cvtpk(s[6 * 33], s[7 * 33]);
        *(u32x4*)(WT + (size_t)(n0 + n) * K + k0 + 8 * c) = o; }
    asm volatile("s_waitcnt lgkmcnt(0)" ::: "memory");
}

__device__ __forceinline__ float silu_f(float v) { return v / (1.0f + expf(-v)); }

__device__ __forceinline__ void phase_prologue(const Ctx& p, LAS unsigned char* lds, const bool partA, const bool partB) {
    const int tid = p.tid, lane = tid & 63, wave = __builtin_amdgcn_readfirstlane(tid >> 6);
    unsigned char* ws = p.ws;
#ifndef PRO_SKIP1
    if (partA) {
        LAS float* S = (LAS float*)lds;
        LAS float* red = (LAS float*)(lds + 69632);
        float* MODL = (float*)(ws + WS_MODL); float* MODC = (float*)(ws + WS_MODC);
        if (p.bid < 192) {
            for (int i = tid; i < 17 * 1024; i += NTHREADS) { const float v = (i < 16 * 1024) ? p.in[I_C][i] : p.in[I_CCTX][i - 16 * 1024]; S[i] = silu_f(v); }
            __syncthreads();
            for (int it = p.bid; it < 192; it += p.nblk) {
                const int layer = it / 96, n0 = (it % 96) * 64, fr = lane & 15, fq = lane >> 4;
                const float* W = p.in[I_WMOD] + (size_t)layer * DM * NMOD + n0 + fr;
                f32x4 acc[2][4];
#pragma unroll
                for (int rt = 0; rt < 2; ++rt)
#pragma unroll
                    for (int ct = 0; ct < 4; ++ct) acc[rt][ct] = (f32x4){0.f, 0.f, 0.f, 0.f};
#pragma unroll 1
                for (int k0 = 0; k0 < 128; k0 += 32) {
                    float bv[8][4];
#pragma unroll
                    for (int j = 0; j < 8; ++j)
#pragma unroll
                        for (int ct = 0; ct < 4; ++ct) bv[j][ct] = W[(size_t)(wave * 128 + k0 + 4 * j + fq) * NMOD + 16 * ct];
#pragma unroll
                    for (int j = 0; j < 8; ++j) { const int k = wave * 128 + k0 + 4 * j + fq;
                        const float a0 = S[fr * 1024 + k], a1 = (fr == 0) ? S[16 * 1024 + k] : 0.f;
#pragma unroll
                        for (int ct = 0; ct < 4; ++ct) { acc[0][ct] = __builtin_amdgcn_mfma_f32_16x16x4f32(a0, bv[j][ct], acc[0][ct], 0, 0, 0);
                                                          acc[1][ct] = __builtin_amdgcn_mfma_f32_16x16x4f32(a1, bv[j][ct], acc[1][ct], 0, 0, 0); } }
                }
#pragma unroll
                for (int rt = 0; rt < 2; ++rt)
#pragma unroll
                    for (int ct = 0; ct < 4; ++ct) *(LAS f32x4*)(red + ((wave * 2 + rt) * 4 + ct) * 256 + lane * 4) = acc[rt][ct];
                __syncthreads();
                for (int idx = tid; idx < 17 * 64; idx += NTHREADS) { const int b = idx >> 6, nn = idx & 63, rt = b >> 4, bb = b & 15, ct = nn >> 4;
                    const int off = (rt * 4 + ct) * 256 + ((bb >> 2) * 16 + (nn & 15)) * 4 + (bb & 3);
                    float s_ = p.in[I_BMOD][layer * NMOD + n0 + nn];
#pragma unroll
                    for (int w = 0; w < 8; ++w) s_ += red[w * 2048 + off];
                    if (b < 16) MODL[(size_t)(layer * 16 + b) * NMOD + n0 + nn] = s_; else if (layer == 0) MODC[n0 + nn] = s_; }
                __syncthreads();
            }
        }
        __syncthreads();
    }
#endif
    const int gw = p.bid * NWAVES + wave, ngw = p.nblk * NWAVES;
#ifndef PRO_SKIP2
    if (partA) {
        float* H3 = (float*)(ws + WS_H3);
        const float* w1 = p.in[I_FW1]; const float* b1 = p.in[I_FB1]; const float* w2 = p.in[I_FW2]; const float* b2 = p.in[I_FB2];
        const float* w3 = p.in[I_FW3]; const float* b3 = p.in[I_FB3]; const float* fr = p.in[I_FFREQ];
        LAS float* w2s = (LAS float*)lds; LAS float* w3s = (LAS float*)(lds + 16384); LAS float* w1s = (LAS float*)(lds + 32768);
        for (int i = tid; i < 4096; i += NTHREADS) { w2s[i] = w2[i]; w3s[i] = w3[i]; if (i < 17 * 64) w1s[i] = w1[i]; }
        __syncthreads();
        for (int t = gw; t < SEQ; t += ngw) {
            const float tf = (float)t, tn = tf / 2048.0f, w = 6.283185307179586f * tf / 2048.0f;
            float feat = 0.f;
            if (lane == 0) feat = tn;
            else if (lane < 17) { const int bi = (lane - 1) & 7; const float band = 1e-4f + (float)bi * ((7.0f - 1e-4f) / 7.0f); const float fw = w * band; feat = (lane < 9) ? fcos(fw) : -fsin(fw); }
            float a = b1[lane];
#pragma unroll
            for (int i = 0; i < 17; ++i) a += __shfl(feat, i) * w1s[i * 64 + lane];
            float h = fsin(fr[lane] * a);
            a = b2[lane];
#pragma unroll 16
            for (int k = 0; k < 64; ++k) a += __shfl(h, k) * w2s[k * 64 + lane];
            h = fsin(fr[64 + lane] * a);
            a = b3[lane];
#pragma unroll 16
            for (int k = 0; k < 64; ++k) a += __shfl(h, k) * w3s[k * 64 + lane];
            h = fsin(fr[128 + lane] * a);
            H3[t * 64 + lane] = h;
        }
    }
#endif
#ifndef PRO_SKIP3
    if (partB) {
        LAS float* scr = (LAS float*)(lds + wave * 16384);
        struct TJob { int in_idx; size_t in_off; int K, N; size_t ws_off; };
        const TJob jobs[10] = {
            {I_AWIN, 0, 1024, 1440, WS_WIN}, {I_AWQB, 0, 384, 768, WS_WQB}, {I_AWKVB, 0, 256, 1024, WS_WKVB}, {I_AWOUT, 0, 1024, 1024, WS_WOUT},
            {I_W1, 0, 1024, 4096, WS_W1_0}, {I_W2, 0, 4096, 1024, WS_W2_0}, {I_W1, (size_t)1024 * 4096, 1024, 4096, WS_W1_1}, {I_W2, (size_t)4096 * 1024, 4096, 1024, WS_W2_1},
            {I_HWIN, 0, 1024, 3072, WS_HIN}, {I_HWOUT, 0, 1024, 1024, WS_HOUT}};
        int base = 0;
#pragma unroll
        for (int j = 0; j < 10; ++j) {
            const int K = jobs[j].K, N = jobs[j].N, nitems = (K / 64) * (N / 32);
            const float* W = p.in[jobs[j].in_idx] + jobs[j].in_off; bf16_t* WT = (bf16_t*)(ws + jobs[j].ws_off);
            int first = gw - (base % ngw); if (first < 0) first += ngw;
            for (int it = first; it < nitems; it += ngw) transpose_item(W, K, N, WT, scr, it, lane);
            base += nitems;
        }
        u32x4* z = (u32x4*)((bf16_t*)(ws + WS_WIN) + (size_t)1440 * 1024);
        unsigned zz = 0u; asm volatile("" : "+v"(zz));
        for (int i = p.bid * NTHREADS + tid; i < 96 * 1024 / 8; i += p.nblk * NTHREADS) z[i] = (u32x4){zz, zz, zz, zz};
    }
#endif
}

__device__ __forceinline__ void modulate_chunk(const float* src, int row0, int nrows, const float* g, const float* sc, const float* sh, bf16_t* dst, int lane) {
    f32x4 gs[4], sv[4];
#pragma unroll
    for (int j = 0; j < 4; ++j) { const int c4 = lane + 64 * j; const f32x4 gg = ((const f32x4*)g)[c4], ss = ((const f32x4*)sc)[c4]; gs[j] = gg * (ss + 1.0f); sv[j] = ((const f32x4*)sh)[c4]; }
    for (int r = row0; r < row0 + nrows; ++r) {
        const f32x4* xr = (const f32x4*)(src + (size_t)r * DM) + lane;
        f32x4 v[4]; float s = 0.f;
#pragma unroll
        for (int j = 0; j < 4; ++j) { v[j] = xr[64 * j]; s += (v[j].x * v[j].x + v[j].y * v[j].y) + (v[j].z * v[j].z + v[j].w * v[j].w); }
        const float rstd = rsqrtf(wave_sum(s) * (1.0f / DM) + EPS);
        u32x2* o8 = (u32x2*)(dst + (size_t)r * DM) + lane;
#pragma unroll
        for (int j = 0; j < 4; ++j) { const f32x4 y = v[j] * rstd * gs[j] + sv[j]; u32x2 w; w.x = cvtpk(y.x, y.y); w.y = cvtpk(y.z, y.w); o8[64 * j] = w; }
    }
}
__device__ __forceinline__ void phase_modulate(const Ctx& p, const float* src, int layer, const float* g, int shoff, int scoff, bool with_ctx) {
    const int lane = p.tid & 63, wave = __builtin_amdgcn_readfirstlane(p.tid >> 6);
    const int gw = p.bid * NWAVES + wave;
    const float* MODL = (const float*)(p.ws + WS_MODL); const float* MODC = (const float*)(p.ws + WS_MODC);
    bf16_t* HL = (bf16_t*)(p.ws + WS_HL);
    {   const int per = ML / NGW, row0 = gw * per, b = row0 / SEQ; const float* mv = MODL + (size_t)(layer * 16 + b) * NMOD;
        modulate_chunk(src, row0, per, g, mv + scoff, mv + shoff, HL, lane); }
    if (with_ctx) { const int per = MC / NGW, row0 = gw * per;
        modulate_chunk(p.in[I_CTX], row0, per, g, MODC + scoff, MODC + shoff, HL + (size_t)ML * DM, lane); }
}
__device__ __forceinline__ void shw_job(const bf16_t* WT, int N, const float* sh, float* out, int gw, int ngw, int lane) {
    const int fr = lane & 15, fq = lane >> 4;
    for (int g = gw; g < N / 16; g += ngw) {
        f32x4 acc = {0.f, 0.f, 0.f, 0.f};
#pragma unroll 8
        for (int ks = 0; ks < 32; ++ks) {
            const float* sp = sh + (size_t)fr * NMOD + 32 * ks + 8 * fq;
            const f32x4 s0 = *(const f32x4*)sp, s1 = *(const f32x4*)(sp + 4);
            const u32x4 aw = {cvtpk(s0[0], s0[1]), cvtpk(s0[2], s0[3]), cvtpk(s1[0], s1[1]), cvtpk(s1[2], s1[3])};
            const bf16x8 bw = *(const bf16x8*)(WT + (size_t)(16 * g + fr) * DM + 32 * ks + 8 * fq);
            acc = __builtin_amdgcn_mfma_f32_16x16x32_bf16(__builtin_bit_cast(bf16x8, aw), bw, acc, 0, 0, 0);
        }
#pragma unroll
        for (int e = 0; e < 4; ++e) out[(size_t)(4 * fq + e) * N + 16 * g + fr] = acc[e];
    }
}
__device__ __forceinline__ void phase_shw(const Ctx& p) {
    const int lane = p.tid & 63, wave = __builtin_amdgcn_readfirstlane(p.tid >> 6);
    const int gw = p.bid * NWAVES + wave, ngw = p.nblk * NWAVES;
    const float* MODL = (const float*)(p.ws + WS_MODL);
    shw_job((const bf16_t*)(p.ws + WS_W1_0), 4096, MODL + 3 * DM, (float*)(p.ws + WS_SHW_UP0), gw, ngw, lane);
    shw_job((const bf16_t*)(p.ws + WS_HIN), 3072, MODL + (size_t)16 * NMOD, (float*)(p.ws + WS_SHW_HIN), gw, ngw, lane);
    shw_job((const bf16_t*)(p.ws + WS_W1_1), 4096, MODL + (size_t)16 * NMOD + 3 * DM, (float*)(p.ws + WS_SHW_UP1), gw, ngw, lane);
}
__device__ __forceinline__ void phase_final(const Ctx& p) {
    const int lane = p.tid & 63, wave = __builtin_amdgcn_readfirstlane(p.tid >> 6);
    const int gw = p.bid * NWAVES + wave, per = ML / NGW;
    const bf16_t* X = (const bf16_t*)(p.ws + WS_XW); const float* g = p.in[I_FINALG]; const float* sqp = (const float*)(p.ws + WS_SQA);
    f32x4 gs[4];
#pragma unroll
    for (int j = 0; j < 2; ++j) { gs[2 * j] = *(const f32x4*)(g + 512 * j + 8 * lane); gs[2 * j + 1] = *(const f32x4*)(g + 512 * j + 8 * lane + 4); }
    for (int r = gw * per; r < (gw + 1) * per; ++r) {
        const float part = (lane < 16) ? sqp[(size_t)r * 16 + lane] : 0.f;
        const float rstd = rsqrtf(wave_sum(part) * (1.0f / DM) + EPS);
#pragma unroll
        for (int j = 0; j < 2; ++j) { const u32x4 xb = *(const u32x4*)(X + (size_t)r * DM + 512 * j + 8 * lane);
            const f32x4 v0 = {bflo(xb.x), bfhi(xb.x), bflo(xb.y), bfhi(xb.y)}, v1 = {bflo(xb.z), bfhi(xb.z), bflo(xb.w), bfhi(xb.w)};
            f32x4* o = (f32x4*)(p.out + (size_t)r * DM + 512 * j + 8 * lane);
            o[0] = v0 * rstd * gs[2 * j]; o[1] = v1 * rstd * gs[2 * j + 1]; }
    }
}

__device__ __forceinline__ void zpost_row(const Ctx& p, int row, bool latent, int lane, const LAS f32x2* tabM, const LAS f32x2* tabG) {
    unsigned char* ws = p.ws;
    const bf16_t* z = (const bf16_t*)(ws + WS_Z) + (size_t)row * ZW;
    int prow = 0, pcol = 0;
    if (latent) { const int s = row & (SEQ - 1); prow = s >> 6; pcol = s & 63; }
    if (latent) {
        float v[6], ss = 0.f;
#pragma unroll
        for (int i = 0; i < 6; ++i) { v[i] = bf2f(z[ZC_CQ + lane + 64 * i]); ss += v[i] * v[i]; }
        const float rstd = rsqrtf(wave_sum(ss) * (1.0f / 384.0f) + EPS);
        bf16_t* o = (bf16_t*)(ws + WS_CQN) + (size_t)row * 384;
#pragma unroll
        for (int i = 0; i < 6; ++i) o[lane + 64 * i] = (bf16_t)f2bf(v[i] * rstd * p.in[I_AQAG][lane + 64 * i]);
    }
    {
        float v[4], ss = 0.f;
#pragma unroll
        for (int i = 0; i < 4; ++i) { v[i] = bf2f(z[ZC_CKV + lane + 64 * i]); ss += v[i] * v[i]; }
        const float rstd = rsqrtf(wave_sum(ss) * (1.0f / 256.0f) + EPS);
        bf16_t* o = (bf16_t*)(ws + WS_CKVN) + (size_t)row * 256;
#pragma unroll
        for (int i = 0; i < 4; ++i) o[lane + 64 * i] = (bf16_t)f2bf(v[i] * rstd * p.in[I_AKVAG][lane + 64 * i]);
    }
    {
        const int d = lane & 31; const float y = bf2f(z[ZC_KR + d]);
        const float pr = __shfl_xor(y, 8);
        float o = y;
        if (latent) { const int pos = (d & 16) ? pcol : prow; const f32x2 cs = tabM[pos * 8 + (d & 7)];
            o = (d & 8) ? (pr * cs.y + y * cs.x) : (y * cs.x - pr * cs.y); }
        if (lane < 32) ((bf16_t*)(ws + WS_KROPE))[(size_t)row * 32 + d] = (bf16_t)f2bf(o);
    }
    if (latent) {
        const float gq = p.in[I_AQNG][lane];
        const int pos = (lane & 32) ? pcol : prow; const f32x2 cs = tabG[pos * 16 + (lane & 15)];
        bf16_t* o = (bf16_t*)(ws + WS_QG) + (size_t)row * 512;
#pragma unroll
        for (int hh = 0; hh < 8; ++hh) {
            const float v = bf2f(z[ZC_GQ + 64 * hh + lane]);
            const float rstd = rsqrtf(wave_sum(v * v) * (1.0f / 64.0f) + EPS);
            const float y = v * rstd * gq, pr = __shfl_xor(y, 16);
            const float r = (lane & 16) ? (pr * cs.y + y * cs.x) : (y * cs.x - pr * cs.y);
            o[64 * hh + lane] = (bf16_t)f2bf(r * QSCALE_GQA);
        }
    }
    {
        const float gk = p.in[I_AKNG][lane];
        f32x2 cs = {1.f, 0.f};
        if (latent) { const int pos = (lane & 32) ? pcol : prow; cs = tabG[pos * 16 + (lane & 15)]; }
        bf16_t* o = (bf16_t*)(ws + WS_KG) + (size_t)row * 128;
#pragma unroll
        for (int hh = 0; hh < 2; ++hh) {
            const float v = bf2f(z[ZC_GK + 64 * hh + lane]);
            const float rstd = rsqrtf(wave_sum(v * v) * (1.0f / 64.0f) + EPS);
            const float y = v * rstd * gk, pr = __shfl_xor(y, 16);
            const float r = (lane & 16) ? (pr * cs.y + y * cs.x) : (y * cs.x - pr * cs.y);
            o[64 * hh + lane] = (bf16_t)f2bf(r);
        }
    }
    {
        bf16_t* o = (bf16_t*)(ws + WS_VG) + (size_t)row * 128;
        o[lane] = z[ZC_GV + lane]; o[64 + lane] = z[ZC_GV + 64 + lane];
    }
}
struct ZGains { f32x4 qa[2], kva0[2], kva1[2], qn[2], kn[2]; };
__device__ __forceinline__ void unpack8(const u32x4 w, float (&v)[8]) { v[0] = bflo(w.x); v[1] = bfhi(w.x); v[2] = bflo(w.y); v[3] = bfhi(w.y); v[4] = bflo(w.z); v[5] = bfhi(w.z); v[6] = bflo(w.w); v[7] = bfhi(w.w); }
__device__ __forceinline__ u32x4 pack8(const float (&v)[8]) { u32x4 w; w.x = cvtpk(v[0], v[1]); w.y = cvtpk(v[2], v[3]); w.z = cvtpk(v[4], v[5]); w.w = cvtpk(v[6], v[7]); return w; }
__device__ __forceinline__ float sumsq8(const float (&v)[8]) { return ((v[0] * v[0] + v[1] * v[1]) + (v[2] * v[2] + v[3] * v[3])) + ((v[4] * v[4] + v[5] * v[5]) + (v[6] * v[6] + v[7] * v[7])); }
__device__ __forceinline__ void rope8(float (&y)[8], const float (&pr)[8], bool second, const LAS f32x2* cs) {
#pragma unroll
    for (int e = 0; e < 8; ++e) { const f32x2 c = cs[e]; y[e] = second ? (pr[e] * c.y + y[e] * c.x) : (y[e] * c.x - pr[e] * c.y); }
}
__device__ __forceinline__ void zpost_row_vec(const Ctx& p, int row, bool latent, int lane, const LAS f32x2* tabM, const LAS f32x2* tabG, const ZGains& G) {
    unsigned char* ws = p.ws;
    const bf16_t* z = (const bf16_t*)(ws + WS_Z) + (size_t)row * ZW;
    int prow = 0, pcol = 0;
    if (latent) { const int s_ = row & (SEQ - 1); prow = s_ >> 6; pcol = s_ & 63; }
    const int cB = 84 + lane, cC = lane < 16 ? 148 + lane : (lane < 32 ? 164 + (lane - 16) : 80 + (lane & 3));
    const u32x4 wA0 = *(const u32x4*)(z + 8 * lane);
    const u32x4 wA1 = *(const u32x4*)(z + 8 * (64 + (lane & 15)));
    const u32x4 wB = *(const u32x4*)(z + 8 * cB);
    const u32x4 wC = *(const u32x4*)(z + 8 * cC);
    float a0[8], a1[8], vb[8], vc[8];
    unpack8(wA0, a0); unpack8(wA1, a1); unpack8(wB, vb); unpack8(wC, vc);
    {
        const float s0 = sumsq8(a0), s1 = sumsq8(a1);
        const float sq_cq = wave_sum(lane < 48 ? s0 : 0.f), sq_ckv = wave_sum((lane >= 48 ? s0 : 0.f) + (lane < 16 ? s1 : 0.f));
        const float rq = rsqrtf(sq_cq * (1.0f / 384.0f) + EPS), rk = rsqrtf(sq_ckv * (1.0f / 256.0f) + EPS);
        float o[8];
        if (lane < 48) { if (latent) {
#pragma unroll
                for (int e = 0; e < 8; ++e) o[e] = a0[e] * rq * G.qa[e >> 2][e & 3];
                *(u32x4*)((bf16_t*)(ws + WS_CQN) + (size_t)row * 384 + 8 * lane) = pack8(o); } }
        else {
#pragma unroll
            for (int e = 0; e < 8; ++e) o[e] = a0[e] * rk * G.kva0[e >> 2][e & 3];
            *(u32x4*)((bf16_t*)(ws + WS_CKVN) + (size_t)row * 256 + 8 * (lane - 48)) = pack8(o); }
        if (lane < 16) {
#pragma unroll
            for (int e = 0; e < 8; ++e) o[e] = a1[e] * rk * G.kva1[e >> 2][e & 3];
            *(u32x4*)((bf16_t*)(ws + WS_CKVN) + (size_t)row * 256 + 128 + 8 * lane) = pack8(o); }
    }
    if (latent) {
        const float sq = sum8(sumsq8(vb));
        const float rs = rsqrtf(sq * (1.0f / 64.0f) + EPS);
        float y[8], pr[8];
#pragma unroll
        for (int e = 0; e < 8; ++e) y[e] = vb[e] * rs * G.qn[e >> 2][e & 3];
#pragma unroll
        for (int e = 0; e < 8; ++e) pr[e] = dpp_xor2(y[e]);
        const int pos = (lane & 4) ? pcol : prow;
        rope8(y, pr, (lane & 2) != 0, tabG + pos * 16 + 8 * (lane & 1));
#pragma unroll
        for (int e = 0; e < 8; ++e) y[e] *= QSCALE_GQA;
        *(u32x4*)((bf16_t*)(ws + WS_QG) + (size_t)row * 512 + 8 * lane) = pack8(y);
    }
    {
        const float sq = sum8(sumsq8(vc));
        const float rs = rsqrtf(sq * (1.0f / 64.0f) + EPS);
        float y[8], pr2[8], pr1[8];
#pragma unroll
        for (int e = 0; e < 8; ++e) y[e] = (lane < 16) ? vc[e] * rs * G.kn[e >> 2][e & 3] : vc[e];
#pragma unroll
        for (int e = 0; e < 8; ++e) { pr2[e] = dpp_xor2(y[e]); pr1[e] = dpp_xor1(y[e]); }
        if (lane < 16) {
            if (latent) { const int pos = (lane & 4) ? pcol : prow; rope8(y, pr2, (lane & 2) != 0, tabG + pos * 16 + 8 * (lane & 1)); }
            *(u32x4*)((bf16_t*)(ws + WS_KG) + (size_t)row * 128 + 8 * lane) = pack8(y);
        } else if (lane < 32) {
            *(u32x4*)((bf16_t*)(ws + WS_VG) + (size_t)row * 128 + 8 * (lane - 16)) = wC;
        } else if (lane < 36) {
            if (latent) { const int pos = (lane & 2) ? pcol : prow; rope8(y, pr1, (lane & 1) != 0, tabM + pos * 8); }
            *(u32x4*)((bf16_t*)(ws + WS_KROPE) + (size_t)row * 32 + 8 * (lane - 32)) = pack8(y);
        }
    }
}
__device__ __forceinline__ void phase_zpost(const Ctx& p, LAS unsigned char* lds) {
    const int tid = p.tid, lane = tid & 63, wave = __builtin_amdgcn_readfirstlane(tid >> 6);
    LAS f32x2* tabM = (LAS f32x2*)lds;
    LAS f32x2* tabG = (LAS f32x2*)(lds + 4096);
    for (int i = tid; i < 512; i += NTHREADS) { const int pos = i >> 3, f = i & 7; const float inv = inv_theta((float)f / 8.0f); const float a = (float)pos * inv; tabM[i] = (f32x2){fcos(a), fsin(a)}; }
    for (int i = tid; i < 1024; i += NTHREADS) { const int pos = i >> 4, f = i & 15; const float inv = inv_theta((float)f / 16.0f); const float a = (float)pos * inv; tabG[i] = (f32x2){fcos(a), fsin(a)}; }
    __syncthreads();
    const int gw = p.bid * NWAVES + wave;
#if ZPOST_REF
    { const int per = ML / NGW; for (int r = gw * per; r < (gw + 1) * per; ++r) zpost_row(p, r, true, lane, tabM, tabG); }
    { const int per = MC / NGW; for (int r = gw * per; r < (gw + 1) * per; ++r) zpost_row(p, ML + r, false, lane, tabM, tabG); }
#else
    ZGains G;
    { const float* qa = p.in[I_AQAG] + 8 * (lane < 48 ? lane : 0); const float* k0 = p.in[I_AKVAG] + 8 * (lane >= 48 ? lane - 48 : 0); const float* k1 = p.in[I_AKVAG] + 128 + 8 * (lane & 15);
      const float* qn = p.in[I_AQNG] + 8 * (lane & 7); const float* kn = p.in[I_AKNG] + 8 * (lane & 7);
#pragma unroll
      for (int h = 0; h < 2; ++h) { G.qa[h] = *(const f32x4*)(qa + 4 * h); G.kva0[h] = *(const f32x4*)(k0 + 4 * h); G.kva1[h] = *(const f32x4*)(k1 + 4 * h); G.qn[h] = *(const f32x4*)(qn + 4 * h); G.kn[h] = *(const f32x4*)(kn + 4 * h); } }
    { const int per = ML / NGW;
#pragma unroll 2
      for (int r = gw * per; r < (gw + 1) * per; ++r) zpost_row_vec(p, r, true, lane, tabM, tabG, G); }
    { const int per = MC / NGW; for (int r = gw * per; r < (gw + 1) * per; ++r) zpost_row_vec(p, ML + r, false, lane, tabM, tabG, G); }
#endif
    __syncthreads();
}

__device__ __forceinline__ float max3f(float a, float b, float c) { float r; asm("v_max3_f32 %0, %1, %2, %3" : "=v"(r) : "v"(a), "v"(b), "v"(c)); return r; }
__device__ __forceinline__ int crow(int r, int hi) { return (r & 3) + 8 * (r >> 2) + 4 * hi; }
__device__ __forceinline__ size_t key_row(int b, int t) { return t < CTXL ? (size_t)(ML + b * CTXL + t) : (size_t)(b * SEQ + (t - CTXL)); }

template <int DK>
__device__ __forceinline__ void attn_naive_one(const Ctx& p, int b, int h, int q) {
    unsigned char* ws = p.ws;
    const bf16_t* KV = (const bf16_t*)(ws + WS_KV); const bf16_t* KR = (const bf16_t*)(ws + WS_KROPE);
    const bf16_t* KG = (const bf16_t*)(ws + WS_KG); const bf16_t* VG = (const bf16_t*)(ws + WS_VG);
    const size_t row = (size_t)b * SEQ + q;
    float qv[DK];
    {
        const bf16_t* qp = (DK == 96) ? (const bf16_t*)(ws + WS_QMR) + row * 768 + h * 96 : (const bf16_t*)(ws + WS_QG) + row * 512 + (h - 8) * 64;
#pragma unroll
        for (int d8 = 0; d8 < DK / 8; ++d8) { const u32x4 w = *(const u32x4*)(qp + 8 * d8);
            qv[8 * d8 + 0] = bflo(w.x); qv[8 * d8 + 1] = bfhi(w.x); qv[8 * d8 + 2] = bflo(w.y); qv[8 * d8 + 3] = bfhi(w.y);
            qv[8 * d8 + 4] = bflo(w.z); qv[8 * d8 + 5] = bfhi(w.z); qv[8 * d8 + 6] = bflo(w.w); qv[8 * d8 + 7] = bfhi(w.w); }
    }
    float o[64];
#pragma unroll
    for (int d = 0; d < 64; ++d) o[d] = 0.f;
    float m = -1e30f, l = 0.f;
    for (int t = 0; t < TKEYS; ++t) {
        const size_t kr = key_row(b, t);
        float s = 0.f;
        const bf16_t* vp;
        if (DK == 96) {
            const bf16_t* kp = KV + kr * 1024 + h * 128; const bf16_t* rp = KR + kr * 32;
#pragma unroll
            for (int d = 0; d < 64; ++d) s += qv[d] * bf2f(kp[d]);
#pragma unroll
            for (int d = 0; d < 32; ++d) s += qv[64 + d] * bf2f(rp[d]);
            vp = kp + 64;
        } else {
            const int kvh = (h - 8) >> 2; const bf16_t* kp = KG + kr * 128 + kvh * 64;
#pragma unroll
            for (int d = 0; d < 64; ++d) s += qv[d] * bf2f(kp[d]);
            vp = VG + kr * 128 + kvh * 64;
        }
        const float mn = fmaxf(m, s), al = exp2f(m - mn), pe = exp2f(s - mn);
        l = l * al + pe; m = mn;
#pragma unroll
        for (int d = 0; d < 64; ++d) o[d] = o[d] * al + pe * bf2f(vp[d]);
    }
    const float rl = 1.0f / l;
    bf16_t* op = (bf16_t*)(ws + WS_O) + row * 1024 + h * 64;
#pragma unroll
    for (int d = 0; d < 64; ++d) op[d] = (bf16_t)f2bf(o[d] * rl);
}
__device__ __forceinline__ void phase_naive_qrope(const Ctx& p) {
    const bf16_t* QM = (const bf16_t*)(p.ws + WS_QM); bf16_t* QMR = (bf16_t*)(p.ws + WS_QMR);
    for (size_t idx = (size_t)p.bid * NTHREADS + p.tid; idx < (size_t)ML * 768; idx += (size_t)p.nblk * NTHREADS) {
        const int col = (int)(idx % 768), d = col % 96; const size_t row = idx / 768; const int q = (int)(row & (SEQ - 1));
        float v = bf2f(QM[idx]);
        if (d >= 64) {
            const int e = d - 64, prow = q >> 6, pcol = q & 63;
            const int pos = (e & 16) ? pcol : prow; const float inv = inv_theta((float)(e & 7) / 8.0f); const float ang = (float)pos * inv;
            const float cs = fcos(ang), sn = fsin(ang);
            const float a = bf2f(QM[idx - e + (e & ~8)]), bb = bf2f(QM[idx - e + (e | 8)]);
            v = (e & 8) ? (a * sn + bb * cs) : (a * cs - bb * sn);
        }
        QMR[idx] = (bf16_t)f2bf(v * QSCALE_MLA);
    }
}
__device__ __forceinline__ void phase_attn_naive(const Ctx& p) {
    for (int idx = p.bid * NTHREADS + p.tid; idx < NB * 16 * SEQ; idx += p.nblk * NTHREADS) {
        const int q = idx & (SEQ - 1), h = (idx >> 11) & 15, b = idx >> 15;
        if (h < 8) attn_naive_one<96>(p, b, h, q); else attn_naive_one<64>(p, b, h, q);
    }
}

template <int DK>
__device__ __forceinline__ void attn_unit(const Ctx& p, int b, int h, int qb, LAS unsigned char* lds) {
    constexpr int NC = DK / 8;
    constexpr int ND = DK / 16;
    constexpr int KB = 12288, VB = 8192;
    unsigned char* ws = p.ws;
    const int tid = p.tid, lane = tid & 63, r32 = lane & 31, hi = lane >> 5; const int wid = __builtin_amdgcn_readfirstlane(tid >> 6);
    const bf16_t* KV = (const bf16_t*)(ws + WS_KV); const bf16_t* KR = (const bf16_t*)(ws + WS_KROPE);
    const bf16_t* KG = (const bf16_t*)(ws + WS_KG); const bf16_t* VG = (const bf16_t*)(ws + WS_VG);
    const int kvh = (h - 8) >> 2;
    LAS unsigned char* Kb = lds; LAS unsigned char* Vb = lds + 2 * KB; LAS float* wsf = (LAS float*)(lds + 2 * KB + 2 * VB) + wid * 64;
    const int qs = qb * 256 + wid * 32 + r32;
    const size_t qrow = (size_t)b * SEQ + qs;
    bf16x8 qr[ND];
    if (DK == 96) {
        const bf16_t* qp = (const bf16_t*)(ws + WS_QM) + qrow * 768 + h * 96;
#pragma unroll
        for (int d0 = 0; d0 < 4; ++d0) { const u32x4 w = *(const u32x4*)(qp + 16 * d0 + 8 * hi); u32x4 o;
            o.x = cvtpk(bflo(w.x) * QSCALE_MLA, bfhi(w.x) * QSCALE_MLA); o.y = cvtpk(bflo(w.y) * QSCALE_MLA, bfhi(w.y) * QSCALE_MLA);
            o.z = cvtpk(bflo(w.z) * QSCALE_MLA, bfhi(w.z) * QSCALE_MLA); o.w = cvtpk(bflo(w.w) * QSCALE_MLA, bfhi(w.w) * QSCALE_MLA);
            qr[d0] = __builtin_bit_cast(bf16x8, o); }
        const int prow = qs >> 6, pcol = qs & 63;
#pragma unroll
        for (int c = 0; c < 2; ++c) {
            const u32x4 wa = *(const u32x4*)(qp + 64 + 16 * c);
            const u32x4 wb = *(const u32x4*)(qp + 64 + 16 * c + 8);
            const float pos = (float)(c == 0 ? prow : pcol);
            float av[8] = {bflo(wa.x), bfhi(wa.x), bflo(wa.y), bfhi(wa.y), bflo(wa.z), bfhi(wa.z), bflo(wa.w), bfhi(wa.w)};
            float bv[8] = {bflo(wb.x), bfhi(wb.x), bflo(wb.y), bfhi(wb.y), bflo(wb.z), bfhi(wb.z), bflo(wb.w), bfhi(wb.w)};
            float ov[8];
#pragma unroll
            for (int j = 0; j < 8; ++j) { const float inv = inv_theta((float)j / 8.0f); const float ang = pos * inv; const float cs = fcos(ang), sn = fsin(ang);
                const float lo = av[j] * cs - bv[j] * sn, hv = av[j] * sn + bv[j] * cs; ov[j] = (hi ? hv : lo) * QSCALE_MLA; }
            u32x4 o; o.x = cvtpk(ov[0], ov[1]); o.y = cvtpk(ov[2], ov[3]); o.z = cvtpk(ov[4], ov[5]); o.w = cvtpk(ov[6], ov[7]);
            qr[4 + c] = __builtin_bit_cast(bf16x8, o);
        }
    } else {
        const bf16_t* qp = (const bf16_t*)(ws + WS_QG) + qrow * 512 + (h - 8) * 64;
#pragma unroll
        for (int d0 = 0; d0 < ND; ++d0) qr[d0] = *(const bf16x8*)(qp + 16 * d0 + 8 * hi);
    }
    const int kkey = tid & 63, kc0 = tid >> 6;
    const int vkv = tid >> 3, vdc = tid & 7;
    const unsigned kdst0 = kc0 * 1024 + kkey * 16, kdst1 = (kc0 + 8) * 1024 + kkey * 16;
    const unsigned vdst = (vdc >> 2) * 4096 + (vkv >> 4) * 1024 + (vkv & 15) * 64 + (vdc & 3) * 16;
    u32x4 kreg0, kreg1, vreg;
    auto load_tile = [&](int kt) {
        const size_t rk = key_row(b, kt * 64 + kkey), rv = key_row(b, kt * 64 + vkv);
        if (DK == 96) {
            kreg0 = *(const u32x4*)(KV + rk * 1024 + h * 128 + 8 * kc0);
            if (wid < 4) kreg1 = *(const u32x4*)(KR + rk * 32 + 8 * kc0);
            vreg = *(const u32x4*)(KV + rv * 1024 + h * 128 + 64 + 8 * vdc);
        } else {
            kreg0 = *(const u32x4*)(KG + rk * 128 + kvh * 64 + 8 * kc0);
            vreg = *(const u32x4*)(VG + rv * 128 + kvh * 64 + 8 * vdc);
        }
    };
    auto store_tile = [&](int buf) {
        *(LAS u32x4*)(Kb + buf * KB + kdst0) = kreg0;
        if (DK == 96) { if (wid < 4) *(LAS u32x4*)(Kb + buf * KB + kdst1) = kreg1; }
        *(LAS u32x4*)(Vb + buf * VB + vdst) = vreg;
    };
    f32x16 o0 = {}, o1 = {};
    float mrun = -1e30f, lrun = 0.f;
    const unsigned kfo = hi * 1024 + r32 * 16;
    const unsigned vfo = ((lane >> 4) & 1) * 32 + (lane & 3) * 8 + (4 * hi + ((lane & 15) >> 2)) * 64;
    load_tile(0); store_tile(0);
    __syncthreads();
    constexpr int NT = TKEYS / 64;
    for (int kt = 0; kt < NT; ++kt) {
        const int buf = kt & 1;
        if (kt + 1 < NT) load_tile(kt + 1);
        f32x16 p0 = {}, p1 = {};
        const LAS unsigned char* kp = Kb + buf * KB + kfo;
#pragma unroll
        for (int d0 = 0; d0 < ND; ++d0) {
            const bf16x8 k0 = *(const LAS bf16x8*)(kp + d0 * 2048), k1 = *(const LAS bf16x8*)(kp + d0 * 2048 + 512);
            p0 = __builtin_amdgcn_mfma_f32_32x32x16_bf16(k0, qr[d0], p0, 0, 0, 0);
            p1 = __builtin_amdgcn_mfma_f32_32x32x16_bf16(k1, qr[d0], p1, 0, 0, 0);
        }
        float mx = fmaxf(p0[0], p1[0]);
#pragma unroll
        for (int r = 1; r < 16; ++r) mx = fmaxf(mx, fmaxf(p0[r], p1[r]));
        mx = fmaxf(mx, __shfl_xor(mx, 32));
        const float mnew = fmaxf(mrun, mx), alpha = __builtin_amdgcn_exp2f(mrun - mnew);
        mrun = mnew;
        float rs = 0.f;
#pragma unroll
        for (int r = 0; r < 16; ++r) { p0[r] = __builtin_amdgcn_exp2f(p0[r] - mnew); p1[r] = __builtin_amdgcn_exp2f(p1[r] - mnew); rs += p0[r] + p1[r]; }
        lrun = lrun * alpha + rs;
        if (hi == 0) wsf[r32] = alpha;
        asm volatile("s_waitcnt lgkmcnt(0)" ::: "memory");
#pragma unroll
        for (int g4 = 0; g4 < 4; ++g4) { const f32x4 a4 = *(const LAS f32x4*)(wsf + 8 * g4 + 4 * hi);
#pragma unroll
            for (int e = 0; e < 4; ++e) { o0[4 * g4 + e] *= a4[e]; o1[4 * g4 + e] *= a4[e]; } }
        u32x4 pw[4];
        pw[0] = (u32x4){cvtpk(p0[0], p0[1]), cvtpk(p0[2], p0[3]), cvtpk(p0[4], p0[5]), cvtpk(p0[6], p0[7])};
        pw[1] = (u32x4){cvtpk(p0[8], p0[9]), cvtpk(p0[10], p0[11]), cvtpk(p0[12], p0[13]), cvtpk(p0[14], p0[15])};
        pw[2] = (u32x4){cvtpk(p1[0], p1[1]), cvtpk(p1[2], p1[3]), cvtpk(p1[4], p1[5]), cvtpk(p1[6], p1[7])};
        pw[3] = (u32x4){cvtpk(p1[8], p1[9]), cvtpk(p1[10], p1[11]), cvtpk(p1[12], p1[13]), cvtpk(p1[14], p1[15])};
        const LAS unsigned char* vp = Vb + buf * VB + vfo;
#pragma unroll
        for (int ks = 0; ks < 4; ++ks) {
            const bf16x8 pa = __builtin_bit_cast(bf16x8, pw[ks]);
            const s16x4 l0 = __builtin_amdgcn_ds_read_tr16_b64_v4i16((LAS s16x4*)(vp + ks * 1024));
            const s16x4 h0 = __builtin_amdgcn_ds_read_tr16_b64_v4i16((LAS s16x4*)(vp + ks * 1024 + 512));
            const s16x4 l1 = __builtin_amdgcn_ds_read_tr16_b64_v4i16((LAS s16x4*)(vp + 4096 + ks * 1024));
            const s16x4 h1 = __builtin_amdgcn_ds_read_tr16_b64_v4i16((LAS s16x4*)(vp + 4096 + ks * 1024 + 512));
            const bf16x8 v0 = {l0[0], l0[1], l0[2], l0[3], h0[0], h0[1], h0[2], h0[3]};
            const bf16x8 v1 = {l1[0], l1[1], l1[2], l1[3], h1[0], h1[1], h1[2], h1[3]};
            o0 = __builtin_amdgcn_mfma_f32_32x32x16_bf16(pa, v0, o0, 0, 0, 0);
            o1 = __builtin_amdgcn_mfma_f32_32x32x16_bf16(pa, v1, o1, 0, 0, 0);
        }
        if (kt + 1 < NT) store_tile(buf ^ 1);
        __syncthreads();
    }
    lrun += __shfl_xor(lrun, 32);
    if (hi == 0) wsf[32 + r32] = lrun;
    asm volatile("s_waitcnt lgkmcnt(0)" ::: "memory");
    bf16_t* Ow = (bf16_t*)(ws + WS_O) + ((size_t)b * SEQ + qb * 256 + wid * 32) * 1024 + h * 64;
#pragma unroll
    for (int r = 0; r < 16; ++r) { const int orow = crow(r, hi); const float rl = __builtin_amdgcn_rcpf(wsf[32 + orow]);
        Ow[(size_t)orow * 1024 + r32] = (bf16_t)f2bf(o0[r] * rl); Ow[(size_t)orow * 1024 + 32 + r32] = (bf16_t)f2bf(o1[r] * rl); }
    __syncthreads();
}
template <int DK>
__device__ __forceinline__ void attn_unit2(const Ctx& p, const int tid, int b, int h, int qb, LAS unsigned char* lds) {
    constexpr int ND = DK / 16;
    constexpr int KB = 12288, VB = 8192, NT = TKEYS / 64;
    constexpr float THR = 8.0f;
    unsigned char* ws = p.ws;
    const int lane = tid & 63, r32 = lane & 31, hi = lane >> 5; const int wid = __builtin_amdgcn_readfirstlane(tid >> 6);
    const bf16_t* KV = (const bf16_t*)(ws + WS_KV); const bf16_t* KR = (const bf16_t*)(ws + WS_KROPE);
    const bf16_t* KG = (const bf16_t*)(ws + WS_KG); const bf16_t* VG = (const bf16_t*)(ws + WS_VG);
    const int kvh = (h - 8) >> 2;
    LAS unsigned char* Kb = lds; LAS unsigned char* Vb = lds + 2 * KB; LAS float* wsf = (LAS float*)(lds + 2 * KB + 2 * VB) + wid * 64;
    const int qs = qb * 256 + wid * 32 + r32;
    const size_t qrow = (size_t)b * SEQ + qs;
    bf16x8 qr[ND];
    if (DK == 96) {
        const bf16_t* qp = (const bf16_t*)(ws + WS_QM) + qrow * 768 + h * 96;
#pragma unroll
        for (int d0 = 0; d0 < 4; ++d0) { const u32x4 w = *(const u32x4*)(qp + 16 * d0 + 8 * hi); u32x4 o;
            o.x = cvtpk(bflo(w.x) * QSCALE_MLA, bfhi(w.x) * QSCALE_MLA); o.y = cvtpk(bflo(w.y) * QSCALE_MLA, bfhi(w.y) * QSCALE_MLA);
            o.z = cvtpk(bflo(w.z) * QSCALE_MLA, bfhi(w.z) * QSCALE_MLA); o.w = cvtpk(bflo(w.w) * QSCALE_MLA, bfhi(w.w) * QSCALE_MLA);
            qr[d0] = __builtin_bit_cast(bf16x8, o); }
        const int prow = qs >> 6, pcol = qs & 63;
#pragma unroll
        for (int c = 0; c < 2; ++c) {
            const u32x4 wa = *(const u32x4*)(qp + 64 + 16 * c);
            const u32x4 wb = *(const u32x4*)(qp + 64 + 16 * c + 8);
            const float pos = (float)(c == 0 ? prow : pcol);
            float av[8], bv[8], ov[8]; unpack8(wa, av); unpack8(wb, bv);
#pragma unroll
            for (int j = 0; j < 8; ++j) { const float inv = inv_theta((float)j / 8.0f); const float ang = pos * inv; const float cs = fcos(ang), sn = fsin(ang);
                const float lo = av[j] * cs - bv[j] * sn, hv = av[j] * sn + bv[j] * cs; ov[j] = (hi ? hv : lo) * QSCALE_MLA; }
            qr[4 + c] = __builtin_bit_cast(bf16x8, pack8(ov));
        }
    } else {
        const bf16_t* qp = (const bf16_t*)(ws + WS_QG) + qrow * 512 + (h - 8) * 64;
#pragma unroll
        for (int d0 = 0; d0 < ND; ++d0) qr[d0] = *(const bf16x8*)(qp + 16 * d0 + 8 * hi);
    }
    const int kkey = tid & 63, kc0 = tid >> 6, vkv = tid >> 3, vdc = tid & 7;
    const unsigned kdst0 = kc0 * 1024 + kkey * 16, kdst1 = (kc0 + 8) * 1024 + kkey * 16;
    const unsigned vdst = (vdc >> 2) * 4096 + (vkv >> 4) * 1024 + (vkv & 15) * 64 + (vdc & 3) * 16;
    u32x4 kreg0, kreg1, vreg;
    auto load_k = [&](int kt) { const size_t rk = key_row(b, kt * 64 + kkey);
        if (DK == 96) { kreg0 = *(const u32x4*)(KV + rk * 1024 + h * 128 + 8 * kc0); if (wid < 4) kreg1 = *(const u32x4*)(KR + rk * 32 + 8 * kc0); }
        else kreg0 = *(const u32x4*)(KG + rk * 128 + kvh * 64 + 8 * kc0); };
    auto load_v = [&](int kt) { const size_t rv = key_row(b, kt * 64 + vkv);
        if (DK == 96) vreg = *(const u32x4*)(KV + rv * 1024 + h * 128 + 64 + 8 * vdc); else vreg = *(const u32x4*)(VG + rv * 128 + kvh * 64 + 8 * vdc); };
    auto store_k = [&](int buf) { *(LAS u32x4*)(Kb + buf * KB + kdst0) = kreg0; if (DK == 96) { if (wid < 4) *(LAS u32x4*)(Kb + buf * KB + kdst1) = kreg1; } };
    auto store_v = [&](int buf) { *(LAS u32x4*)(Vb + buf * VB + vdst) = vreg; };
    f32x16 o0 = {}, o1 = {};
    float mhat = 0.f, lrun = 0.f;
    const unsigned kfo = hi * 1024 + r32 * 16;
    const unsigned vfo = ((lane >> 4) & 1) * 32 + (lane & 3) * 8 + (4 * hi + ((lane & 15) >> 2)) * 64;
#define A2_SBAR() __builtin_amdgcn_sched_barrier(0)
#define A2_EL(X0, X1, i) ((i) < 16 ? X0[(i) & 15] : X1[(i) & 15])
    f32x16 negm; { float z0 = 0.f; asm volatile("" : "+v"(z0));
#pragma unroll
        for (int r = 0; r < 16; ++r) negm[r] = z0; }
    float rmx = 0.f;
#define A2_STEP(C0, C1, P0, P1, T, HASK) do { const int t_ = (T); \
        float f_ = 1.0f; const bool resc_ = __any(rmx > THR); \
        if (resc_) { const float dl_ = __builtin_fmaxf(rmx, 0.f); mhat += dl_; f_ = __builtin_amdgcn_exp2f(-dl_); if (hi == 0) wsf[r32] = f_; \
            _Pragma("unroll") for (int r = 0; r < 16; ++r) negm[r] = -mhat; } \
        if (HASK) load_k(t_ + 1); \
        load_v(t_); \
        const LAS unsigned char* kp_ = Kb + (t_ & 1) * KB + kfo; const LAS unsigned char* vp_ = Vb + ((t_ + 1) & 1) * VB + vfo; \
        float sacc_ = 0.f; unsigned pw_[16]; s16x4 vl_[8], vh_[8]; bf16x8 kf_[2 * ND]; \
        kf_[0] = *(const LAS bf16x8*)(kp_); kf_[1] = *(const LAS bf16x8*)(kp_ + 512); \
        A2_SBAR(); \
        _Pragma("unroll") for (int g = 0; g < 2 * ND; ++g) { \
            if (g + 2 < 2 * ND) kf_[g + 2] = *(const LAS bf16x8*)(kp_ + ((g + 2) >> 1) * 2048 + ((g + 2) & 1) * 512); \
            if (g < 8) { vl_[g] = __builtin_amdgcn_ds_read_tr16_b64_v4i16((LAS s16x4*)(vp_ + (g >> 2) * 4096 + (g & 3) * 1024)); \
                         vh_[g] = __builtin_amdgcn_ds_read_tr16_b64_v4i16((LAS s16x4*)(vp_ + (g >> 2) * 4096 + (g & 3) * 1024 + 512)); } \
            if ((g & 1) == 0) { if (g == 0) C0 = __builtin_amdgcn_mfma_f32_32x32x16_bf16(kf_[g], qr[g >> 1], negm, 0, 0, 0); else C0 = __builtin_amdgcn_mfma_f32_32x32x16_bf16(kf_[g], qr[g >> 1], C0, 0, 0, 0); } \
            else { if (g == 1) C1 = __builtin_amdgcn_mfma_f32_32x32x16_bf16(kf_[g], qr[g >> 1], negm, 0, 0, 0); else C1 = __builtin_amdgcn_mfma_f32_32x32x16_bf16(kf_[g], qr[g >> 1], C1, 0, 0, 0); } \
            { constexpr int NA = (ND == 6) ? 3 : 4; \
                _Pragma("unroll") for (int i = 0; i < NA; ++i) { const int e = NA * g + i; if (e < 32) sacc_ += A2_EL(P0, P1, e); } \
                if (g < 8) { pw_[2 * g] = cvtpk(A2_EL(P0, P1, 4 * g), A2_EL(P0, P1, 4 * g + 1)); pw_[2 * g + 1] = cvtpk(A2_EL(P0, P1, 4 * g + 2), A2_EL(P0, P1, 4 * g + 3)); asm volatile("" : "+v"(pw_[2 * g]), "+v"(pw_[2 * g + 1])); } \
                asm volatile("" : "+v"(sacc_)); } \
            A2_SBAR(); } \
        lrun = (lrun + sacc_) * f_; \
        float rm_ = 0.f; \
        _Pragma("unroll") for (int g = 0; g < 8; ++g) { \
            { const int ks = g >> 1, dv = g & 1; const u32x4 pa_ = {pw_[4 * ks], pw_[4 * ks + 1], pw_[4 * ks + 2], pw_[4 * ks + 3]}; \
                const s16x4 l_ = vl_[dv * 4 + ks], h_ = vh_[dv * 4 + ks]; const bf16x8 vf_ = {l_[0], l_[1], l_[2], l_[3], h_[0], h_[1], h_[2], h_[3]}; \
                if (dv == 0) o0 = __builtin_amdgcn_mfma_f32_32x32x16_bf16(__builtin_bit_cast(bf16x8, pa_), vf_, o0, 0, 0, 0); \
                else o1 = __builtin_amdgcn_mfma_f32_32x32x16_bf16(__builtin_bit_cast(bf16x8, pa_), vf_, o1, 0, 0, 0); } \
            if (g == 0) { rm_ = __builtin_fmaxf(__builtin_fmaxf(C0[0], C0[1]), __builtin_fmaxf(C0[2], C0[3])); }          \
            else if (g == 4) { rm_ = __builtin_fmaxf(rm_, __builtin_fmaxf(__builtin_fmaxf(C1[0], C1[1]), __builtin_fmaxf(C1[2], C1[3]))); } \
            else if (g < 4) { rm_ = max3f(rm_, C0[4 * g], C0[4 * g + 1]); rm_ = max3f(rm_, C0[4 * g + 2], C0[4 * g + 3]); } \
            else { rm_ = max3f(rm_, C1[4 * g - 16], C1[4 * g - 15]); rm_ = max3f(rm_, C1[4 * g - 14], C1[4 * g - 13]); } \
            asm volatile("" : "+v"(rm_)); \
            _Pragma("unroll") for (int i = 0; i < 4; ++i) { const int e = 4 * g + i; if (e < 16) C0[e & 15] = __builtin_amdgcn_exp2f(C0[e & 15]); else C1[e & 15] = __builtin_amdgcn_exp2f(C1[e & 15]); } \
            if (g < 4) asm volatile("" : "+v"(C0)); else asm volatile("" : "+v"(C1)); \
            A2_SBAR(); } \
        { auto rr_ = __builtin_amdgcn_permlane32_swap(__float_as_uint(rm_), __float_as_uint(rm_), false, false); rmx = __builtin_fmaxf(__uint_as_float(rr_[0]), __uint_as_float(rr_[1])); } \
        if (resc_) { asm volatile("s_waitcnt lgkmcnt(0)" ::: "memory"); \
            _Pragma("unroll") for (int g4 = 0; g4 < 4; ++g4) { const f32x4 a4 = *(const LAS f32x4*)(wsf + 8 * g4 + 4 * hi); \
                _Pragma("unroll") for (int e = 0; e < 4; ++e) { o0[4 * g4 + e] *= a4[e]; o1[4 * g4 + e] *= a4[e]; } } } \
        if (HASK) store_k((t_ + 1) & 1); \
        store_v(t_ & 1); \
        __syncthreads(); } while (0)
    load_k(0); store_k(0);
    __syncthreads();
    f32x16 sA0, sA1, sB0, sB1;
    {
        load_k(1); load_v(0);
        const LAS unsigned char* kp_ = Kb + kfo;
#pragma unroll
        for (int d0 = 0; d0 < ND; ++d0) { const bf16x8 k0 = *(const LAS bf16x8*)(kp_ + d0 * 2048), k1 = *(const LAS bf16x8*)(kp_ + d0 * 2048 + 512);
            sA0 = __builtin_amdgcn_mfma_f32_32x32x16_bf16(k0, qr[d0], d0 == 0 ? negm : sA0, 0, 0, 0); sA1 = __builtin_amdgcn_mfma_f32_32x32x16_bf16(k1, qr[d0], d0 == 0 ? negm : sA1, 0, 0, 0); }
        float rm = __builtin_fmaxf(sA0[0], sA1[0]);
#pragma unroll
        for (int r = 1; r < 16; ++r) rm = __builtin_fmaxf(rm, __builtin_fmaxf(sA0[r], sA1[r]));
        { auto rr = __builtin_amdgcn_permlane32_swap(__float_as_uint(rm), __float_as_uint(rm), false, false); rm = __builtin_fmaxf(__uint_as_float(rr[0]), __uint_as_float(rr[1])); }
        mhat = rm;
#pragma unroll
        for (int r = 0; r < 16; ++r) { negm[r] = -mhat; sA0[r] = __builtin_amdgcn_exp2f(sA0[r] - mhat); sA1[r] = __builtin_amdgcn_exp2f(sA1[r] - mhat); }
        store_k(1); store_v(0);
        __syncthreads();
    }
    for (int t = 1; t + 1 < NT; t += 2) {
        A2_STEP(sB0, sB1, sA0, sA1, t, true);
        A2_STEP(sA0, sA1, sB0, sB1, t + 1, true);
    }
    A2_STEP(sB0, sB1, sA0, sA1, NT - 1, false);
    {
        float sacc = 0.f;
#pragma unroll
        for (int r = 0; r < 16; ++r) sacc += sB0[r] + sB1[r];
        lrun += sacc;
        const LAS unsigned char* vp = Vb + ((NT - 1) & 1) * VB + vfo;
#pragma unroll
        for (int ks = 0; ks < 4; ++ks) {
            const f32x16& P = (ks < 2) ? sB0 : sB1; const int bse = 8 * (ks & 1);
            const u32x4 pa = {cvtpk(P[bse], P[bse + 1]), cvtpk(P[bse + 2], P[bse + 3]), cvtpk(P[bse + 4], P[bse + 5]), cvtpk(P[bse + 6], P[bse + 7])};
            const s16x4 l0 = __builtin_amdgcn_ds_read_tr16_b64_v4i16((LAS s16x4*)(vp + ks * 1024)), h0 = __builtin_amdgcn_ds_read_tr16_b64_v4i16((LAS s16x4*)(vp + ks * 1024 + 512));
            const s16x4 l1 = __builtin_amdgcn_ds_read_tr16_b64_v4i16((LAS s16x4*)(vp + 4096 + ks * 1024)), h1 = __builtin_amdgcn_ds_read_tr16_b64_v4i16((LAS s16x4*)(vp + 4096 + ks * 1024 + 512));
            const bf16x8 v0 = {l0[0], l0[1], l0[2], l0[3], h0[0], h0[1], h0[2], h0[3]}, v1 = {l1[0], l1[1], l1[2], l1[3], h1[0], h1[1], h1[2], h1[3]};
            o0 = __builtin_amdgcn_mfma_f32_32x32x16_bf16(__builtin_bit_cast(bf16x8, pa), v0, o0, 0, 0, 0);
            o1 = __builtin_amdgcn_mfma_f32_32x32x16_bf16(__builtin_bit_cast(bf16x8, pa), v1, o1, 0, 0, 0);
        }
    }
#undef A2_STEP
#undef A2_EL
#undef A2_SBAR
    lrun += __shfl_xor(lrun, 32);
    if (hi == 0) wsf[32 + r32] = lrun;
    asm volatile("s_waitcnt lgkmcnt(0)" ::: "memory");
    bf16_t* Ow = (bf16_t*)(ws + WS_O) + ((size_t)b * SEQ + qb * 256 + wid * 32) * 1024 + h * 64;
#pragma unroll
    for (int r = 0; r < 16; ++r) { const int orow = crow(r, hi); const float rl = __builtin_amdgcn_rcpf(wsf[32 + orow]);
        Ow[(size_t)orow * 1024 + r32] = (bf16_t)f2bf(o0[r] * rl); Ow[(size_t)orow * 1024 + 32 + r32] = (bf16_t)f2bf(o1[r] * rl); }
    __syncthreads();
}
__device__ __forceinline__ void phase_attn(const Ctx& p, LAS unsigned char* lds) {
    const int xcd = p.bid & 7, sl = p.bid >> 3, c = sl & 1, b = 2 * xcd + (sl >> 4), qb = (sl >> 1) & 7;
    for (int i = 0; i < 8; ++i) { const int h = 2 * i + (c & 1);
#if ATTN_V1
        if (h < 8) attn_unit<96>(p, b, h, qb, lds); else attn_unit<64>(p, b, h, qb, lds); }
#else
        int tid = p.tid; asm volatile("" : "+v"(tid));
        if (h < 8) attn_unit2<96>(p, tid, b, h, qb, lds); else attn_unit2<64>(p, tid, b, h, qb, lds); }
#endif
}

__device__ __forceinline__ void hyena_taps(const Ctx& p, int c, LAS unsigned char* scratch, float (&taps)[4][2][2]) {
    const int tid = p.tid, lane = tid & 63, wave = __builtin_amdgcn_readfirstlane(tid >> 6);
    LAS float* w4s = (LAS float*)scratch;
    LAS float* red = (LAS float*)(scratch + 1024);
    const float* w4 = p.in[I_FW4]; const float* H3 = (const float*)(p.ws + WS_H3);
    if (tid < 256) { const int cc = tid >> 6, k = tid & 63; w4s[cc * 64 + k] = w4[(size_t)k * 4096 + (cc >> 1) * 2048 + (cc & 1) * 1024 + c]; }
    __syncthreads();
    const float dmin = -3.0701134573253940f, dmax = -15.350567286626970f;
    const float delta = fabsf(dmin + (float)c * ((dmax - dmin) / 1023.0f));
    float ss0 = 0.f, ss1 = 0.f;
    float a[4][4];
#pragma unroll
    for (int i = 0; i < 4; ++i)
#pragma unroll
        for (int cc = 0; cc < 4; ++cc) a[i][cc] = 0.f;
#pragma unroll 2
    for (int k4 = 0; k4 < 16; ++k4) {
        f32x4 wv[4];
#pragma unroll
        for (int cc = 0; cc < 4; ++cc) wv[cc] = *(const LAS f32x4*)(w4s + cc * 64 + 4 * k4);
#pragma unroll
        for (int i = 0; i < 4; ++i) { const f32x4 hv = *((const f32x4*)(H3 + (size_t)(tid + 512 * i) * 64) + k4);
#pragma unroll
            for (int cc = 0; cc < 4; ++cc) a[i][cc] += (hv[0] * wv[cc][0] + hv[1] * wv[cc][1]) + (hv[2] * wv[cc][2] + hv[3] * wv[cc][3]); }
    }
#pragma unroll
    for (int i = 0; i < 4; ++i) {
        const int t = tid + 512 * i;
        const float win = expf(-((float)t / 2048.0f) * delta);
#pragma unroll
        for (int cc = 0; cc < 4; ++cc) a[i][cc] *= win;
        taps[i][0][0] = a[i][0]; taps[i][0][1] = a[i][1]; taps[i][1][0] = a[i][2]; taps[i][1][1] = a[i][3];
        ss0 += a[i][0] * a[i][0] + a[i][2] * a[i][2]; ss1 += a[i][1] * a[i][1] + a[i][3] * a[i][3];
    }
    ss0 = wave_sum(ss0); ss1 = wave_sum(ss1);
    if (lane == 0) { red[wave * 2] = ss0; red[wave * 2 + 1] = ss1; }
    __syncthreads();
    float t0 = 0.f, t1 = 0.f;
#pragma unroll
    for (int w = 0; w < 8; ++w) { t0 += red[w * 2]; t1 += red[w * 2 + 1]; }
    const float n0 = rsqrtf(t0 + EPS), n1 = rsqrtf(t1 + EPS);
#pragma unroll
    for (int i = 0; i < 4; ++i) { taps[i][0][0] *= n0; taps[i][1][0] *= n0; taps[i][0][1] *= n1; taps[i][1][1] *= n1; }
    __syncthreads();
}
__device__ __forceinline__ void hyena_taps_block(const Ctx& p, LAS unsigned char* lds) {
    const int tid = p.tid, lane = tid & 63, wave = __builtin_amdgcn_readfirstlane(tid >> 6), fr = lane & 15, fq = lane >> 4;
    LAS float* w4s = (LAS float*)lds;
    LAS float* red = (LAS float*)(lds + 4096);
    const float* w4 = p.in[I_FW4]; const float* H3 = (const float*)(p.ws + WS_H3); bf16_t* F = (bf16_t*)(p.ws + WS_FILT);
    for (int i = tid; i < 1024; i += NTHREADS) { const int col = i >> 6, k = i & 63, q = col >> 2, cc = col & 3; const int c = p.bid + p.nblk * q;
        w4s[i] = (c < DM) ? w4[(size_t)k * 4096 + (cc >> 1) * 2048 + (cc & 1) * 1024 + c] : 0.f; }
    __syncthreads();
    bf16x8 bfr[2];
#pragma unroll
    for (int ks = 0; ks < 2; ++ks) { const f32x4 b0 = *(const LAS f32x4*)(w4s + fr * 64 + 32 * ks + 8 * fq), b1 = *(const LAS f32x4*)(w4s + fr * 64 + 32 * ks + 8 * fq + 4);
        const u32x4 w = {cvtpk(b0[0], b0[1]), cvtpk(b0[2], b0[3]), cvtpk(b1[0], b1[1]), cvtpk(b1[2], b1[3])}; bfr[ks] = __builtin_bit_cast(bf16x8, w); }
    f32x4 acc[16];
#pragma unroll
    for (int g = 0; g < 4; ++g) {
        f32x4 hv[4][2][2];
#pragma unroll
        for (int j = 0; j < 4; ++j)
#pragma unroll
            for (int ks = 0; ks < 2; ++ks) { const float* hp = H3 + (size_t)(16 * (wave * 16 + 4 * g + j) + fr) * 64 + 32 * ks + 8 * fq; hv[j][ks][0] = *(const f32x4*)hp; hv[j][ks][1] = *(const f32x4*)(hp + 4); }
#pragma unroll
        for (int j = 0; j < 4; ++j) { f32x4 a = {0.f, 0.f, 0.f, 0.f};
#pragma unroll
            for (int ks = 0; ks < 2; ++ks) { const f32x4 h0 = hv[j][ks][0], h1 = hv[j][ks][1];
                const u32x4 w = {cvtpk(h0[0], h0[1]), cvtpk(h0[2], h0[3]), cvtpk(h1[0], h1[1]), cvtpk(h1[2], h1[3])};
                a = __builtin_amdgcn_mfma_f32_16x16x32_bf16(__builtin_bit_cast(bf16x8, w), bfr[ks], a, 0, 0, 0); }
            acc[4 * g + j] = a; }
        __builtin_amdgcn_sched_barrier(0);
    }
    const int q = fr >> 2, o = fr & 1, dir = (fr >> 1) & 1, c = p.bid + p.nblk * q;
    const float dmin = -3.0701134573253940f, dmax = -15.350567286626970f;
    const float delta = fabsf(dmin + (float)c * ((dmax - dmin) / 1023.0f));
    const float r1 = expf(-delta / 2048.0f);
    float ssq = 0.f;
#pragma unroll
    for (int tt = 0; tt < 16; ++tt) { const int tb = 16 * (16 * wave + tt) + 4 * fq; float win = expf(-((float)tb / 2048.0f) * delta);
#pragma unroll
        for (int e = 0; e < 4; ++e) { const float v = acc[tt][e] * win; acc[tt][e] = v; ssq += v * v; win *= r1; } }
    ssq += __shfl_xor(ssq, 16); ssq += __shfl_xor(ssq, 32); ssq += __shfl_xor(ssq, 2);
    if (fq == 0 && dir == 0) red[wave * 8 + q * 2 + o] = ssq;
    __syncthreads();
    float tot = 0.f;
#pragma unroll
    for (int w = 0; w < 8; ++w) tot += red[w * 8 + q * 2 + o];
    const float nrm = rsqrtf(tot + EPS);
    LAS bf16_t* st = (LAS bf16_t*)(lds + 8192) + (q * 2 + o) * 4096 + 2048;
#pragma unroll
    for (int tt = 0; tt < 16; ++tt)
#pragma unroll
        for (int e = 0; e < 4; ++e) { const int t = 16 * (16 * wave + tt) + 4 * fq + e; const bf16_t v = (bf16_t)f2bf(acc[tt][e] * nrm);
            if (dir == 0) st[-t] = v; else if (t > 0) st[t] = v; }
    __syncthreads();
#pragma unroll
    for (int j = 0; j < 8; ++j) { const int idx = tid + 512 * j, arr = idx >> 9, off = idx & 511; const int cq = p.bid + p.nblk * (arr >> 1);
        const u32x4 w = *(const LAS u32x4*)(lds + 8192 + arr * 8192 + off * 16);
        if (cq < DM) *(u32x4*)(F + (size_t)(cq * 2 + (arr & 1)) * 4096 + 8 * off) = w; }
    __builtin_amdgcn_fence(__ATOMIC_RELEASE, "workgroup");
    asm volatile("s_waitcnt vmcnt(0)" ::: "memory");
    __syncthreads();
    __builtin_amdgcn_fence(__ATOMIC_ACQUIRE, "workgroup");
}
__device__ __forceinline__ float sconv_at(const bf16_t* zr, int b, int n, float w0, float w1, float w2, float cb) {
    const bf16_t* q = zr + b * SEQ + n;
    const float l = n > 0 ? bf2f(q[-1]) : 0.f, m = bf2f(q[0]), r = n < SEQ - 1 ? bf2f(q[1]) : 0.f;
    return cb + w0 * l + w1 * m + w2 * r;
}

__device__ __forceinline__ void phase_nconv_filt(const Ctx& p, LAS unsigned char* lds) {
    bf16_t* F = (bf16_t*)(p.ws + WS_FILT);
    for (int c = p.bid; c < DM; c += p.nblk) {
        float taps[4][2][2];
        hyena_taps(p, c, lds, taps);
#pragma unroll
        for (int i = 0; i < 4; ++i) { const int t = p.tid + 512 * i;
#pragma unroll
            for (int o = 0; o < 2; ++o) { bf16_t* f = F + (size_t)(c * 2 + o) * 4096;
                f[2048 - t] = (bf16_t)f2bf(taps[i][0][o]);
                if (t > 0) f[2048 + t] = (bf16_t)f2bf(taps[i][1][o]); } }
    }
}
__device__ __forceinline__ void phase_nconv_u0(const Ctx& p) {
    const bf16_t* ZT = (const bf16_t*)(p.ws + WS_ZT); bf16_t* U0 = (bf16_t*)(p.ws + WS_U0T);
    const float* cw = p.in[I_HCW]; const float* cb = p.in[I_HCB];
    for (size_t idx = (size_t)p.bid * NTHREADS + p.tid; idx < (size_t)DM * ML; idx += (size_t)p.nblk * NTHREADS) {
        const int c = (int)(idx >> 15), bn = (int)(idx & 32767), b = bn >> 11, n = bn & 2047; const int ch = 2048 + c;
        U0[idx] = (bf16_t)f2bf(sconv_at(ZT + (size_t)ch * ML, b, n, cw[ch], cw[3072 + ch], cw[6144 + ch], cb[ch]));
    }
}
__device__ __forceinline__ void phase_nconv_pass(const Ctx& p, int o) {
    const bf16_t* ZT = (const bf16_t*)(p.ws + WS_ZT); const bf16_t* F = (const bf16_t*)(p.ws + WS_FILT);
    const bf16_t* U = (const bf16_t*)(p.ws + (o == 0 ? WS_U0T : WS_Y1T)); bf16_t* Y = (bf16_t*)(p.ws + (o == 0 ? WS_Y1T : WS_Y2T));
    const float* cw = p.in[I_HCW]; const float* cb = p.in[I_HCB]; const float* skip = p.in[I_HSKIP];
    for (size_t idx = (size_t)p.bid * NTHREADS + p.tid; idx < (size_t)DM * ML; idx += (size_t)p.nblk * NTHREADS) {
        const int c = (int)(idx >> 15), bn = (int)(idx & 32767), b = bn >> 11, n = bn & 2047;
        const bf16_t* u = U + (size_t)c * ML + b * SEQ; const bf16_t* f = F + (size_t)(c * 2 + o) * 4096 + 2048 - n;
        float acc = 0.f;
        for (int m = 0; m < SEQ; ++m) acc += bf2f(f[m]) * bf2f(u[m]);
        acc += skip[o * DM + c] * bf2f(u[n]);
        const int ch = o * 1024 + c;
        const float gate = sconv_at(ZT + (size_t)ch * ML, b, n, cw[ch], cw[3072 + ch], cw[6144 + ch], cb[ch]);
        Y[idx] = (bf16_t)f2bf(gate * acc);
    }
}

constexpr int CV_USTRIDE = 4112;
constexpr int CV_U = 0;
constexpr int CV_CP = 65792, CV_CPSTRIDE = 8208;
static_assert(CV_CP + 8 * CV_CPSTRIDE <= LDS_BYTES, "conv LDS map");

__device__ __forceinline__ void conv_build_copies(const int tid, LAS unsigned char* lds, const bf16_t* rev) {
    const u32x4 cur = *(const u32x4*)(rev + 8 * tid);
    u32x4 prv = {0u, 0u, 0u, 0u};
    if (tid > 0) prv = *(const u32x4*)(rev + 8 * tid - 8);
    const unsigned W[8] = {prv.x, prv.y, prv.z, prv.w, cur.x, cur.y, cur.z, cur.w};
#pragma unroll
    for (int rho = 0; rho < 8; ++rho) {
        unsigned o[4];
#pragma unroll
        for (int d = 0; d < 4; ++d) { const int e0 = 8 - rho + 2 * d;
            o[d] = (e0 & 1) ? __builtin_amdgcn_alignbit(W[(e0 >> 1) + 1], W[e0 >> 1], 16) : W[e0 >> 1]; }
        *(LAS u32x4*)(lds + CV_CP + rho * CV_CPSTRIDE + 16 * tid) = (u32x4){o[0], o[1], o[2], o[3]};
    }
}
__device__ __forceinline__ void sconv4(const bf16_t* zr, int n, float w0, float w1, float w2, float cb, float (&g)[4]) {
    const u32x2 w = *(const u32x2*)(zr + n);
    const float l = n > 0 ? bf2f(zr[n - 1]) : 0.f, r = n + 4 < SEQ ? bf2f(zr[n + 4]) : 0.f;
    const float x[6] = {l, bflo(w.x), bfhi(w.x), bflo(w.y), bfhi(w.y), r};
#pragma unroll
    for (int e = 0; e < 4; ++e) g[e] = cb + w0 * x[e] + w1 * x[e + 1] + w2 * x[e + 2];
}
__device__ __forceinline__ void conv_mma(const int tid, LAS unsigned char* lds, f32x4 (&acc)[16]) {
    const int lane = tid & 63, wave = __builtin_amdgcn_readfirstlane(tid >> 6);
#pragma unroll
    for (int i = 0; i < 16; ++i) acc[i] = (f32x4){0.f, 0.f, 0.f, 0.f};
    const LAS unsigned char* ab = lds + CV_CP + (lane & 7) * CV_CPSTRIDE + 2 * (2048 - 8 * ((lane & 15) >> 3) + 8 * (lane >> 4)) - 32 * (16 * wave);
    const LAS unsigned char* ub = lds + CV_U + (lane & 15) * CV_USTRIDE + 16 * (lane >> 4);
    bf16x8 w0, w1, w2, w3, w4, w5, w6, w7, w8, w9, w10, w11, w12, w13, w14, w15;
#define CV_LD(i) (*(const LAS bf16x8*)(ab - 32 * (i)))
    w0 = CV_LD(0); w1 = CV_LD(1); w2 = CV_LD(2); w3 = CV_LD(3); w4 = CV_LD(4); w5 = CV_LD(5); w6 = CV_LD(6); w7 = CV_LD(7);
    w8 = CV_LD(8); w9 = CV_LD(9); w10 = CV_LD(10); w11 = CV_LD(11); w12 = CV_LD(12); w13 = CV_LD(13); w14 = CV_LD(14); w15 = CV_LD(15);
#undef CV_LD
#define CV_MF(i, W) acc[i] = __builtin_amdgcn_mfma_f32_16x16x32_bf16(W, uf, acc[i], 0, 0, 0)
#define CV_STEP(jj, A0, A1, A2, A3, A4, A5, A6, A7, A8, A9, A10, A11, A12, A13, A14, A15) do { \
        const int j = J * 8 + (jj); \
        const int jn = (j + 1 < 64) ? (j + 1) : j; \
        const bf16x8 ufn = *(const LAS bf16x8*)(ub + 64 * jn); \
        const bf16x8 n0 = *(const LAS bf16x8*)(ab + 64 * jn), n1 = *(const LAS bf16x8*)(ab + 64 * jn - 32); \
        CV_MF(0, A0); CV_MF(1, A1); CV_MF(2, A2); CV_MF(3, A3); CV_MF(4, A4); CV_MF(5, A5); CV_MF(6, A6); CV_MF(7, A7); \
        CV_MF(8, A8); CV_MF(9, A9); CV_MF(10, A10); CV_MF(11, A11); CV_MF(12, A12); CV_MF(13, A13); CV_MF(14, A14); CV_MF(15, A15); \
        A14 = n0; A15 = n1; uf = ufn; } while (0)
    bf16x8 uf = *(const LAS bf16x8*)ub;
    for (int J = 0; J < 8; ++J) {
        CV_STEP(0, w0, w1, w2, w3, w4, w5, w6, w7, w8, w9, w10, w11, w12, w13, w14, w15);
        CV_STEP(1, w14, w15, w0, w1, w2, w3, w4, w5, w6, w7, w8, w9, w10, w11, w12, w13);
        CV_STEP(2, w12, w13, w14, w15, w0, w1, w2, w3, w4, w5, w6, w7, w8, w9, w10, w11);
        CV_STEP(3, w10, w11, w12, w13, w14, w15, w0, w1, w2, w3, w4, w5, w6, w7, w8, w9);
        CV_STEP(4, w8, w9, w10, w11, w12, w13, w14, w15, w0, w1, w2, w3, w4, w5, w6, w7);
        CV_STEP(5, w6, w7, w8, w9, w10, w11, w12, w13, w14, w15, w0, w1, w2, w3, w4, w5);
        CV_STEP(6, w4, w5, w6, w7, w8, w9, w10, w11, w12, w13, w14, w15, w0, w1, w2, w3);
        CV_STEP(7, w2, w3, w4, w5, w6, w7, w8, w9, w10, w11, w12, w13, w14, w15, w0, w1);
    }
#undef CV_STEP
#undef CV_MF
}
struct SconvRow { u32x4 w[8]; float prev, last; };
__device__ __forceinline__ void sconv_row_load(const int tid, const bf16_t* zrow, SconvRow& R) {
    const int b = tid >> 5, m0 = (tid & 31) * 64; const bf16_t* zr = zrow + b * SEQ;
#pragma unroll
    for (int k8 = 0; k8 < 8; ++k8) R.w[k8] = *(const u32x4*)(zr + m0 + 8 * k8);
    R.prev = m0 > 0 ? bf2f(zr[m0 - 1]) : 0.f;
    R.last = m0 + 64 < SEQ ? bf2f(zr[m0 + 64]) : 0.f;
}
template <int STRIDE, bool W16>
__device__ __forceinline__ void sconv_row_store(const int tid, const SconvRow& R, float w0, float w1, float w2, float bb, LAS unsigned char* dst) {
    const int b = tid >> 5, m0 = (tid & 31) * 64;
    float prev = R.prev;
#pragma unroll
    for (int k8 = 0; k8 < 8; ++k8) {
        const float nxt = k8 < 7 ? bflo(R.w[k8 < 7 ? k8 + 1 : 7].x) : R.last;
        const float x[10] = {prev, bflo(R.w[k8].x), bfhi(R.w[k8].x), bflo(R.w[k8].y), bfhi(R.w[k8].y), bflo(R.w[k8].z), bfhi(R.w[k8].z), bflo(R.w[k8].w), bfhi(R.w[k8].w), nxt};
        float y[8];
#pragma unroll
        for (int e = 0; e < 8; ++e) y[e] = bb + w0 * x[e] + w1 * x[e + 1] + w2 * x[e + 2];
        const u32x4 o = {cvtpk(y[0], y[1]), cvtpk(y[2], y[3]), cvtpk(y[4], y[5]), cvtpk(y[6], y[7])};
        LAS unsigned char* d = dst + b * STRIDE + 2 * (m0 + 8 * k8);
        if (W16) *(LAS u32x4*)d = o; else { *(LAS u32x2*)d = (u32x2){o.x, o.y}; *(LAS u32x2*)(d + 8) = (u32x2){o.z, o.w}; }
        prev = x[8];
    }
}
constexpr int CV_GSTRIDE = 4104;
static_assert(16 * CV_GSTRIDE <= 8 * CV_CPSTRIDE, "gate image fits the copies region");
__device__ __forceinline__ void phase_conv(const Ctx& p, LAS unsigned char* lds) {
    const bf16_t* ZT = (const bf16_t*)(p.ws + WS_ZT); bf16_t* Y2T = (bf16_t*)(p.ws + WS_Y2T); const bf16_t* F = (const bf16_t*)(p.ws + WS_FILT);
    const float* cw = p.in[I_HCW]; const float* cb = p.in[I_HCB]; const float* skip = p.in[I_HSKIP];
    hyena_taps_block(p, lds);
    for (int c = p.bid; c < DM; c += p.nblk) {
        int tid = p.tid; asm volatile("" : "+v"(tid));
        const int lane = tid & 63, wave = __builtin_amdgcn_readfirstlane(tid >> 6);
        const int b = lane & 15, nq = 256 * wave + 4 * (lane >> 4);
        LAS unsigned char* Ul = lds + CV_U; LAS unsigned char* Gl = lds + CV_CP;
        { const int ch = 2048 + c; SconvRow R; sconv_row_load(tid, ZT + (size_t)ch * ML, R); sconv_row_store<CV_USTRIDE, true>(tid, R, cw[ch], cw[3072 + ch], cw[6144 + ch], cb[ch], Ul); }
        conv_build_copies(tid, lds, F + (size_t)(c * 2 + 0) * 4096);
        __syncthreads();
        f32x4 acc[16];
#pragma unroll 1
        for (int o = 0; o < 2; ++o) {
            const int chg = o * 1024 + c; SconvRow RG; sconv_row_load(tid, ZT + (size_t)chg * ML, RG);
            conv_mma(tid, lds, acc);
            __syncthreads();
            sconv_row_store<CV_GSTRIDE, false>(tid, RG, cw[chg], cw[3072 + chg], cw[6144 + chg], cb[chg], Gl);
            __syncthreads();
            { const float sk = skip[o * DM + c];
#pragma unroll
              for (int i = 0; i < 16; ++i) { const int n = nq + 16 * i; LAS u32x2* up = (LAS u32x2*)(Ul + b * CV_USTRIDE + 2 * n);
                  const u32x2 uw = *up, gw = *(const LAS u32x2*)(Gl + b * CV_GSTRIDE + 2 * n);
                  const float u[4] = {bflo(uw.x), bfhi(uw.x), bflo(uw.y), bfhi(uw.y)}, g[4] = {bflo(gw.x), bfhi(gw.x), bflo(gw.y), bfhi(gw.y)};
                  float y[4];
#pragma unroll
                  for (int e = 0; e < 4; ++e) y[e] = g[e] * (acc[i][e] + sk * u[e]);
                  *up = (u32x2){cvtpk(y[0], y[1]), cvtpk(y[2], y[3])}; } }
            __syncthreads();
            if (o == 0) { conv_build_copies(tid, lds, F + (size_t)(c * 2 + 1) * 4096); __syncthreads(); }
        }
        { const int bb_ = tid >> 5, m0 = (tid & 31) * 64; bf16_t* dst = Y2T + (size_t)c * ML + bb_ * SEQ + m0;
#pragma unroll
          for (int k8 = 0; k8 < 8; ++k8) *(u32x4*)(dst + 8 * k8) = *(const LAS u32x4*)(Ul + bb_ * CV_USTRIDE + 2 * (m0 + 8 * k8)); }
        __syncthreads();
    }
}

__device__ __forceinline__ void phase_transpose(const Ctx& p, LAS unsigned char* lds) {
    const int tid = p.tid, lane = tid & 63, wave = __builtin_amdgcn_readfirstlane(tid >> 6);
    const bf16_t* src = (const bf16_t*)(p.ws + WS_Y2T); bf16_t* dst = (bf16_t*)(p.ws + WS_Y2);
    LAS bf16_t* tile = (LAS bf16_t*)(lds + wave * 16384);
    const int gw = p.bid * NWAVES + wave, ngw = p.nblk * NWAVES;
    for (int it = gw; it < (DM / 64) * (ML / 64); it += ngw) {
        const int cb = it & 15, tb = it >> 4, c0 = cb * 64, t0 = tb * 64;
#pragma unroll
        for (int i = 0; i < 8; ++i) { const int r = 8 * i + (lane >> 3), ch = lane & 7;
            const u32x4 w = *(const u32x4*)(src + (size_t)(c0 + r) * ML + t0 + 8 * ch);
            LAS unsigned* d = (LAS unsigned*)(tile + r * 66 + 8 * ch); d[0] = w.x; d[1] = w.y; d[2] = w.z; d[3] = w.w; }
        asm volatile("s_waitcnt lgkmcnt(0)" ::: "memory");
#pragma unroll
        for (int i = 0; i < 8; ++i) { const int t = 8 * i + (lane >> 3), ch = lane & 7; unsigned short e[8];
#pragma unroll
            for (int k = 0; k < 8; ++k) e[k] = tile[(8 * ch + k) * 66 + t];
            u32x4 w; w.x = e[0] | ((unsigned)e[1] << 16); w.y = e[2] | ((unsigned)e[3] << 16); w.z = e[4] | ((unsigned)e[5] << 16); w.w = e[6] | ((unsigned)e[7] << 16);
            *(u32x4*)(dst + (size_t)(t0 + t) * DM + c0 + 8 * ch) = w; }
        asm volatile("s_waitcnt lgkmcnt(0)" ::: "memory");
    }
}

#define XB_TMO      128
#define XB_XCNT(j)  (256  + 64 * (j))
#define XB_XSUB(j)  (1280 + 64 * (j))
#define XB_XGEN(j)  (2304 + 64 * (j))
#define XB_TOP      3328
#define XB_TOPGEN   3392
#define XCD_BAR_WORDS 3456
#define XB_SPIN_CAP (1u << 18)
__device__ __forceinline__ unsigned xb_ld(unsigned* p)              { return __hip_atomic_load(p, __ATOMIC_RELAXED, __HIP_MEMORY_SCOPE_AGENT); }
__device__ __forceinline__ unsigned xb_add(unsigned* p, unsigned v) { return __hip_atomic_fetch_add(p, v, __ATOMIC_RELAXED, __HIP_MEMORY_SCOPE_AGENT); }
__device__ __forceinline__ unsigned xb_xcc_id() { return (unsigned)__builtin_amdgcn_s_getreg((3 << 11) | 20) & 0xFu; }
#define XB_SPIN(cond, bar) do { unsigned _sp = 0; while (cond) { __builtin_amdgcn_s_sleep(1); \
    if ((++_sp & 255u) == 0u) { if (xb_ld(&(bar)[XB_TMO])) break; if (_sp > XB_SPIN_CAP) { atomicAdd(&(bar)[XB_TMO], 1u); break; } } } } while (0)
struct XcdBarrier { unsigned* bar; unsigned x; volatile LAS unsigned* st; };
__device__ __forceinline__ XcdBarrier xcd_barrier_post(unsigned* bar, volatile LAS unsigned* st) {
    XcdBarrier b; b.bar = bar; b.x = xb_xcc_id(); b.st = st;
    if (threadIdx.x == 0) (void)xb_add(&bar[XB_XCNT(b.x)], 1u);
    return b;
}
__device__ __forceinline__ void xcd_barrier_complete(unsigned* bar, unsigned x, unsigned& nloc, unsigned& nx) {
    const unsigned G = gridDim.x * gridDim.y * gridDim.z;
    unsigned sum, cnt, mine, sp = 0u;
    for (;;) {
        sum = 0u; cnt = 0u; mine = 0u;
#pragma unroll
        for (unsigned j = 0; j < 16; ++j) { const unsigned c = xb_ld(&bar[XB_XCNT(j)]); sum += c; cnt += (c > 0u) ? 1u : 0u; mine = (j == x) ? c : mine; }
        if (sum == G) break;
        __builtin_amdgcn_s_sleep(1);
        if ((++sp & 255u) == 0u) { if (xb_ld(&bar[XB_TMO])) break; if (sp > XB_SPIN_CAP) { atomicAdd(&bar[XB_TMO], 1u); break; } }
    }
    nloc = mine > 0u ? mine : 1u; nx = cnt > 0u ? cnt : 1u;
}
__device__ __forceinline__ void xcd_barrier(const XcdBarrier& b) {
    asm volatile("s_waitcnt vmcnt(0)" ::: "memory");
    __syncthreads();
    if (threadIdx.x == 0) {
        unsigned* bar = b.bar;
        __builtin_amdgcn_s_waitcnt(0);
        unsigned nloc = b.st[0], nx = b.st[1];
        if (nloc == 0u) { xcd_barrier_complete(bar, b.x, nloc, nx); b.st[0] = nloc; b.st[1] = nx; }
        const unsigned old = xb_add(&bar[XB_XSUB(b.x)], 1u);
        const unsigned gen = old / nloc;
        if (old + 1u == (gen + 1u) * nloc) {
            __builtin_amdgcn_fence(__ATOMIC_RELEASE, "agent");
            asm volatile("s_waitcnt vmcnt(0)" ::: "memory");
            const unsigned og = xb_add(&bar[XB_TOP], 1u);
            const unsigned tg = og / nx;
            if (og + 1u == (tg + 1u) * nx) xb_add(&bar[XB_TOPGEN], 1u);
            else XB_SPIN(xb_ld(&bar[XB_TOPGEN]) == tg, bar);
            __builtin_amdgcn_fence(__ATOMIC_ACQUIRE, "agent");
            xb_add(&bar[XB_XGEN(b.x)], 1u);
            asm volatile("s_waitcnt vmcnt(0)" ::: "memory");
        } else {
            XB_SPIN(xb_ld(&bar[XB_XGEN(b.x)]) == gen, bar);
            __builtin_amdgcn_fence(__ATOMIC_ACQUIRE, "agent");
            asm volatile("s_waitcnt vmcnt(0)" ::: "memory");
        }
    }
    __syncthreads();
}
constexpr int LDS_CTL_OFF = LDS_BYTES - 64;
constexpr size_t CTL_BAR_OFF = 16384;
constexpr size_t CTL_STAMP_OFF = 65536;
constexpr size_t CTL_ZERO_BYTES = 131072;

enum { P_PRO = 0, P_MOD1_0, P_GEMM_IN, P_ZPOST, P_GEMM_QKV, P_ATTN, P_GEMM_OUT0, P_MOD2_0, P_MLP_UP0, P_MLP_DN0,
       P_MOD1_1, P_GEMM_HIN, P_CONV, P_TRANS, P_GEMM_OUT1, P_MOD2_1, P_MLP_UP1, P_MLP_DN1, P_FINAL,
       P_NC_FILT, P_NC_U0, P_NC_A, P_NC_B, P_NA_Q, P_NONE };
__host__ __device__ __forceinline__ int prog(int i) {
    int k = 0;
#define PRG(x) do { if (i == k) return (x); ++k; } while (0)
    PRG(P_PRO); PRG(P_MOD1_0); PRG(P_GEMM_IN); PRG(P_ZPOST); PRG(P_GEMM_QKV);
#if NAIVE_ATTN
    PRG(P_NA_Q);
#endif
    PRG(P_ATTN); PRG(P_GEMM_OUT0); PRG(P_MLP_UP0); PRG(P_MLP_DN0); PRG(P_GEMM_HIN);
#if NAIVE_CONV
    PRG(P_NC_FILT); PRG(P_NC_U0); PRG(P_NC_A); PRG(P_NC_B);
#else
    PRG(P_CONV);
#endif
    PRG(P_TRANS); PRG(P_GEMM_OUT1); PRG(P_MLP_UP1); PRG(P_MLP_DN1); PRG(P_FINAL);
#undef PRG
    return P_NONE;
}
constexpr int N_PROG = 16 + (NAIVE_ATTN ? 1 : 0) + (NAIVE_CONV ? 3 : 0);

__device__ __forceinline__ bool gemm_job(const Ctx& p, int ph, int jj, GemmJob& J) {
    unsigned char* ws = p.ws;
    const float* MODL = (const float*)(ws + WS_MODL);
    size_t a = 0, b = 0, o = 0, sq = 0, shw = 0; int M = 0, N = 0, K = 0, kind = 0, ldc = 0, shw_ld = 0; bool has_o = true, has_sq = false;
    const float* base = nullptr; const float* gate = nullptr; const float* ng = nullptr; const float* nsc = nullptr;
    if (jj == 0) {
        if (ph == P_GEMM_IN) { a = WS_HL; b = WS_WIN; o = WS_Z; M = MT; N = ZW; K = DM; ldc = ZW; }
        else if (ph == P_GEMM_QKV) { a = WS_CQN; b = WS_WQB; o = WS_QM; M = ML; N = 768; K = 384; ldc = 768; }
        else if (ph == P_GEMM_OUT0) { a = WS_O; b = WS_WOUT; M = ML; N = DM; K = DM; kind = 2; base = p.in[I_X]; gate = MODL + 2 * DM;
            o = WS_HL; ng = p.in[I_N2G]; nsc = MODL + 4 * DM; sq = WS_SQA; has_sq = true; }
        else if (ph == P_MLP_UP0) { a = WS_HL; b = WS_W1_0; o = WS_HID; M = ML; N = 4096; K = DM; kind = 1; ldc = 4096; sq = WS_SQA; has_sq = true; shw = WS_SHW_UP0; shw_ld = 4096; }
        else if (ph == P_MLP_DN0) { a = WS_HID; b = WS_W2_0; M = ML; N = DM; K = 4096; kind = 2; gate = MODL + 5 * DM;
            o = WS_HL; ng = p.in[I_N1G] + DM; nsc = MODL + (size_t)16 * NMOD + DM; sq = WS_SQB; has_sq = true; }
        else if (ph == P_GEMM_HIN) { a = WS_HIN; b = WS_HL; o = WS_ZT; M = 3 * DM; N = ML; K = DM; ldc = ML; kind = 3; sq = WS_SQB; has_sq = true; shw = WS_SHW_HIN; shw_ld = 3 * DM; }
        else if (ph == P_GEMM_OUT1) { a = WS_Y2; b = WS_HOUT; M = ML; N = DM; K = DM; kind = 2; gate = MODL + (size_t)16 * NMOD + 2 * DM;
            o = WS_HL; ng = p.in[I_N2G] + DM; nsc = MODL + (size_t)16 * NMOD + 4 * DM; sq = WS_SQC; has_sq = true; }
        else if (ph == P_MLP_UP1) { a = WS_HL; b = WS_W1_1; o = WS_HID; M = ML; N = 4096; K = DM; kind = 1; ldc = 4096; sq = WS_SQC; has_sq = true; shw = WS_SHW_UP1; shw_ld = 4096; }
        else if (ph == P_MLP_DN1) { a = WS_HID; b = WS_W2_1; M = ML; N = DM; K = 4096; kind = 2; gate = MODL + (size_t)16 * NMOD + 5 * DM; has_o = false; sq = WS_SQA; has_sq = true; }
        else return false;
    } else {
        if (ph == P_GEMM_QKV) { a = WS_CKVN; b = WS_WKVB; o = WS_KV; M = MT; N = 1024; K = 256; ldc = 1024; }
        else return false;
    }
    J.A = (const bf16_t*)(ws + a); J.Bt = (const bf16_t*)(ws + b); J.M = M; J.N = N; J.K = K;
    J.E.kind = kind; J.E.O = has_o ? (bf16_t*)(ws + o) : nullptr; J.E.ldc = ldc; J.E.base = base; J.E.xres = (bf16_t*)(ws + WS_XW); J.E.gate = gate; J.E.ng = ng; J.E.nsc = nsc;
    J.E.sqp = has_sq ? (float*)(ws + sq) : nullptr; J.E.shw = (const float*)(ws + shw); J.E.shw_ld = shw_ld;
    return true;
}

__global__ void __launch_bounds__(NTHREADS, 2) fwd(Params kp) {
    extern __shared__ __attribute__((aligned(16))) unsigned char lds_raw[];
    LAS unsigned char* lds = (LAS unsigned char*)lds_raw;
    const int wave0 = __builtin_amdgcn_readfirstlane((int)threadIdx.x >> 6);
#if !CG_SYNC
    if (threadIdx.x < 16) ((volatile LAS unsigned*)(lds + LDS_CTL_OFF))[threadIdx.x] = 0u;
    __syncthreads();
    const XcdBarrier xbar = xcd_barrier_post((unsigned*)(kp.ws + WS_CTL + CTL_BAR_OFF), (volatile LAS unsigned*)(lds + LDS_CTL_OFF));
#endif
#if PROBE_A >= 0
#define STAMP(k) do { if (blockIdx.x == 0 && threadIdx.x == 0) ((unsigned long long*)(kp.ws + WS_CTL + CTL_STAMP_OFF))[(k)] = __builtin_amdgcn_s_memrealtime(); } while (0)
#else
#define STAMP(k) do { } while (0)
#endif
    for (int pi = kp.ph_lo; pi < kp.ph_hi; ++pi) {
        if (pi > kp.ph_lo) {
            STAMP(2 * pi - 1);
#if CG_SYNC
            cg::this_grid().sync();
#else
            xcd_barrier(xbar);
#endif
        }
        STAMP(2 * pi);
        const int ph = prog(pi);
        for (int rep = 0; rep < ((pi == REPEAT_PI) ? 2 : 1); ++rep) {
        if (rep) {
#if CG_SYNC
            cg::this_grid().sync();
#else
            xcd_barrier(xbar);
#endif
        }
        Ctx p;
        { int z_ = 0, lane_; asm volatile("v_mbcnt_lo_u32_b32 %0, -1, 0\n\tv_mbcnt_hi_u32_b32 %0, -1, %0" : "=v"(lane_)); asm volatile("" : "+s"(z_));
          const int tid_ = ((wave0 + z_) << 6) + lane_;
          const CAS cfptr_t* in_ = (const CAS cfptr_t*)kp.in + z_; float* out_ = kp.out + z_; unsigned char* ws_ = kp.ws + z_; const int bid_ = (int)blockIdx.x + z_, nb_ = (int)gridDim.x + z_;
          p.in = in_; p.out = out_; p.ws = ws_; p.tid = tid_; p.bid = bid_; p.nblk = nb_; }
        float* XW = (float*)(p.ws + WS_XW);
#ifndef NO_GEMM
        for (int jj = 0; jj < 2; ++jj) { GemmJob J; if (!gemm_job(p, ph, jj, J)) break; run_gemm(p, lds, J); }
#endif
        if (ph == P_PRO && PHON(P_PRO)) phase_prologue(p, lds, true, false);
        else if (ph == P_MOD1_0 && PHON(P_MOD1_0)) { phase_prologue(p, lds, false, true); phase_modulate(p, p.in[I_X], 0, p.in[I_N1G], 0, DM, true); }
        else if (ph == P_ZPOST && PHON(P_ZPOST)) { phase_zpost(p, lds); phase_shw(p); }
        else if (ph == P_ATTN && PHON(P_ATTN)) {
#if NAIVE_ATTN
            phase_attn_naive(p);
#else
            phase_attn(p, lds);
#endif
        }
        else if (ph == P_NA_Q && PHON(P_NA_Q)) phase_naive_qrope(p);
        else if (ph == P_CONV && PHON(P_CONV)) phase_conv(p, lds);
        else if (ph == P_NC_FILT && PHON(P_NC_FILT)) phase_nconv_filt(p, lds);
        else if (ph == P_NC_U0 && PHON(P_NC_U0)) phase_nconv_u0(p);
        else if (ph == P_NC_A && PHON(P_NC_A)) phase_nconv_pass(p, 0);
        else if (ph == P_NC_B && PHON(P_NC_B)) phase_nconv_pass(p, 1);
        else if (ph == P_TRANS && PHON(P_TRANS)) phase_transpose(p, lds);
        else if (ph == P_FINAL && PHON(P_FINAL)) phase_final(p);
        }
    }
#if PROBE_A >= 0
    STAMP(2 * kp.ph_hi - 1);
    __syncthreads();
    if (blockIdx.x == 0) {
        asm volatile("s_waitcnt vmcnt(0)" ::: "memory");
        const unsigned long long* st = (const unsigned long long*)(kp.ws + WS_CTL + CTL_STAMP_OFF);
        const float dta = (float)(st[PROBE_A_TO] - st[PROBE_A]) * 0.01f, dtb = (float)(st[PROBE_B_TO] - st[PROBE_B]) * 0.01f;
        for (int i = threadIdx.x + 1024; i < 1024 + 100000; i += NTHREADS) kp.out[i] += 0.001f * dtb;
        if (threadIdx.x == 0) kp.out[0] += 0.004f * dta;
    }
#endif
}

extern "C" void kernel_launch(void* const* d_in, const int* in_sizes, int n_in, void* d_out, int out_size, void* d_ws, size_t ws_size, hipStream_t stream) {
    static int ok = 0;
    if (ok == 0) {
        ok = 1;
        if (n_in != 32 || in_sizes[0] != ML * DM || out_size != ML * DM || ws_size < WS_END) { fprintf(stderr, "kernel_launch: unexpected shapes (n_in %d, in0 %d, out %d, ws %zu)\n", n_in, n_in > 0 ? in_sizes[0] : -1, out_size, ws_size); ok = -1; }
        int dev = 0, cus = 0;
        if (hipGetDevice(&dev) != hipSuccess || hipDeviceGetAttribute(&cus, hipDeviceAttributeMultiprocessorCount, dev) != hipSuccess || cus < GRID) { fprintf(stderr, "kernel_launch: needs %d CUs, device reports %d\n", GRID, cus); ok = -1; }
        if (hipFuncSetAttribute((const void*)fwd, hipFuncAttributeMaxDynamicSharedMemorySize, LDS_BYTES) != hipSuccess) { fprintf(stderr, "kernel_launch: hipFuncSetAttribute failed\n"); ok = -1; }
        int per_cu = 0;
        if (hipOccupancyMaxActiveBlocksPerMultiprocessor(&per_cu, (const void*)fwd, NTHREADS, LDS_BYTES) != hipSuccess || per_cu < 1) { fprintf(stderr, "kernel_launch: occupancy query says %d blocks per CU\n", per_cu); }
        (void)hipGetLastError();
    }
    if (ok < 0) return;
    Params p{};
    for (int i = 0; i < 32; ++i) p.in[i] = (const float*)d_in[i];
    p.out = (float*)d_out; p.ws = (unsigned char*)d_ws;
#if !CG_SYNC || PROBE_A >= 0
    if (hipMemsetAsync((char*)d_ws + WS_CTL, 0, CTL_ZERO_BYTES, stream) != hipSuccess) { fprintf(stderr, "kernel_launch: memset of the control words failed\n"); return; }
#endif
#if ONE_LAUNCH
    p.ph_lo = 0; p.ph_hi = N_PROG;
    void* args[] = {&p};
    hipError_t e = hipLaunchCooperativeKernel((const void*)fwd, dim3(GRID), dim3(NTHREADS), args, LDS_BYTES, stream);
    if (e != hipSuccess) fprintf(stderr, "kernel_launch: cooperative launch failed: %s\n", hipGetErrorString(e));
#else
    for (int i = 0; i < N_PROG; ++i) { p.ph_lo = i; p.ph_hi = i + 1; hipLaunchKernelGGL(fwd, dim3(GRID), dim3(NTHREADS), LDS_BYTES, stream, p); }
#endif
}
```

```cpp
#include <hip/hip_runtime.h>
#include <hip/hip_cooperative_groups.h>
#include <cstdio>
#include <cstdint>
namespace cg = cooperative_groups;

#ifndef ONE_LAUNCH
#define ONE_LAUNCH 1
#endif
#ifndef CG_SYNC
#define CG_SYNC 0
#endif
#ifndef REPEAT_PI
#define REPEAT_PI -1
#endif
#ifndef PROBE_A
#define PROBE_A -1
#endif
#ifndef ATTN_V1
#define ATTN_V1 0
#endif
#ifndef ZPOST_REF
#define ZPOST_REF 0
#endif
#ifndef SIMPLE_GEMM
#define SIMPLE_GEMM 0
#endif
#ifndef NAIVE_ATTN
#define NAIVE_ATTN 0
#endif
#ifndef NAIVE_CONV
#define NAIVE_CONV 0
#endif

#ifndef PHASE_MASK
#define PHASE_MASK 0xFFFFFFFFu
#endif
#define PHON(x) (((PHASE_MASK) >> (x)) & 1u)
#define LAS __attribute__((address_space(3)))
typedef unsigned short bf16_t;
typedef short bf16x8 __attribute__((ext_vector_type(8)));
typedef short s16x4 __attribute__((ext_vector_type(4)));
typedef float f32x2 __attribute__((ext_vector_type(2)));
typedef float f32x4 __attribute__((ext_vector_type(4)));
typedef float f32x16 __attribute__((ext_vector_type(16)));
typedef unsigned u32x2 __attribute__((ext_vector_type(2)));
typedef unsigned u32x4 __attribute__((ext_vector_type(4)));
typedef __bf16 bf16x2_t __attribute__((ext_vector_type(2)));

constexpr int NB = 16, SEQ = 2048, DM = 1024, CTXL = 256, TKEYS = CTXL + SEQ;
constexpr int ML = NB * SEQ;
constexpr int MC = NB * CTXL;
constexpr int MT = ML + MC;
constexpr int NMOD = 6 * DM;
constexpr int ZW = 1536;
constexpr float EPS = 1e-6f;
constexpr int NWAVES = 8, NTHREADS = 512, GRID = 256, NGW = GRID * NWAVES;
constexpr int LDS_BYTES = 155648;
constexpr int ZC_CQ = 0, ZC_CKV = 384, ZC_KR = 640, ZC_GQ = 672, ZC_GK = 1184, ZC_GV = 1312;
constexpr float LOG2E = 1.4426950408889634f;
constexpr float QSCALE_MLA = 0.10206207261596577f * LOG2E;
constexpr float QSCALE_GQA = 0.125f * LOG2E;

constexpr size_t MiB = 1ull << 20;
constexpr size_t WS_CTL = 0;
constexpr size_t WS_MODL = 1 * MiB;
constexpr size_t WS_MODC = 1 * MiB + 786432;
constexpr size_t WS_H3 = 2 * MiB;
constexpr size_t WS_SHW_UP0 = 3 * MiB, WS_SHW_HIN = 3 * MiB + 262144, WS_SHW_UP1 = 3 * MiB + 262144 + 196608;
constexpr size_t WS_SQA = 244 * MiB, WS_SQB = 246 * MiB, WS_SQC = 248 * MiB;
constexpr size_t WS_WIN = 4 * MiB, WS_WQB = 7 * MiB, WS_WKVB = 8 * MiB, WS_WOUT = 9 * MiB;
constexpr size_t WS_W1_0 = 11 * MiB, WS_W2_0 = 19 * MiB, WS_W1_1 = 27 * MiB, WS_W2_1 = 35 * MiB, WS_HIN = 43 * MiB, WS_HOUT = 49 * MiB;
constexpr size_t WS_XW = 52 * MiB;
constexpr size_t WS_HL = 180 * MiB;
constexpr size_t WS_Z = 252 * MiB, WS_CQN = 360 * MiB, WS_CKVN = 384 * MiB, WS_KROPE = 402 * MiB, WS_QG = 405 * MiB, WS_KG = 437 * MiB, WS_VG = 446 * MiB, WS_QM = 455 * MiB;
constexpr size_t WS_KV = WS_HL, WS_O = 252 * MiB;
constexpr size_t WS_HID = 252 * MiB;
constexpr size_t WS_ZT = 252 * MiB, WS_Y2T = WS_HL, WS_Y2 = 252 * MiB;
constexpr size_t WS_QMR = 316 * MiB;
constexpr size_t WS_FILT = 4 * MiB, WS_U0T = 444 * MiB, WS_Y1T = 380 * MiB;
constexpr size_t WS_END = 508 * MiB;

struct Params { const float* in[32]; float* out; unsigned char* ws; int ph_lo, ph_hi; };
#define CAS __attribute__((address_space(4)))
typedef const float* cfptr_t;
struct Ctx { const CAS cfptr_t* in; float* out; unsigned char* ws; int tid, bid, nblk; };

enum { I_X = 0, I_C, I_CTX, I_CCTX, I_WMOD, I_BMOD, I_N1G, I_N2G, I_W1, I_W2, I_AWIN, I_AQAG, I_AWQB, I_AKVAG, I_AWKVB, I_AQNG, I_AKNG, I_AWOUT,
       I_HWIN, I_HCW, I_HCB, I_FW1, I_FB1, I_FW2, I_FB2, I_FW3, I_FB3, I_FFREQ, I_FW4, I_HSKIP, I_HWOUT, I_FINALG };

__device__ __forceinline__ unsigned f2bf(float f) { unsigned u = __float_as_uint(f); return (u + 0x7fffu + ((u >> 16) & 1u)) >> 16; }
__device__ __forceinline__ float bf2f(unsigned h) { return __uint_as_float(h << 16); }
__device__ __forceinline__ unsigned cvtpk(float lo, float hi) { f32x2 v = {lo, hi}; bf16x2_t b = __builtin_convertvector(v, bf16x2_t); return __builtin_bit_cast(unsigned, b); }
__device__ __forceinline__ float wave_sum(float v) {
#pragma unroll
    for (int o = 1; o < 64; o <<= 1) v += __shfl_xor(v, o);
    return v;
}
__device__ __forceinline__ float fsin(float x) { return __builtin_amdgcn_sinf(__builtin_amdgcn_fractf(x * 0.15915494309189535f)); }
__device__ __forceinline__ float fcos(float x) { return __builtin_amdgcn_cosf(__builtin_amdgcn_fractf(x * 0.15915494309189535f)); }
__device__ __forceinline__ float inv_theta(float x) { return exp2f(-x * 13.287712379549449f); }
__device__ __forceinline__ float dpp_xor1(float v) { return __builtin_bit_cast(float, __builtin_amdgcn_update_dpp(0, __builtin_bit_cast(int, v), 0xB1, 0xF, 0xF, true)); }
__device__ __forceinline__ float dpp_xor2(float v) { return __builtin_bit_cast(float, __builtin_amdgcn_update_dpp(0, __builtin_bit_cast(int, v), 0x4E, 0xF, 0xF, true)); }
__device__ __forceinline__ float dpp_hmirror(float v) { return __builtin_bit_cast(float, __builtin_amdgcn_update_dpp(0, __builtin_bit_cast(int, v), 0x141, 0xF, 0xF, true)); }
__device__ __forceinline__ float sum8(float v) { v += dpp_xor1(v); v += dpp_xor2(v); v += dpp_hmirror(v); return v; }
__device__ __forceinline__ float bflo(unsigned w) { return __uint_as_float(w << 16); }
__device__ __forceinline__ float bfhi(unsigned w) { return __uint_as_float(w & 0xffff0000u); }

namespace pg8 {
constexpr int BM = 256, BK = 64, HALF = 128, HTB = HALF * BK * 2, STAGE_BYTES = 8 * HTB, NXCD = 8, WGM = 8;
__host__ __device__ __forceinline__ int lds_byte(int r, int c) { const int st = (r >> 4) * 2 + (c >> 5), rr = r & 15, cc = c & 31, ob = rr * 64 + cc * 2; return st * 1024 + (ob ^ (((ob >> 9) & 1) << 5)); }
__host__ __device__ __forceinline__ void stage_rc(int b, int& R, int& C) { const int st = b / 1024, sb = b % 1024, swz = sb ^ (((sb >> 9) & 1) << 5); R = (st >> 1) * 16 + swz / 64; C = (st & 1) * 32 + (swz % 64) / 2; }
__host__ __device__ __forceinline__ int perm32(int rho) { const int n = rho >> 4, i = rho & 15; return 8 * (i >> 2) + 4 * n + (i & 3); }

struct Unit { int pm, pn; };
struct Gemm { const bf16_t* A; const bf16_t* Bt; int M, N, K; };

struct StaticOrder {
    int nM, nN, nwg, G, c;
    __host__ __device__ void init(int M, int N, int G_, int c_) { nM = M / BM; nN = N / BM; nwg = nM * nN; G = G_; c = c_; }
    __host__ __device__ bool next(int i, Unit& u) const {
        const long L = (long)i * G + c; if (L >= nwg) return false;
        int wgid = (int)L; { const int q = nwg / NXCD, r = nwg % NXCD, xcd = wgid % NXCD, off = wgid / NXCD; wgid = (xcd < r ? xcd * (q + 1) : r * (q + 1) + (xcd - r) * q) + off; }
        const int nig = WGM * nN, gid = wgid / nig, fm = gid * WGM, gsz = (nM - fm) < WGM ? (nM - fm) : WGM;
        u.pm = fm + ((wgid % nig) % gsz); u.pn = (wgid % nig) / gsz; return true;
    }
    __device__ __forceinline__ void a_ready(const Unit&) const {}
    __device__ __forceinline__ void done(const Unit&) const {}
};

struct EpiAny {
    static constexpr bool AFTER_DRAIN = false;
    int kind; bf16_t* O; int ldc; const float* base; bf16_t* xres; const float* gate; const float* ng; const float* nsc; float* sqp; const float* shw; int shw_ld; LAS float* tab;
    __device__ __forceinline__ bool perm() const { return true; }
    __device__ __forceinline__ void operator()(const f32x4 (&acc)[2][2][4][2], const Unit& u, int ui, int wr, int wc, int fr, int fq) const {
        const int rt = wr * 64 + fr, ct = wc * 32 + 8 * fq;
        const int row0 = u.pm * BM + rt, col0 = u.pn * BM + ct;
        if (kind != 2) {
            const LAS float* T0 = tab + ui * 512; const LAS float* T1 = T0 + 256;
            f32x4 cs[2][2], ca[2][2];
#pragma unroll
            for (int bj = 0; bj < 2; ++bj)
#pragma unroll
                for (int h = 0; h < 2; ++h) { cs[bj][h] = (f32x4){1.f, 1.f, 1.f, 1.f}; ca[bj][h] = (f32x4){0.f, 0.f, 0.f, 0.f}; }
            if (kind == 1) {
#pragma unroll
                for (int bj = 0; bj < 2; ++bj) { ca[bj][0] = *(const LAS f32x4*)(T1 + ct + bj * HALF); ca[bj][1] = *(const LAS f32x4*)(T1 + ct + bj * HALF + 4); } }
            if (kind == 3) {
#pragma unroll
                for (int bj = 0; bj < 2; ++bj) { cs[bj][0] = *(const LAS f32x4*)(T0 + ct + bj * HALF); cs[bj][1] = *(const LAS f32x4*)(T0 + ct + bj * HALF + 4); } }
#pragma unroll
            for (int ai = 0; ai < 2; ++ai)
#pragma unroll
                for (int m = 0; m < 4; ++m) { const int rr = rt + ai * HALF + m * 16; bf16_t* rowp = O + (size_t)(u.pm * BM + rr) * ldc + col0;
                    float rs = 1.f, ra = 0.f;
                    if (kind == 1) rs = T0[rr];
                    if (kind == 3) ra = T1[rr];
#pragma unroll
                    for (int bj = 0; bj < 2; ++bj) { f32x4 v0 = acc[ai][bj][m][0], v1 = acc[ai][bj][m][1];
                        if (kind == 1) { v0 = v0 * rs + ca[bj][0]; v1 = v1 * rs + ca[bj][1];
#pragma unroll
                            for (int e = 0; e < 4; ++e) { const float a = fmaxf(v0[e], 0.f), b = fmaxf(v1[e], 0.f); v0[e] = a * a; v1[e] = b * b; } }
                        if (kind == 3) { v0 = v0 * cs[bj][0] + ra; v1 = v1 * cs[bj][1] + ra; }
                        u32x4 w; w.x = cvtpk(v0[0], v0[1]); w.y = cvtpk(v0[2], v0[3]); w.z = cvtpk(v1[0], v1[1]); w.w = cvtpk(v1[2], v1[3]);
                        *(u32x4*)(rowp + bj * HALF) = w; } }
        } else {
            const bool hasO = O != nullptr;
            const LAS float* T0 = tab + ui * 512; const LAS float* T1 = T0 + 256;
#pragma unroll
            for (int ai = 0; ai < 2; ++ai) {
                u32x4 xb[4][2];
#pragma unroll
                for (int m = 0; m < 4; ++m)
#pragma unroll
                    for (int bj = 0; bj < 2; ++bj) xb[m][bj] = *(const u32x4*)(xres + (size_t)(row0 + ai * HALF + m * 16) * DM + col0 + bj * HALF);
                __builtin_amdgcn_sched_barrier(0);
#pragma unroll
                for (int m = 0; m < 4; ++m) { const size_t off = (size_t)(row0 + ai * HALF + m * 16) * DM + col0; float sq = 0.f;
#pragma unroll
                    for (int bj = 0; bj < 2; ++bj) {
                        const u32x4 xw = xb[m][bj];
                        const f32x4 x0 = {bflo(xw.x), bfhi(xw.x), bflo(xw.y), bfhi(xw.y)}, x1 = {bflo(xw.z), bfhi(xw.z), bflo(xw.w), bfhi(xw.w)};
                        const f32x4 gv0 = *(const LAS f32x4*)(T0 + ct + bj * HALF), gv1 = *(const LAS f32x4*)(T0 + ct + bj * HALF + 4);
                        const f32x4 y0 = x0 + gv0 * acc[ai][bj][m][0], y1 = x1 + gv1 * acc[ai][bj][m][1];
                        { u32x4 w; w.x = cvtpk(y0[0], y0[1]); w.y = cvtpk(y0[2], y0[3]); w.z = cvtpk(y1[0], y1[1]); w.w = cvtpk(y1[2], y1[3]); *(u32x4*)(xres + off + bj * HALF) = w; }
                        sq += ((y0[0] * y0[0] + y0[1] * y0[1]) + (y0[2] * y0[2] + y0[3] * y0[3])) + ((y1[0] * y1[0] + y1[1] * y1[1]) + (y1[2] * y1[2] + y1[3] * y1[3]));
                        if (hasO) { const f32x4 gs0 = *(const LAS f32x4*)(T1 + ct + bj * HALF), gs1 = *(const LAS f32x4*)(T1 + ct + bj * HALF + 4); const f32x4 a0 = y0 * gs0, a1 = y1 * gs1; u32x4 w; w.x = cvtpk(a0[0], a0[1]); w.y = cvtpk(a0[2], a0[3]); w.z = cvtpk(a1[0], a1[1]); w.w = cvtpk(a1[2], a1[3]);
                            *(u32x4*)(O + off + bj * HALF) = w; } }
                    if (sqp) { sq += __shfl_xor(sq, 16); sq += __shfl_xor(sq, 32); if (fq == 0) sqp[(size_t)(row0 + ai * HALF + m * 16) * 16 + u.pn * 4 + wc] = sq; }
                    __builtin_amdgcn_sched_barrier(0); }
            }
        }
    }
};

template <class Epi, class Sched>
__device__ __forceinline__ void gemm_simple(const int tid, const Gemm g, const Sched& S, const Epi& E) {
    const int  wid = __builtin_amdgcn_readfirstlane(tid >> 6), lane = tid & 63, wr = wid >> 2, wc = wid & 3, fr = lane & 15, fq = lane >> 4;
    const int K = g.K;
    Unit u;
    for (int ui = 0; S.next(ui, u); ++ui) {
        f32x4 acc[2][2][4][2];
#pragma unroll
        for (int a = 0; a < 2; ++a)
#pragma unroll
            for (int b = 0; b < 2; ++b)
#pragma unroll
                for (int m = 0; m < 4; ++m)
#pragma unroll
                    for (int n = 0; n < 2; ++n) acc[a][b][m][n] = (f32x4){0.f, 0.f, 0.f, 0.f};
        const bf16_t* Ab = g.A + (size_t)(u.pm * BM + wr * 64 + fr) * K + fq * 8;
        const bf16_t* Bb = g.Bt + (size_t)(u.pn * BM + wc * 32) * K + fq * 8;
        for (int k0 = 0; k0 < K; k0 += 32) {
            bf16x8 At[2][4], Bf[2][2];
#pragma unroll
            for (int ai = 0; ai < 2; ++ai)
#pragma unroll
                for (int m = 0; m < 4; ++m) At[ai][m] = *(const bf16x8*)(Ab + (size_t)(ai * HALF + m * 16) * K + k0);
#pragma unroll
            for (int bj = 0; bj < 2; ++bj)
#pragma unroll
                for (int n = 0; n < 2; ++n) { const int rr = E.perm() ? perm32(16 * n + fr) : (16 * n + fr);
                    Bf[bj][n] = *(const bf16x8*)(Bb + (size_t)(bj * HALF + rr) * K + k0); }
#pragma unroll
            for (int ai = 0; ai < 2; ++ai)
#pragma unroll
                for (int bj = 0; bj < 2; ++bj)
#pragma unroll
                    for (int m = 0; m < 4; ++m)
#pragma unroll
                        for (int n = 0; n < 2; ++n) acc[ai][bj][m][n] = __builtin_amdgcn_mfma_f32_16x16x32_bf16(Bf[bj][n], At[ai][m], acc[ai][bj][m][n], 0, 0, 0);
        }
        E(acc, u, ui, wr, wc, fr, fq);
    }
}

template <class Epi, class Sched, bool ALIGN_EPI = true>
__device__ __forceinline__ void gemm_phase(const int tid, LAS unsigned char* lds, const Gemm g, const Sched& S, const Epi& E) {
    const int  wid = __builtin_amdgcn_readfirstlane(tid >> 6), lane = tid & 63, wr = wid >> 2, wc = wid & 3, fr = lane & 15, fq = lane >> 4;
    const int K = g.K, nt = K / BK;
    unsigned voffA[2], voffB[2];
#pragma unroll
    for (int i = 0; i < 2; ++i) { int R, C; stage_rc(tid * 16 + i * 8192, R, C); const int Rb = E.perm() ? ((R & ~31) + perm32(R & 31)) : R;
        voffA[i] = (unsigned)(R * K + C) * 2u; voffB[i] = (unsigned)(Rb * K + C) * 2u; }
    const size_t kstep = (size_t)(BK * 2);
    const size_t hstep = (size_t)HALF * K * 2;
    const size_t tstep = 2 * hstep;
    const unsigned ldsw = (unsigned)wid * 1024u;
    const int aoff = lds_byte(wr * 64 + fr, fq * 8), boff = lds_byte(wc * 32 + fr, fq * 8);
#define PG8_SA(b, h) (((b) * 2 + (h)) * HTB)
#define PG8_SB(b, h) ((4 + (b) * 2 + (h)) * HTB)
#define PG8_STAGE(bufoff, gbase, voff) do { _Pragma("unroll") for (int _i = 0; _i < 2; ++_i) \
        __builtin_amdgcn_global_load_lds((const unsigned*)((const char*)(gbase) + (voff)[_i]), (LAS unsigned*)(lds + (bufoff) + ldsw + _i * 8192), 16, 0, 0); } while (0)
#define PG8_LDA(dst, b, h) do { _Pragma("unroll") for (int m = 0; m < 4; ++m) _Pragma("unroll") for (int k = 0; k < 2; ++k) dst[m][k] = *(const LAS bf16x8*)(lds + PG8_SA(b, h) + aoff + m * 2048 + k * 1024); } while (0)
#define PG8_LDB(dst, b, h) do { _Pragma("unroll") for (int n = 0; n < 2; ++n) _Pragma("unroll") for (int k = 0; k < 2; ++k) dst[n][k] = *(const LAS bf16x8*)(lds + PG8_SB(b, h) + boff + n * 2048 + k * 1024); } while (0)
#define PG8_MMA(ai, bj, At, Bt) do { __builtin_amdgcn_s_setprio(1); _Pragma("unroll") for (int m = 0; m < 4; ++m) _Pragma("unroll") for (int n = 0; n < 2; ++n) _Pragma("unroll") for (int k = 0; k < 2; ++k) \
        acc[ai][bj][m][n] = __builtin_amdgcn_mfma_f32_16x16x32_bf16(Bt[n][k], At[m][k], acc[ai][bj][m][n], 0, 0, 0); __builtin_amdgcn_s_setprio(0); } while (0)
#define PG8_WAIT_V(n) asm volatile("s_waitcnt vmcnt(" #n ")" ::: "memory")
#define PG8_WAIT_L(n) asm volatile("s_waitcnt lgkmcnt(" #n ")" ::: "memory")
#define PG8_BAR __builtin_amdgcn_s_barrier()
#define PG8_SCHED __builtin_amdgcn_sched_barrier(0)
    Unit cur, nxt; int ui = 0;
    if (!S.next(0, cur)) return;
    f32x4 acc[2][2][4][2];
#pragma unroll
    for (int a = 0; a < 2; ++a)
#pragma unroll
        for (int b = 0; b < 2; ++b)
#pragma unroll
            for (int m = 0; m < 4; ++m)
#pragma unroll
                for (int n = 0; n < 2; ++n) acc[a][b][m][n] = (f32x4){0.f, 0.f, 0.f, 0.f};
    bf16x8 At[4][2], B0[2][2], B1[2][2];
    const char* cA = (const char*)g.A + (size_t)cur.pm * tstep; const char* cB = (const char*)g.Bt + (size_t)cur.pn * tstep;
    S.a_ready(cur);
    PG8_STAGE(PG8_SB(0, 0), cB, voffB); PG8_STAGE(PG8_SB(0, 1), cB + hstep, voffB); PG8_STAGE(PG8_SA(0, 0), cA, voffA); PG8_STAGE(PG8_SA(0, 1), cA + hstep, voffA);
    if (wr == 1) PG8_BAR;
    PG8_WAIT_V(2); PG8_BAR;
    PG8_STAGE(PG8_SB(1, 0), cB + kstep, voffB); PG8_STAGE(PG8_SA(1, 0), cA + kstep, voffA); PG8_STAGE(PG8_SB(1, 1), cB + hstep + kstep, voffB);
    PG8_WAIT_V(6); PG8_BAR;
    for (;;) {
        const bool has_next = S.next(ui + 1, nxt);
        const char* nA = has_next ? (const char*)g.A + (size_t)nxt.pm * tstep : cA; const char* nB = has_next ? (const char*)g.Bt + (size_t)nxt.pn * tstep : cB;
        for (int t = 0; t < nt; t += 2) {
            const bool last = (t == nt - 2);
            const char* a1 = cA + (size_t)(t + 1) * kstep;
            const char* a2 = last ? nA : cA + (size_t)(t + 2) * kstep; const char* b2 = last ? nB : cB + (size_t)(t + 2) * kstep;
            const char* a3 = a2 + kstep; const char* b3 = b2 + kstep;
            if (last && has_next) S.a_ready(nxt);
            PG8_LDB(B0, 0, 0); PG8_LDB(B1, 0, 1); PG8_SCHED; PG8_LDA(At, 0, 0); PG8_STAGE(PG8_SA(1, 1), a1 + hstep, voffA);
            PG8_WAIT_V(8); PG8_WAIT_L(0); PG8_BAR; PG8_MMA(0, 0, At, B0); PG8_MMA(0, 1, At, B1); PG8_BAR; PG8_SCHED;
            PG8_LDA(At, 0, 1); PG8_STAGE(PG8_SB(0, 0), b2, voffB); PG8_STAGE(PG8_SB(0, 1), b2 + hstep, voffB); PG8_STAGE(PG8_SA(0, 0), a2, voffA);
            PG8_WAIT_V(8); PG8_WAIT_L(0); PG8_BAR; PG8_MMA(1, 0, At, B0); PG8_MMA(1, 1, At, B1); PG8_BAR; PG8_SCHED;
            PG8_LDB(B0, 1, 0); PG8_LDB(B1, 1, 1); PG8_SCHED; PG8_LDA(At, 1, 0); PG8_STAGE(PG8_SA(0, 1), a2 + hstep, voffA);
            PG8_WAIT_V(8); PG8_WAIT_L(0); PG8_BAR; PG8_MMA(0, 0, At, B0); PG8_MMA(0, 1, At, B1); PG8_BAR; PG8_SCHED;
            PG8_LDA(At, 1, 1); PG8_STAGE(PG8_SB(1, 0), b3, voffB); PG8_STAGE(PG8_SB(1, 1), b3 + hstep, voffB); PG8_STAGE(PG8_SA(1, 0), a3, voffA);
            PG8_WAIT_V(8); PG8_WAIT_L(0); PG8_BAR; PG8_MMA(1, 0, At, B0); PG8_MMA(1, 1, At, B1); PG8_BAR; PG8_SCHED;
        }
        if constexpr (ALIGN_EPI) { if (wr == 0) PG8_BAR; }
        E(acc, cur, ui, wr, wc, fr, fq); S.done(cur);
        if (!has_next) break;
#pragma unroll
        for (int a = 0; a < 2; ++a)
#pragma unroll
            for (int b = 0; b < 2; ++b)
#pragma unroll
                for (int m = 0; m < 4; ++m)
#pragma unroll
                    for (int n = 0; n < 2; ++n) acc[a][b][m][n] = (f32x4){0.f, 0.f, 0.f, 0.f};
        cur = nxt; cA = nA; cB = nB; ++ui;
        if constexpr (ALIGN_EPI) { if (wr == 1) PG8_BAR; }
    }
    PG8_WAIT_V(0);
    if constexpr (!ALIGN_EPI) { if (wr == 0) PG8_BAR; }
    PG8_BAR;
#undef PG8_SA
#undef PG8_SB
#undef PG8_STAGE
#undef PG8_LDA
#undef PG8_LDB
#undef PG8_MMA
#undef PG8_WAIT_V
#undef PG8_WAIT_L
#undef PG8_BAR
#undef PG8_SCHED
}
}

struct GemmJob { const bf16_t* A; const bf16_t* Bt; int M, N, K; pg8::EpiAny E; };
constexpr int GEMM_TAB_OFF = 131072;
__device__ __forceinline__ void gemm_tables(const Ctx& p, const GemmJob& J, const pg8::StaticOrder& S) {
    const int tid = p.tid; pg8::Unit u;
    for (int ui = 0; S.next(ui, u); ++ui) {
        LAS float* T = J.E.tab + ui * 512;
        const int r = tid & 255;
        if (J.E.kind == 2) {
            const size_t bo = (size_t)((u.pm * 256) / SEQ) * NMOD + u.pn * 256 + r;
            if (tid < 256) T[r] = J.E.gate[bo]; else T[256 + r] = J.E.O ? J.E.ng[u.pn * 256 + r] * (1.0f + J.E.nsc[bo]) : 0.f;
        } else {
            const int tokt = (J.E.kind == 1) ? u.pm : u.pn, vect = (J.E.kind == 1) ? u.pn : u.pm;
            if (tid < 256) { const f32x4* q = (const f32x4*)(J.E.sqp + (size_t)(tokt * 256 + r) * 16); const f32x4 a = q[0], b = q[1], c = q[2], d = q[3];
                const float sm = ((a[0] + a[1]) + (a[2] + a[3])) + ((b[0] + b[1]) + (b[2] + b[3])) + ((c[0] + c[1]) + (c[2] + c[3])) + ((d[0] + d[1]) + (d[2] + d[3]));
                T[r] = rsqrtf(sm * (1.0f / DM) + EPS); }
            else T[256 + r] = J.E.shw[(size_t)((tokt * 256) / SEQ) * J.E.shw_ld + vect * 256 + r];
        }
    }
    __syncthreads();
}
__device__ __forceinline__ void run_gemm(const Ctx& p, LAS unsigned char* lds, GemmJob& J) {
    J.E.tab = (LAS float*)(lds + GEMM_TAB_OFF);
    pg8::Gemm g{J.A, J.Bt, J.M, J.N, J.K}; pg8::StaticOrder S; S.init(J.M, J.N, p.nblk, p.bid);
    if (J.E.kind != 0) gemm_tables(p, J, S);
#if SIMPLE_GEMM
    pg8::gemm_simple<pg8::EpiAny, pg8::StaticOrder>(p.tid, g, S, J.E);
#else
    { int tid2 = p.tid; asm volatile("" : "+v"(tid2));
      pg8::gemm_phase<pg8::EpiAny, pg8::StaticOrder, true>(tid2, lds, g, S, J.E); }
#endif
    __syncthreads();
}

__device__ __forceinline__ void transpose_item(const float* W, int K, int N, bf16_t* WT, LAS float* scr, int item, int lane) {
    const int nblk = N / 32, kb = item / nblk, nb = item % nblk, k0 = 64 * kb, n0 = 32 * nb;
    float v[32];
#pragma unroll
    for (int i = 0; i < 32; ++i) { const int kk = 2 * i + (lane >> 5); v[i] = W[(size_t)(k0 + kk) * N + n0 + (lane & 31)]; }
#pragma unroll
    for (int i = 0; i < 32; ++i) { const int kk = 2 * i + (lane >> 5); scr[kk * 33 + (lane & 31)] = v[i]; }
    asm volatile("s_waitcnt lgkmcnt(0)" ::: "memory");
    const int c = lane & 7;
#pragma unroll
    for (int j = 0; j < 4; ++j) { const int n = (lane >> 3) + 8 * j; const LAS float* s = scr + (8 * c) * 33 + n;
        u32x4 o; o.x = cvtpk(s[0 * 33], s[1 * 33]); o.y = cvtpk(s[2 * 33], s[3 * 33]); o.z = cvtpk(s[4 * 33], s[5 * 33]); o.w = cvtpk(s[6 * 33], s[7 * 33]);
        *(u32x4*)(WT + (size_t)(n0 + n) * K + k0 + 8 * c) = o; }
    asm volatile("s_waitcnt lgkmcnt(0)" ::: "memory");
}

__device__ __forceinline__ float silu_f(float v) { return v / (1.0f + expf(-v)); }

__device__ __forceinline__ void phase_prologue(const Ctx& p, LAS unsigned char* lds, const bool partA, const bool partB) {
    const int tid = p.tid, lane = tid & 63, wave = __builtin_amdgcn_readfirstlane(tid >> 6);
    unsigned char* ws = p.ws;
#ifndef PRO_SKIP1
    if (partA) {
        LAS float* S = (LAS float*)lds;
        LAS float* red = (LAS float*)(lds + 69632);
        float* MODL = (float*)(ws + WS_MODL); float* MODC = (float*)(ws + WS_MODC);
        if (p.bid < 192) {
            for (int i = tid; i < 17 * 1024; i += NTHREADS) { const float v = (i < 16 * 1024) ? p.in[I_C][i] : p.in[I_CCTX][i - 16 * 1024]; S[i] = silu_f(v); }
            __syncthreads();
            for (int it = p.bid; it < 192; it += p.nblk) {
                const int layer = it / 96, n0 = (it % 96) * 64, fr = lane & 15, fq = lane >> 4;
                const float* W = p.in[I_WMOD] + (size_t)layer * DM * NMOD + n0 + fr;
                f32x4 acc[2][4];
#pragma unroll
                for (int rt = 0; rt < 2; ++rt)
#pragma unroll
                    for (int ct = 0; ct < 4; ++ct) acc[rt][ct] = (f32x4){0.f, 0.f, 0.f, 0.f};
#pragma unroll 1
                for (int k0 = 0; k0 < 128; k0 += 32) {
                    float bv[8][4];
#pragma unroll
                    for (int j = 0; j < 8; ++j)
#pragma unroll
                        for (int ct = 0; ct < 4; ++ct) bv[j][ct] = W[(size_t)(wave * 128 + k0 + 4 * j + fq) * NMOD + 16 * ct];
#pragma unroll
                    for (int j = 0; j < 8; ++j) { const int k = wave * 128 + k0 + 4 * j + fq;
                        const float a0 = S[fr * 1024 + k], a1 = (fr == 0) ? S[16 * 1024 + k] : 0.f;
#pragma unroll
                        for (int ct = 0; ct < 4; ++ct) { acc[0][ct] = __builtin_amdgcn_mfma_f32_16x16x4f32(a0, bv[j][ct], acc[0][ct], 0, 0, 0);
                                                          acc[1][ct] = __builtin_amdgcn_mfma_f32_16x16x4f32(a1, bv[j][ct], acc[1][ct], 0, 0, 0); } }
                }
#pragma unroll
                for (int rt = 0; rt < 2; ++rt)
#pragma unroll
                    for (int ct = 0; ct < 4; ++ct) *(LAS f32x4*)(red + ((wave * 2 + rt) * 4 + ct) * 256 + lane * 4) = acc[rt][ct];
                __syncthreads();
                for (int idx = tid; idx < 17 * 64; idx += NTHREADS) { const int b = idx >> 6, nn = idx & 63, rt = b >> 4, bb = b & 15, ct = nn >> 4;
                    const int off = (rt * 4 + ct) * 256 + ((bb >> 2) * 16 + (nn & 15)) * 4 + (bb & 3);
                    float s_ = p.in[I_BMOD][layer * NMOD + n0 + nn];
#pragma unroll
                    for (int w = 0; w < 8; ++w) s_ += red[w * 2048 + off];
                    if (b < 16) MODL[(size_t)(layer * 16 + b) * NMOD + n0 + nn] = s_; else if (layer == 0) MODC[n0 + nn] = s_; }
                __syncthreads();
            }
        }
        __syncthreads();
    }
#endif
    const int gw = p.bid * NWAVES + wave, ngw = p.nblk * NWAVES;
#ifndef PRO_SKIP2
    if (partA) {
        float* H3 = (float*)(ws + WS_H3);
        const float* w1 = p.in[I_FW1]; const float* b1 = p.in[I_FB1]; const float* w2 = p.in[I_FW2]; const float* b2 = p.in[I_FB2];
        const float* w3 = p.in[I_FW3]; const float* b3 = p.in[I_FB3]; const float* fr = p.in[I_FFREQ];
        LAS float* w2s = (LAS float*)lds; LAS float* w3s = (LAS float*)(lds + 16384); LAS float* w1s = (LAS float*)(lds + 32768);
        for (int i = tid; i < 4096; i += NTHREADS) { w2s[i] = w2[i]; w3s[i] = w3[i]; if (i < 17 * 64) w1s[i] = w1[i]; }
        __syncthreads();
        for (int t = gw; t < SEQ; t += ngw) {
            const float tf = (float)t, tn = tf / 2048.0f, w = 6.283185307179586f * tf / 2048.0f;
            float feat = 0.f;
            if (lane == 0) feat = tn;
            else if (lane < 17) { const int bi = (lane - 1) & 7; const float band = 1e-4f + (float)bi * ((7.0f - 1e-4f) / 7.0f); const float fw = w * band; feat = (lane < 9) ? fcos(fw) : -fsin(fw); }
            float a = b1[lane];
#pragma unroll
            for (int i = 0; i < 17; ++i) a += __shfl(feat, i) * w1s[i * 64 + lane];
            float h = fsin(fr[lane] * a);
            a = b2[lane];
#pragma unroll 16
            for (int k = 0; k < 64; ++k) a += __shfl(h, k) * w2s[k * 64 + lane];
            h = fsin(fr[64 + lane] * a);
            a = b3[lane];
#pragma unroll 16
            for (int k = 0; k < 64; ++k) a += __shfl(h, k) * w3s[k * 64 + lane];
            h = fsin(fr[128 + lane] * a);
            H3[t * 64 + lane] = h;
        }
    }
#endif
#ifndef PRO_SKIP3
    if (partB) {
        LAS float* scr = (LAS float*)(lds + wave * 16384);
        struct TJob { int in_idx; size_t in_off; int K, N; size_t ws_off; };
        const TJob jobs[10] = {
            {I_AWIN, 0, 1024, 1440, WS_WIN}, {I_AWQB, 0, 384, 768, WS_WQB}, {I_AWKVB, 0, 256, 1024, WS_WKVB}, {I_AWOUT, 0, 1024, 1024, WS_WOUT},
            {I_W1, 0, 1024, 4096, WS_W1_0}, {I_W2, 0, 4096, 1024, WS_W2_0}, {I_W1, (size_t)1024 * 4096, 1024, 4096, WS_W1_1}, {I_W2, (size_t)4096 * 1024, 4096, 1024, WS_W2_1},
            {I_HWIN, 0, 1024, 3072, WS_HIN}, {I_HWOUT, 0, 1024, 1024, WS_HOUT}};
        int base = 0;
#pragma unroll
        for (int j = 0; j < 10; ++j) {
            const int K = jobs[j].K, N = jobs[j].N, nitems = (K / 64) * (N / 32);
            const float* W = p.in[jobs[j].in_idx] + jobs[j].in_off; bf16_t* WT = (bf16_t*)(ws + jobs[j].ws_off);
            int first = gw - (base % ngw); if (first < 0) first += ngw;
            for (int it = first; it < nitems; it += ngw) transpose_item(W, K, N, WT, scr, it, lane);
            base += nitems;
        }
        u32x4* z = (u32x4*)((bf16_t*)(ws + WS_WIN) + (size_t)1440 * 1024);
        unsigned zz = 0u; asm volatile("" : "+v"(zz));
        for (int i = p.bid * NTHREADS + tid; i < 96 * 1024 / 8; i += p.nblk * NTHREADS) z[i] = (u32x4){zz, zz, zz, zz};
    }
#endif
}

__device__ __forceinline__ void modulate_chunk(const float* src, int row0, int nrows, const float* g, const float* sc, const float* sh, bf16_t* dst, int lane, bf16_t* xcopy = nullptr) {
    f32x4 gs[4], sv[4];
#pragma unroll
    for (int j = 0; j < 4; ++j) { const int c4 = lane + 64 * j; const f32x4 gg = ((const f32x4*)g)[c4], ss = ((const f32x4*)sc)[c4]; gs[j] = gg * (ss + 1.0f); sv[j] = ((const f32x4*)sh)[c4]; }
    for (int r = row0; r < row0 + nrows; ++r) {
        const f32x4* xr = (const f32x4*)(src + (size_t)r * DM) + lane;
        f32x4 v[4]; float s = 0.f;
#pragma unroll
        for (int j = 0; j < 4; ++j) { v[j] = xr[64 * j]; s += (v[j].x * v[j].x + v[j].y * v[j].y) + (v[j].z * v[j].z + v[j].w * v[j].w); }
        const float rstd = rsqrtf(wave_sum(s) * (1.0f / DM) + EPS);
        u32x2* o8 = (u32x2*)(dst + (size_t)r * DM) + lane;
#pragma unroll
        for (int j = 0; j < 4; ++j) { const f32x4 y = v[j] * rstd * gs[j] + sv[j]; u32x2 w; w.x = cvtpk(y.x, y.y); w.y = cvtpk(y.z, y.w); o8[64 * j] = w; }
        if (xcopy) { u32x2* x8 = (u32x2*)(xcopy + (size_t)r * DM) + lane;
#pragma unroll
            for (int j = 0; j < 4; ++j) { u32x2 w; w.x = cvtpk(v[j].x, v[j].y); w.y = cvtpk(v[j].z, v[j].w); x8[64 * j] = w; } }
    }
}
__device__ __forceinline__ void phase_modulate(const Ctx& p, const float* src, int layer, const float* g, int shoff, int scoff, bool with_ctx) {
    const int lane = p.tid & 63, wave = __builtin_amdgcn_readfirstlane(p.tid >> 6);
    const int gw = p.bid * NWAVES + wave;
    const float* MODL = (const float*)(p.ws + WS_MODL); const float* MODC = (const float*)(p.ws + WS_MODC);
    bf16_t* HL = (bf16_t*)(p.ws + WS_HL);
    {   const int per = ML / NGW, row0 = gw * per, b = row0 / SEQ; const float* mv = MODL + (size_t)(layer * 16 + b) * NMOD;
        modulate_chunk(src, row0, per, g, mv + scoff, mv + shoff, HL, lane, (bf16_t*)(p.ws + WS_XW)); }
    if (with_ctx) { const int per = MC / NGW, row0 = gw * per;
        modulate_chunk(p.in[I_CTX], row0, per, g, MODC + scoff, MODC + shoff, HL + (size_t)ML * DM, lane); }
}
__device__ __forceinline__ void shw_job(const bf16_t* WT, int N, const float* sh, float* out, int gw, int ngw, int lane) {
    const int fr = lane & 15, fq = lane >> 4;
    for (int g = gw; g < N / 16; g += ngw) {
        f32x4 acc = {0.f, 0.f, 0.f, 0.f};
#pragma unroll 8
        for (int ks = 0; ks < 32; ++ks) {
            const float* sp = sh + (size_t)fr * NMOD + 32 * ks + 8 * fq;
            const f32x4 s0 = *(const f32x4*)sp, s1 = *(const f32x4*)(sp + 4);
            const u32x4 aw = {cvtpk(s0[0], s0[1]), cvtpk(s0[2], s0[3]), cvtpk(s1[0], s1[1]), cvtpk(s1[2], s1[3])};
            const bf16x8 bw = *(const bf16x8*)(WT + (size_t)(16 * g + fr) * DM + 32 * ks + 8 * fq);
            acc = __builtin_amdgcn_mfma_f32_16x16x32_bf16(__builtin_bit_cast(bf16x8, aw), bw, acc, 0, 0, 0);
        }
#pragma unroll
        for (int e = 0; e < 4; ++e) out[(size_t)(4 * fq + e) * N + 16 * g + fr] = acc[e];
    }
}
__device__ __forceinline__ void phase_shw(const Ctx& p) {
    const int lane = p.tid & 63, wave = __builtin_amdgcn_readfirstlane(p.tid >> 6);
    const int gw = p.bid * NWAVES + wave, ngw = p.nblk * NWAVES;
    const float* MODL = (const float*)(p.ws + WS_MODL);
    shw_job((const bf16_t*)(p.ws + WS_W1_0), 4096, MODL + 3 * DM, (float*)(p.ws + WS_SHW_UP0), gw, ngw, lane);
    shw_job((const bf16_t*)(p.ws + WS_HIN), 3072, MODL + (size_t)16 * NMOD, (float*)(p.ws + WS_SHW_HIN), gw, ngw, lane);
    shw_job((const bf16_t*)(p.ws + WS_W1_1), 4096, MODL + (size_t)16 * NMOD + 3 * DM, (float*)(p.ws + WS_SHW_UP1), gw, ngw, lane);
}
__device__ __forceinline__ void phase_final(const Ctx& p) {
    const int lane = p.tid & 63, wave = __builtin_amdgcn_readfirstlane(p.tid >> 6);
    const int gw = p.bid * NWAVES + wave, per = ML / NGW;
    const bf16_t* X = (const bf16_t*)(p.ws + WS_XW); const float* g = p.in[I_FINALG]; const float* sqp = (const float*)(p.ws + WS_SQA);
    f32x4 gs[4];
#pragma unroll
    for (int j = 0; j < 2; ++j) { gs[2 * j] = *(const f32x4*)(g + 512 * j + 8 * lane); gs[2 * j + 1] = *(const f32x4*)(g + 512 * j + 8 * lane + 4); }
    for (int r = gw * per; r < (gw + 1) * per; ++r) {
        const float part = (lane < 16) ? sqp[(size_t)r * 16 + lane] : 0.f;
        const float rstd = rsqrtf(wave_sum(part) * (1.0f / DM) + EPS);
#pragma unroll
        for (int j = 0; j < 2; ++j) { const u32x4 xb = *(const u32x4*)(X + (size_t)r * DM + 512 * j + 8 * lane);
            const f32x4 v0 = {bflo(xb.x), bfhi(xb.x), bflo(xb.y), bfhi(xb.y)}, v1 = {bflo(xb.z), bfhi(xb.z), bflo(xb.w), bfhi(xb.w)};
            f32x4* o = (f32x4*)(p.out + (size_t)r * DM + 512 * j + 8 * lane);
            o[0] = v0 * rstd * gs[2 * j]; o[1] = v1 * rstd * gs[2 * j + 1]; }
    }
}

__device__ __forceinline__ void zpost_row(const Ctx& p, int row, bool latent, int lane, const LAS f32x2* tabM, const LAS f32x2* tabG) {
    unsigned char* ws = p.ws;
    const bf16_t* z = (const bf16_t*)(ws + WS_Z) + (size_t)row * ZW;
    int prow = 0, pcol = 0;
    if (latent) { const int s = row & (SEQ - 1); prow = s >> 6; pcol = s & 63; }
    if (latent) {
        float v[6], ss = 0.f;
#pragma unroll
        for (int i = 0; i < 6; ++i) { v[i] = bf2f(z[ZC_CQ + lane + 64 * i]); ss += v[i] * v[i]; }
        const float rstd = rsqrtf(wave_sum(ss) * (1.0f / 384.0f) + EPS);
        bf16_t* o = (bf16_t*)(ws + WS_CQN) + (size_t)row * 384;
#pragma unroll
        for (int i = 0; i < 6; ++i) o[lane + 64 * i] = (bf16_t)f2bf(v[i] * rstd * p.in[I_AQAG][lane + 64 * i]);
    }
    {
        float v[4], ss = 0.f;
#pragma unroll
        for (int i = 0; i < 4; ++i) { v[i] = bf2f(z[ZC_CKV + lane + 64 * i]); ss += v[i] * v[i]; }
        const float rstd = rsqrtf(wave_sum(ss) * (1.0f / 256.0f) + EPS);
        bf16_t* o = (bf16_t*)(ws + WS_CKVN) + (size_t)row * 256;
#pragma unroll
        for (int i = 0; i < 4; ++i) o[lane + 64 * i] = (bf16_t)f2bf(v[i] * rstd * p.in[I_AKVAG][lane + 64 * i]);
    }
    {
        const int d = lane & 31; const float y = bf2f(z[ZC_KR + d]);
        const float pr = __shfl_xor(y, 8);
        float o = y;
        if (latent) { const int pos = (d & 16) ? pcol : prow; const f32x2 cs = tabM[pos * 8 + (d & 7)];
            o = (d & 8) ? (pr * cs.y + y * cs.x) : (y * cs.x - pr * cs.y); }
        if (lane < 32) ((bf16_t*)(ws + WS_KROPE))[(size_t)row * 32 + d] = (bf16_t)f2bf(o);
    }
    if (latent) {
        const float gq = p.in[I_AQNG][lane];
        const int pos = (lane & 32) ? pcol : prow; const f32x2 cs = tabG[pos * 16 + (lane & 15)];
        bf16_t* o = (bf16_t*)(ws + WS_QG) + (size_t)row * 512;
#pragma unroll
        for (int hh = 0; hh < 8; ++hh) {
            const float v = bf2f(z[ZC_GQ + 64 * hh + lane]);
            const float rstd = rsqrtf(wave_sum(v * v) * (1.0f / 64.0f) + EPS);
            const float y = v * rstd * gq, pr = __shfl_xor(y, 16);
            const float r = (lane & 16) ? (pr * cs.y + y * cs.x) : (y * cs.x - pr * cs.y);
            o[64 * hh + lane] = (bf16_t)f2bf(r * QSCALE_GQA);
        }
    }
    {
        const float gk = p.in[I_AKNG][lane];
        f32x2 cs = {1.f, 0.f};
        if (latent) { const int pos = (lane & 32) ? pcol : prow; cs = tabG[pos * 16 + (lane & 15)]; }
        bf16_t* o = (bf16_t*)(ws + WS_KG) + (size_t)row * 128;
#pragma unroll
        for (int hh = 0; hh < 2; ++hh) {
            const float v = bf2f(z[ZC_GK + 64 * hh + lane]);
            const float rstd = rsqrtf(wave_sum(v * v) * (1.0f / 64.0f) + EPS);
            const float y = v * rstd * gk, pr = __shfl_xor(y, 16);
            const float r = (lane & 16) ? (pr * cs.y + y * cs.x) : (y * cs.x - pr * cs.y);
            o[64 * hh + lane] = (bf16_t)f2bf(r);
        }
    }
    {
        bf16_t* o = (bf16_t*)(ws + WS_VG) + (size_t)row * 128;
        o[lane] = z[ZC_GV + lane]; o[64 + lane] = z[ZC_GV + 64 + lane];
    }
}
struct ZGains { f32x4 qa[2], kva0[2], kva1[2], qn[2], kn[2]; };
__device__ __forceinline__ void unpack8(const u32x4 w, float (&v)[8]) { v[0] = bflo(w.x); v[1] = bfhi(w.x); v[2] = bflo(w.y); v[3] = bfhi(w.y); v[4] = bflo(w.z); v[5] = bfhi(w.z); v[6] = bflo(w.w); v[7] = bfhi(w.w); }
__device__ __forceinline__ u32x4 pack8(const float (&v)[8]) { u32x4 w; w.x = cvtpk(v[0], v[1]); w.y = cvtpk(v[2], v[3]); w.z = cvtpk(v[4], v[5]); w.w = cvtpk(v[6], v[7]); return w; }
__device__ __forceinline__ float sumsq8(const float (&v)[8]) { return ((v[0] * v[0] + v[1] * v[1]) + (v[2] * v[2] + v[3] * v[3])) + ((v[4] * v[4] + v[5] * v[5]) + (v[6] * v[6] + v[7] * v[7])); }
__device__ __forceinline__ void rope8(float (&y)[8], const float (&pr)[8], bool second, const LAS f32x2* cs) {
#pragma unroll
    for (int e = 0; e < 8; ++e) { const f32x2 c = cs[e]; y[e] = second ? (pr[e] * c.y + y[e] * c.x) : (y[e] * c.x - pr[e] * c.y); }
}
__device__ __forceinline__ void zpost_row_vec(const Ctx& p, int row, bool latent, int lane, const LAS f32x2* tabM, const LAS f32x2* tabG, const ZGains& G) {
    unsigned char* ws = p.ws;
    const bf16_t* z = (const bf16_t*)(ws + WS_Z) + (size_t)row * ZW;
    int prow = 0, pcol = 0;
    if (latent) { const int s_ = row & (SEQ - 1); prow = s_ >> 6; pcol = s_ & 63; }
    const int cB = 84 + lane, cC = lane < 16 ? 148 + lane : (lane < 32 ? 164 + (lane - 16) : 80 + (lane & 3));
    const u32x4 wA0 = *(const u32x4*)(z + 8 * lane);
    const u32x4 wA1 = *(const u32x4*)(z + 8 * (64 + (lane & 15)));
    const u32x4 wB = *(const u32x4*)(z + 8 * cB);
    const u32x4 wC = *(const u32x4*)(z + 8 * cC);
    float a0[8], a1[8], vb[8], vc[8];
    unpack8(wA0, a0); unpack8(wA1, a1); unpack8(wB, vb); unpack8(wC, vc);
    {
        const float s0 = sumsq8(a0), s1 = sumsq8(a1);
        const float sq_cq = wave_sum(lane < 48 ? s0 : 0.f), sq_ckv = wave_sum((lane >= 48 ? s0 : 0.f) + (lane < 16 ? s1 : 0.f));
        const float rq = rsqrtf(sq_cq * (1.0f / 384.0f) + EPS), rk = rsqrtf(sq_ckv * (1.0f / 256.0f) + EPS);
        float o[8];
        if (lane < 48) { if (latent) {
#pragma unroll
                for (int e = 0; e < 8; ++e) o[e] = a0[e] * rq * G.qa[e >> 2][e & 3];
                *(u32x4*)((bf16_t*)(ws + WS_CQN) + (size_t)row * 384 + 8 * lane) = pack8(o); } }
        else {
#pragma unroll
            for (int e = 0; e < 8; ++e) o[e] = a0[e] * rk * G.kva0[e >> 2][e & 3];
            *(u32x4*)((bf16_t*)(ws + WS_CKVN) + (size_t)row * 256 + 8 * (lane - 48)) = pack8(o); }
        if (lane < 16) {
#pragma unroll
            for (int e = 0; e < 8; ++e) o[e] = a1[e] * rk * G.kva1[e >> 2][e & 3];
            *(u32x4*)((bf16_t*)(ws + WS_CKVN) + (size_t)row * 256 + 128 + 8 * lane) = pack8(o); }
    }
    if (latent) {
        const float sq = sum8(sumsq8(vb));
        const float rs = rsqrtf(sq * (1.0f / 64.0f) + EPS);
        float y[8], pr[8];
#pragma unroll
        for (int e = 0; e < 8; ++e) y[e] = vb[e] * rs * G.qn[e >> 2][e & 3];
#pragma unroll
        for (int e = 0; e < 8; ++e) pr[e] = dpp_xor2(y[e]);
        const int pos = (lane & 4) ? pcol : prow;
        rope8(y, pr, (lane & 2) != 0, tabG + pos * 16 + 8 * (lane & 1));
#pragma unroll
        for (int e = 0; e < 8; ++e) y[e] *= QSCALE_GQA;
        *(u32x4*)((bf16_t*)(ws + WS_QG) + (size_t)row * 512 + 8 * lane) = pack8(y);
    }
    {
        const float sq = sum8(sumsq8(vc));
        const float rs = rsqrtf(sq * (1.0f / 64.0f) + EPS);
        float y[8], pr2[8], pr1[8];
#pragma unroll
        for (int e = 0; e < 8; ++e) y[e] = (lane < 16) ? vc[e] * rs * G.kn[e >> 2][e & 3] : vc[e];
#pragma unroll
        for (int e = 0; e < 8; ++e) { pr2[e] = dpp_xor2(y[e]); pr1[e] = dpp_xor1(y[e]); }
        if (lane < 16) {
            if (latent) { const int pos = (lane & 4) ? pcol : prow; rope8(y, pr2, (lane & 2) != 0, tabG + pos * 16 + 8 * (lane & 1)); }
            *(u32x4*)((bf16_t*)(ws + WS_KG) + (size_t)row * 128 + 8 * lane) = pack8(y);
        } else if (lane < 32) {
            *(u32x4*)((bf16_t*)(ws + WS_VG) + (size_t)row * 128 + 8 * (lane - 16)) = wC;
        } else if (lane < 36) {
            if (latent) { const int pos = (lane & 2) ? pcol : prow; rope8(y, pr1, (lane & 1) != 0, tabM + pos * 8); }
            *(u32x4*)((bf16_t*)(ws + WS_KROPE) + (size_t)row * 32 + 8 * (lane - 32)) = pack8(y);
        }
    }
}
__device__ __forceinline__ void phase_zpost(const Ctx& p, LAS unsigned char* lds) {
    const int tid = p.tid, lane = tid & 63, wave = __builtin_amdgcn_readfirstlane(tid >> 6);
    LAS f32x2* tabM = (LAS f32x2*)lds;
    LAS f32x2* tabG = (LAS f32x2*)(lds + 4096);
    for (int i = tid; i < 512; i += NTHREADS) { const int pos = i >> 3, f = i & 7; const float inv = inv_theta((float)f / 8.0f); const float a = (float)pos * inv; tabM[i] = (f32x2){fcos(a), fsin(a)}; }
    for (int i = tid; i < 1024; i += NTHREADS) { const int pos = i >> 4, f = i & 15; const float inv = inv_theta((float)f / 16.0f); const float a = (float)pos * inv; tabG[i] = (f32x2){fcos(a), fsin(a)}; }
    __syncthreads();
    const int gw = p.bid * NWAVES + wave;
#if ZPOST_REF
    { const int per = ML / NGW; for (int r = gw * per; r < (gw + 1) * per; ++r) zpost_row(p, r, true, lane, tabM, tabG); }
    { const int per = MC / NGW; for (int r = gw * per; r < (gw + 1) * per; ++r) zpost_row(p, ML + r, false, lane, tabM, tabG); }
#else
    ZGains G;
    { const float* qa = p.in[I_AQAG] + 8 * (lane < 48 ? lane : 0); const float* k0 = p.in[I_AKVAG] + 8 * (lane >= 48 ? lane - 48 : 0); const float* k1 = p.in[I_AKVAG] + 128 + 8 * (lane & 15);
      const float* qn = p.in[I_AQNG] + 8 * (lane & 7); const float* kn = p.in[I_AKNG] + 8 * (lane & 7);
#pragma unroll
      for (int h = 0; h < 2; ++h) { G.qa[h] = *(const f32x4*)(qa + 4 * h); G.kva0[h] = *(const f32x4*)(k0 + 4 * h); G.kva1[h] = *(const f32x4*)(k1 + 4 * h); G.qn[h] = *(const f32x4*)(qn + 4 * h); G.kn[h] = *(const f32x4*)(kn + 4 * h); } }
    { const int per = ML / NGW;
#pragma unroll 2
      for (int r = gw * per; r < (gw + 1) * per; ++r) zpost_row_vec(p, r, true, lane, tabM, tabG, G); }
    { const int per = MC / NGW; for (int r = gw * per; r < (gw + 1) * per; ++r) zpost_row_vec(p, ML + r, false, lane, tabM, tabG, G); }
#endif
    __syncthreads();
}

__device__ __forceinline__ float max3f(float a, float b, float c) { float r; asm("v_max3_f32 %0, %1, %2, %3" : "=v"(r) : "v"(a), "v"(b), "v"(c)); return r; }
__device__ __forceinline__ int crow(int r, int hi) { return (r & 3) + 8 * (r >> 2) + 4 * hi; }
__device__ __forceinline__ size_t key_row(int b, int t) { return t < CTXL ? (size_t)(ML + b * CTXL + t) : (size_t)(b * SEQ + (t - CTXL)); }

template <int DK>
__device__ __forceinline__ void attn_naive_one(const Ctx& p, int b, int h, int q) {
    unsigned char* ws = p.ws;
    const bf16_t* KV = (const bf16_t*)(ws + WS_KV); const bf16_t* KR = (const bf16_t*)(ws + WS_KROPE);
    const bf16_t* KG = (const bf16_t*)(ws + WS_KG); const bf16_t* VG = (const bf16_t*)(ws + WS_VG);
    const size_t row = (size_t)b * SEQ + q;
    float qv[DK];
    {
        const bf16_t* qp = (DK == 96) ? (const bf16_t*)(ws + WS_QMR) + row * 768 + h * 96 : (const bf16_t*)(ws + WS_QG) + row * 512 + (h - 8) * 64;
#pragma unroll
        for (int d8 = 0; d8 < DK / 8; ++d8) { const u32x4 w = *(const u32x4*)(qp + 8 * d8);
            qv[8 * d8 + 0] = bflo(w.x); qv[8 * d8 + 1] = bfhi(w.x); qv[8 * d8 + 2] = bflo(w.y); qv[8 * d8 + 3] = bfhi(w.y);
            qv[8 * d8 + 4] = bflo(w.z); qv[8 * d8 + 5] = bfhi(w.z); qv[8 * d8 + 6] = bflo(w.w); qv[8 * d8 + 7] = bfhi(w.w); }
    }
    float o[64];
#pragma unroll
    for (int d = 0; d < 64; ++d) o[d] = 0.f;
    float m = -1e30f, l = 0.f;
    for (int t = 0; t < TKEYS; ++t) {
        const size_t kr = key_row(b, t);
        float s = 0.f;
        const bf16_t* vp;
        if (DK == 96) {
            const bf16_t* kp = KV + kr * 1024 + h * 128; const bf16_t* rp = KR + kr * 32;
#pragma unroll
            for (int d = 0; d < 64; ++d) s += qv[d] * bf2f(kp[d]);
#pragma unroll
            for (int d = 0; d < 32; ++d) s += qv[64 + d] * bf2f(rp[d]);
            vp = kp + 64;
        } else {
            const int kvh = (h - 8) >> 2; const bf16_t* kp = KG + kr * 128 + kvh * 64;
#pragma unroll
            for (int d = 0; d < 64; ++d) s += qv[d] * bf2f(kp[d]);
            vp = VG + kr * 128 + kvh * 64;
        }
        const float mn = fmaxf(m, s), al = exp2f(m - mn), pe = exp2f(s - mn);
        l = l * al + pe; m = mn;
#pragma unroll
        for (int d = 0; d < 64; ++d) o[d] = o[d] * al + pe * bf2f(vp[d]);
    }
    const float rl = 1.0f / l;
    bf16_t* op = (bf16_t*)(ws + WS_O) + row * 1024 + h * 64;
#pragma unroll
    for (int d = 0; d < 64; ++d) op[d] = (bf16_t)f2bf(o[d] * rl);
}
__device__ __forceinline__ void phase_naive_qrope(const Ctx& p) {
    const bf16_t* QM = (const bf16_t*)(p.ws + WS_QM); bf16_t* QMR = (bf16_t*)(p.ws + WS_QMR);
    for (size_t idx = (size_t)p.bid * NTHREADS + p.tid; idx < (size_t)ML * 768; idx += (size_t)p.nblk * NTHREADS) {
        const int col = (int)(idx % 768), d = col % 96; const size_t row = idx / 768; const int q = (int)(row & (SEQ - 1));
        float v = bf2f(QM[idx]);
        if (d >= 64) {
            const int e = d - 64, prow = q >> 6, pcol = q & 63;
            const int pos = (e & 16) ? pcol : prow; const float inv = inv_theta((float)(e & 7) / 8.0f); const float ang = (float)pos * inv;
            const float cs = fcos(ang), sn = fsin(ang);
            const float a = bf2f(QM[idx - e + (e & ~8)]), bb = bf2f(QM[idx - e + (e | 8)]);
            v = (e & 8) ? (a * sn + bb * cs) : (a * cs - bb * sn);
        }
        QMR[idx] = (bf16_t)f2bf(v * QSCALE_MLA);
    }
}
__device__ __forceinline__ void phase_attn_naive(const Ctx& p) {
    for (int idx = p.bid * NTHREADS + p.tid; idx < NB * 16 * SEQ; idx += p.nblk * NTHREADS) {
        const int q = idx & (SEQ - 1), h = (idx >> 11) & 15, b = idx >> 15;
        if (h < 8) attn_naive_one<96>(p, b, h, q); else attn_naive_one<64>(p, b, h, q);
    }
}

template <int DK>
__device__ __forceinline__ void attn_unit(const Ctx& p, int b, int h, int qb, LAS unsigned char* lds) {
    constexpr int NC = DK / 8;
    constexpr int ND = DK / 16;
    constexpr int KB = 12288, VB = 8192;
    unsigned char* ws = p.ws;
    const int tid = p.tid, lane = tid & 63, r32 = lane & 31, hi = lane >> 5; const int wid = __builtin_amdgcn_readfirstlane(tid >> 6);
    const bf16_t* KV = (const bf16_t*)(ws + WS_KV); const bf16_t* KR = (const bf16_t*)(ws + WS_KROPE);
    const bf16_t* KG = (const bf16_t*)(ws + WS_KG); const bf16_t* VG = (const bf16_t*)(ws + WS_VG);
    const int kvh = (h - 8) >> 2;
    LAS unsigned char* Kb = lds; LAS unsigned char* Vb = lds + 2 * KB; LAS float* wsf = (LAS float*)(lds + 2 * KB + 2 * VB) + wid * 64;
    const int qs = qb * 256 + wid * 32 + r32;
    const size_t qrow = (size_t)b * SEQ + qs;
    bf16x8 qr[ND];
    if (DK == 96) {
        const bf16_t* qp = (const bf16_t*)(ws + WS_QM) + qrow * 768 + h * 96;
#pragma unroll
        for (int d0 = 0; d0 < 4; ++d0) { const u32x4 w = *(const u32x4*)(qp + 16 * d0 + 8 * hi); u32x4 o;
            o.x = cvtpk(bflo(w.x) * QSCALE_MLA, bfhi(w.x) * QSCALE_MLA); o.y = cvtpk(bflo(w.y) * QSCALE_MLA, bfhi(w.y) * QSCALE_MLA);
            o.z = cvtpk(bflo(w.z) * QSCALE_MLA, bfhi(w.z) * QSCALE_MLA); o.w = cvtpk(bflo(w.w) * QSCALE_MLA, bfhi(w.w) * QSCALE_MLA);
            qr[d0] = __builtin_bit_cast(bf16x8, o); }
        const int prow = qs >> 6, pcol = qs & 63;
#pragma unroll
        for (int c = 0; c < 2; ++c) {
            const u32x4 wa = *(const u32x4*)(qp + 64 + 16 * c);
            const u32x4 wb = *(const u32x4*)(qp + 64 + 16 * c + 8);
            const float pos = (float)(c == 0 ? prow : pcol);
            float av[8] = {bflo(wa.x), bfhi(wa.x), bflo(wa.y), bfhi(wa.y), bflo(wa.z), bfhi(wa.z), bflo(wa.w), bfhi(wa.w)};
            float bv[8] = {bflo(wb.x), bfhi(wb.x), bflo(wb.y), bfhi(wb.y), bflo(wb.z), bfhi(wb.z), bflo(wb.w), bfhi(wb.w)};
            float ov[8];
#pragma unroll
            for (int j = 0; j < 8; ++j) { const float inv = inv_theta((float)j / 8.0f); const float ang = pos * inv; const float cs = fcos(ang), sn = fsin(ang);
                const float lo = av[j] * cs - bv[j] * sn, hv = av[j] * sn + bv[j] * cs; ov[j] = (hi ? hv : lo) * QSCALE_MLA; }
            u32x4 o; o.x = cvtpk(ov[0], ov[1]); o.y = cvtpk(ov[2], ov[3]); o.z = cvtpk(ov[4], ov[5]); o.w = cvtpk(ov[6], ov[7]);
            qr[4 + c] = __builtin_bit_cast(bf16x8, o);
        }
    } else {
        const bf16_t* qp = (const bf16_t*)(ws + WS_QG) + qrow * 512 + (h - 8) * 64;
#pragma unroll
        for (int d0 = 0; d0 < ND; ++d0) qr[d0] = *(const bf16x8*)(qp + 16 * d0 + 8 * hi);
    }
    const int kkey = tid & 63, kc0 = tid >> 6;
    const int vkv = tid >> 3, vdc = tid & 7;
    const unsigned kdst0 = kc0 * 1024 + kkey * 16, kdst1 = (kc0 + 8) * 1024 + kkey * 16;
    const unsigned vdst = (vdc >> 2) * 4096 + (vkv >> 4) * 1024 + (vkv & 15) * 64 + (vdc & 3) * 16;
    u32x4 kreg0, kreg1, vreg;
    auto load_tile = [&](int kt) {
        const size_t rk = key_row(b, kt * 64 + kkey), rv = key_row(b, kt * 64 + vkv);
        if (DK == 96) {
            kreg0 = *(const u32x4*)(KV + rk * 1024 + h * 128 + 8 * kc0);
            if (wid < 4) kreg1 = *(const u32x4*)(KR + rk * 32 + 8 * kc0);
            vreg = *(const u32x4*)(KV + rv * 1024 + h * 128 + 64 + 8 * vdc);
        } else {
            kreg0 = *(const u32x4*)(KG + rk * 128 + kvh * 64 + 8 * kc0);
            vreg = *(const u32x4*)(VG + rv * 128 + kvh * 64 + 8 * vdc);
        }
    };
    auto store_tile = [&](int buf) {
        *(LAS u32x4*)(Kb + buf * KB + kdst0) = kreg0;
        if (DK == 96) { if (wid < 4) *(LAS u32x4*)(Kb + buf * KB + kdst1) = kreg1; }
        *(LAS u32x4*)(Vb + buf * VB + vdst) = vreg;
    };
    f32x16 o0 = {}, o1 = {};
    float mrun = -1e30f, lrun = 0.f;
    const unsigned kfo = hi * 1024 + r32 * 16;
    const unsigned vfo = ((lane >> 4) & 1) * 32 + (lane & 3) * 8 + (4 * hi + ((lane & 15) >> 2)) * 64;
    load_tile(0); store_tile(0);
    __syncthreads();
    constexpr int NT = TKEYS / 64;
    for (int kt = 0; kt < NT; ++kt) {
        const int buf = kt & 1;
        if (kt + 1 < NT) load_tile(kt + 1);
        f32x16 p0 = {}, p1 = {};
        const LAS unsigned char* kp = Kb + buf * KB + kfo;
#pragma unroll
        for (int d0 = 0; d0 < ND; ++d0) {
            const bf16x8 k0 = *(const LAS bf16x8*)(kp + d0 * 2048), k1 = *(const LAS bf16x8*)(kp + d0 * 2048 + 512);
            p0 = __builtin_amdgcn_mfma_f32_32x32x16_bf16(k0, qr[d0], p0, 0, 0, 0);
            p1 = __builtin_amdgcn_mfma_f32_32x32x16_bf16(k1, qr[d0], p1, 0, 0, 0);
        }
        float mx = fmaxf(p0[0], p1[0]);
#pragma unroll
        for (int r = 1; r < 16; ++r) mx = fmaxf(mx, fmaxf(p0[r], p1[r]));
        mx = fmaxf(mx, __shfl_xor(mx, 32));
        const float mnew = fmaxf(mrun, mx), alpha = __builtin_amdgcn_exp2f(mrun - mnew);
        mrun = mnew;
        float rs = 0.f;
#pragma unroll
        for (int r = 0; r < 16; ++r) { p0[r] = __builtin_amdgcn_exp2f(p0[r] - mnew); p1[r] = __builtin_amdgcn_exp2f(p1[r] - mnew); rs += p0[r] + p1[r]; }
        lrun = lrun * alpha + rs;
        if (hi == 0) wsf[r32] = alpha;
        asm volatile("s_waitcnt lgkmcnt(0)" ::: "memory");
#pragma unroll
        for (int g4 = 0; g4 < 4; ++g4) { const f32x4 a4 = *(const LAS f32x4*)(wsf + 8 * g4 + 4 * hi);
#pragma unroll
            for (int e = 0; e < 4; ++e) { o0[4 * g4 + e] *= a4[e]; o1[4 * g4 + e] *= a4[e]; } }
        u32x4 pw[4];
        pw[0] = (u32x4){cvtpk(p0[0], p0[1]), cvtpk(p0[2], p0[3]), cvtpk(p0[4], p0[5]), cvtpk(p0[6], p0[7])};
        pw[1] = (u32x4){cvtpk(p0[8], p0[9]), cvtpk(p0[10], p0[11]), cvtpk(p0[12], p0[13]), cvtpk(p0[14], p0[15])};
        pw[2] = (u32x4){cvtpk(p1[0], p1[1]), cvtpk(p1[2], p1[3]), cvtpk(p1[4], p1[5]), cvtpk(p1[6], p1[7])};
        pw[3] = (u32x4){cvtpk(p1[8], p1[9]), cvtpk(p1[10], p1[11]), cvtpk(p1[12], p1[13]), cvtpk(p1[14], p1[15])};
        const LAS unsigned char* vp = Vb + buf * VB + vfo;
#pragma unroll
        for (int ks = 0; ks < 4; ++ks) {
            const bf16x8 pa = __builtin_bit_cast(bf16x8, pw[ks]);
            const s16x4 l0 = __builtin_amdgcn_ds_read_tr16_b64_v4i16((LAS s16x4*)(vp + ks * 1024));
            const s16x4 h0 = __builtin_amdgcn_ds_read_tr16_b64_v4i16((LAS s16x4*)(vp + ks * 1024 + 512));
            const s16x4 l1 = __builtin_amdgcn_ds_read_tr16_b64_v4i16((LAS s16x4*)(vp + 4096 + ks * 1024));
            const s16x4 h1 = __builtin_amdgcn_ds_read_tr16_b64_v4i16((LAS s16x4*)(vp + 4096 + ks * 1024 + 512));
            const bf16x8 v0 = {l0[0], l0[1], l0[2], l0[3], h0[0], h0[1], h0[2], h0[3]};
            const bf16x8 v1 = {l1[0], l1[1], l1[2], l1[3], h1[0], h1[1], h1[2], h1[3]};
            o0 = __builtin_amdgcn_mfma_f32_32x32x16_bf16(pa, v0, o0, 0, 0, 0);
            o1 = __builtin_amdgcn_mfma_f32_32x32x16_bf16(pa, v1, o1, 0, 0, 0);
        }
        if (kt + 1 < NT) store_tile(buf ^ 1);
        __syncthreads();
    }
    lrun += __shfl_xor(lrun, 32);
    if (hi == 0) wsf[32 + r32] = lrun;
    asm volatile("s_waitcnt lgkmcnt(0)" ::: "memory");
    bf16_t* Ow = (bf16_t*)(ws + WS_O) + ((size_t)b * SEQ + qb * 256 + wid * 32) * 1024 + h * 64;
#pragma unroll
    for (int r = 0; r < 16; ++r) { const int orow = crow(r, hi); const float rl = __builtin_amdgcn_rcpf(wsf[32 + orow]);
        Ow[(size_t)orow * 1024 + r32] = (bf16_t)f2bf(o0[r] * rl); Ow[(size_t)orow * 1024 + 32 + r32] = (bf16_t)f2bf(o1[r] * rl); }
    __syncthreads();
}
template <int DK>
__device__ __forceinline__ void attn_unit2(const Ctx& p, const int tid, int b, int h, int qb, LAS unsigned char* lds) {
    constexpr int ND = DK / 16;
    constexpr int KB = 12288, VB = 8192, NT = TKEYS / 64;
    constexpr float THR = 8.0f;
    unsigned char* ws = p.ws;
    const int lane = tid & 63, r32 = lane & 31, hi = lane >> 5; const int wid = __builtin_amdgcn_readfirstlane(tid >> 6);
    const bf16_t* KV = (const bf16_t*)(ws + WS_KV); const bf16_t* KR = (const bf16_t*)(ws + WS_KROPE);
    const bf16_t* KG = (const bf16_t*)(ws + WS_KG); const bf16_t* VG = (const bf16_t*)(ws + WS_VG);
    const int kvh = (h - 8) >> 2;
    LAS unsigned char* Kb = lds; LAS unsigned char* Vb = lds + 2 * KB; LAS float* wsf = (LAS float*)(lds + 2 * KB + 2 * VB) + wid * 64;
    const int qs = qb * 256 + wid * 32 + r32;
    const size_t qrow = (size_t)b * SEQ + qs;
    bf16x8 qr[ND];
    if (DK == 96) {
        const bf16_t* qp = (const bf16_t*)(ws + WS_QM) + qrow * 768 + h * 96;
#pragma unroll
        for (int d0 = 0; d0 < 4; ++d0) { const u32x4 w = *(const u32x4*)(qp + 16 * d0 + 8 * hi); u32x4 o;
            o.x = cvtpk(bflo(w.x) * QSCALE_MLA, bfhi(w.x) * QSCALE_MLA); o.y = cvtpk(bflo(w.y) * QSCALE_MLA, bfhi(w.y) * QSCALE_MLA);
            o.z = cvtpk(bflo(w.z) * QSCALE_MLA, bfhi(w.z) * QSCALE_MLA); o.w = cvtpk(bflo(w.w) * QSCALE_MLA, bfhi(w.w) * QSCALE_MLA);
            qr[d0] = __builtin_bit_cast(bf16x8, o); }
        const int prow = qs >> 6, pcol = qs & 63;
#pragma unroll
        for (int c = 0; c < 2; ++c) {
            const u32x4 wa = *(const u32x4*)(qp + 64 + 16 * c);
            const u32x4 wb = *(const u32x4*)(qp + 64 + 16 * c + 8);
            const float pos = (float)(c == 0 ? prow : pcol);
            float av[8], bv[8], ov[8]; unpack8(wa, av); unpack8(wb, bv);
#pragma unroll
            for (int j = 0; j < 8; ++j) { const float inv = inv_theta((float)j / 8.0f); const float ang = pos * inv; const float cs = fcos(ang), sn = fsin(ang);
                const float lo = av[j] * cs - bv[j] * sn, hv = av[j] * sn + bv[j] * cs; ov[j] = (hi ? hv : lo) * QSCALE_MLA; }
            qr[4 + c] = __builtin_bit_cast(bf16x8, pack8(ov));
        }
    } else {
        const bf16_t* qp = (const bf16_t*)(ws + WS_QG) + qrow * 512 + (h - 8) * 64;
#pragma unroll
        for (int d0 = 0; d0 < ND; ++d0) qr[d0] = *(const bf16x8*)(qp + 16 * d0 + 8 * hi);
    }
    const int kkey = tid & 63, kc0 = tid >> 6, vkv = tid >> 3, vdc = tid & 7;
    const unsigned kdst0 = kc0 * 1024 + kkey * 16, kdst1 = (kc0 + 8) * 1024 + kkey * 16;
    const unsigned vdst = (vdc >> 2) * 4096 + (vkv >> 4) * 1024 + (vkv & 15) * 64 + (vdc & 3) * 16;
    u32x4 kreg0, kreg1, vreg;
    auto load_k = [&](int kt) { const size_t rk = key_row(b, kt * 64 + kkey);
        if (DK == 96) { kreg0 = *(const u32x4*)(KV + rk * 1024 + h * 128 + 8 * kc0); if (wid < 4) kreg1 = *(const u32x4*)(KR + rk * 32 + 8 * kc0); }
        else kreg0 = *(const u32x4*)(KG + rk * 128 + kvh * 64 + 8 * kc0); };
    auto load_v = [&](int kt) { const size_t rv = key_row(b, kt * 64 + vkv);
        if (DK == 96) vreg = *(const u32x4*)(KV + rv * 1024 + h * 128 + 64 + 8 * vdc); else vreg = *(const u32x4*)(VG + rv * 128 + kvh * 64 + 8 * vdc); };
    auto store_k = [&](int buf) { *(LAS u32x4*)(Kb + buf * KB + kdst0) = kreg0; if (DK == 96) { if (wid < 4) *(LAS u32x4*)(Kb + buf * KB + kdst1) = kreg1; } };
    auto store_v = [&](int buf) { *(LAS u32x4*)(Vb + buf * VB + vdst) = vreg; };
    f32x16 o0 = {}, o1 = {};
    float mhat = 0.f, lrun = 0.f;
    const unsigned kfo = hi * 1024 + r32 * 16;
    const unsigned vfo = ((lane >> 4) & 1) * 32 + (lane & 3) * 8 + (4 * hi + ((lane & 15) >> 2)) * 64;
#define A2_SBAR() __builtin_amdgcn_sched_barrier(0)
#define A2_EL(X0, X1, i) ((i) < 16 ? X0[(i) & 15] : X1[(i) & 15])
    f32x16 negm; { float z0 = 0.f; asm volatile("" : "+v"(z0));
#pragma unroll
        for (int r = 0; r < 16; ++r) negm[r] = z0; }
    float rmx = 0.f;
#define A2_STEP(C0, C1, P0, P1, T, HASK) do { const int t_ = (T); \
        float f_ = 1.0f; const bool resc_ = __any(rmx > THR); \
        if (resc_) { const float dl_ = __builtin_fmaxf(rmx, 0.f); mhat += dl_; f_ = __builtin_amdgcn_exp2f(-dl_); if (hi == 0) wsf[r32] = f_; \
            _Pragma("unroll") for (int r = 0; r < 16; ++r) negm[r] = -mhat; } \
        if (HASK) load_k(t_ + 1); \
        load_v(t_); \
        const LAS unsigned char* kp_ = Kb + (t_ & 1) * KB + kfo; const LAS unsigned char* vp_ = Vb + ((t_ + 1) & 1) * VB + vfo; \
        float sacc_ = 0.f; unsigned pw_[16]; s16x4 vl_[8], vh_[8]; bf16x8 kf_[2 * ND]; \
        kf_[0] = *(const LAS bf16x8*)(kp_); kf_[1] = *(const LAS bf16x8*)(kp_ + 512); \
        A2_SBAR(); \
        _Pragma("unroll") for (int g = 0; g < 2 * ND; ++g) { \
            if (g + 2 < 2 * ND) kf_[g + 2] = *(const LAS bf16x8*)(kp_ + ((g + 2) >> 1) * 2048 + ((g + 2) & 1) * 512); \
            if (g < 8) { vl_[g] = __builtin_amdgcn_ds_read_tr16_b64_v4i16((LAS s16x4*)(vp_ + (g >> 2) * 4096 + (g & 3) * 1024)); \
                         vh_[g] = __builtin_amdgcn_ds_read_tr16_b64_v4i16((LAS s16x4*)(vp_ + (g >> 2) * 4096 + (g & 3) * 1024 + 512)); } \
            if ((g & 1) == 0) { if (g == 0) C0 = __builtin_amdgcn_mfma_f32_32x32x16_bf16(kf_[g], qr[g >> 1], negm, 0, 0, 0); else C0 = __builtin_amdgcn_mfma_f32_32x32x16_bf16(kf_[g], qr[g >> 1], C0, 0, 0, 0); } \
            else { if (g == 1) C1 = __builtin_amdgcn_mfma_f32_32x32x16_bf16(kf_[g], qr[g >> 1], negm, 0, 0, 0); else C1 = __builtin_amdgcn_mfma_f32_32x32x16_bf16(kf_[g], qr[g >> 1], C1, 0, 0, 0); } \
            { constexpr int NA = (ND == 6) ? 3 : 4; \
                _Pragma("unroll") for (int i = 0; i < NA; ++i) { const int e = NA * g + i; if (e < 32) sacc_ += A2_EL(P0, P1, e); } \
                if (g < 8) { pw_[2 * g] = cvtpk(A2_EL(P0, P1, 4 * g), A2_EL(P0, P1, 4 * g + 1)); pw_[2 * g + 1] = cvtpk(A2_EL(P0, P1, 4 * g + 2), A2_EL(P0, P1, 4 * g + 3)); asm volatile("" : "+v"(pw_[2 * g]), "+v"(pw_[2 * g + 1])); } \
                asm volatile("" : "+v"(sacc_)); } \
            A2_SBAR(); } \
        lrun = (lrun + sacc_) * f_; \
        float rm_ = 0.f; \
        _Pragma("unroll") for (int g = 0; g < 8; ++g) { \
            { const int ks = g >> 1, dv = g & 1; const u32x4 pa_ = {pw_[4 * ks], pw_[4 * ks + 1], pw_[4 * ks + 2], pw_[4 * ks + 3]}; \
                const s16x4 l_ = vl_[dv * 4 + ks], h_ = vh_[dv * 4 + ks]; const bf16x8 vf_ = {l_[0], l_[1], l_[2], l_[3], h_[0], h_[1], h_[2], h_[3]}; \
                if (dv == 0) o0 = __builtin_amdgcn_mfma_f32_32x32x16_bf16(__builtin_bit_cast(bf16x8, pa_), vf_, o0, 0, 0, 0); \
                else o1 = __builtin_amdgcn_mfma_f32_32x32x16_bf16(__builtin_bit_cast(bf16x8, pa_), vf_, o1, 0, 0, 0); } \
            if (g == 0) { rm_ = __builtin_fmaxf(__builtin_fmaxf(C0[0], C0[1]), __builtin_fmaxf(C0[2], C0[3])); }          \
            else if (g == 4) { rm_ = __builtin_fmaxf(rm_, __builtin_fmaxf(__builtin_fmaxf(C1[0], C1[1]), __builtin_fmaxf(C1[2], C1[3]))); } \
            else if (g < 4) { rm_ = max3f(rm_, C0[4 * g], C0[4 * g + 1]); rm_ = max3f(rm_, C0[4 * g + 2], C0[4 * g + 3]); } \
            else { rm_ = max3f(rm_, C1[4 * g - 16], C1[4 * g - 15]); rm_ = max3f(rm_, C1[4 * g - 14], C1[4 * g - 13]); } \
            asm volatile("" : "+v"(rm_)); \
            _Pragma("unroll") for (int i = 0; i < 4; ++i) { const int e = 4 * g + i; if (e < 16) C0[e & 15] = __builtin_amdgcn_exp2f(C0[e & 15]); else C1[e & 15] = __builtin_amdgcn_exp2f(C1[e & 15]); } \
            if (g < 4) asm volatile("" : "+v"(C0)); else asm volatile("" : "+v"(C1)); \
            A2_SBAR(); } \
        { auto rr_ = __builtin_amdgcn_permlane32_swap(__float_as_uint(rm_), __float_as_uint(rm_), false, false); rmx = __builtin_fmaxf(__uint_as_float(rr_[0]), __uint_as_float(rr_[1])); } \
        if (resc_) { asm volatile("s_waitcnt lgkmcnt(0)" ::: "memory"); \
            _Pragma("unroll") for (int g4 = 0; g4 < 4; ++g4) { const f32x4 a4 = *(const LAS f32x4*)(wsf + 8 * g4 + 4 * hi); \
                _Pragma("unroll") for (int e = 0; e < 4; ++e) { o0[4 * g4 + e] *= a4[e]; o1[4 * g4 + e] *= a4[e]; } } } \
        if (HASK) store_k((t_ + 1) & 1); \
        store_v(t_ & 1); \
        __syncthreads(); } while (0)
    if (wid >= 4) __builtin_amdgcn_s_setprio(1);
    load_k(0); store_k(0);
    __syncthreads();
    f32x16 sA0, sA1, sB0, sB1;
    {
        load_k(1); load_v(0);
        const LAS unsigned char* kp_ = Kb + kfo;
#pragma unroll
        for (int d0 = 0; d0 < ND; ++d0) { const bf16x8 k0 = *(const LAS bf16x8*)(kp_ + d0 * 2048), k1 = *(const LAS bf16x8*)(kp_ + d0 * 2048 + 512);
            sA0 = __builtin_amdgcn_mfma_f32_32x32x16_bf16(k0, qr[d0], d0 == 0 ? negm : sA0, 0, 0, 0); sA1 = __builtin_amdgcn_mfma_f32_32x32x16_bf16(k1, qr[d0], d0 == 0 ? negm : sA1, 0, 0, 0); }
        float rm = __builtin_fmaxf(sA0[0], sA1[0]);
#pragma unroll
        for (int r = 1; r < 16; ++r) rm = __builtin_fmaxf(rm, __builtin_fmaxf(sA0[r], sA1[r]));
        { auto rr = __builtin_amdgcn_permlane32_swap(__float_as_uint(rm), __float_as_uint(rm), false, false); rm = __builtin_fmaxf(__uint_as_float(rr[0]), __uint_as_float(rr[1])); }
        mhat = rm;
#pragma unroll
        for (int r = 0; r < 16; ++r) { negm[r] = -mhat; sA0[r] = __builtin_amdgcn_exp2f(sA0[r] - mhat); sA1[r] = __builtin_amdgcn_exp2f(sA1[r] - mhat); }
        store_k(1); store_v(0);
        __syncthreads();
    }
    for (int t = 1; t + 1 < NT; t += 2) {
        A2_STEP(sB0, sB1, sA0, sA1, t, true);
        A2_STEP(sA0, sA1, sB0, sB1, t + 1, true);
    }
    A2_STEP(sB0, sB1, sA0, sA1, NT - 1, false);
    {
        float sacc = 0.f;
#pragma unroll
        for (int r = 0; r < 16; ++r) sacc += sB0[r] + sB1[r];
        lrun += sacc;
        const LAS unsigned char* vp = Vb + ((NT - 1) & 1) * VB + vfo;
#pragma unroll
        for (int ks = 0; ks < 4; ++ks) {
            const f32x16& P = (ks < 2) ? sB0 : sB1; const int bse = 8 * (ks & 1);
            const u32x4 pa = {cvtpk(P[bse], P[bse + 1]), cvtpk(P[bse + 2], P[bse + 3]), cvtpk(P[bse + 4], P[bse + 5]), cvtpk(P[bse + 6], P[bse + 7])};
            const s16x4 l0 = __builtin_amdgcn_ds_read_tr16_b64_v4i16((LAS s16x4*)(vp + ks * 1024)), h0 = __builtin_amdgcn_ds_read_tr16_b64_v4i16((LAS s16x4*)(vp + ks * 1024 + 512));
            const s16x4 l1 = __builtin_amdgcn_ds_read_tr16_b64_v4i16((LAS s16x4*)(vp + 4096 + ks * 1024)), h1 = __builtin_amdgcn_ds_read_tr16_b64_v4i16((LAS s16x4*)(vp + 4096 + ks * 1024 + 512));
            const bf16x8 v0 = {l0[0], l0[1], l0[2], l0[3], h0[0], h0[1], h0[2], h0[3]}, v1 = {l1[0], l1[1], l1[2], l1[3], h1[0], h1[1], h1[2], h1[3]};
            o0 = __builtin_amdgcn_mfma_f32_32x32x16_bf16(__builtin_bit_cast(bf16x8, pa), v0, o0, 0, 0, 0);
            o1 = __builtin_amdgcn_mfma_f32_32x32x16_bf16(__builtin_bit_cast(bf16x8, pa), v1, o1, 0, 0, 0);
        }
    }
#undef A2_STEP
#undef A2_EL
#undef A2_SBAR
    __builtin_amdgcn_s_setprio(0);
    lrun += __shfl_xor(lrun, 32);
    if (hi == 0) wsf[32 + r32] = lrun;
    asm volatile("s_waitcnt lgkmcnt(0)" ::: "memory");
    bf16_t* Ow = (bf16_t*)(ws + WS_O) + ((size_t)b * SEQ + qb * 256 + wid * 32) * 1024 + h * 64;
#pragma unroll
    for (int r = 0; r < 16; ++r) { const int orow = crow(r, hi); const float rl = __builtin_amdgcn_rcpf(wsf[32 + orow]);
        Ow[(size_t)orow * 1024 + r32] = (bf16_t)f2bf(o0[r] * rl); Ow[(size_t)orow * 1024 + 32 + r32] = (bf16_t)f2bf(o1[r] * rl); }
    __syncthreads();
}
__device__ __forceinline__ void phase_attn(const Ctx& p, LAS unsigned char* lds) {
    const int xcd = p.bid & 7, sl = p.bid >> 3, c = sl & 1, b = 2 * xcd + (sl >> 4), qb = (sl >> 1) & 7;
    for (int i = 0; i < 8; ++i) { const int h = 2 * i + (c & 1);
#if ATTN_V1
        if (h < 8) attn_unit<96>(p, b, h, qb, lds); else attn_unit<64>(p, b, h, qb, lds); }
#else
        int tid = p.tid; asm volatile("" : "+v"(tid));
        if (h < 8) attn_unit2<96>(p, tid, b, h, qb, lds); else attn_unit2<64>(p, tid, b, h, qb, lds); }
#endif
}

__device__ __forceinline__ void hyena_taps(const Ctx& p, int c, LAS unsigned char* scratch, float (&taps)[4][2][2]) {
    const int tid = p.tid, lane = tid & 63, wave = __builtin_amdgcn_readfirstlane(tid >> 6);
    LAS float* w4s = (LAS float*)scratch;
    LAS float* red = (LAS float*)(scratch + 1024);
    const float* w4 = p.in[I_FW4]; const float* H3 = (const float*)(p.ws + WS_H3);
    if (tid < 256) { const int cc = tid >> 6, k = tid & 63; w4s[cc * 64 + k] = w4[(size_t)k * 4096 + (cc >> 1) * 2048 + (cc & 1) * 1024 + c]; }
    __syncthreads();
    const float dmin = -3.0701134573253940f, dmax = -15.350567286626970f;
    const float delta = fabsf(dmin + (float)c * ((dmax - dmin) / 1023.0f));
    float ss0 = 0.f, ss1 = 0.f;
    float a[4][4];
#pragma unroll
    for (int i = 0; i < 4; ++i)
#pragma unroll
        for (int cc = 0; cc < 4; ++cc) a[i][cc] = 0.f;
#pragma unroll 2
    for (int k4 = 0; k4 < 16; ++k4) {
        f32x4 wv[4];
#pragma unroll
        for (int cc = 0; cc < 4; ++cc) wv[cc] = *(const LAS f32x4*)(w4s + cc * 64 + 4 * k4);
#pragma unroll
        for (int i = 0; i < 4; ++i) { const f32x4 hv = *((const f32x4*)(H3 + (size_t)(tid + 512 * i) * 64) + k4);
#pragma unroll
            for (int cc = 0; cc < 4; ++cc) a[i][cc] += (hv[0] * wv[cc][0] + hv[1] * wv[cc][1]) + (hv[2] * wv[cc][2] + hv[3] * wv[cc][3]); }
    }
#pragma unroll
    for (int i = 0; i < 4; ++i) {
        const int t = tid + 512 * i;
        const float win = expf(-((float)t / 2048.0f) * delta);
#pragma unroll
        for (int cc = 0; cc < 4; ++cc) a[i][cc] *= win;
        taps[i][0][0] = a[i][0]; taps[i][0][1] = a[i][1]; taps[i][1][0] = a[i][2]; taps[i][1][1] = a[i][3];
        ss0 += a[i][0] * a[i][0] + a[i][2] * a[i][2]; ss1 += a[i][1] * a[i][1] + a[i][3] * a[i][3];
    }
    ss0 = wave_sum(ss0); ss1 = wave_sum(ss1);
    if (lane == 0) { red[wave * 2] = ss0; red[wave * 2 + 1] = ss1; }
    __syncthreads();
    float t0 = 0.f, t1 = 0.f;
#pragma unroll
    for (int w = 0; w < 8; ++w) { t0 += red[w * 2]; t1 += red[w * 2 + 1]; }
    const float n0 = rsqrtf(t0 + EPS), n1 = rsqrtf(t1 + EPS);
#pragma unroll
    for (int i = 0; i < 4; ++i) { taps[i][0][0] *= n0; taps[i][1][0] *= n0; taps[i][0][1] *= n1; taps[i][1][1] *= n1; }
    __syncthreads();
}
__device__ __forceinline__ void hyena_taps_block(const Ctx& p, LAS unsigned char* lds) {
    const int tid = p.tid, lane = tid & 63, wave = __builtin_amdgcn_readfirstlane(tid >> 6), fr = lane & 15, fq = lane >> 4;
    LAS float* w4s = (LAS float*)lds;
    LAS float* red = (LAS float*)(lds + 4096);
    const float* w4 = p.in[I_FW4]; const float* H3 = (const float*)(p.ws + WS_H3); bf16_t* F = (bf16_t*)(p.ws + WS_FILT);
    for (int i = tid; i < 1024; i += NTHREADS) { const int col = i >> 6, k = i & 63, q = col >> 2, cc = col & 3; const int c = p.bid + p.nblk * q;
        w4s[i] = (c < DM) ? w4[(size_t)k * 4096 + (cc >> 1) * 2048 + (cc & 1) * 1024 + c] : 0.f; }
    __syncthreads();
    bf16x8 bfr[2];
#pragma unroll
    for (int ks = 0; ks < 2; ++ks) { const f32x4 b0 = *(const LAS f32x4*)(w4s + fr * 64 + 32 * ks + 8 * fq), b1 = *(const LAS f32x4*)(w4s + fr * 64 + 32 * ks + 8 * fq + 4);
        const u32x4 w = {cvtpk(b0[0], b0[1]), cvtpk(b0[2], b0[3]), cvtpk(b1[0], b1[1]), cvtpk(b1[2], b1[3])}; bfr[ks] = __builtin_bit_cast(bf16x8, w); }
    f32x4 acc[16];
#pragma unroll
    for (int g = 0; g < 4; ++g) {
        f32x4 hv[4][2][2];
#pragma unroll
        for (int j = 0; j < 4; ++j)
#pragma unroll
            for (int ks = 0; ks < 2; ++ks) { const float* hp = H3 + (size_t)(16 * (wave * 16 + 4 * g + j) + fr) * 64 + 32 * ks + 8 * fq; hv[j][ks][0] = *(const f32x4*)hp; hv[j][ks][1] = *(const f32x4*)(hp + 4); }
#pragma unroll
        for (int j = 0; j < 4; ++j) { f32x4 a = {0.f, 0.f, 0.f, 0.f};
#pragma unroll
            for (int ks = 0; ks < 2; ++ks) { const f32x4 h0 = hv[j][ks][0], h1 = hv[j][ks][1];
                const u32x4 w = {cvtpk(h0[0], h0[1]), cvtpk(h0[2], h0[3]), cvtpk(h1[0], h1[1]), cvtpk(h1[2], h1[3])};
                a = __builtin_amdgcn_mfma_f32_16x16x32_bf16(__builtin_bit_cast(bf16x8, w), bfr[ks], a, 0, 0, 0); }
            acc[4 * g + j] = a; }
        __builtin_amdgcn_sched_barrier(0);
    }
    const int q = fr >> 2, o = fr & 1, dir = (fr >> 1) & 1, c = p.bid + p.nblk * q;
    const float dmin = -3.0701134573253940f, dmax = -15.350567286626970f;
    const float delta = fabsf(dmin + (float)c * ((dmax - dmin) / 1023.0f));
    const float r1 = expf(-delta / 2048.0f);
    float ssq = 0.f;
#pragma unroll
    for (int tt = 0; tt < 16; ++tt) { const int tb = 16 * (16 * wave + tt) + 4 * fq; float win = expf(-((float)tb / 2048.0f) * delta);
#pragma unroll
        for (int e = 0; e < 4; ++e) { const float v = acc[tt][e] * win; acc[tt][e] = v; ssq += v * v; win *= r1; } }
    ssq += __shfl_xor(ssq, 16); ssq += __shfl_xor(ssq, 32); ssq += __shfl_xor(ssq, 2);
    if (fq == 0 && dir == 0) red[wave * 8 + q * 2 + o] = ssq;
    __syncthreads();
    float tot = 0.f;
#pragma unroll
    for (int w = 0; w < 8; ++w) tot += red[w * 8 + q * 2 + o];
    const float nrm = rsqrtf(tot + EPS);
    LAS bf16_t* st = (LAS bf16_t*)(lds + 8192) + (q * 2 + o) * 4096 + 2048;
#pragma unroll
    for (int tt = 0; tt < 16; ++tt)
#pragma unroll
        for (int e = 0; e < 4; ++e) { const int t = 16 * (16 * wave + tt) + 4 * fq + e; const bf16_t v = (bf16_t)f2bf(acc[tt][e] * nrm);
            if (dir == 0) st[-t] = v; else if (t > 0) st[t] = v; }
    __syncthreads();
#pragma unroll
    for (int j = 0; j < 8; ++j) { const int idx = tid + 512 * j, arr = idx >> 9, off = idx & 511; const int cq = p.bid + p.nblk * (arr >> 1);
        const u32x4 w = *(const LAS u32x4*)(lds + 8192 + arr * 8192 + off * 16);
        if (cq < DM) *(u32x4*)(F + (size_t)(cq * 2 + (arr & 1)) * 4096 + 8 * off) = w; }
    __builtin_amdgcn_fence(__ATOMIC_RELEASE, "workgroup");
    asm volatile("s_waitcnt vmcnt(0)" ::: "memory");
    __syncthreads();
    __builtin_amdgcn_fence(__ATOMIC_ACQUIRE, "workgroup");
}
__device__ __forceinline__ float sconv_at(const bf16_t* zr, int b, int n, float w0, float w1, float w2, float cb) {
    const bf16_t* q = zr + b * SEQ + n;
    const float l = n > 0 ? bf2f(q[-1]) : 0.f, m = bf2f(q[0]), r = n < SEQ - 1 ? bf2f(q[1]) : 0.f;
    return cb + w0 * l + w1 * m + w2 * r;
}

__device__ __forceinline__ void phase_nconv_filt(const Ctx& p, LAS unsigned char* lds) {
    bf16_t* F = (bf16_t*)(p.ws + WS_FILT);
    for (int c = p.bid; c < DM; c += p.nblk) {
        float taps[4][2][2];
        hyena_taps(p, c, lds, taps);
#pragma unroll
        for (int i = 0; i < 4; ++i) { const int t = p.tid + 512 * i;
#pragma unroll
            for (int o = 0; o < 2; ++o) { bf16_t* f = F + (size_t)(c * 2 + o) * 4096;
                f[2048 - t] = (bf16_t)f2bf(taps[i][0][o]);
                if (t > 0) f[2048 + t] = (bf16_t)f2bf(taps[i][1][o]); } }
    }
}
__device__ __forceinline__ void phase_nconv_u0(const Ctx& p) {
    const bf16_t* ZT = (const bf16_t*)(p.ws + WS_ZT); bf16_t* U0 = (bf16_t*)(p.ws + WS_U0T);
    const float* cw = p.in[I_HCW]; const float* cb = p.in[I_HCB];
    for (size_t idx = (size_t)p.bid * NTHREADS + p.tid; idx < (size_t)DM * ML; idx += (size_t)p.nblk * NTHREADS) {
        const int c = (int)(idx >> 15), bn = (int)(idx & 32767), b = bn >> 11, n = bn & 2047; const int ch = 2048 + c;
        U0[idx] = (bf16_t)f2bf(sconv_at(ZT + (size_t)ch * ML, b, n, cw[ch], cw[3072 + ch], cw[6144 + ch], cb[ch]));
    }
}
__device__ __forceinline__ void phase_nconv_pass(const Ctx& p, int o) {
    const bf16_t* ZT = (const bf16_t*)(p.ws + WS_ZT); const bf16_t* F = (const bf16_t*)(p.ws + WS_FILT);
    const bf16_t* U = (const bf16_t*)(p.ws + (o == 0 ? WS_U0T : WS_Y1T)); bf16_t* Y = (bf16_t*)(p.ws + (o == 0 ? WS_Y1T : WS_Y2T));
    const float* cw = p.in[I_HCW]; const float* cb = p.in[I_HCB]; const float* skip = p.in[I_HSKIP];
    for (size_t idx = (size_t)p.bid * NTHREADS + p.tid; idx < (size_t)DM * ML; idx += (size_t)p.nblk * NTHREADS) {
        const int c = (int)(idx >> 15), bn = (int)(idx & 32767), b = bn >> 11, n = bn & 2047;
        const bf16_t* u = U + (size_t)c * ML + b * SEQ; const bf16_t* f = F + (size_t)(c * 2 + o) * 4096 + 2048 - n;
        float acc = 0.f;
        for (int m = 0; m < SEQ; ++m) acc += bf2f(f[m]) * bf2f(u[m]);
        acc += skip[o * DM + c] * bf2f(u[n]);
        const int ch = o * 1024 + c;
        const float gate = sconv_at(ZT + (size_t)ch * ML, b, n, cw[ch], cw[3072 + ch], cw[6144 + ch], cb[ch]);
        Y[idx] = (bf16_t)f2bf(gate * acc);
    }
}

constexpr int CV_USTRIDE = 4112;
constexpr int CV_U = 0;
constexpr int CV_CP = 65792, CV_CPSTRIDE = 8208;
static_assert(CV_CP + 8 * CV_CPSTRIDE <= LDS_BYTES, "conv LDS map");

__device__ __forceinline__ void conv_build_copies(const int tid, LAS unsigned char* lds, const bf16_t* rev) {
    const u32x4 cur = *(const u32x4*)(rev + 8 * tid);
    u32x4 prv = {0u, 0u, 0u, 0u};
    if (tid > 0) prv = *(const u32x4*)(rev + 8 * tid - 8);
    const unsigned W[8] = {prv.x, prv.y, prv.z, prv.w, cur.x, cur.y, cur.z, cur.w};
#pragma unroll
    for (int rho = 0; rho < 8; ++rho) {
        unsigned o[4];
#pragma unroll
        for (int d = 0; d < 4; ++d) { const int e0 = 8 - rho + 2 * d;
            o[d] = (e0 & 1) ? __builtin_amdgcn_alignbit(W[(e0 >> 1) + 1], W[e0 >> 1], 16) : W[e0 >> 1]; }
        *(LAS u32x4*)(lds + CV_CP + rho * CV_CPSTRIDE + 16 * tid) = (u32x4){o[0], o[1], o[2], o[3]};
    }
}
__device__ __forceinline__ void sconv4(const bf16_t* zr, int n, float w0, float w1, float w2, float cb, float (&g)[4]) {
    const u32x2 w = *(const u32x2*)(zr + n);
    const float l = n > 0 ? bf2f(zr[n - 1]) : 0.f, r = n + 4 < SEQ ? bf2f(zr[n + 4]) : 0.f;
    const float x[6] = {l, bflo(w.x), bfhi(w.x), bflo(w.y), bfhi(w.y), r};
#pragma unroll
    for (int e = 0; e < 4; ++e) g[e] = cb + w0 * x[e] + w1 * x[e + 1] + w2 * x[e + 2];
}
__device__ __forceinline__ void conv_mma(const int tid, LAS unsigned char* lds, f32x4 (&acc)[16]) {
    const int lane = tid & 63, wave = __builtin_amdgcn_readfirstlane(tid >> 6);
#pragma unroll
    for (int i = 0; i < 16; ++i) acc[i] = (f32x4){0.f, 0.f, 0.f, 0.f};
    const LAS unsigned char* ab = lds + CV_CP + (lane & 7) * CV_CPSTRIDE + 2 * (2048 - 8 * ((lane & 15) >> 3) + 8 * (lane >> 4)) - 32 * (16 * wave);
    const LAS unsigned char* ub = lds + CV_U + (lane & 15) * CV_USTRIDE + 16 * (lane >> 4);
    bf16x8 w0, w1, w2, w3, w4, w5, w6, w7, w8, w9, w10, w11, w12, w13, w14, w15;
#define CV_LD(i) (*(const LAS bf16x8*)(ab - 32 * (i)))
    w0 = CV_LD(0); w1 = CV_LD(1); w2 = CV_LD(2); w3 = CV_LD(3); w4 = CV_LD(4); w5 = CV_LD(5); w6 = CV_LD(6); w7 = CV_LD(7);
    w8 = CV_LD(8); w9 = CV_LD(9); w10 = CV_LD(10); w11 = CV_LD(11); w12 = CV_LD(12); w13 = CV_LD(13); w14 = CV_LD(14); w15 = CV_LD(15);
#undef CV_LD
#define CV_MF(i, W) acc[i] = __builtin_amdgcn_mfma_f32_16x16x32_bf16(W, uf, acc[i], 0, 0, 0)
#define CV_STEP(jj, A0, A1, A2, A3, A4, A5, A6, A7, A8, A9, A10, A11, A12, A13, A14, A15) do { \
        const int j = J * 8 + (jj); \
        const int jn = (j + 1 < 64) ? (j + 1) : j; \
        const bf16x8 ufn = *(const LAS bf16x8*)(ub + 64 * jn); \
        const bf16x8 n0 = *(const LAS bf16x8*)(ab + 64 * jn), n1 = *(const LAS bf16x8*)(ab + 64 * jn - 32); \
        CV_MF(0, A0); CV_MF(1, A1); CV_MF(2, A2); CV_MF(3, A3); CV_MF(4, A4); CV_MF(5, A5); CV_MF(6, A6); CV_MF(7, A7); \
        CV_MF(8, A8); CV_MF(9, A9); CV_MF(10, A10); CV_MF(11, A11); CV_MF(12, A12); CV_MF(13, A13); CV_MF(14, A14); CV_MF(15, A15); \
        A14 = n0; A15 = n1; uf = ufn; } while (0)
    bf16x8 uf = *(const LAS bf16x8*)ub;
    for (int J = 0; J < 8; ++J) {
        CV_STEP(0, w0, w1, w2, w3, w4, w5, w6, w7, w8, w9, w10, w11, w12, w13, w14, w15);
        CV_STEP(1, w14, w15, w0, w1, w2, w3, w4, w5, w6, w7, w8, w9, w10, w11, w12, w13);
        CV_STEP(2, w12, w13, w14, w15, w0, w1, w2, w3, w4, w5, w6, w7, w8, w9, w10, w11);
        CV_STEP(3, w10, w11, w12, w13, w14, w15, w0, w1, w2, w3, w4, w5, w6, w7, w8, w9);
        CV_STEP(4, w8, w9, w10, w11, w12, w13, w14, w15, w0, w1, w2, w3, w4, w5, w6, w7);
        CV_STEP(5, w6, w7, w8, w9, w10, w11, w12, w13, w14, w15, w0, w1, w2, w3, w4, w5);
        CV_STEP(6, w4, w5, w6, w7, w8, w9, w10, w11, w12, w13, w14, w15, w0, w1, w2, w3);
        CV_STEP(7, w2, w3, w4, w5, w6, w7, w8, w9, w10, w11, w12, w13, w14, w15, w0, w1);
    }
#undef CV_STEP
#undef CV_MF
}
struct SconvRow { u32x4 w[8]; float prev, last; };
__device__ __forceinline__ void sconv_row_load(const int tid, const bf16_t* zrow, SconvRow& R) {
    const int b = tid >> 5, m0 = (tid & 31) * 64; const bf16_t* zr = zrow + b * SEQ;
#pragma unroll
    for (int k8 = 0; k8 < 8; ++k8) R.w[k8] = *(const u32x4*)(zr + m0 + 8 * k8);
    R.prev = m0 > 0 ? bf2f(zr[m0 - 1]) : 0.f;
    R.last = m0 + 64 < SEQ ? bf2f(zr[m0 + 64]) : 0.f;
}
template <int STRIDE, bool W16>
__device__ __forceinline__ void sconv_row_store(const int tid, const SconvRow& R, float w0, float w1, float w2, float bb, LAS unsigned char* dst) {
    const int b = tid >> 5, m0 = (tid & 31) * 64;
    float prev = R.prev;
#pragma unroll
    for (int k8 = 0; k8 < 8; ++k8) {
        const float nxt = k8 < 7 ? bflo(R.w[k8 < 7 ? k8 + 1 : 7].x) : R.last;
        const float x[10] = {prev, bflo(R.w[k8].x), bfhi(R.w[k8].x), bflo(R.w[k8].y), bfhi(R.w[k8].y), bflo(R.w[k8].z), bfhi(R.w[k8].z), bflo(R.w[k8].w), bfhi(R.w[k8].w), nxt};
        float y[8];
#pragma unroll
        for (int e = 0; e < 8; ++e) y[e] = bb + w0 * x[e] + w1 * x[e + 1] + w2 * x[e + 2];
        const u32x4 o = {cvtpk(y[0], y[1]), cvtpk(y[2], y[3]), cvtpk(y[4], y[5]), cvtpk(y[6], y[7])};
        LAS unsigned char* d = dst + b * STRIDE + 2 * (m0 + 8 * k8);
        if (W16) *(LAS u32x4*)d = o; else { *(LAS u32x2*)d = (u32x2){o.x, o.y}; *(LAS u32x2*)(d + 8) = (u32x2){o.z, o.w}; }
        prev = x[8];
    }
}
constexpr int CV_GSTRIDE = 4104;
static_assert(16 * CV_GSTRIDE <= 8 * CV_CPSTRIDE, "gate image fits the copies region");
__device__ __forceinline__ void phase_conv(const Ctx& p, LAS unsigned char* lds) {
    const bf16_t* ZT = (const bf16_t*)(p.ws + WS_ZT); bf16_t* Y2T = (bf16_t*)(p.ws + WS_Y2T); const bf16_t* F = (const bf16_t*)(p.ws + WS_FILT);
    const float* cw = p.in[I_HCW]; const float* cb = p.in[I_HCB]; const float* skip = p.in[I_HSKIP];
    hyena_taps_block(p, lds);
    for (int c = p.bid; c < DM; c += p.nblk) {
        int tid = p.tid; asm volatile("" : "+v"(tid));
        const int lane = tid & 63, wave = __builtin_amdgcn_readfirstlane(tid >> 6);
        const int b = lane & 15, nq = 256 * wave + 4 * (lane >> 4);
        LAS unsigned char* Ul = lds + CV_U; LAS unsigned char* Gl = lds + CV_CP;
        { const int ch = 2048 + c; SconvRow R; sconv_row_load(tid, ZT + (size_t)ch * ML, R); sconv_row_store<CV_USTRIDE, true>(tid, R, cw[ch], cw[3072 + ch], cw[6144 + ch], cb[ch], Ul); }
        conv_build_copies(tid, lds, F + (size_t)(c * 2 + 0) * 4096);
        __syncthreads();
        f32x4 acc[16];
#pragma unroll 1
        for (int o = 0; o < 2; ++o) {
            const int chg = o * 1024 + c; SconvRow RG; sconv_row_load(tid, ZT + (size_t)chg * ML, RG);
            conv_mma(tid, lds, acc);
            __syncthreads();
            sconv_row_store<CV_GSTRIDE, false>(tid, RG, cw[chg], cw[3072 + chg], cw[6144 + chg], cb[chg], Gl);
            __syncthreads();
            { const float sk = skip[o * DM + c];
#pragma unroll
              for (int i = 0; i < 16; ++i) { const int n = nq + 16 * i; LAS u32x2* up = (LAS u32x2*)(Ul + b * CV_USTRIDE + 2 * n);
                  const u32x2 uw = *up, gw = *(const LAS u32x2*)(Gl + b * CV_GSTRIDE + 2 * n);
                  const float u[4] = {bflo(uw.x), bfhi(uw.x), bflo(uw.y), bfhi(uw.y)}, g[4] = {bflo(gw.x), bfhi(gw.x), bflo(gw.y), bfhi(gw.y)};
                  float y[4];
#pragma unroll
                  for (int e = 0; e < 4; ++e) y[e] = g[e] * (acc[i][e] + sk * u[e]);
                  *up = (u32x2){cvtpk(y[0], y[1]), cvtpk(y[2], y[3])}; } }
            __syncthreads();
            if (o == 0) { conv_build_copies(tid, lds, F + (size_t)(c * 2 + 1) * 4096); __syncthreads(); }
        }
        { const int bb_ = tid >> 5, m0 = (tid & 31) * 64; bf16_t* dst = Y2T + (size_t)c * ML + bb_ * SEQ + m0;
#pragma unroll
          for (int k8 = 0; k8 < 8; ++k8) *(u32x4*)(dst + 8 * k8) = *(const LAS u32x4*)(Ul + bb_ * CV_USTRIDE + 2 * (m0 + 8 * k8)); }
        __syncthreads();
    }
}

__device__ __forceinline__ void phase_transpose(const Ctx& p, LAS unsigned char* lds) {
    const int tid = p.tid, lane = tid & 63, wave = __builtin_amdgcn_readfirstlane(tid >> 6);
    const bf16_t* src = (const bf16_t*)(p.ws + WS_Y2T); bf16_t* dst = (bf16_t*)(p.ws + WS_Y2);
    LAS bf16_t* tile = (LAS bf16_t*)(lds + wave * 16384);
    const int gw = p.bid * NWAVES + wave, ngw = p.nblk * NWAVES;
    for (int it = gw; it < (DM / 64) * (ML / 64); it += ngw) {
        const int cb = it & 15, tb = it >> 4, c0 = cb * 64, t0 = tb * 64;
#pragma unroll
        for (int i = 0; i < 8; ++i) { const int r = 8 * i + (lane >> 3), ch = lane & 7;
            const u32x4 w = *(const u32x4*)(src + (size_t)(c0 + r) * ML + t0 + 8 * ch);
            LAS unsigned* d = (LAS unsigned*)(tile + r * 66 + 8 * ch); d[0] = w.x; d[1] = w.y; d[2] = w.z; d[3] = w.w; }
        asm volatile("s_waitcnt lgkmcnt(0)" ::: "memory");
#pragma unroll
        for (int i = 0; i < 8; ++i) { const int t = 8 * i + (lane >> 3), ch = lane & 7; unsigned short e[8];
#pragma unroll
            for (int k = 0; k < 8; ++k) e[k] = tile[(8 * ch + k) * 66 + t];
            u32x4 w; w.x = e[0] | ((unsigned)e[1] << 16); w.y = e[2] | ((unsigned)e[3] << 16); w.z = e[4] | ((unsigned)e[5] << 16); w.w = e[6] | ((unsigned)e[7] << 16);
            *(u32x4*)(dst + (size_t)(t0 + t) * DM + c0 + 8 * ch) = w; }
        asm volatile("s_waitcnt lgkmcnt(0)" ::: "memory");
    }
}

#define XB_TMO      128
#define XB_XCNT(j)  (256  + 64 * (j))
#define XB_XSUB(j)  (1280 + 64 * (j))
#define XB_XGEN(j)  (2304 + 64 * (j))
#define XB_TOP      3328
#define XB_TOPGEN   3392
#define XCD_BAR_WORDS 3456
#define XB_SPIN_CAP (1u << 18)
__device__ __forceinline__ unsigned xb_ld(unsigned* p)              { return __hip_atomic_load(p, __ATOMIC_RELAXED, __HIP_MEMORY_SCOPE_AGENT); }
__device__ __forceinline__ unsigned xb_add(unsigned* p, unsigned v) { return __hip_atomic_fetch_add(p, v, __ATOMIC_RELAXED, __HIP_MEMORY_SCOPE_AGENT); }
__device__ __forceinline__ unsigned xb_xcc_id() { return (unsigned)__builtin_amdgcn_s_getreg((3 << 11) | 20) & 0xFu; }
#define XB_SPIN(cond, bar) do { unsigned _sp = 0; while (cond) { __builtin_amdgcn_s_sleep(1); \
    if ((++_sp & 255u) == 0u) { if (xb_ld(&(bar)[XB_TMO])) break; if (_sp > XB_SPIN_CAP) { atomicAdd(&(bar)[XB_TMO], 1u); break; } } } } while (0)
struct XcdBarrier { unsigned* bar; unsigned x; volatile LAS unsigned* st; };
__device__ __forceinline__ XcdBarrier xcd_barrier_post(unsigned* bar, volatile LAS unsigned* st) {
    XcdBarrier b; b.bar = bar; b.x = xb_xcc_id(); b.st = st;
    if (threadIdx.x == 0) (void)xb_add(&bar[XB_XCNT(b.x)], 1u);
    return b;
}
__device__ __forceinline__ void xcd_barrier_complete(unsigned* bar, unsigned x, unsigned& nloc, unsigned& nx) {
    const unsigned G = gridDim.x * gridDim.y * gridDim.z;
    unsigned sum, cnt, mine, sp = 0u;
    for (;;) {
        sum = 0u; cnt = 0u; mine = 0u;
#pragma unroll
        for (unsigned j = 0; j < 16; ++j) { const unsigned c = xb_ld(&bar[XB_XCNT(j)]); sum += c; cnt += (c > 0u) ? 1u : 0u; mine = (j == x) ? c : mine; }
        if (sum == G) break;
        __builtin_amdgcn_s_sleep(1);
        if ((++sp & 255u) == 0u) { if (xb_ld(&bar[XB_TMO])) break; if (sp > XB_SPIN_CAP) { atomicAdd(&bar[XB_TMO], 1u); break; } }
    }
    nloc = mine > 0u ? mine : 1u; nx = cnt > 0u ? cnt : 1u;
}
__device__ __forceinline__ void xcd_barrier(const XcdBarrier& b) {
    asm volatile("s_waitcnt vmcnt(0)" ::: "memory");
    __syncthreads();
    if (threadIdx.x == 0) {
        unsigned* bar = b.bar;
        __builtin_amdgcn_s_waitcnt(0);
        unsigned nloc = b.st[0], nx = b.st[1];
        if (nloc == 0u) { xcd_barrier_complete(bar, b.x, nloc, nx); b.st[0] = nloc; b.st[1] = nx; }
        const unsigned old = xb_add(&bar[XB_XSUB(b.x)], 1u);
        const unsigned gen = old / nloc;
        if (old + 1u == (gen + 1u) * nloc) {
            __builtin_amdgcn_fence(__ATOMIC_RELEASE, "agent");
            asm volatile("s_waitcnt vmcnt(0)" ::: "memory");
            const unsigned og = xb_add(&bar[XB_TOP], 1u);
            const unsigned tg = og / nx;
            if (og + 1u == (tg + 1u) * nx) xb_add(&bar[XB_TOPGEN], 1u);
            else XB_SPIN(xb_ld(&bar[XB_TOPGEN]) == tg, bar);
            __builtin_amdgcn_fence(__ATOMIC_ACQUIRE, "agent");
            xb_add(&bar[XB_XGEN(b.x)], 1u);
            asm volatile("s_waitcnt vmcnt(0)" ::: "memory");
        } else {
            XB_SPIN(xb_ld(&bar[XB_XGEN(b.x)]) == gen, bar);
            __builtin_amdgcn_fence(__ATOMIC_ACQUIRE, "agent");
            asm volatile("s_waitcnt vmcnt(0)" ::: "memory");
        }
    }
    __syncthreads();
}
constexpr int LDS_CTL_OFF = LDS_BYTES - 64;
constexpr size_t CTL_BAR_OFF = 16384;
constexpr size_t CTL_STAMP_OFF = 65536;
constexpr size_t CTL_ZERO_BYTES = 131072;

enum { P_PRO = 0, P_MOD1_0, P_GEMM_IN, P_ZPOST, P_GEMM_QKV, P_ATTN, P_GEMM_OUT0, P_MOD2_0, P_MLP_UP0, P_MLP_DN0,
       P_MOD1_1, P_GEMM_HIN, P_CONV, P_TRANS, P_GEMM_OUT1, P_MOD2_1, P_MLP_UP1, P_MLP_DN1, P_FINAL,
       P_NC_FILT, P_NC_U0, P_NC_A, P_NC_B, P_NA_Q, P_NONE };
__host__ __device__ __forceinline__ int prog(int i) {
    int k = 0;
#define PRG(x) do { if (i == k) return (x); ++k; } while (0)
    PRG(P_PRO); PRG(P_MOD1_0); PRG(P_GEMM_IN); PRG(P_ZPOST); PRG(P_GEMM_QKV);
#if NAIVE_ATTN
    PRG(P_NA_Q);
#endif
    PRG(P_ATTN); PRG(P_GEMM_OUT0); PRG(P_MLP_UP0); PRG(P_MLP_DN0); PRG(P_GEMM_HIN);
#if NAIVE_CONV
    PRG(P_NC_FILT); PRG(P_NC_U0); PRG(P_NC_A); PRG(P_NC_B);
#else
    PRG(P_CONV);
#endif
    PRG(P_TRANS); PRG(P_GEMM_OUT1); PRG(P_MLP_UP1); PRG(P_MLP_DN1); PRG(P_FINAL);
#undef PRG
    return P_NONE;
}
constexpr int N_PROG = 16 + (NAIVE_ATTN ? 1 : 0) + (NAIVE_CONV ? 3 : 0);

__device__ __forceinline__ bool gemm_job(const Ctx& p, int ph, int jj, GemmJob& J) {
    unsigned char* ws = p.ws;
    const float* MODL = (const float*)(ws + WS_MODL);
    size_t a = 0, b = 0, o = 0, sq = 0, shw = 0; int M = 0, N = 0, K = 0, kind = 0, ldc = 0, shw_ld = 0; bool has_o = true, has_sq = false;
    const float* base = nullptr; const float* gate = nullptr; const float* ng = nullptr; const float* nsc = nullptr;
    if (jj == 0) {
        if (ph == P_GEMM_IN) { a = WS_HL; b = WS_WIN; o = WS_Z; M = MT; N = ZW; K = DM; ldc = ZW; }
        else if (ph == P_GEMM_QKV) { a = WS_CQN; b = WS_WQB; o = WS_QM; M = ML; N = 768; K = 384; ldc = 768; }
        else if (ph == P_GEMM_OUT0) { a = WS_O; b = WS_WOUT; M = ML; N = DM; K = DM; kind = 2; gate = MODL + 2 * DM;
            o = WS_HL; ng = p.in[I_N2G]; nsc = MODL + 4 * DM; sq = WS_SQA; has_sq = true; }
        else if (ph == P_MLP_UP0) { a = WS_HL; b = WS_W1_0; o = WS_HID; M = ML; N = 4096; K = DM; kind = 1; ldc = 4096; sq = WS_SQA; has_sq = true; shw = WS_SHW_UP0; shw_ld = 4096; }
        else if (ph == P_MLP_DN0) { a = WS_HID; b = WS_W2_0; M = ML; N = DM; K = 4096; kind = 2; gate = MODL + 5 * DM;
            o = WS_HL; ng = p.in[I_N1G] + DM; nsc = MODL + (size_t)16 * NMOD + DM; sq = WS_SQB; has_sq = true; }
        else if (ph == P_GEMM_HIN) { a = WS_HIN; b = WS_HL; o = WS_ZT; M = 3 * DM; N = ML; K = DM; ldc = ML; kind = 3; sq = WS_SQB; has_sq = true; shw = WS_SHW_HIN; shw_ld = 3 * DM; }
        else if (ph == P_GEMM_OUT1) { a = WS_Y2; b = WS_HOUT; M = ML; N = DM; K = DM; kind = 2; gate = MODL + (size_t)16 * NMOD + 2 * DM;
            o = WS_HL; ng = p.in[I_N2G] + DM; nsc = MODL + (size_t)16 * NMOD + 4 * DM; sq = WS_SQC; has_sq = true; }
        else if (ph == P_MLP_UP1) { a = WS_HL; b = WS_W1_1; o = WS_HID; M = ML; N = 4096; K = DM; kind = 1; ldc = 4096; sq = WS_SQC; has_sq = true; shw = WS_SHW_UP1; shw_ld = 4096; }
        else if (ph == P_MLP_DN1) { a = WS_HID; b = WS_W2_1; M = ML; N = DM; K = 4096; kind = 2; gate = MODL + (size_t)16 * NMOD + 5 * DM; has_o = false; sq = WS_SQA; has_sq = true; ng = p.in[I_FINALG]; nsc = MODL; }
        else return false;
    } else {
        if (ph == P_GEMM_QKV) { a = WS_CKVN; b = WS_WKVB; o = WS_KV; M = MT; N = 1024; K = 256; ldc = 1024; }
        else return false;
    }
    J.A = (const bf16_t*)(ws + a); J.Bt = (const bf16_t*)(ws + b); J.M = M; J.N = N; J.K = K;
    J.E.kind = kind; J.E.O = has_o ? (bf16_t*)(ws + o) : nullptr; J.E.ldc = ldc; J.E.base = base; J.E.xres = (bf16_t*)(ws + WS_XW); J.E.gate = gate; J.E.ng = ng; J.E.nsc = nsc;
    J.E.sqp = has_sq ? (float*)(ws + sq) : nullptr; J.E.shw = (const float*)(ws + shw); J.E.shw_ld = shw_ld;
    return true;
}

__global__ void __launch_bounds__(NTHREADS, 2) fwd(Params kp) {
    extern __shared__ __attribute__((aligned(16))) unsigned char lds_raw[];
    LAS unsigned char* lds = (LAS unsigned char*)lds_raw;
    const int wave0 = __builtin_amdgcn_readfirstlane((int)threadIdx.x >> 6);
#if !CG_SYNC
    if (threadIdx.x < 16) ((volatile LAS unsigned*)(lds + LDS_CTL_OFF))[threadIdx.x] = 0u;
    __syncthreads();
    const XcdBarrier xbar = xcd_barrier_post((unsigned*)(kp.ws + WS_CTL + CTL_BAR_OFF), (volatile LAS unsigned*)(lds + LDS_CTL_OFF));
#endif
#if PROBE_A >= 0
#define STAMP(k) do { if (blockIdx.x == 0 && threadIdx.x == 0) ((unsigned long long*)(kp.ws + WS_CTL + CTL_STAMP_OFF))[(k)] = __builtin_amdgcn_s_memrealtime(); } while (0)
#else
#define STAMP(k) do { } while (0)
#endif
    for (int pi = kp.ph_lo; pi < kp.ph_hi; ++pi) {
        if (pi > kp.ph_lo) {
            STAMP(2 * pi - 1);
#if CG_SYNC
            cg::this_grid().sync();
#else
            xcd_barrier(xbar);
#endif
        }
        STAMP(2 * pi);
        const int ph = prog(pi);
        for (int rep = 0; rep < ((pi == REPEAT_PI) ? 2 : 1); ++rep) {
        if (rep) {
#if CG_SYNC
            cg::this_grid().sync();
#else
            xcd_barrier(xbar);
#endif
        }
#define MAKE_CTX(p) Ctx p; { int z_ = 0, lane_; asm volatile("v_mbcnt_lo_u32_b32 %0, -1, 0\n\tv_mbcnt_hi_u32_b32 %0, -1, %0" : "=v"(lane_)); asm volatile("" : "+s"(z_)); \
          p.in = (const CAS cfptr_t*)kp.in + z_; p.out = kp.out + z_; p.ws = kp.ws + z_; p.tid = ((wave0 + z_) << 6) + lane_; p.bid = (int)blockIdx.x + z_; p.nblk = (int)gridDim.x + z_; }
#ifndef NO_GEMM
        { MAKE_CTX(pg); for (int jj = 0; jj < 2; ++jj) { GemmJob J; if (!gemm_job(pg, ph, jj, J)) break; run_gemm(pg, lds, J); } }
#endif
        MAKE_CTX(p);
        if (ph == P_PRO && PHON(P_PRO)) phase_prologue(p, lds, true, false);
        else if (ph == P_MOD1_0 && PHON(P_MOD1_0)) { phase_prologue(p, lds, false, true); phase_modulate(p, p.in[I_X], 0, p.in[I_N1G], 0, DM, true); }
        else if (ph == P_ZPOST && PHON(P_ZPOST)) { phase_zpost(p, lds); phase_shw(p); }
        else if (ph == P_ATTN && PHON(P_ATTN)) {
#if NAIVE_ATTN
            phase_attn_naive(p);
#else
            phase_attn(p, lds);
#endif
        }
        else if (ph == P_NA_Q && PHON(P_NA_Q)) phase_naive_qrope(p);
        else if (ph == P_CONV && PHON(P_CONV)) phase_conv(p, lds);
        else if (ph == P_NC_FILT && PHON(P_NC_FILT)) phase_nconv_filt(p, lds);
        else if (ph == P_NC_U0 && PHON(P_NC_U0)) phase_nconv_u0(p);
        else if (ph == P_NC_A && PHON(P_NC_A)) phase_nconv_pass(p, 0);
        else if (ph == P_NC_B && PHON(P_NC_B)) phase_nconv_pass(p, 1);
        else if (ph == P_TRANS && PHON(P_TRANS)) phase_transpose(p, lds);
        else if (ph == P_FINAL && PHON(P_FINAL)) phase_final(p);
        }
    }
#if PROBE_A >= 0
    STAMP(2 * kp.ph_hi - 1);
    __syncthreads();
    if (blockIdx.x == 0) {
        asm volatile("s_waitcnt vmcnt(0)" ::: "memory");
        const unsigned long long* st = (const unsigned long long*)(kp.ws + WS_CTL + CTL_STAMP_OFF);
        const float dta = (float)(st[PROBE_A_TO] - st[PROBE_A]) * 0.01f, dtb = (float)(st[PROBE_B_TO] - st[PROBE_B]) * 0.01f;
        for (int i = threadIdx.x + 1024; i < 1024 + 100000; i += NTHREADS) kp.out[i] += 0.001f * dtb;
        if (threadIdx.x == 0) kp.out[0] += 0.004f * dta;
    }
#endif
}

extern "C" void kernel_launch(void* const* d_in, const int* in_sizes, int n_in, void* d_out, int out_size, void* d_ws, size_t ws_size, hipStream_t stream) {
    static int ok = 0;
    if (ok == 0) {
        ok = 1;
        if (n_in != 32 || in_sizes[0] != ML * DM || out_size != ML * DM || ws_size < WS_END) { fprintf(stderr, "kernel_launch: unexpected shapes (n_in %d, in0 %d, out %d, ws %zu)\n", n_in, n_in > 0 ? in_sizes[0] : -1, out_size, ws_size); ok = -1; }
        int dev = 0, cus = 0;
        if (hipGetDevice(&dev) != hipSuccess || hipDeviceGetAttribute(&cus, hipDeviceAttributeMultiprocessorCount, dev) != hipSuccess || cus < GRID) { fprintf(stderr, "kernel_launch: needs %d CUs, device reports %d\n", GRID, cus); ok = -1; }
        if (hipFuncSetAttribute((const void*)fwd, hipFuncAttributeMaxDynamicSharedMemorySize, LDS_BYTES) != hipSuccess) { fprintf(stderr, "kernel_launch: hipFuncSetAttribute failed\n"); ok = -1; }
        int per_cu = 0;
        if (hipOccupancyMaxActiveBlocksPerMultiprocessor(&per_cu, (const void*)fwd, NTHREADS, LDS_BYTES) != hipSuccess || per_cu < 1) { fprintf(stderr, "kernel_launch: occupancy query says %d blocks per CU\n", per_cu); }
        (void)hipGetLastError();
    }
    if (ok < 0) return;
    Params p{};
    for (int i = 0; i < 32; ++i) p.in[i] = (const float*)d_in[i];
    p.out = (float*)d_out; p.ws = (unsigned char*)d_ws;
#if !CG_SYNC || PROBE_A >= 0
    if (hipMemsetAsync((char*)d_ws + WS_CTL, 0, CTL_ZERO_BYTES, stream) != hipSuccess) { fprintf(stderr, "kernel_launch: memset of the control words failed\n"); return; }
#endif
#if ONE_LAUNCH
    p.ph_lo = 0; p.ph_hi = N_PROG;
    void* args[] = {&p};
    hipError_t e = hipLaunchCooperativeKernel((const void*)fwd, dim3(GRID), dim3(NTHREADS), args, LDS_BYTES, stream);
    if (e != hipSuccess) fprintf(stderr, "kernel_launch: cooperative launch failed: %s\n", hipGetErrorString(e));
#else
    for (int i = 0; i < N_PROG; ++i) { p.ph_lo = i; p.ph_hi = i + 1; hipLaunchKernelGGL(fwd, dim3(GRID), dim3(NTHREADS), LDS_BYTES, stream, p); }
#endif
}
```

```cpp
#include <hip/hip_runtime.h>
#include <hip/hip_cooperative_groups.h>
#include <cstdio>
#include <cstdint>
namespace cg = cooperative_groups;

#ifndef ONE_LAUNCH
#define ONE_LAUNCH 1
#endif
#ifndef CG_SYNC
#define CG_SYNC 0
#endif
#ifndef REPEAT_PI
#define REPEAT_PI -1
#endif
#ifndef PROBE_A
#define PROBE_A -1
#endif
#ifndef ATTN_V1
#define ATTN_V1 0
#endif
#ifndef ZPOST_REF
#define ZPOST_REF 0
#endif
#ifndef SIMPLE_GEMM
#define SIMPLE_GEMM 0
#endif
#ifndef NAIVE_ATTN
#define NAIVE_ATTN 0
#endif
#ifndef NAIVE_CONV
#define NAIVE_CONV 0
#endif

#ifndef PHASE_MASK
#define PHASE_MASK 0xFFFFFFFFu
#endif
#define PHON(x) (((PHASE_MASK) >> (x)) & 1u)
#define LAS __attribute__((address_space(3)))
typedef unsigned short bf16_t;
typedef short bf16x8 __attribute__((ext_vector_type(8)));
typedef short s16x4 __attribute__((ext_vector_type(4)));
typedef float f32x2 __attribute__((ext_vector_type(2)));
typedef float f32x4 __attribute__((ext_vector_type(4)));
typedef float f32x16 __attribute__((ext_vector_type(16)));
typedef unsigned u32x2 __attribute__((ext_vector_type(2)));
typedef unsigned u32x4 __attribute__((ext_vector_type(4)));
typedef __bf16 bf16x2_t __attribute__((ext_vector_type(2)));

constexpr int NB = 16, SEQ = 2048, DM = 1024, CTXL = 256, TKEYS = CTXL + SEQ;
constexpr int ML = NB * SEQ;
constexpr int MC = NB * CTXL;
constexpr int MT = ML + MC;
constexpr int NMOD = 6 * DM;
constexpr int ZW = 1536;
constexpr float EPS = 1e-6f;
constexpr int NWAVES = 8, NTHREADS = 512, GRID = 256, NGW = GRID * NWAVES;
constexpr int LDS_BYTES = 155648;
constexpr int ZC_CQ = 0, ZC_CKV = 384, ZC_KR = 640, ZC_GQ = 672, ZC_GK = 1184, ZC_GV = 1312;
constexpr float LOG2E = 1.4426950408889634f;
constexpr float QSCALE_MLA = 0.10206207261596577f * LOG2E;
constexpr float QSCALE_GQA = 0.125f * LOG2E;

constexpr size_t MiB = 1ull << 20;
constexpr size_t WS_CTL = 0;
constexpr size_t WS_MODL = 1 * MiB;
constexpr size_t WS_MODC = 1 * MiB + 786432;
constexpr size_t WS_H3 = 2 * MiB;
constexpr size_t WS_SHW_UP0 = 3 * MiB, WS_SHW_HIN = 3 * MiB + 262144, WS_SHW_UP1 = 3 * MiB + 262144 + 196608;
constexpr size_t WS_SQA = 244 * MiB, WS_SQB = 246 * MiB, WS_SQC = 248 * MiB;
constexpr size_t WS_WIN = 4 * MiB, WS_WQB = 7 * MiB, WS_WKVB = 8 * MiB, WS_WOUT = 9 * MiB;
constexpr size_t WS_W1_0 = 11 * MiB, WS_W2_0 = 19 * MiB, WS_W1_1 = 27 * MiB, WS_W2_1 = 35 * MiB, WS_HIN = 43 * MiB, WS_HOUT = 49 * MiB;
constexpr size_t WS_XW = 52 * MiB;
constexpr size_t WS_HL = 180 * MiB;
constexpr size_t WS_Z = 252 * MiB, WS_CQN = 360 * MiB, WS_CKVN = 384 * MiB, WS_KROPE = 402 * MiB, WS_QG = 405 * MiB, WS_KG = 437 * MiB, WS_VG = 446 * MiB, WS_QM = 455 * MiB;
constexpr size_t WS_KV = WS_HL, WS_O = 252 * MiB;
constexpr size_t WS_HID = 252 * MiB;
constexpr size_t WS_ZT = 252 * MiB, WS_Y2T = WS_HL, WS_Y2 = 252 * MiB;
constexpr size_t WS_QMR = 316 * MiB;
constexpr size_t WS_FILT = 4 * MiB, WS_U0T = 444 * MiB, WS_Y1T = 380 * MiB;
constexpr size_t WS_END = 508 * MiB;

struct Params { const float* in[32]; float* out; unsigned char* ws; int ph_lo, ph_hi; };
#define CAS __attribute__((address_space(4)))
typedef const float* cfptr_t;
struct Ctx { const CAS cfptr_t* in; float* out; unsigned char* ws; int tid, bid, nblk; };

enum { I_X = 0, I_C, I_CTX, I_CCTX, I_WMOD, I_BMOD, I_N1G, I_N2G, I_W1, I_W2, I_AWIN, I_AQAG, I_AWQB, I_AKVAG, I_AWKVB, I_AQNG, I_AKNG, I_AWOUT,
       I_HWIN, I_HCW, I_HCB, I_FW1, I_FB1, I_FW2, I_FB2, I_FW3, I_FB3, I_FFREQ, I_FW4, I_HSKIP, I_HWOUT, I_FINALG };

__device__ __forceinline__ unsigned f2bf(float f) { unsigned u = __float_as_uint(f); return (u + 0x7fffu + ((u >> 16) & 1u)) >> 16; }
__device__ __forceinline__ float bf2f(unsigned h) { return __uint_as_float(h << 16); }
__device__ __forceinline__ unsigned cvtpk(float lo, float hi) { f32x2 v = {lo, hi}; bf16x2_t b = __builtin_convertvector(v, bf16x2_t); return __builtin_bit_cast(unsigned, b); }
__device__ __forceinline__ float wave_sum(float v) {
#pragma unroll
    for (int o = 1; o < 64; o <<= 1) v += __shfl_xor(v, o);
    return v;
}
__device__ __forceinline__ float fsin(float x) { return __builtin_amdgcn_sinf(__builtin_amdgcn_fractf(x * 0.15915494309189535f)); }
__device__ __forceinline__ float fcos(float x) { return __builtin_amdgcn_cosf(__builtin_amdgcn_fractf(x * 0.15915494309189535f)); }
__device__ __forceinline__ float inv_theta(float x) { return exp2f(-x * 13.287712379549449f); }
__device__ __forceinline__ float dpp_xor1(float v) { return __builtin_bit_cast(float, __builtin_amdgcn_update_dpp(0, __builtin_bit_cast(int, v), 0xB1, 0xF, 0xF, true)); }
__device__ __forceinline__ float dpp_xor2(float v) { return __builtin_bit_cast(float, __builtin_amdgcn_update_dpp(0, __builtin_bit_cast(int, v), 0x4E, 0xF, 0xF, true)); }
__device__ __forceinline__ float dpp_hmirror(float v) { return __builtin_bit_cast(float, __builtin_amdgcn_update_dpp(0, __builtin_bit_cast(int, v), 0x141, 0xF, 0xF, true)); }
__device__ __forceinline__ float sum8(float v) { v += dpp_xor1(v); v += dpp_xor2(v); v += dpp_hmirror(v); return v; }
__device__ __forceinline__ float bflo(unsigned w) { return __uint_as_float(w << 16); }
__device__ __forceinline__ float bfhi(unsigned w) { return __uint_as_float(w & 0xffff0000u); }

namespace pg8 {
constexpr int BM = 256, BK = 64, HALF = 128, HTB = HALF * BK * 2, STAGE_BYTES = 8 * HTB, NXCD = 8, WGM = 8;
__host__ __device__ __forceinline__ int lds_byte(int r, int c) { const int st = (r >> 4) * 2 + (c >> 5), rr = r & 15, cc = c & 31, ob = rr * 64 + cc * 2; return st * 1024 + (ob ^ (((ob >> 9) & 1) << 5)); }
__host__ __device__ __forceinline__ void stage_rc(int b, int& R, int& C) { const int st = b / 1024, sb = b % 1024, swz = sb ^ (((sb >> 9) & 1) << 5); R = (st >> 1) * 16 + swz / 64; C = (st & 1) * 32 + (swz % 64) / 2; }
__host__ __device__ __forceinline__ int perm32(int rho) { const int n = rho >> 4, i = rho & 15; return 8 * (i >> 2) + 4 * n + (i & 3); }

struct Unit { int pm, pn; };
struct Gemm { const bf16_t* A; const bf16_t* Bt; int M, N, K; };

struct StaticOrder {
    int nM, nN, nwg, G, c;
    __host__ __device__ void init(int M, int N, int G_, int c_) { nM = M / BM; nN = N / BM; nwg = nM * nN; G = G_; c = c_; }
    __host__ __device__ bool next(int i, Unit& u) const {
        const long L = (long)i * G + c; if (L >= nwg) return false;
        int wgid = (int)L; { const int q = nwg / NXCD, r = nwg % NXCD, xcd = wgid % NXCD, off = wgid / NXCD; wgid = (xcd < r ? xcd * (q + 1) : r * (q + 1) + (xcd - r) * q) + off; }
        const int nig = WGM * nN, gid = wgid / nig, fm = gid * WGM, gsz = (nM - fm) < WGM ? (nM - fm) : WGM;
        u.pm = fm + ((wgid % nig) % gsz); u.pn = (wgid % nig) / gsz; return true;
    }
    __device__ __forceinline__ void a_ready(const Unit&) const {}
    __device__ __forceinline__ void done(const Unit&) const {}
};

struct EpiAny {
    static constexpr bool AFTER_DRAIN = false;
    int kind; bf16_t* O; int ldc; const float* base; bf16_t* xres; const float* gate; const float* ng; const float* nsc; float* sqp; const float* shw; int shw_ld; LAS float* tab;
    __device__ __forceinline__ bool perm() const { return true; }
    __device__ __forceinline__ void operator()(const f32x4 (&acc)[2][2][4][2], const Unit& u, int ui, int wr, int wc, int fr, int fq) const {
        const int rt = wr * 64 + fr, ct = wc * 32 + 8 * fq;
        const int row0 = u.pm * BM + rt, col0 = u.pn * BM + ct;
        if (kind != 2) {
            const LAS float* T0 = tab + ui * 512; const LAS float* T1 = T0 + 256;
            f32x4 cs[2][2], ca[2][2];
#pragma unroll
            for (int bj = 0; bj < 2; ++bj)
#pragma unroll
                for (int h = 0; h < 2; ++h) { cs[bj][h] = (f32x4){1.f, 1.f, 1.f, 1.f}; ca[bj][h] = (f32x4){0.f, 0.f, 0.f, 0.f}; }
            if (kind == 1) {
#pragma unroll
                for (int bj = 0; bj < 2; ++bj) { ca[bj][0] = *(const LAS f32x4*)(T1 + ct + bj * HALF); ca[bj][1] = *(const LAS f32x4*)(T1 + ct + bj * HALF + 4); } }
            if (kind == 3) {
#pragma unroll
                for (int bj = 0; bj < 2; ++bj) { cs[bj][0] = *(const LAS f32x4*)(T0 + ct + bj * HALF); cs[bj][1] = *(const LAS f32x4*)(T0 + ct + bj * HALF + 4); } }
#pragma unroll
            for (int ai = 0; ai < 2; ++ai)
#pragma unroll
                for (int m = 0; m < 4; ++m) { const int rr = rt + ai * HALF + m * 16; bf16_t* rowp = O + (size_t)(u.pm * BM + rr) * ldc + col0;
                    float rs = 1.f, ra = 0.f;
                    if (kind == 1) rs = T0[rr];
                    if (kind == 3) ra = T1[rr];
#pragma unroll
                    for (int bj = 0; bj < 2; ++bj) { f32x4 v0 = acc[ai][bj][m][0], v1 = acc[ai][bj][m][1];
                        if (kind == 1) { v0 = v0 * rs + ca[bj][0]; v1 = v1 * rs + ca[bj][1];
#pragma unroll
                            for (int e = 0; e < 4; ++e) { const float a = fmaxf(v0[e], 0.f), b = fmaxf(v1[e], 0.f); v0[e] = a * a; v1[e] = b * b; } }
                        if (kind == 3) { v0 = v0 * cs[bj][0] + ra; v1 = v1 * cs[bj][1] + ra; }
                        u32x4 w; w.x = cvtpk(v0[0], v0[1]); w.y = cvtpk(v0[2], v0[3]); w.z = cvtpk(v1[0], v1[1]); w.w = cvtpk(v1[2], v1[3]);
                        *(u32x4*)(rowp + bj * HALF) = w; } }
        } else {
            const bool hasO = O != nullptr;
            const LAS float* T0 = tab + ui * 512; const LAS float* T1 = T0 + 256;
#pragma unroll
            for (int ai = 0; ai < 2; ++ai) {
                u32x4 xb[4][2];
#pragma unroll
                for (int m = 0; m < 4; ++m)
#pragma unroll
                    for (int bj = 0; bj < 2; ++bj) xb[m][bj] = *(const u32x4*)(xres + (size_t)(row0 + ai * HALF + m * 16) * DM + col0 + bj * HALF);
                __builtin_amdgcn_sched_barrier(0);
#pragma unroll
                for (int m = 0; m < 4; ++m) { const size_t off = (size_t)(row0 + ai * HALF + m * 16) * DM + col0; float sq = 0.f;
#pragma unroll
                    for (int bj = 0; bj < 2; ++bj) {
                        const u32x4 xw = xb[m][bj];
                        const f32x4 x0 = {bflo(xw.x), bfhi(xw.x), bflo(xw.y), bfhi(xw.y)}, x1 = {bflo(xw.z), bfhi(xw.z), bflo(xw.w), bfhi(xw.w)};
                        const f32x4 gv0 = *(const LAS f32x4*)(T0 + ct + bj * HALF), gv1 = *(const LAS f32x4*)(T0 + ct + bj * HALF + 4);
                        const f32x4 y0 = x0 + gv0 * acc[ai][bj][m][0], y1 = x1 + gv1 * acc[ai][bj][m][1];
                        { u32x4 w; w.x = cvtpk(y0[0], y0[1]); w.y = cvtpk(y0[2], y0[3]); w.z = cvtpk(y1[0], y1[1]); w.w = cvtpk(y1[2], y1[3]); *(u32x4*)(xres + off + bj * HALF) = w; }
                        sq += ((y0[0] * y0[0] + y0[1] * y0[1]) + (y0[2] * y0[2] + y0[3] * y0[3])) + ((y1[0] * y1[0] + y1[1] * y1[1]) + (y1[2] * y1[2] + y1[3] * y1[3]));
                        if (hasO) { const f32x4 gs0 = *(const LAS f32x4*)(T1 + ct + bj * HALF), gs1 = *(const LAS f32x4*)(T1 + ct + bj * HALF + 4); const f32x4 a0 = y0 * gs0, a1 = y1 * gs1; u32x4 w; w.x = cvtpk(a0[0], a0[1]); w.y = cvtpk(a0[2], a0[3]); w.z = cvtpk(a1[0], a1[1]); w.w = cvtpk(a1[2], a1[3]);
                            *(u32x4*)(O + off + bj * HALF) = w; } }
                    if (sqp) { sq += __shfl_xor(sq, 16); sq += __shfl_xor(sq, 32); if (fq == 0) sqp[(size_t)(row0 + ai * HALF + m * 16) * 16 + u.pn * 4 + wc] = sq; }
                    __builtin_amdgcn_sched_barrier(0); }
            }
        }
    }
};

template <class Epi, class Sched>
__device__ __forceinline__ void gemm_simple(const int tid, const Gemm g, const Sched& S, const Epi& E) {
    const int  wid = __builtin_amdgcn_readfirstlane(tid >> 6), lane = tid & 63, wr = wid >> 2, wc = wid & 3, fr = lane & 15, fq = lane >> 4;
    const int K = g.K;
    Unit u;
    for (int ui = 0; S.next(ui, u); ++ui) {
        f32x4 acc[2][2][4][2];
#pragma unroll
        for (int a = 0; a < 2; ++a)
#pragma unroll
            for (int b = 0; b < 2; ++b)
#pragma unroll
                for (int m = 0; m < 4; ++m)
#pragma unroll
                    for (int n = 0; n < 2; ++n) acc[a][b][m][n] = (f32x4){0.f, 0.f, 0.f, 0.f};
        const bf16_t* Ab = g.A + (size_t)(u.pm * BM + wr * 64 + fr) * K + fq * 8;
        const bf16_t* Bb = g.Bt + (size_t)(u.pn * BM + wc * 32) * K + fq * 8;
        for (int k0 = 0; k0 < K; k0 += 32) {
            bf16x8 At[2][4], Bf[2][2];
#pragma unroll
            for (int ai = 0; ai < 2; ++ai)
#pragma unroll
                for (int m = 0; m < 4; ++m) At[ai][m] = *(const bf16x8*)(Ab + (size_t)(ai * HALF + m * 16) * K + k0);
#pragma unroll
            for (int bj = 0; bj < 2; ++bj)
#pragma unroll
                for (int n = 0; n < 2; ++n) { const int rr = E.perm() ? perm32(16 * n + fr) : (16 * n + fr);
                    Bf[bj][n] = *(const bf16x8*)(Bb + (size_t)(bj * HALF + rr) * K + k0); }
#pragma unroll
            for (int ai = 0; ai < 2; ++ai)
#pragma unroll
                for (int bj = 0; bj < 2; ++bj)
#pragma unroll
                    for (int m = 0; m < 4; ++m)
#pragma unroll
                        for (int n = 0; n < 2; ++n) acc[ai][bj][m][n] = __builtin_amdgcn_mfma_f32_16x16x32_bf16(Bf[bj][n], At[ai][m], acc[ai][bj][m][n], 0, 0, 0);
        }
        E(acc, u, ui, wr, wc, fr, fq);
    }
}

template <class Epi, class Sched, bool ALIGN_EPI = true>
__device__ __forceinline__ void gemm_phase(const int tid, LAS unsigned char* lds, const Gemm g, const Sched& S, const Epi& E) {
    const int  wid = __builtin_amdgcn_readfirstlane(tid >> 6), lane = tid & 63, wr = wid >> 2, wc = wid & 3, fr = lane & 15, fq = lane >> 4;
    const int K = g.K, nt = K / BK;
    unsigned voffA[2], voffB[2];
#pragma unroll
    for (int i = 0; i < 2; ++i) { int R, C; stage_rc(tid * 16 + i * 8192, R, C); const int Rb = E.perm() ? ((R & ~31) + perm32(R & 31)) : R;
        voffA[i] = (unsigned)(R * K + C) * 2u; voffB[i] = (unsigned)(Rb * K + C) * 2u; }
    const size_t kstep = (size_t)(BK * 2);
    const size_t hstep = (size_t)HALF * K * 2;
    const size_t tstep = 2 * hstep;
    const unsigned ldsw = (unsigned)wid * 1024u;
    const int aoff = lds_byte(wr * 64 + fr, fq * 8), boff = lds_byte(wc * 32 + fr, fq * 8);
#define PG8_SA(b, h) (((b) * 2 + (h)) * HTB)
#define PG8_SB(b, h) ((4 + (b) * 2 + (h)) * HTB)
#define PG8_STAGE(bufoff, gbase, voff) do { _Pragma("unroll") for (int _i = 0; _i < 2; ++_i) \
        __builtin_amdgcn_global_load_lds((const unsigned*)((const char*)(gbase) + (voff)[_i]), (LAS unsigned*)(lds + (bufoff) + ldsw + _i * 8192), 16, 0, 0); } while (0)
#define PG8_LDA(dst, b, h) do { _Pragma("unroll") for (int m = 0; m < 4; ++m) _Pragma("unroll") for (int k = 0; k < 2; ++k) dst[m][k] = *(const LAS bf16x8*)(lds + PG8_SA(b, h) + aoff + m * 2048 + k * 1024); } while (0)
#define PG8_LDB(dst, b, h) do { _Pragma("unroll") for (int n = 0; n < 2; ++n) _Pragma("unroll") for (int k = 0; k < 2; ++k) dst[n][k] = *(const LAS bf16x8*)(lds + PG8_SB(b, h) + boff + n * 2048 + k * 1024); } while (0)
#define PG8_MMA(ai, bj, At, Bt) do { __builtin_amdgcn_s_setprio(1); _Pragma("unroll") for (int m = 0; m < 4; ++m) _Pragma("unroll") for (int n = 0; n < 2; ++n) _Pragma("unroll") for (int k = 0; k < 2; ++k) \
        acc[ai][bj][m][n] = __builtin_amdgcn_mfma_f32_16x16x32_bf16(Bt[n][k], At[m][k], acc[ai][bj][m][n], 0, 0, 0); __builtin_amdgcn_s_setprio(0); } while (0)
#define PG8_WAIT_V(n) asm volatile("s_waitcnt vmcnt(" #n ")" ::: "memory")
#define PG8_WAIT_L(n) asm volatile("s_waitcnt lgkmcnt(" #n ")" ::: "memory")
#define PG8_BAR __builtin_amdgcn_s_barrier()
#define PG8_SCHED __builtin_amdgcn_sched_barrier(0)
    Unit cur, nxt; int ui = 0;
    if (!S.next(0, cur)) return;
    f32x4 acc[2][2][4][2];
#pragma unroll
    for (int a = 0; a < 2; ++a)
#pragma unroll
        for (int b = 0; b < 2; ++b)
#pragma unroll
            for (int m = 0; m < 4; ++m)
#pragma unroll
                for (int n = 0; n < 2; ++n) acc[a][b][m][n] = (f32x4){0.f, 0.f, 0.f, 0.f};
    bf16x8 At[4][2], B0[2][2], B1[2][2];
    const char* cA = (const char*)g.A + (size_t)cur.pm * tstep; const char* cB = (const char*)g.Bt + (size_t)cur.pn * tstep;
    S.a_ready(cur);
    PG8_STAGE(PG8_SB(0, 0), cB, voffB); PG8_STAGE(PG8_SB(0, 1), cB + hstep, voffB); PG8_STAGE(PG8_SA(0, 0), cA, voffA); PG8_STAGE(PG8_SA(0, 1), cA + hstep, voffA);
    if (wr == 1) PG8_BAR;
    PG8_WAIT_V(2); PG8_BAR;
    PG8_STAGE(PG8_SB(1, 0), cB + kstep, voffB); PG8_STAGE(PG8_SA(1, 0), cA + kstep, voffA); PG8_STAGE(PG8_SB(1, 1), cB + hstep + kstep, voffB);
    PG8_WAIT_V(6); PG8_BAR;
    for (;;) {
        const bool has_next = S.next(ui + 1, nxt);
        const char* nA = has_next ? (const char*)g.A + (size_t)nxt.pm * tstep : cA; const char* nB = has_next ? (const char*)g.Bt + (size_t)nxt.pn * tstep : cB;
        for (int t = 0; t < nt; t += 2) {
            const bool last = (t == nt - 2);
            const char* a1 = cA + (size_t)(t + 1) * kstep;
            const char* a2 = last ? nA : cA + (size_t)(t + 2) * kstep; const char* b2 = last ? nB : cB + (size_t)(t + 2) * kstep;
            const char* a3 = a2 + kstep; const char* b3 = b2 + kstep;
            if (last && has_next) S.a_ready(nxt);
            PG8_LDB(B0, 0, 0); PG8_LDB(B1, 0, 1); PG8_SCHED; PG8_LDA(At, 0, 0); PG8_STAGE(PG8_SA(1, 1), a1 + hstep, voffA);
            PG8_WAIT_V(8); PG8_WAIT_L(0); PG8_BAR; PG8_MMA(0, 0, At, B0); PG8_MMA(0, 1, At, B1); PG8_BAR; PG8_SCHED;
            PG8_LDA(At, 0, 1); PG8_STAGE(PG8_SB(0, 0), b2, voffB); PG8_STAGE(PG8_SB(0, 1), b2 + hstep, voffB); PG8_STAGE(PG8_SA(0, 0), a2, voffA);
            PG8_WAIT_V(8); PG8_WAIT_L(0); PG8_BAR; PG8_MMA(1, 0, At, B0); PG8_MMA(1, 1, At, B1); PG8_BAR; PG8_SCHED;
            PG8_LDB(B0, 1, 0); PG8_LDB(B1, 1, 1); PG8_SCHED; PG8_LDA(At, 1, 0); PG8_STAGE(PG8_SA(0, 1), a2 + hstep, voffA);
            PG8_WAIT_V(8); PG8_WAIT_L(0); PG8_BAR; PG8_MMA(0, 0, At, B0); PG8_MMA(0, 1, At, B1); PG8_BAR; PG8_SCHED;
            PG8_LDA(At, 1, 1); PG8_STAGE(PG8_SB(1, 0), b3, voffB); PG8_STAGE(PG8_SB(1, 1), b3 + hstep, voffB); PG8_STAGE(PG8_SA(1, 0), a3, voffA);
            PG8_WAIT_V(8); PG8_WAIT_L(0); PG8_BAR; PG8_MMA(1, 0, At, B0); PG8_MMA(1, 1, At, B1); PG8_BAR; PG8_SCHED;
        }
        if constexpr (ALIGN_EPI) { if (wr == 0) PG8_BAR; }
        E(acc, cur, ui, wr, wc, fr, fq); S.done(cur);
        if (!has_next) break;
#pragma unroll
        for (int a = 0; a < 2; ++a)
#pragma unroll
            for (int b = 0; b < 2; ++b)
#pragma unroll
                for (int m = 0; m < 4; ++m)
#pragma unroll
                    for (int n = 0; n < 2; ++n) acc[a][b][m][n] = (f32x4){0.f, 0.f, 0.f, 0.f};
        cur = nxt; cA = nA; cB = nB; ++ui;
        if constexpr (ALIGN_EPI) { if (wr == 1) PG8_BAR; }
    }
    PG8_WAIT_V(0);
    if constexpr (!ALIGN_EPI) { if (wr == 0) PG8_BAR; }
    PG8_BAR;
#undef PG8_SA
#undef PG8_SB
#undef PG8_STAGE
#undef PG8_LDA
#undef PG8_LDB
#undef PG8_MMA
#undef PG8_WAIT_V
#undef PG8_WAIT_L
#undef PG8_BAR
#undef PG8_SCHED
}
}

struct GemmJob { const bf16_t* A; const bf16_t* Bt; int M, N, K; pg8::EpiAny E; int rot; };
constexpr int GEMM_TAB_OFF = 131072;
__device__ __forceinline__ void gemm_tables(const Ctx& p, const GemmJob& J, const pg8::StaticOrder& S) {
    const int tid = p.tid; pg8::Unit u;
    for (int ui = 0; S.next(ui, u); ++ui) {
        LAS float* T = J.E.tab + ui * 512;
        const int r = tid & 255;
        if (J.E.kind == 2) {
            const size_t bo = (size_t)((u.pm * 256) / SEQ) * NMOD + u.pn * 256 + r;
            if (tid < 256) T[r] = J.E.gate[bo]; else T[256 + r] = J.E.O ? J.E.ng[u.pn * 256 + r] * (1.0f + J.E.nsc[bo]) : 0.f;
        } else {
            const int tokt = (J.E.kind == 1) ? u.pm : u.pn, vect = (J.E.kind == 1) ? u.pn : u.pm;
            if (tid < 256) { const f32x4* q = (const f32x4*)(J.E.sqp + (size_t)(tokt * 256 + r) * 16); const f32x4 a = q[0], b = q[1], c = q[2], d = q[3];
                const float sm = ((a[0] + a[1]) + (a[2] + a[3])) + ((b[0] + b[1]) + (b[2] + b[3])) + ((c[0] + c[1]) + (c[2] + c[3])) + ((d[0] + d[1]) + (d[2] + d[3]));
                T[r] = rsqrtf(sm * (1.0f / DM) + EPS); }
            else T[256 + r] = J.E.shw[(size_t)((tokt * 256) / SEQ) * J.E.shw_ld + vect * 256 + r];
        }
    }
    __syncthreads();
}
__device__ __forceinline__ void run_gemm(const Ctx& p, LAS unsigned char* lds, GemmJob& J) {
    J.E.tab = (LAS float*)(lds + GEMM_TAB_OFF);
    pg8::Gemm g{J.A, J.Bt, J.M, J.N, J.K}; pg8::StaticOrder S; S.init(J.M, J.N, p.nblk, (p.bid + J.rot) % p.nblk);
    if (J.E.kind != 0) gemm_tables(p, J, S);
#if SIMPLE_GEMM
    pg8::gemm_simple<pg8::EpiAny, pg8::StaticOrder>(p.tid, g, S, J.E);
#else
    { int tid2 = p.tid; asm volatile("" : "+v"(tid2));
      pg8::gemm_phase<pg8::EpiAny, pg8::StaticOrder, true>(tid2, lds, g, S, J.E); }
#endif
    __syncthreads();
}

__device__ __forceinline__ void transpose_item(const float* W, int K, int N, bf16_t* WT, LAS float* scr, int item, int lane) {
    const int nblk = N / 32, kb = item / nblk, nb = item % nblk, k0 = 64 * kb, n0 = 32 * nb;
    float v[32];
#pragma unroll
    for (int i = 0; i < 32; ++i) { const int kk = 2 * i + (lane >> 5); v[i] = W[(size_t)(k0 + kk) * N + n0 + (lane & 31)]; }
#pragma unroll
    for (int i = 0; i < 32; ++i) { const int kk = 2 * i + (lane >> 5); scr[kk * 33 + (lane & 31)] = v[i]; }
    asm volatile("s_waitcnt lgkmcnt(0)" ::: "memory");
    const int c = lane & 7;
#pragma unroll
    for (int j = 0; j < 4; ++j) { const int n = (lane >> 3) + 8 * j; const LAS float* s = scr + (8 * c) * 33 + n;
        u32x4 o; o.x = cvtpk(s[0 * 33], s[1 * 33]); o.y = cvtpk(s[2 * 33], s[3 * 33]); o.z = cvtpk(s[4 * 33], s[5 * 33]); o.w = cvtpk(s[6 * 33], s[7 * 33]);
        *(u32x4*)(WT + (size_t)(n0 + n) * K + k0 + 8 * c) = o; }
    asm volatile("s_waitcnt lgkmcnt(0)" ::: "memory");
}

__device__ __forceinline__ float silu_f(float v) { return v / (1.0f + expf(-v)); }

__device__ __forceinline__ void phase_prologue(const Ctx& p, LAS unsigned char* lds, const bool partA, const bool partB) {
    const int tid = p.tid, lane = tid & 63, wave = __builtin_amdgcn_readfirstlane(tid >> 6);
    unsigned char* ws = p.ws;
#ifndef PRO_SKIP1
    if (partA) {
        LAS float* S = (LAS float*)lds;
        LAS float* red = (LAS float*)(lds + 69632);
        float* MODL = (float*)(ws + WS_MODL); float* MODC = (float*)(ws + WS_MODC);
        if (p.bid < 192) {
            for (int i = tid; i < 17 * 1024; i += NTHREADS) { const float v = (i < 16 * 1024) ? p.in[I_C][i] : p.in[I_CCTX][i - 16 * 1024]; S[i] = silu_f(v); }
            __syncthreads();
            for (int it = p.bid; it < 192; it += p.nblk) {
                const int layer = it / 96, n0 = (it % 96) * 64, fr = lane & 15, fq = lane >> 4;
                const float* W = p.in[I_WMOD] + (size_t)layer * DM * NMOD + n0 + fr;
                f32x4 acc[2][4];
#pragma unroll
                for (int rt = 0; rt < 2; ++rt)
#pragma unroll
                    for (int ct = 0; ct < 4; ++ct) acc[rt][ct] = (f32x4){0.f, 0.f, 0.f, 0.f};
#pragma unroll 1
                for (int k0 = 0; k0 < 128; k0 += 32) {
                    float bv[8][4];
#pragma unroll
                    for (int j = 0; j < 8; ++j)
#pragma unroll
                        for (int ct = 0; ct < 4; ++ct) bv[j][ct] = W[(size_t)(wave * 128 + k0 + 4 * j + fq) * NMOD + 16 * ct];
#pragma unroll
                    for (int j = 0; j < 8; ++j) { const int k = wave * 128 + k0 + 4 * j + fq;
                        const float a0 = S[fr * 1024 + k], a1 = (fr == 0) ? S[16 * 1024 + k] : 0.f;
#pragma unroll
                        for (int ct = 0; ct < 4; ++ct) { acc[0][ct] = __builtin_amdgcn_mfma_f32_16x16x4f32(a0, bv[j][ct], acc[0][ct], 0, 0, 0);
                                                          acc[1][ct] = __builtin_amdgcn_mfma_f32_16x16x4f32(a1, bv[j][ct], acc[1][ct], 0, 0, 0); } }
                }
#pragma unroll
                for (int rt = 0; rt < 2; ++rt)
#pragma unroll
                    for (int ct = 0; ct < 4; ++ct) *(LAS f32x4*)(red + ((wave * 2 + rt) * 4 + ct) * 256 + lane * 4) = acc[rt][ct];
                __syncthreads();
                for (int idx = tid; idx < 17 * 64; idx += NTHREADS) { const int b = idx >> 6, nn = idx & 63, rt = b >> 4, bb = b & 15, ct = nn >> 4;
                    const int off = (rt * 4 + ct) * 256 + ((bb >> 2) * 16 + (nn & 15)) * 4 + (bb & 3);
                    float s_ = p.in[I_BMOD][layer * NMOD + n0 + nn];
#pragma unroll
                    for (int w = 0; w < 8; ++w) s_ += red[w * 2048 + off];
                    if (b < 16) MODL[(size_t)(layer * 16 + b) * NMOD + n0 + nn] = s_; else if (layer == 0) MODC[n0 + nn] = s_; }
                __syncthreads();
            }
        }
        __syncthreads();
    }
#endif
    const int gw = p.bid * NWAVES + wave, ngw = p.nblk * NWAVES;
#ifndef PRO_SKIP2
    if (partA) {
        float* H3 = (float*)(ws + WS_H3);
        const float* w1 = p.in[I_FW1]; const float* b1 = p.in[I_FB1]; const float* w2 = p.in[I_FW2]; const float* b2 = p.in[I_FB2];
        const float* w3 = p.in[I_FW3]; const float* b3 = p.in[I_FB3]; const float* fr = p.in[I_FFREQ];
        LAS float* w2s = (LAS float*)lds; LAS float* w3s = (LAS float*)(lds + 16384); LAS float* w1s = (LAS float*)(lds + 32768);
        for (int i = tid; i < 4096; i += NTHREADS) { w2s[i] = w2[i]; w3s[i] = w3[i]; if (i < 17 * 64) w1s[i] = w1[i]; }
        __syncthreads();
        for (int t = gw; t < SEQ; t += ngw) {
            const float tf = (float)t, tn = tf / 2048.0f, w = 6.283185307179586f * tf / 2048.0f;
            float feat = 0.f;
            if (lane == 0) feat = tn;
            else if (lane < 17) { const int bi = (lane - 1) & 7; const float band = 1e-4f + (float)bi * ((7.0f - 1e-4f) / 7.0f); const float fw = w * band; feat = (lane < 9) ? fcos(fw) : -fsin(fw); }
            float a = b1[lane];
#pragma unroll
            for (int i = 0; i < 17; ++i) a += __shfl(feat, i) * w1s[i * 64 + lane];
            float h = fsin(fr[lane] * a);
            a = b2[lane];
#pragma unroll 16
            for (int k = 0; k < 64; ++k) a += __shfl(h, k) * w2s[k * 64 + lane];
            h = fsin(fr[64 + lane] * a);
            a = b3[lane];
#pragma unroll 16
            for (int k = 0; k < 64; ++k) a += __shfl(h, k) * w3s[k * 64 + lane];
            h = fsin(fr[128 + lane] * a);
            H3[t * 64 + lane] = h;
        }
    }
#endif
#ifndef PRO_SKIP3
    if (partB) {
        LAS float* scr = (LAS float*)(lds + wave * 16384);
        struct TJob { int in_idx; size_t in_off; int K, N; size_t ws_off; };
        const TJob jobs[10] = {
            {I_AWIN, 0, 1024, 1440, WS_WIN}, {I_AWQB, 0, 384, 768, WS_WQB}, {I_AWKVB, 0, 256, 1024, WS_WKVB}, {I_AWOUT, 0, 1024, 1024, WS_WOUT},
            {I_W1, 0, 1024, 4096, WS_W1_0}, {I_W2, 0, 4096, 1024, WS_W2_0}, {I_W1, (size_t)1024 * 4096, 1024, 4096, WS_W1_1}, {I_W2, (size_t)4096 * 1024, 4096, 1024, WS_W2_1},
            {I_HWIN, 0, 1024, 3072, WS_HIN}, {I_HWOUT, 0, 1024, 1024, WS_HOUT}};
        int base = 0;
#pragma unroll
        for (int j = 0; j < 10; ++j) {
            const int K = jobs[j].K, N = jobs[j].N, nitems = (K / 64) * (N / 32);
            const float* W = p.in[jobs[j].in_idx] + jobs[j].in_off; bf16_t* WT = (bf16_t*)(ws + jobs[j].ws_off);
            int first = gw - (base % ngw); if (first < 0) first += ngw;
            for (int it = first; it < nitems; it += ngw) transpose_item(W, K, N, WT, scr, it, lane);
            base += nitems;
        }
        u32x4* z = (u32x4*)((bf16_t*)(ws + WS_WIN) + (size_t)1440 * 1024);
        unsigned zz = 0u; asm volatile("" : "+v"(zz));
        for (int i = p.bid * NTHREADS + tid; i < 96 * 1024 / 8; i += p.nblk * NTHREADS) z[i] = (u32x4){zz, zz, zz, zz};
    }
#endif
}

__device__ __forceinline__ void modulate_chunk(const float* src, int row0, int nrows, const float* g, const float* sc, const float* sh, bf16_t* dst, int lane, bf16_t* xcopy = nullptr) {
    f32x4 gs[4], sv[4];
#pragma unroll
    for (int j = 0; j < 4; ++j) { const int c4 = lane + 64 * j; const f32x4 gg = ((const f32x4*)g)[c4], ss = ((const f32x4*)sc)[c4]; gs[j] = gg * (ss + 1.0f); sv[j] = ((const f32x4*)sh)[c4]; }
    for (int r = row0; r < row0 + nrows; ++r) {
        const f32x4* xr = (const f32x4*)(src + (size_t)r * DM) + lane;
        f32x4 v[4]; float s = 0.f;
#pragma unroll
        for (int j = 0; j < 4; ++j) { v[j] = xr[64 * j]; s += (v[j].x * v[j].x + v[j].y * v[j].y) + (v[j].z * v[j].z + v[j].w * v[j].w); }
        const float rstd = rsqrtf(wave_sum(s) * (1.0f / DM) + EPS);
        u32x2* o8 = (u32x2*)(dst + (size_t)r * DM) + lane;
#pragma unroll
        for (int j = 0; j < 4; ++j) { const f32x4 y = v[j] * rstd * gs[j] + sv[j]; u32x2 w; w.x = cvtpk(y.x, y.y); w.y = cvtpk(y.z, y.w); o8[64 * j] = w; }
        if (xcopy) { u32x2* x8 = (u32x2*)(xcopy + (size_t)r * DM) + lane;
#pragma unroll
            for (int j = 0; j < 4; ++j) { u32x2 w; w.x = cvtpk(v[j].x, v[j].y); w.y = cvtpk(v[j].z, v[j].w); x8[64 * j] = w; } }
    }
}
__device__ __forceinline__ void phase_modulate(const Ctx& p, const float* src, int layer, const float* g, int shoff, int scoff, bool with_ctx) {
    const int lane = p.tid & 63, wave = __builtin_amdgcn_readfirstlane(p.tid >> 6);
    const int gw = p.bid * NWAVES + wave;
    const float* MODL = (const float*)(p.ws + WS_MODL); const float* MODC = (const float*)(p.ws + WS_MODC);
    bf16_t* HL = (bf16_t*)(p.ws + WS_HL);
    {   const int per = ML / NGW, row0 = gw * per, b = row0 / SEQ; const float* mv = MODL + (size_t)(layer * 16 + b) * NMOD;
        modulate_chunk(src, row0, per, g, mv + scoff, mv + shoff, HL, lane, (bf16_t*)(p.ws + WS_XW)); }
    if (with_ctx) { const int per = MC / NGW, row0 = gw * per;
        modulate_chunk(p.in[I_CTX], row0, per, g, MODC + scoff, MODC + shoff, HL + (size_t)ML * DM, lane); }
}
__device__ __forceinline__ void shw_job(const bf16_t* WT, int N, const float* sh, float* out, int gw, int ngw, int lane) {
    const int fr = lane & 15, fq = lane >> 4;
    for (int g = gw; g < N / 16; g += ngw) {
        f32x4 acc = {0.f, 0.f, 0.f, 0.f};
#pragma unroll 8
        for (int ks = 0; ks < 32; ++ks) {
            const float* sp = sh + (size_t)fr * NMOD + 32 * ks + 8 * fq;
            const f32x4 s0 = *(const f32x4*)sp, s1 = *(const f32x4*)(sp + 4);
            const u32x4 aw = {cvtpk(s0[0], s0[1]), cvtpk(s0[2], s0[3]), cvtpk(s1[0], s1[1]), cvtpk(s1[2], s1[3])};
            const bf16x8 bw = *(const bf16x8*)(WT + (size_t)(16 * g + fr) * DM + 32 * ks + 8 * fq);
            acc = __builtin_amdgcn_mfma_f32_16x16x32_bf16(__builtin_bit_cast(bf16x8, aw), bw, acc, 0, 0, 0);
        }
#pragma unroll
        for (int e = 0; e < 4; ++e) out[(size_t)(4 * fq + e) * N + 16 * g + fr] = acc[e];
    }
}
__device__ __forceinline__ void phase_shw(const Ctx& p) {
    const int lane = p.tid & 63, wave = __builtin_amdgcn_readfirstlane(p.tid >> 6);
    const int gw = p.bid * NWAVES + wave, ngw = p.nblk * NWAVES;
    const float* MODL = (const float*)(p.ws + WS_MODL);
    shw_job((const bf16_t*)(p.ws + WS_W1_0), 4096, MODL + 3 * DM, (float*)(p.ws + WS_SHW_UP0), gw, ngw, lane);
    shw_job((const bf16_t*)(p.ws + WS_HIN), 3072, MODL + (size_t)16 * NMOD, (float*)(p.ws + WS_SHW_HIN), gw, ngw, lane);
    shw_job((const bf16_t*)(p.ws + WS_W1_1), 4096, MODL + (size_t)16 * NMOD + 3 * DM, (float*)(p.ws + WS_SHW_UP1), gw, ngw, lane);
}
__device__ __forceinline__ void phase_final(const Ctx& p) {
    const int lane = p.tid & 63, wave = __builtin_amdgcn_readfirstlane(p.tid >> 6);
    const int gw = p.bid * NWAVES + wave, per = ML / NGW;
    const bf16_t* X = (const bf16_t*)(p.ws + WS_XW); const float* g = p.in[I_FINALG]; const float* sqp = (const float*)(p.ws + WS_SQA);
    f32x4 gs[4];
#pragma unroll
    for (int j = 0; j < 2; ++j) { gs[2 * j] = *(const f32x4*)(g + 512 * j + 8 * lane); gs[2 * j + 1] = *(const f32x4*)(g + 512 * j + 8 * lane + 4); }
    for (int r = gw * per; r < (gw + 1) * per; ++r) {
        const float part = (lane < 16) ? sqp[(size_t)r * 16 + lane] : 0.f;
        const float rstd = rsqrtf(wave_sum(part) * (1.0f / DM) + EPS);
#pragma unroll
        for (int j = 0; j < 2; ++j) { const u32x4 xb = *(const u32x4*)(X + (size_t)r * DM + 512 * j + 8 * lane);
            const f32x4 v0 = {bflo(xb.x), bfhi(xb.x), bflo(xb.y), bfhi(xb.y)}, v1 = {bflo(xb.z), bfhi(xb.z), bflo(xb.w), bfhi(xb.w)};
            f32x4* o = (f32x4*)(p.out + (size_t)r * DM + 512 * j + 8 * lane);
            o[0] = v0 * rstd * gs[2 * j]; o[1] = v1 * rstd * gs[2 * j + 1]; }
    }
}

__device__ __forceinline__ void zpost_row(const Ctx& p, int row, bool latent, int lane, const LAS f32x2* tabM, const LAS f32x2* tabG) {
    unsigned char* ws = p.ws;
    const bf16_t* z = (const bf16_t*)(ws + WS_Z) + (size_t)row * ZW;
    int prow = 0, pcol = 0;
    if (latent) { const int s = row & (SEQ - 1); prow = s >> 6; pcol = s & 63; }
    if (latent) {
        float v[6], ss = 0.f;
#pragma unroll
        for (int i = 0; i < 6; ++i) { v[i] = bf2f(z[ZC_CQ + lane + 64 * i]); ss += v[i] * v[i]; }
        const float rstd = rsqrtf(wave_sum(ss) * (1.0f / 384.0f) + EPS);
        bf16_t* o = (bf16_t*)(ws + WS_CQN) + (size_t)row * 384;
#pragma unroll
        for (int i = 0; i < 6; ++i) o[lane + 64 * i] = (bf16_t)f2bf(v[i] * rstd * p.in[I_AQAG][lane + 64 * i]);
    }
    {
        float v[4], ss = 0.f;
#pragma unroll
        for (int i = 0; i < 4; ++i) { v[i] = bf2f(z[ZC_CKV + lane + 64 * i]); ss += v[i] * v[i]; }
        const float rstd = rsqrtf(wave_sum(ss) * (1.0f / 256.0f) + EPS);
        bf16_t* o = (bf16_t*)(ws + WS_CKVN) + (size_t)row * 256;
#pragma unroll
        for (int i = 0; i < 4; ++i) o[lane + 64 * i] = (bf16_t)f2bf(v[i] * rstd * p.in[I_AKVAG][lane + 64 * i]);
    }
    {
        const int d = lane & 31; const float y = bf2f(z[ZC_KR + d]);
        const float pr = __shfl_xor(y, 8);
        float o = y;
        if (latent) { const int pos = (d & 16) ? pcol : prow; const f32x2 cs = tabM[pos * 8 + (d & 7)];
            o = (d & 8) ? (pr * cs.y + y * cs.x) : (y * cs.x - pr * cs.y); }
        if (lane < 32) ((bf16_t*)(ws + WS_KROPE))[(size_t)row * 32 + d] = (bf16_t)f2bf(o);
    }
    if (latent) {
        const float gq = p.in[I_AQNG][lane];
        const int pos = (lane & 32) ? pcol : prow; const f32x2 cs = tabG[pos * 16 + (lane & 15)];
        bf16_t* o = (bf16_t*)(ws + WS_QG) + (size_t)row * 512;
#pragma unroll
        for (int hh = 0; hh < 8; ++hh) {
            const float v = bf2f(z[ZC_GQ + 64 * hh + lane]);
            const float rstd = rsqrtf(wave_sum(v * v) * (1.0f / 64.0f) + EPS);
            const float y = v * rstd * gq, pr = __shfl_xor(y, 16);
            const float r = (lane & 16) ? (pr * cs.y + y * cs.x) : (y * cs.x - pr * cs.y);
            o[64 * hh + lane] = (bf16_t)f2bf(r * QSCALE_GQA);
        }
    }
    {
        const float gk = p.in[I_AKNG][lane];
        f32x2 cs = {1.f, 0.f};
        if (latent) { const int pos = (lane & 32) ? pcol : prow; cs = tabG[pos * 16 + (lane & 15)]; }
        bf16_t* o = (bf16_t*)(ws + WS_KG) + (size_t)row * 128;
#pragma unroll
        for (int hh = 0; hh < 2; ++hh) {
            const float v = bf2f(z[ZC_GK + 64 * hh + lane]);
            const float rstd = rsqrtf(wave_sum(v * v) * (1.0f / 64.0f) + EPS);
            const float y = v * rstd * gk, pr = __shfl_xor(y, 16);
            const float r = (lane & 16) ? (pr * cs.y + y * cs.x) : (y * cs.x - pr * cs.y);
            o[64 * hh + lane] = (bf16_t)f2bf(r);
        }
    }
    {
        bf16_t* o = (bf16_t*)(ws + WS_VG) + (size_t)row * 128;
        o[lane] = z[ZC_GV + lane]; o[64 + lane] = z[ZC_GV + 64 + lane];
    }
}
struct ZGains { f32x4 qa[2], kva0[2], kva1[2], qn[2], kn[2]; };
__device__ __forceinline__ void unpack8(const u32x4 w, float (&v)[8]) { v[0] = bflo(w.x); v[1] = bfhi(w.x); v[2] = bflo(w.y); v[3] = bfhi(w.y); v[4] = bflo(w.z); v[5] = bfhi(w.z); v[6] = bflo(w.w); v[7] = bfhi(w.w); }
__device__ __forceinline__ u32x4 pack8(const float (&v)[8]) { u32x4 w; w.x = cvtpk(v[0], v[1]); w.y = cvtpk(v[2], v[3]); w.z = cvtpk(v[4], v[5]); w.w = cvtpk(v[6], v[7]); return w; }
__device__ __forceinline__ float sumsq8(const float (&v)[8]) { return ((v[0] * v[0] + v[1] * v[1]) + (v[2] * v[2] + v[3] * v[3])) + ((v[4] * v[4] + v[5] * v[5]) + (v[6] * v[6] + v[7] * v[7])); }
__device__ __forceinline__ void rope8(float (&y)[8], const float (&pr)[8], bool second, const LAS f32x2* cs) {
#pragma unroll
    for (int e = 0; e < 8; ++e) { const f32x2 c = cs[e]; y[e] = second ? (pr[e] * c.y + y[e] * c.x) : (y[e] * c.x - pr[e] * c.y); }
}
__device__ __forceinline__ void zpost_row_vec(const Ctx& p, int row, bool latent, int lane, const LAS f32x2* tabM, const LAS f32x2* tabG, const ZGains& G) {
    unsigned char* ws = p.ws;
    const bf16_t* z = (const bf16_t*)(ws + WS_Z) + (size_t)row * ZW;
    int prow = 0, pcol = 0;
    if (latent) { const int s_ = row & (SEQ - 1); prow = s_ >> 6; pcol = s_ & 63; }
    const int cB = 84 + lane, cC = lane < 16 ? 148 + lane : (lane < 32 ? 164 + (lane - 16) : 80 + (lane & 3));
    const u32x4 wA0 = *(const u32x4*)(z + 8 * lane);
    const u32x4 wA1 = *(const u32x4*)(z + 8 * (64 + (lane & 15)));
    const u32x4 wB = *(const u32x4*)(z + 8 * cB);
    const u32x4 wC = *(const u32x4*)(z + 8 * cC);
    float a0[8], a1[8], vb[8], vc[8];
    unpack8(wA0, a0); unpack8(wA1, a1); unpack8(wB, vb); unpack8(wC, vc);
    {
        const float s0 = sumsq8(a0), s1 = sumsq8(a1);
        const float sq_cq = wave_sum(lane < 48 ? s0 : 0.f), sq_ckv = wave_sum((lane >= 48 ? s0 : 0.f) + (lane < 16 ? s1 : 0.f));
        const float rq = rsqrtf(sq_cq * (1.0f / 384.0f) + EPS), rk = rsqrtf(sq_ckv * (1.0f / 256.0f) + EPS);
        float o[8];
        if (lane < 48) { if (latent) {
#pragma unroll
                for (int e = 0; e < 8; ++e) o[e] = a0[e] * rq * G.qa[e >> 2][e & 3];
                *(u32x4*)((bf16_t*)(ws + WS_CQN) + (size_t)row * 384 + 8 * lane) = pack8(o); } }
        else {
#pragma unroll
            for (int e = 0; e < 8; ++e) o[e] = a0[e] * rk * G.kva0[e >> 2][e & 3];
            *(u32x4*)((bf16_t*)(ws + WS_CKVN) + (size_t)row * 256 + 8 * (lane - 48)) = pack8(o); }
        if (lane < 16) {
#pragma unroll
            for (int e = 0; e < 8; ++e) o[e] = a1[e] * rk * G.kva1[e >> 2][e & 3];
            *(u32x4*)((bf16_t*)(ws + WS_CKVN) + (size_t)row * 256 + 128 + 8 * lane) = pack8(o); }
    }
    if (latent) {
        const float sq = sum8(sumsq8(vb));
        const float rs = rsqrtf(sq * (1.0f / 64.0f) + EPS);
        float y[8], pr[8];
#pragma unroll
        for (int e = 0; e < 8; ++e) y[e] = vb[e] * rs * G.qn[e >> 2][e & 3];
#pragma unroll
        for (int e = 0; e < 8; ++e) pr[e] = dpp_xor2(y[e]);
        const int pos = (lane & 4) ? pcol : prow;
        rope8(y, pr, (lane & 2) != 0, tabG + pos * 16 + 8 * (lane & 1));
#pragma unroll
        for (int e = 0; e < 8; ++e) y[e] *= QSCALE_GQA;
        *(u32x4*)((bf16_t*)(ws + WS_QG) + (size_t)row * 512 + 8 * lane) = pack8(y);
    }
    {
        const float sq = sum8(sumsq8(vc));
        const float rs = rsqrtf(sq * (1.0f / 64.0f) + EPS);
        float y[8], pr2[8], pr1[8];
#pragma unroll
        for (int e = 0; e < 8; ++e) y[e] = (lane < 16) ? vc[e] * rs * G.kn[e >> 2][e & 3] : vc[e];
#pragma unroll
        for (int e = 0; e < 8; ++e) { pr2[e] = dpp_xor2(y[e]); pr1[e] = dpp_xor1(y[e]); }
        if (lane < 16) {
            if (latent) { const int pos = (lane & 4) ? pcol : prow; rope8(y, pr2, (lane & 2) != 0, tabG + pos * 16 + 8 * (lane & 1)); }
            *(u32x4*)((bf16_t*)(ws + WS_KG) + (size_t)row * 128 + 8 * lane) = pack8(y);
        } else if (lane < 32) {
            *(u32x4*)((bf16_t*)(ws + WS_VG) + (size_t)row * 128 + 8 * (lane - 16)) = wC;
        } else if (lane < 36) {
            if (latent) { const int pos = (lane & 2) ? pcol : prow; rope8(y, pr1, (lane & 1) != 0, tabM + pos * 8); }
            *(u32x4*)((bf16_t*)(ws + WS_KROPE) + (size_t)row * 32 + 8 * (lane - 32)) = pack8(y);
        }
    }
}
__device__ __forceinline__ void phase_zpost(const Ctx& p, LAS unsigned char* lds) {
    const int tid = p.tid, lane = tid & 63, wave = __builtin_amdgcn_readfirstlane(tid >> 6);
    LAS f32x2* tabM = (LAS f32x2*)lds;
    LAS f32x2* tabG = (LAS f32x2*)(lds + 4096);
    for (int i = tid; i < 512; i += NTHREADS) { const int pos = i >> 3, f = i & 7; const float inv = inv_theta((float)f / 8.0f); const float a = (float)pos * inv; tabM[i] = (f32x2){fcos(a), fsin(a)}; }
    for (int i = tid; i < 1024; i += NTHREADS) { const int pos = i >> 4, f = i & 15; const float inv = inv_theta((float)f / 16.0f); const float a = (float)pos * inv; tabG[i] = (f32x2){fcos(a), fsin(a)}; }
    __syncthreads();
    const int gw = p.bid * NWAVES + wave;
#if ZPOST_REF
    { const int per = ML / NGW; for (int r = gw * per; r < (gw + 1) * per; ++r) zpost_row(p, r, true, lane, tabM, tabG); }
    { const int per = MC / NGW; for (int r = gw * per; r < (gw + 1) * per; ++r) zpost_row(p, ML + r, false, lane, tabM, tabG); }
#else
    ZGains G;
    { const float* qa = p.in[I_AQAG] + 8 * (lane < 48 ? lane : 0); const float* k0 = p.in[I_AKVAG] + 8 * (lane >= 48 ? lane - 48 : 0); const float* k1 = p.in[I_AKVAG] + 128 + 8 * (lane & 15);
      const float* qn = p.in[I_AQNG] + 8 * (lane & 7); const float* kn = p.in[I_AKNG] + 8 * (lane & 7);
#pragma unroll
      for (int h = 0; h < 2; ++h) { G.qa[h] = *(const f32x4*)(qa + 4 * h); G.kva0[h] = *(const f32x4*)(k0 + 4 * h); G.kva1[h] = *(const f32x4*)(k1 + 4 * h); G.qn[h] = *(const f32x4*)(qn + 4 * h); G.kn[h] = *(const f32x4*)(kn + 4 * h); } }
    { const int per = ML / NGW;
#pragma unroll 2
      for (int r = gw * per; r < (gw + 1) * per; ++r) zpost_row_vec(p, r, true, lane, tabM, tabG, G); }
    { const int per = MC / NGW; for (int r = gw * per; r < (gw + 1) * per; ++r) zpost_row_vec(p, ML + r, false, lane, tabM, tabG, G); }
#endif
    __syncthreads();
}

__device__ __forceinline__ float max3f(float a, float b, float c) { float r; asm("v_max3_f32 %0, %1, %2, %3" : "=v"(r) : "v"(a), "v"(b), "v"(c)); return r; }
__device__ __forceinline__ int crow(int r, int hi) { return (r & 3) + 8 * (r >> 2) + 4 * hi; }
__device__ __forceinline__ size_t key_row(int b, int t) { return t < CTXL ? (size_t)(ML + b * CTXL + t) : (size_t)(b * SEQ + (t - CTXL)); }

template <int DK>
__device__ __forceinline__ void attn_naive_one(const Ctx& p, int b, int h, int q) {
    unsigned char* ws = p.ws;
    const bf16_t* KV = (const bf16_t*)(ws + WS_KV); const bf16_t* KR = (const bf16_t*)(ws + WS_KROPE);
    const bf16_t* KG = (const bf16_t*)(ws + WS_KG); const bf16_t* VG = (const bf16_t*)(ws + WS_VG);
    const size_t row = (size_t)b * SEQ + q;
    float qv[DK];
    {
        const bf16_t* qp = (DK == 96) ? (const bf16_t*)(ws + WS_QMR) + row * 768 + h * 96 : (const bf16_t*)(ws + WS_QG) + row * 512 + (h - 8) * 64;
#pragma unroll
        for (int d8 = 0; d8 < DK / 8; ++d8) { const u32x4 w = *(const u32x4*)(qp + 8 * d8);
            qv[8 * d8 + 0] = bflo(w.x); qv[8 * d8 + 1] = bfhi(w.x); qv[8 * d8 + 2] = bflo(w.y); qv[8 * d8 + 3] = bfhi(w.y);
            qv[8 * d8 + 4] = bflo(w.z); qv[8 * d8 + 5] = bfhi(w.z); qv[8 * d8 + 6] = bflo(w.w); qv[8 * d8 + 7] = bfhi(w.w); }
    }
    float o[64];
#pragma unroll
    for (int d = 0; d < 64; ++d) o[d] = 0.f;
    float m = -1e30f, l = 0.f;
    for (int t = 0; t < TKEYS; ++t) {
        const size_t kr = key_row(b, t);
        float s = 0.f;
        const bf16_t* vp;
        if (DK == 96) {
            const bf16_t* kp = KV + kr * 1024 + h * 128; const bf16_t* rp = KR + kr * 32;
#pragma unroll
            for (int d = 0; d < 64; ++d) s += qv[d] * bf2f(kp[d]);
#pragma unroll
            for (int d = 0; d < 32; ++d) s += qv[64 + d] * bf2f(rp[d]);
            vp = kp + 64;
        } else {
            const int kvh = (h - 8) >> 2; const bf16_t* kp = KG + kr * 128 + kvh * 64;
#pragma unroll
            for (int d = 0; d < 64; ++d) s += qv[d] * bf2f(kp[d]);
            vp = VG + kr * 128 + kvh * 64;
        }
        const float mn = fmaxf(m, s), al = exp2f(m - mn), pe = exp2f(s - mn);
        l = l * al + pe; m = mn;
#pragma unroll
        for (int d = 0; d < 64; ++d) o[d] = o[d] * al + pe * bf2f(vp[d]);
    }
    const float rl = 1.0f / l;
    bf16_t* op = (bf16_t*)(ws + WS_O) + row * 1024 + h * 64;
#pragma unroll
    for (int d = 0; d < 64; ++d) op[d] = (bf16_t)f2bf(o[d] * rl);
}
__device__ __forceinline__ void phase_naive_qrope(const Ctx& p) {
    const bf16_t* QM = (const bf16_t*)(p.ws + WS_QM); bf16_t* QMR = (bf16_t*)(p.ws + WS_QMR);
    for (size_t idx = (size_t)p.bid * NTHREADS + p.tid; idx < (size_t)ML * 768; idx += (size_t)p.nblk * NTHREADS) {
        const int col = (int)(idx % 768), d = col % 96; const size_t row = idx / 768; const int q = (int)(row & (SEQ - 1));
        float v = bf2f(QM[idx]);
        if (d >= 64) {
            const int e = d - 64, prow = q >> 6, pcol = q & 63;
            const int pos = (e & 16) ? pcol : prow; const float inv = inv_theta((float)(e & 7) / 8.0f); const float ang = (float)pos * inv;
            const float cs = fcos(ang), sn = fsin(ang);
            const float a = bf2f(QM[idx - e + (e & ~8)]), bb = bf2f(QM[idx - e + (e | 8)]);
            v = (e & 8) ? (a * sn + bb * cs) : (a * cs - bb * sn);
        }
        QMR[idx] = (bf16_t)f2bf(v * QSCALE_MLA);
    }
}
__device__ __forceinline__ void phase_attn_naive(const Ctx& p) {
    for (int idx = p.bid * NTHREADS + p.tid; idx < NB * 16 * SEQ; idx += p.nblk * NTHREADS) {
        const int q = idx & (SEQ - 1), h = (idx >> 11) & 15, b = idx >> 15;
        if (h < 8) attn_naive_one<96>(p, b, h, q); else attn_naive_one<64>(p, b, h, q);
    }
}

template <int DK>
__device__ __forceinline__ void attn_unit(const Ctx& p, int b, int h, int qb, LAS unsigned char* lds) {
    constexpr int NC = DK / 8;
    constexpr int ND = DK / 16;
    constexpr int KB = 12288, VB = 8192;
    unsigned char* ws = p.ws;
    const int tid = p.tid, lane = tid & 63, r32 = lane & 31, hi = lane >> 5; const int wid = __builtin_amdgcn_readfirstlane(tid >> 6);
    const bf16_t* KV = (const bf16_t*)(ws + WS_KV); const bf16_t* KR = (const bf16_t*)(ws + WS_KROPE);
    const bf16_t* KG = (const bf16_t*)(ws + WS_KG); const bf16_t* VG = (const bf16_t*)(ws + WS_VG);
    const int kvh = (h - 8) >> 2;
    LAS unsigned char* Kb = lds; LAS unsigned char* Vb = lds + 2 * KB; LAS float* wsf = (LAS float*)(lds + 2 * KB + 2 * VB) + wid * 64;
    const int qs = qb * 256 + wid * 32 + r32;
    const size_t qrow = (size_t)b * SEQ + qs;
    bf16x8 qr[ND];
    if (DK == 96) {
        const bf16_t* qp = (const bf16_t*)(ws + WS_QM) + qrow * 768 + h * 96;
#pragma unroll
        for (int d0 = 0; d0 < 4; ++d0) { const u32x4 w = *(const u32x4*)(qp + 16 * d0 + 8 * hi); u32x4 o;
            o.x = cvtpk(bflo(w.x) * QSCALE_MLA, bfhi(w.x) * QSCALE_MLA); o.y = cvtpk(bflo(w.y) * QSCALE_MLA, bfhi(w.y) * QSCALE_MLA);
            o.z = cvtpk(bflo(w.z) * QSCALE_MLA, bfhi(w.z) * QSCALE_MLA); o.w = cvtpk(bflo(w.w) * QSCALE_MLA, bfhi(w.w) * QSCALE_MLA);
            qr[d0] = __builtin_bit_cast(bf16x8, o); }
        const int prow = qs >> 6, pcol = qs & 63;
#pragma unroll
        for (int c = 0; c < 2; ++c) {
            const u32x4 wa = *(const u32x4*)(qp + 64 + 16 * c);
            const u32x4 wb = *(const u32x4*)(qp + 64 + 16 * c + 8);
            const float pos = (float)(c == 0 ? prow : pcol);
            float av[8] = {bflo(wa.x), bfhi(wa.x), bflo(wa.y), bfhi(wa.y), bflo(wa.z), bfhi(wa.z), bflo(wa.w), bfhi(wa.w)};
            float bv[8] = {bflo(wb.x), bfhi(wb.x), bflo(wb.y), bfhi(wb.y), bflo(wb.z), bfhi(wb.z), bflo(wb.w), bfhi(wb.w)};
            float ov[8];
#pragma unroll
            for (int j = 0; j < 8; ++j) { const float inv = inv_theta((float)j / 8.0f); const float ang = pos * inv; const float cs = fcos(ang), sn = fsin(ang);
                const float lo = av[j] * cs - bv[j] * sn, hv = av[j] * sn + bv[j] * cs; ov[j] = (hi ? hv : lo) * QSCALE_MLA; }
            u32x4 o; o.x = cvtpk(ov[0], ov[1]); o.y = cvtpk(ov[2], ov[3]); o.z = cvtpk(ov[4], ov[5]); o.w = cvtpk(ov[6], ov[7]);
            qr[4 + c] = __builtin_bit_cast(bf16x8, o);
        }
    } else {
        const bf16_t* qp = (const bf16_t*)(ws + WS_QG) + qrow * 512 + (h - 8) * 64;
#pragma unroll
        for (int d0 = 0; d0 < ND; ++d0) qr[d0] = *(const bf16x8*)(qp + 16 * d0 + 8 * hi);
    }
    const int kkey = tid & 63, kc0 = tid >> 6;
    const int vkv = tid >> 3, vdc = tid & 7;
    const unsigned kdst0 = kc0 * 1024 + kkey * 16, kdst1 = (kc0 + 8) * 1024 + kkey * 16;
    const unsigned vdst = (vdc >> 2) * 4096 + (vkv >> 4) * 1024 + (vkv & 15) * 64 + (vdc & 3) * 16;
    u32x4 kreg0, kreg1, vreg;
    auto load_tile = [&](int kt) {
        const size_t rk = key_row(b, kt * 64 + kkey), rv = key_row(b, kt * 64 + vkv);
        if (DK == 96) {
            kreg0 = *(const u32x4*)(KV + rk * 1024 + h * 128 + 8 * kc0);
            if (wid < 4) kreg1 = *(const u32x4*)(KR + rk * 32 + 8 * kc0);
            vreg = *(const u32x4*)(KV + rv * 1024 + h * 128 + 64 + 8 * vdc);
        } else {
            kreg0 = *(const u32x4*)(KG + rk * 128 + kvh * 64 + 8 * kc0);
            vreg = *(const u32x4*)(VG + rv * 128 + kvh * 64 + 8 * vdc);
        }
    };
    auto store_tile = [&](int buf) {
        *(LAS u32x4*)(Kb + buf * KB + kdst0) = kreg0;
        if (DK == 96) { if (wid < 4) *(LAS u32x4*)(Kb + buf * KB + kdst1) = kreg1; }
        *(LAS u32x4*)(Vb + buf * VB + vdst) = vreg;
    };
    f32x16 o0 = {}, o1 = {};
    float mrun = -1e30f, lrun = 0.f;
    const unsigned kfo = hi * 1024 + r32 * 16;
    const unsigned vfo = ((lane >> 4) & 1) * 32 + (lane & 3) * 8 + (4 * hi + ((lane & 15) >> 2)) * 64;
    load_tile(0); store_tile(0);
    __syncthreads();
    constexpr int NT = TKEYS / 64;
    for (int kt = 0; kt < NT; ++kt) {
        const int buf = kt & 1;
        if (kt + 1 < NT) load_tile(kt + 1);
        f32x16 p0 = {}, p1 = {};
        const LAS unsigned char* kp = Kb + buf * KB + kfo;
#pragma unroll
        for (int d0 = 0; d0 < ND; ++d0) {
            const bf16x8 k0 = *(const LAS bf16x8*)(kp + d0 * 2048), k1 = *(const LAS bf16x8*)(kp + d0 * 2048 + 512);
            p0 = __builtin_amdgcn_mfma_f32_32x32x16_bf16(k0, qr[d0], p0, 0, 0, 0);
            p1 = __builtin_amdgcn_mfma_f32_32x32x16_bf16(k1, qr[d0], p1, 0, 0, 0);
        }
        float mx = fmaxf(p0[0], p1[0]);
#pragma unroll
        for (int r = 1; r < 16; ++r) mx = fmaxf(mx, fmaxf(p0[r], p1[r]));
        mx = fmaxf(mx, __shfl_xor(mx, 32));
        const float mnew = fmaxf(mrun, mx), alpha = __builtin_amdgcn_exp2f(mrun - mnew);
        mrun = mnew;
        float rs = 0.f;
#pragma unroll
        for (int r = 0; r < 16; ++r) { p0[r] = __builtin_amdgcn_exp2f(p0[r] - mnew); p1[r] = __builtin_amdgcn_exp2f(p1[r] - mnew); rs += p0[r] + p1[r]; }
        lrun = lrun * alpha + rs;
        if (hi == 0) wsf[r32] = alpha;
        asm volatile("s_waitcnt lgkmcnt(0)" ::: "memory");
#pragma unroll
        for (int g4 = 0; g4 < 4; ++g4) { const f32x4 a4 = *(const LAS f32x4*)(wsf + 8 * g4 + 4 * hi);
#pragma unroll
            for (int e = 0; e < 4; ++e) { o0[4 * g4 + e] *= a4[e]; o1[4 * g4 + e] *= a4[e]; } }
        u32x4 pw[4];
        pw[0] = (u32x4){cvtpk(p0[0], p0[1]), cvtpk(p0[2], p0[3]), cvtpk(p0[4], p0[5]), cvtpk(p0[6], p0[7])};
        pw[1] = (u32x4){cvtpk(p0[8], p0[9]), cvtpk(p0[10], p0[11]), cvtpk(p0[12], p0[13]), cvtpk(p0[14], p0[15])};
        pw[2] = (u32x4){cvtpk(p1[0], p1[1]), cvtpk(p1[2], p1[3]), cvtpk(p1[4], p1[5]), cvtpk(p1[6], p1[7])};
        pw[3] = (u32x4){cvtpk(p1[8], p1[9]), cvtpk(p1[10], p1[11]), cvtpk(p1[12], p1[13]), cvtpk(p1[14], p1[15])};
        const LAS unsigned char* vp = Vb + buf * VB + vfo;
#pragma unroll
        for (int ks = 0; ks < 4; ++ks) {
            const bf16x8 pa = __builtin_bit_cast(bf16x8, pw[ks]);
            const s16x4 l0 = __builtin_amdgcn_ds_read_tr16_b64_v4i16((LAS s16x4*)(vp + ks * 1024));
            const s16x4 h0 = __builtin_amdgcn_ds_read_tr16_b64_v4i16((LAS s16x4*)(vp + ks * 1024 + 512));
            const s16x4 l1 = __builtin_amdgcn_ds_read_tr16_b64_v4i16((LAS s16x4*)(vp + 4096 + ks * 1024));
            const s16x4 h1 = __builtin_amdgcn_ds_read_tr16_b64_v4i16((LAS s16x4*)(vp + 4096 + ks * 1024 + 512));
            const bf16x8 v0 = {l0[0], l0[1], l0[2], l0[3], h0[0], h0[1], h0[2], h0[3]};
            const bf16x8 v1 = {l1[0], l1[1], l1[2], l1[3], h1[0], h1[1], h1[2], h1[3]};
            o0 = __builtin_amdgcn_mfma_f32_32x32x16_bf16(pa, v0, o0, 0, 0, 0);
            o1 = __builtin_amdgcn_mfma_f32_32x32x16_bf16(pa, v1, o1, 0, 0, 0);
        }
        if (kt + 1 < NT) store_tile(buf ^ 1);
        __syncthreads();
    }
    lrun += __shfl_xor(lrun, 32);
    if (hi == 0) wsf[32 + r32] = lrun;
    asm volatile("s_waitcnt lgkmcnt(0)" ::: "memory");
    bf16_t* Ow = (bf16_t*)(ws + WS_O) + ((size_t)b * SEQ + qb * 256 + wid * 32) * 1024 + h * 64;
#pragma unroll
    for (int r = 0; r < 16; ++r) { const int orow = crow(r, hi); const float rl = __builtin_amdgcn_rcpf(wsf[32 + orow]);
        Ow[(size_t)orow * 1024 + r32] = (bf16_t)f2bf(o0[r] * rl); Ow[(size_t)orow * 1024 + 32 + r32] = (bf16_t)f2bf(o1[r] * rl); }
    __syncthreads();
}
template <int DK>
__device__ __forceinline__ void attn_unit2(const Ctx& p, const int tid, int b, int h, int qb, LAS unsigned char* lds) {
    constexpr int ND = DK / 16;
    constexpr int KB = 12288, VB = 8192, NT = TKEYS / 64;
    constexpr float THR = 8.0f;
    unsigned char* ws = p.ws;
    const int lane = tid & 63, r32 = lane & 31, hi = lane >> 5; const int wid = __builtin_amdgcn_readfirstlane(tid >> 6);
    const bf16_t* KV = (const bf16_t*)(ws + WS_KV); const bf16_t* KR = (const bf16_t*)(ws + WS_KROPE);
    const bf16_t* KG = (const bf16_t*)(ws + WS_KG); const bf16_t* VG = (const bf16_t*)(ws + WS_VG);
    const int kvh = (h - 8) >> 2;
    LAS unsigned char* Kb = lds; LAS unsigned char* Vb = lds + 2 * KB; LAS float* wsf = (LAS float*)(lds + 2 * KB + 2 * VB) + wid * 64;
    const int qs = qb * 256 + wid * 32 + r32;
    const size_t qrow = (size_t)b * SEQ + qs;
    bf16x8 qr[ND];
    if (DK == 96) {
        const bf16_t* qp = (const bf16_t*)(ws + WS_QM) + qrow * 768 + h * 96;
#pragma unroll
        for (int d0 = 0; d0 < 4; ++d0) { const u32x4 w = *(const u32x4*)(qp + 16 * d0 + 8 * hi); u32x4 o;
            o.x = cvtpk(bflo(w.x) * QSCALE_MLA, bfhi(w.x) * QSCALE_MLA); o.y = cvtpk(bflo(w.y) * QSCALE_MLA, bfhi(w.y) * QSCALE_MLA);
            o.z = cvtpk(bflo(w.z) * QSCALE_MLA, bfhi(w.z) * QSCALE_MLA); o.w = cvtpk(bflo(w.w) * QSCALE_MLA, bfhi(w.w) * QSCALE_MLA);
            qr[d0] = __builtin_bit_cast(bf16x8, o); }
        const int prow = qs >> 6, pcol = qs & 63;
#pragma unroll
        for (int c = 0; c < 2; ++c) {
            const u32x4 wa = *(const u32x4*)(qp + 64 + 16 * c);
            const u32x4 wb = *(const u32x4*)(qp + 64 + 16 * c + 8);
            const float pos = (float)(c == 0 ? prow : pcol);
            float av[8], bv[8], ov[8]; unpack8(wa, av); unpack8(wb, bv);
#pragma unroll
            for (int j = 0; j < 8; ++j) { const float inv = inv_theta((float)j / 8.0f); const float ang = pos * inv; const float cs = fcos(ang), sn = fsin(ang);
                const float lo = av[j] * cs - bv[j] * sn, hv = av[j] * sn + bv[j] * cs; ov[j] = (hi ? hv : lo) * QSCALE_MLA; }
            qr[4 + c] = __builtin_bit_cast(bf16x8, pack8(ov));
        }
    } else {
        const bf16_t* qp = (const bf16_t*)(ws + WS_QG) + qrow * 512 + (h - 8) * 64;
#pragma unroll
        for (int d0 = 0; d0 < ND; ++d0) qr[d0] = *(const bf16x8*)(qp + 16 * d0 + 8 * hi);
    }
    const int kkey = tid & 63, kc0 = tid >> 6, vkv = tid >> 3, vdc = tid & 7;
    const unsigned kdst0 = kc0 * 1024 + kkey * 16, kdst1 = (kc0 + 8) * 1024 + kkey * 16;
    const unsigned vdst = (vdc >> 2) * 4096 + (vkv >> 4) * 1024 + (vkv & 15) * 64 + (vdc & 3) * 16;
    u32x4 kreg0, kreg1, vreg;
    auto load_k = [&](int kt) { const size_t rk = key_row(b, kt * 64 + kkey);
        if (DK == 96) { kreg0 = *(const u32x4*)(KV + rk * 1024 + h * 128 + 8 * kc0); if (wid < 4) kreg1 = *(const u32x4*)(KR + rk * 32 + 8 * kc0); }
        else kreg0 = *(const u32x4*)(KG + rk * 128 + kvh * 64 + 8 * kc0); };
    auto load_v = [&](int kt) { const size_t rv = key_row(b, kt * 64 + vkv);
        if (DK == 96) vreg = *(const u32x4*)(KV + rv * 1024 + h * 128 + 64 + 8 * vdc); else vreg = *(const u32x4*)(VG + rv * 128 + kvh * 64 + 8 * vdc); };
    auto store_k = [&](int buf) { *(LAS u32x4*)(Kb + buf * KB + kdst0) = kreg0; if (DK == 96) { if (wid < 4) *(LAS u32x4*)(Kb + buf * KB + kdst1) = kreg1; } };
    auto store_v = [&](int buf) { *(LAS u32x4*)(Vb + buf * VB + vdst) = vreg; };
    f32x16 o0 = {}, o1 = {};
    float mhat = 0.f, lrun = 0.f;
    const unsigned kfo = hi * 1024 + r32 * 16;
    const unsigned vfo = ((lane >> 4) & 1) * 32 + (lane & 3) * 8 + (4 * hi + ((lane & 15) >> 2)) * 64;
#define A2_SBAR() __builtin_amdgcn_sched_barrier(0)
#define A2_EL(X0, X1, i) ((i) < 16 ? X0[(i) & 15] : X1[(i) & 15])
    f32x16 negm; { float z0 = 0.f; asm volatile("" : "+v"(z0));
#pragma unroll
        for (int r = 0; r < 16; ++r) negm[r] = z0; }
    float rmx = 0.f;
#define A2_STEP(C0, C1, P0, P1, T, HASK) do { const int t_ = (T); \
        float f_ = 1.0f; const bool resc_ = __any(rmx > THR); \
        if (resc_) { const float dl_ = __builtin_fmaxf(rmx, 0.f); mhat += dl_; f_ = __builtin_amdgcn_exp2f(-dl_); if (hi == 0) wsf[r32] = f_; \
            _Pragma("unroll") for (int r = 0; r < 16; ++r) negm[r] = -mhat; } \
        if (HASK) load_k(t_ + 1); \
        load_v(t_); \
        const LAS unsigned char* kp_ = Kb + (t_ & 1) * KB + kfo; const LAS unsigned char* vp_ = Vb + ((t_ + 1) & 1) * VB + vfo; \
        float sacc_ = 0.f; unsigned pw_[16]; s16x4 vl_[8], vh_[8]; bf16x8 kf_[2 * ND]; \
        kf_[0] = *(const LAS bf16x8*)(kp_); kf_[1] = *(const LAS bf16x8*)(kp_ + 512); \
        A2_SBAR(); \
        _Pragma("unroll") for (int g = 0; g < 2 * ND; ++g) { \
            if (g + 2 < 2 * ND) kf_[g + 2] = *(const LAS bf16x8*)(kp_ + ((g + 2) >> 1) * 2048 + ((g + 2) & 1) * 512); \
            if (g < 8) { vl_[g] = __builtin_amdgcn_ds_read_tr16_b64_v4i16((LAS s16x4*)(vp_ + (g >> 2) * 4096 + (g & 3) * 1024)); \
                         vh_[g] = __builtin_amdgcn_ds_read_tr16_b64_v4i16((LAS s16x4*)(vp_ + (g >> 2) * 4096 + (g & 3) * 1024 + 512)); } \
            if ((g & 1) == 0) { if (g == 0) C0 = __builtin_amdgcn_mfma_f32_32x32x16_bf16(kf_[g], qr[g >> 1], negm, 0, 0, 0); else C0 = __builtin_amdgcn_mfma_f32_32x32x16_bf16(kf_[g], qr[g >> 1], C0, 0, 0, 0); } \
            else { if (g == 1) C1 = __builtin_amdgcn_mfma_f32_32x32x16_bf16(kf_[g], qr[g >> 1], negm, 0, 0, 0); else C1 = __builtin_amdgcn_mfma_f32_32x32x16_bf16(kf_[g], qr[g >> 1], C1, 0, 0, 0); } \
            { constexpr int NA = (ND == 6) ? 3 : 4; \
                _Pragma("unroll") for (int i = 0; i < NA; ++i) { const int e = NA * g + i; if (e < 32) sacc_ += A2_EL(P0, P1, e); } \
                if (g < 8) { pw_[2 * g] = cvtpk(A2_EL(P0, P1, 4 * g), A2_EL(P0, P1, 4 * g + 1)); pw_[2 * g + 1] = cvtpk(A2_EL(P0, P1, 4 * g + 2), A2_EL(P0, P1, 4 * g + 3)); asm volatile("" : "+v"(pw_[2 * g]), "+v"(pw_[2 * g + 1])); } \
                asm volatile("" : "+v"(sacc_)); } \
            A2_SBAR(); } \
        lrun = (lrun + sacc_) * f_; \
        float rm_ = 0.f; \
        _Pragma("unroll") for (int g = 0; g < 8; ++g) { \
            { const int ks = g >> 1, dv = g & 1; const u32x4 pa_ = {pw_[4 * ks], pw_[4 * ks + 1], pw_[4 * ks + 2], pw_[4 * ks + 3]}; \
                const s16x4 l_ = vl_[dv * 4 + ks], h_ = vh_[dv * 4 + ks]; const bf16x8 vf_ = {l_[0], l_[1], l_[2], l_[3], h_[0], h_[1], h_[2], h_[3]}; \
                if (dv == 0) o0 = __builtin_amdgcn_mfma_f32_32x32x16_bf16(__builtin_bit_cast(bf16x8, pa_), vf_, o0, 0, 0, 0); \
                else o1 = __builtin_amdgcn_mfma_f32_32x32x16_bf16(__builtin_bit_cast(bf16x8, pa_), vf_, o1, 0, 0, 0); } \
            if (g == 0) { rm_ = __builtin_fmaxf(__builtin_fmaxf(C0[0], C0[1]), __builtin_fmaxf(C0[2], C0[3])); }          \
            else if (g == 4) { rm_ = __builtin_fmaxf(rm_, __builtin_fmaxf(__builtin_fmaxf(C1[0], C1[1]), __builtin_fmaxf(C1[2], C1[3]))); } \
            else if (g < 4) { rm_ = max3f(rm_, C0[4 * g], C0[4 * g + 1]); rm_ = max3f(rm_, C0[4 * g + 2], C0[4 * g + 3]); } \
            else { rm_ = max3f(rm_, C1[4 * g - 16], C1[4 * g - 15]); rm_ = max3f(rm_, C1[4 * g - 14], C1[4 * g - 13]); } \
            asm volatile("" : "+v"(rm_)); \
            _Pragma("unroll") for (int i = 0; i < 4; ++i) { const int e = 4 * g + i; if (e < 16) C0[e & 15] = __builtin_amdgcn_exp2f(C0[e & 15]); else C1[e & 15] = __builtin_amdgcn_exp2f(C1[e & 15]); } \
            if (g < 4) asm volatile("" : "+v"(C0)); else asm volatile("" : "+v"(C1)); \
            A2_SBAR(); } \
        { auto rr_ = __builtin_amdgcn_permlane32_swap(__float_as_uint(rm_), __float_as_uint(rm_), false, false); rmx = __builtin_fmaxf(__uint_as_float(rr_[0]), __uint_as_float(rr_[1])); } \
        if (resc_) { asm volatile("s_waitcnt lgkmcnt(0)" ::: "memory"); \
            _Pragma("unroll") for (int g4 = 0; g4 < 4; ++g4) { const f32x4 a4 = *(const LAS f32x4*)(wsf + 8 * g4 + 4 * hi); \
                _Pragma("unroll") for (int e = 0; e < 4; ++e) { o0[4 * g4 + e] *= a4[e]; o1[4 * g4 + e] *= a4[e]; } } } \
        if (HASK) store_k((t_ + 1) & 1); \
        store_v(t_ & 1); \
        __syncthreads(); } while (0)
    if (wid >= 4) __builtin_amdgcn_s_setprio(1);
    load_k(0); store_k(0);
    __syncthreads();
    f32x16 sA0, sA1, sB0, sB1;
    {
        load_k(1); load_v(0);
        const LAS unsigned char* kp_ = Kb + kfo;
#pragma unroll
        for (int d0 = 0; d0 < ND; ++d0) { const bf16x8 k0 = *(const LAS bf16x8*)(kp_ + d0 * 2048), k1 = *(const LAS bf16x8*)(kp_ + d0 * 2048 + 512);
            sA0 = __builtin_amdgcn_mfma_f32_32x32x16_bf16(k0, qr[d0], d0 == 0 ? negm : sA0, 0, 0, 0); sA1 = __builtin_amdgcn_mfma_f32_32x32x16_bf16(k1, qr[d0], d0 == 0 ? negm : sA1, 0, 0, 0); }
        float rm = __builtin_fmaxf(sA0[0], sA1[0]);
#pragma unroll
        for (int r = 1; r < 16; ++r) rm = __builtin_fmaxf(rm, __builtin_fmaxf(sA0[r], sA1[r]));
        { auto rr = __builtin_amdgcn_permlane32_swap(__float_as_uint(rm), __float_as_uint(rm), false, false); rm = __builtin_fmaxf(__uint_as_float(rr[0]), __uint_as_float(rr[1])); }
        mhat = rm;
#pragma unroll
        for (int r = 0; r < 16; ++r) { negm[r] = -mhat; sA0[r] = __builtin_amdgcn_exp2f(sA0[r] - mhat); sA1[r] = __builtin_amdgcn_exp2f(sA1[r] - mhat); }
        store_k(1); store_v(0);
        __syncthreads();
    }
    for (int t = 1; t + 1 < NT; t += 2) {
        A2_STEP(sB0, sB1, sA0, sA1, t, true);
        A2_STEP(sA0, sA1, sB0, sB1, t + 1, true);
    }
    A2_STEP(sB0, sB1, sA0, sA1, NT - 1, false);
    {
        float sacc = 0.f;
#pragma unroll
        for (int r = 0; r < 16; ++r) sacc += sB0[r] + sB1[r];
        lrun += sacc;
        const LAS unsigned char* vp = Vb + ((NT - 1) & 1) * VB + vfo;
#pragma unroll
        for (int ks = 0; ks < 4; ++ks) {
            const f32x16& P = (ks < 2) ? sB0 : sB1; const int bse = 8 * (ks & 1);
            const u32x4 pa = {cvtpk(P[bse], P[bse + 1]), cvtpk(P[bse + 2], P[bse + 3]), cvtpk(P[bse + 4], P[bse + 5]), cvtpk(P[bse + 6], P[bse + 7])};
            const s16x4 l0 = __builtin_amdgcn_ds_read_tr16_b64_v4i16((LAS s16x4*)(vp + ks * 1024)), h0 = __builtin_amdgcn_ds_read_tr16_b64_v4i16((LAS s16x4*)(vp + ks * 1024 + 512));
            const s16x4 l1 = __builtin_amdgcn_ds_read_tr16_b64_v4i16((LAS s16x4*)(vp + 4096 + ks * 1024)), h1 = __builtin_amdgcn_ds_read_tr16_b64_v4i16((LAS s16x4*)(vp + 4096 + ks * 1024 + 512));
            const bf16x8 v0 = {l0[0], l0[1], l0[2], l0[3], h0[0], h0[1], h0[2], h0[3]}, v1 = {l1[0], l1[1], l1[2], l1[3], h1[0], h1[1], h1[2], h1[3]};
            o0 = __builtin_amdgcn_mfma_f32_32x32x16_bf16(__builtin_bit_cast(bf16x8, pa), v0, o0, 0, 0, 0);
            o1 = __builtin_amdgcn_mfma_f32_32x32x16_bf16(__builtin_bit_cast(bf16x8, pa), v1, o1, 0, 0, 0);
        }
    }
#undef A2_STEP
#undef A2_EL
#undef A2_SBAR
    __builtin_amdgcn_s_setprio(0);
    lrun += __shfl_xor(lrun, 32);
    if (hi == 0) wsf[32 + r32] = lrun;
    asm volatile("s_waitcnt lgkmcnt(0)" ::: "memory");
    bf16_t* Ow = (bf16_t*)(ws + WS_O) + ((size_t)b * SEQ + qb * 256 + wid * 32) * 1024 + h * 64;
#pragma unroll
    for (int r = 0; r < 16; ++r) { const int orow = crow(r, hi); const float rl = __builtin_amdgcn_rcpf(wsf[32 + orow]);
        Ow[(size_t)orow * 1024 + r32] = (bf16_t)f2bf(o0[r] * rl); Ow[(size_t)orow * 1024 + 32 + r32] = (bf16_t)f2bf(o1[r] * rl); }
    __syncthreads();
}
__device__ __forceinline__ void phase_attn(const Ctx& p, LAS unsigned char* lds) {
    const int xcd = p.bid & 7, sl = p.bid >> 3, c = sl & 1, b = 2 * xcd + (sl >> 4), qb = (sl >> 1) & 7;
    for (int i = 0; i < 8; ++i) { const int h = 2 * i + (c & 1);
#if ATTN_V1
        if (h < 8) attn_unit<96>(p, b, h, qb, lds); else attn_unit<64>(p, b, h, qb, lds); }
#else
        int tid = p.tid; asm volatile("" : "+v"(tid));
        if (h < 8) attn_unit2<96>(p, tid, b, h, qb, lds); else attn_unit2<64>(p, tid, b, h, qb, lds); }
#endif
}

__device__ __forceinline__ void hyena_taps(const Ctx& p, int c, LAS unsigned char* scratch, float (&taps)[4][2][2]) {
    const int tid = p.tid, lane = tid & 63, wave = __builtin_amdgcn_readfirstlane(tid >> 6);
    LAS float* w4s = (LAS float*)scratch;
    LAS float* red = (LAS float*)(scratch + 1024);
    const float* w4 = p.in[I_FW4]; const float* H3 = (const float*)(p.ws + WS_H3);
    if (tid < 256) { const int cc = tid >> 6, k = tid & 63; w4s[cc * 64 + k] = w4[(size_t)k * 4096 + (cc >> 1) * 2048 + (cc & 1) * 1024 + c]; }
    __syncthreads();
    const float dmin = -3.0701134573253940f, dmax = -15.350567286626970f;
    const float delta = fabsf(dmin + (float)c * ((dmax - dmin) / 1023.0f));
    float ss0 = 0.f, ss1 = 0.f;
    float a[4][4];
#pragma unroll
    for (int i = 0; i < 4; ++i)
#pragma unroll
        for (int cc = 0; cc < 4; ++cc) a[i][cc] = 0.f;
#pragma unroll 2
    for (int k4 = 0; k4 < 16; ++k4) {
        f32x4 wv[4];
#pragma unroll
        for (int cc = 0; cc < 4; ++cc) wv[cc] = *(const LAS f32x4*)(w4s + cc * 64 + 4 * k4);
#pragma unroll
        for (int i = 0; i < 4; ++i) { const f32x4 hv = *((const f32x4*)(H3 + (size_t)(tid + 512 * i) * 64) + k4);
#pragma unroll
            for (int cc = 0; cc < 4; ++cc) a[i][cc] += (hv[0] * wv[cc][0] + hv[1] * wv[cc][1]) + (hv[2] * wv[cc][2] + hv[3] * wv[cc][3]); }
    }
#pragma unroll
    for (int i = 0; i < 4; ++i) {
        const int t = tid + 512 * i;
        const float win = expf(-((float)t / 2048.0f) * delta);
#pragma unroll
        for (int cc = 0; cc < 4; ++cc) a[i][cc] *= win;
        taps[i][0][0] = a[i][0]; taps[i][0][1] = a[i][1]; taps[i][1][0] = a[i][2]; taps[i][1][1] = a[i][3];
        ss0 += a[i][0] * a[i][0] + a[i][2] * a[i][2]; ss1 += a[i][1] * a[i][1] + a[i][3] * a[i][3];
    }
    ss0 = wave_sum(ss0); ss1 = wave_sum(ss1);
    if (lane == 0) { red[wave * 2] = ss0; red[wave * 2 + 1] = ss1; }
    __syncthreads();
    float t0 = 0.f, t1 = 0.f;
#pragma unroll
    for (int w = 0; w < 8; ++w) { t0 += red[w * 2]; t1 += red[w * 2 + 1]; }
    const float n0 = rsqrtf(t0 + EPS), n1 = rsqrtf(t1 + EPS);
#pragma unroll
    for (int i = 0; i < 4; ++i) { taps[i][0][0] *= n0; taps[i][1][0] *= n0; taps[i][0][1] *= n1; taps[i][1][1] *= n1; }
    __syncthreads();
}
__device__ __forceinline__ void hyena_taps_block(const Ctx& p, LAS unsigned char* lds) {
    const int tid = p.tid, lane = tid & 63, wave = __builtin_amdgcn_readfirstlane(tid >> 6), fr = lane & 15, fq = lane >> 4;
    LAS float* w4s = (LAS float*)lds;
    LAS float* red = (LAS float*)(lds + 4096);
    const float* w4 = p.in[I_FW4]; const float* H3 = (const float*)(p.ws + WS_H3); bf16_t* F = (bf16_t*)(p.ws + WS_FILT);
    for (int i = tid; i < 1024; i += NTHREADS) { const int col = i >> 6, k = i & 63, q = col >> 2, cc = col & 3; const int c = p.bid + p.nblk * q;
        w4s[i] = (c < DM) ? w4[(size_t)k * 4096 + (cc >> 1) * 2048 + (cc & 1) * 1024 + c] : 0.f; }
    __syncthreads();
    bf16x8 bfr[2];
#pragma unroll
    for (int ks = 0; ks < 2; ++ks) { const f32x4 b0 = *(const LAS f32x4*)(w4s + fr * 64 + 32 * ks + 8 * fq), b1 = *(const LAS f32x4*)(w4s + fr * 64 + 32 * ks + 8 * fq + 4);
        const u32x4 w = {cvtpk(b0[0], b0[1]), cvtpk(b0[2], b0[3]), cvtpk(b1[0], b1[1]), cvtpk(b1[2], b1[3])}; bfr[ks] = __builtin_bit_cast(bf16x8, w); }
    f32x4 acc[16];
#pragma unroll
    for (int g = 0; g < 4; ++g) {
        f32x4 hv[4][2][2];
#pragma unroll
        for (int j = 0; j < 4; ++j)
#pragma unroll
            for (int ks = 0; ks < 2; ++ks) { const float* hp = H3 + (size_t)(16 * (wave * 16 + 4 * g + j) + fr) * 64 + 32 * ks + 8 * fq; hv[j][ks][0] = *(const f32x4*)hp; hv[j][ks][1] = *(const f32x4*)(hp + 4); }
#pragma unroll
        for (int j = 0; j < 4; ++j) { f32x4 a = {0.f, 0.f, 0.f, 0.f};
#pragma unroll
            for (int ks = 0; ks < 2; ++ks) { const f32x4 h0 = hv[j][ks][0], h1 = hv[j][ks][1];
                const u32x4 w = {cvtpk(h0[0], h0[1]), cvtpk(h0[2], h0[3]), cvtpk(h1[0], h1[1]), cvtpk(h1[2], h1[3])};
                a = __builtin_amdgcn_mfma_f32_16x16x32_bf16(__builtin_bit_cast(bf16x8, w), bfr[ks], a, 0, 0, 0); }
            acc[4 * g + j] = a; }
        __builtin_amdgcn_sched_barrier(0);
    }
    const int q = fr >> 2, o = fr & 1, dir = (fr >> 1) & 1, c = p.bid + p.nblk * q;
    const float dmin = -3.0701134573253940f, dmax = -15.350567286626970f;
    const float delta = fabsf(dmin + (float)c * ((dmax - dmin) / 1023.0f));
    const float r1 = expf(-delta / 2048.0f);
    float ssq = 0.f;
#pragma unroll
    for (int tt = 0; tt < 16; ++tt) { const int tb = 16 * (16 * wave + tt) + 4 * fq; float win = expf(-((float)tb / 2048.0f) * delta);
#pragma unroll
        for (int e = 0; e < 4; ++e) { const float v = acc[tt][e] * win; acc[tt][e] = v; ssq += v * v; win *= r1; } }
    ssq += __shfl_xor(ssq, 16); ssq += __shfl_xor(ssq, 32); ssq += __shfl_xor(ssq, 2);
    if (fq == 0 && dir == 0) red[wave * 8 + q * 2 + o] = ssq;
    __syncthreads();
    float tot = 0.f;
#pragma unroll
    for (int w = 0; w < 8; ++w) tot += red[w * 8 + q * 2 + o];
    const float nrm = rsqrtf(tot + EPS);
    LAS bf16_t* st = (LAS bf16_t*)(lds + 8192) + (q * 2 + o) * 4096 + 2048;
#pragma unroll
    for (int tt = 0; tt < 16; ++tt)
#pragma unroll
        for (int e = 0; e < 4; ++e) { const int t = 16 * (16 * wave + tt) + 4 * fq + e; const bf16_t v = (bf16_t)f2bf(acc[tt][e] * nrm);
            if (dir == 0) st[-t] = v; else if (t > 0) st[t] = v; }
    __syncthreads();
#pragma unroll
    for (int j = 0; j < 8; ++j) { const int idx = tid + 512 * j, arr = idx >> 9, off = idx & 511; const int cq = p.bid + p.nblk * (arr >> 1);
        const u32x4 w = *(const LAS u32x4*)(lds + 8192 + arr * 8192 + off * 16);
        if (cq < DM) *(u32x4*)(F + (size_t)(cq * 2 + (arr & 1)) * 4096 + 8 * off) = w; }
    __builtin_amdgcn_fence(__ATOMIC_RELEASE, "workgroup");
    asm volatile("s_waitcnt vmcnt(0)" ::: "memory");
    __syncthreads();
    __builtin_amdgcn_fence(__ATOMIC_ACQUIRE, "workgroup");
}
__device__ __forceinline__ float sconv_at(const bf16_t* zr, int b, int n, float w0, float w1, float w2, float cb) {
    const bf16_t* q = zr + b * SEQ + n;
    const float l = n > 0 ? bf2f(q[-1]) : 0.f, m = bf2f(q[0]), r = n < SEQ - 1 ? bf2f(q[1]) : 0.f;
    return cb + w0 * l + w1 * m + w2 * r;
}

__device__ __forceinline__ void phase_nconv_filt(const Ctx& p, LAS unsigned char* lds) {
    bf16_t* F = (bf16_t*)(p.ws + WS_FILT);
    for (int c = p.bid; c < DM; c += p.nblk) {
        float taps[4][2][2];
        hyena_taps(p, c, lds, taps);
#pragma unroll
        for (int i = 0; i < 4; ++i) { const int t = p.tid + 512 * i;
#pragma unroll
            for (int o = 0; o < 2; ++o) { bf16_t* f = F + (size_t)(c * 2 + o) * 4096;
                f[2048 - t] = (bf16_t)f2bf(taps[i][0][o]);
                if (t > 0) f[2048 + t] = (bf16_t)f2bf(taps[i][1][o]); } }
    }
}
__device__ __forceinline__ void phase_nconv_u0(const Ctx& p) {
    const bf16_t* ZT = (const bf16_t*)(p.ws + WS_ZT); bf16_t* U0 = (bf16_t*)(p.ws + WS_U0T);
    const float* cw = p.in[I_HCW]; const float* cb = p.in[I_HCB];
    for (size_t idx = (size_t)p.bid * NTHREADS + p.tid; idx < (size_t)DM * ML; idx += (size_t)p.nblk * NTHREADS) {
        const int c = (int)(idx >> 15), bn = (int)(idx & 32767), b = bn >> 11, n = bn & 2047; const int ch = 2048 + c;
        U0[idx] = (bf16_t)f2bf(sconv_at(ZT + (size_t)ch * ML, b, n, cw[ch], cw[3072 + ch], cw[6144 + ch], cb[ch]));
    }
}
__device__ __forceinline__ void phase_nconv_pass(const Ctx& p, int o) {
    const bf16_t* ZT = (const bf16_t*)(p.ws + WS_ZT); const bf16_t* F = (const bf16_t*)(p.ws + WS_FILT);
    const bf16_t* U = (const bf16_t*)(p.ws + (o == 0 ? WS_U0T : WS_Y1T)); bf16_t* Y = (bf16_t*)(p.ws + (o == 0 ? WS_Y1T : WS_Y2T));
    const float* cw = p.in[I_HCW]; const float* cb = p.in[I_HCB]; const float* skip = p.in[I_HSKIP];
    for (size_t idx = (size_t)p.bid * NTHREADS + p.tid; idx < (size_t)DM * ML; idx += (size_t)p.nblk * NTHREADS) {
        const int c = (int)(idx >> 15), bn = (int)(idx & 32767), b = bn >> 11, n = bn & 2047;
        const bf16_t* u = U + (size_t)c * ML + b * SEQ; const bf16_t* f = F + (size_t)(c * 2 + o) * 4096 + 2048 - n;
        float acc = 0.f;
        for (int m = 0; m < SEQ; ++m) acc += bf2f(f[m]) * bf2f(u[m]);
        acc += skip[o * DM + c] * bf2f(u[n]);
        const int ch = o * 1024 + c;
        const float gate = sconv_at(ZT + (size_t)ch * ML, b, n, cw[ch], cw[3072 + ch], cw[6144 + ch], cb[ch]);
        Y[idx] = (bf16_t)f2bf(gate * acc);
    }
}

constexpr int CV_USTRIDE = 4112;
constexpr int CV_U = 0;
constexpr int CV_CP = 65792, CV_CPSTRIDE = 8208;
static_assert(CV_CP + 8 * CV_CPSTRIDE <= LDS_BYTES, "conv LDS map");

__device__ __forceinline__ void conv_build_copies(const int tid, LAS unsigned char* lds, const bf16_t* rev) {
    const u32x4 cur = *(const u32x4*)(rev + 8 * tid);
    u32x4 prv = {0u, 0u, 0u, 0u};
    if (tid > 0) prv = *(const u32x4*)(rev + 8 * tid - 8);
    const unsigned W[8] = {prv.x, prv.y, prv.z, prv.w, cur.x, cur.y, cur.z, cur.w};
#pragma unroll
    for (int rho = 0; rho < 8; ++rho) {
        unsigned o[4];
#pragma unroll
        for (int d = 0; d < 4; ++d) { const int e0 = 8 - rho + 2 * d;
            o[d] = (e0 & 1) ? __builtin_amdgcn_alignbit(W[(e0 >> 1) + 1], W[e0 >> 1], 16) : W[e0 >> 1]; }
        *(LAS u32x4*)(lds + CV_CP + rho * CV_CPSTRIDE + 16 * tid) = (u32x4){o[0], o[1], o[2], o[3]};
    }
}
__device__ __forceinline__ void sconv4(const bf16_t* zr, int n, float w0, float w1, float w2, float cb, float (&g)[4]) {
    const u32x2 w = *(const u32x2*)(zr + n);
    const float l = n > 0 ? bf2f(zr[n - 1]) : 0.f, r = n + 4 < SEQ ? bf2f(zr[n + 4]) : 0.f;
    const float x[6] = {l, bflo(w.x), bfhi(w.x), bflo(w.y), bfhi(w.y), r};
#pragma unroll
    for (int e = 0; e < 4; ++e) g[e] = cb + w0 * x[e] + w1 * x[e + 1] + w2 * x[e + 2];
}
__device__ __forceinline__ void conv_mma(const int tid, LAS unsigned char* lds, f32x4 (&acc)[16]) {
    const int lane = tid & 63, wave = __builtin_amdgcn_readfirstlane(tid >> 6);
#pragma unroll
    for (int i = 0; i < 16; ++i) acc[i] = (f32x4){0.f, 0.f, 0.f, 0.f};
    const LAS unsigned char* ab = lds + CV_CP + (lane & 7) * CV_CPSTRIDE + 2 * (2048 - 8 * ((lane & 15) >> 3) + 8 * (lane >> 4)) - 32 * (16 * wave);
    const LAS unsigned char* ub = lds + CV_U + (lane & 15) * CV_USTRIDE + 16 * (lane >> 4);
    bf16x8 w0, w1, w2, w3, w4, w5, w6, w7, w8, w9, w10, w11, w12, w13, w14, w15;
#define CV_LD(i) (*(const LAS bf16x8*)(ab - 32 * (i)))
    w0 = CV_LD(0); w1 = CV_LD(1); w2 = CV_LD(2); w3 = CV_LD(3); w4 = CV_LD(4); w5 = CV_LD(5); w6 = CV_LD(6); w7 = CV_LD(7);
    w8 = CV_LD(8); w9 = CV_LD(9); w10 = CV_LD(10); w11 = CV_LD(11); w12 = CV_LD(12); w13 = CV_LD(13); w14 = CV_LD(14); w15 = CV_LD(15);
#undef CV_LD
#define CV_MF(i, W) acc[i] = __builtin_amdgcn_mfma_f32_16x16x32_bf16(W, uf, acc[i], 0, 0, 0)
#define CV_STEP(jj, A0, A1, A2, A3, A4, A5, A6, A7, A8, A9, A10, A11, A12, A13, A14, A15) do { \
        const int j = J * 8 + (jj); \
        const int jn = (j + 1 < 64) ? (j + 1) : j; \
        const bf16x8 ufn = *(const LAS bf16x8*)(ub + 64 * jn); \
        const bf16x8 n0 = *(const LAS bf16x8*)(ab + 64 * jn), n1 = *(const LAS bf16x8*)(ab + 64 * jn - 32); \
        CV_MF(0, A0); CV_MF(1, A1); CV_MF(2, A2); CV_MF(3, A3); CV_MF(4, A4); CV_MF(5, A5); CV_MF(6, A6); CV_MF(7, A7); \
        CV_MF(8, A8); CV_MF(9, A9); CV_MF(10, A10); CV_MF(11, A11); CV_MF(12, A12); CV_MF(13, A13); CV_MF(14, A14); CV_MF(15, A15); \
        A14 = n0; A15 = n1; uf = ufn; } while (0)
    bf16x8 uf = *(const LAS bf16x8*)ub;
    for (int J = 0; J < 8; ++J) {
        CV_STEP(0, w0, w1, w2, w3, w4, w5, w6, w7, w8, w9, w10, w11, w12, w13, w14, w15);
        CV_STEP(1, w14, w15, w0, w1, w2, w3, w4, w5, w6, w7, w8, w9, w10, w11, w12, w13);
        CV_STEP(2, w12, w13, w14, w15, w0, w1, w2, w3, w4, w5, w6, w7, w8, w9, w10, w11);
        CV_STEP(3, w10, w11, w12, w13, w14, w15, w0, w1, w2, w3, w4, w5, w6, w7, w8, w9);
        CV_STEP(4, w8, w9, w10, w11, w12, w13, w14, w15, w0, w1, w2, w3, w4, w5, w6, w7);
        CV_STEP(5, w6, w7, w8, w9, w10, w11, w12, w13, w14, w15, w0, w1, w2, w3, w4, w5);
        CV_STEP(6, w4, w5, w6, w7, w8, w9, w10, w11, w12, w13, w14, w15, w0, w1, w2, w3);
        CV_STEP(7, w2, w3, w4, w5, w6, w7, w8, w9, w10, w11, w12, w13, w14, w15, w0, w1);
    }
#undef CV_STEP
#undef CV_MF
}
struct SconvRow { u32x4 w[8]; float prev, last; };
__device__ __forceinline__ void sconv_row_load(const int tid, const bf16_t* zrow, SconvRow& R) {
    const int b = tid >> 5, m0 = (tid & 31) * 64; const bf16_t* zr = zrow + b * SEQ;
#pragma unroll
    for (int k8 = 0; k8 < 8; ++k8) R.w[k8] = *(const u32x4*)(zr + m0 + 8 * k8);
    R.prev = m0 > 0 ? bf2f(zr[m0 - 1]) : 0.f;
    R.last = m0 + 64 < SEQ ? bf2f(zr[m0 + 64]) : 0.f;
}
template <int STRIDE, bool W16>
__device__ __forceinline__ void sconv_row_store(const int tid, const SconvRow& R, float w0, float w1, float w2, float bb, LAS unsigned char* dst) {
    const int b = tid >> 5, m0 = (tid & 31) * 64;
    float prev = R.prev;
#pragma unroll
    for (int k8 = 0; k8 < 8; ++k8) {
        const float nxt = k8 < 7 ? bflo(R.w[k8 < 7 ? k8 + 1 : 7].x) : R.last;
        const float x[10] = {prev, bflo(R.w[k8].x), bfhi(R.w[k8].x), bflo(R.w[k8].y), bfhi(R.w[k8].y), bflo(R.w[k8].z), bfhi(R.w[k8].z), bflo(R.w[k8].w), bfhi(R.w[k8].w), nxt};
        float y[8];
#pragma unroll
        for (int e = 0; e < 8; ++e) y[e] = bb + w0 * x[e] + w1 * x[e + 1] + w2 * x[e + 2];
        const u32x4 o = {cvtpk(y[0], y[1]), cvtpk(y[2], y[3]), cvtpk(y[4], y[5]), cvtpk(y[6], y[7])};
        LAS unsigned char* d = dst + b * STRIDE + 2 * (m0 + 8 * k8);
        if (W16) *(LAS u32x4*)d = o; else { *(LAS u32x2*)d = (u32x2){o.x, o.y}; *(LAS u32x2*)(d + 8) = (u32x2){o.z, o.w}; }
        prev = x[8];
    }
}
constexpr int CV_GSTRIDE = 4104;
static_assert(16 * CV_GSTRIDE <= 8 * CV_CPSTRIDE, "gate image fits the copies region");
__device__ __forceinline__ void phase_conv(const Ctx& p, LAS unsigned char* lds) {
    const bf16_t* ZT = (const bf16_t*)(p.ws + WS_ZT); bf16_t* Y2T = (bf16_t*)(p.ws + WS_Y2T); const bf16_t* F = (const bf16_t*)(p.ws + WS_FILT);
    const float* cw = p.in[I_HCW]; const float* cb = p.in[I_HCB]; const float* skip = p.in[I_HSKIP];
    hyena_taps_block(p, lds);
    for (int c = p.bid; c < DM; c += p.nblk) {
        int tid = p.tid; asm volatile("" : "+v"(tid));
        const int lane = tid & 63, wave = __builtin_amdgcn_readfirstlane(tid >> 6);
        const int b = lane & 15, nq = 256 * wave + 4 * (lane >> 4);
        LAS unsigned char* Ul = lds + CV_U; LAS unsigned char* Gl = lds + CV_CP;
        { const int ch = 2048 + c; SconvRow R; sconv_row_load(tid, ZT + (size_t)ch * ML, R); sconv_row_store<CV_USTRIDE, true>(tid, R, cw[ch], cw[3072 + ch], cw[6144 + ch], cb[ch], Ul); }
        conv_build_copies(tid, lds, F + (size_t)(c * 2 + 0) * 4096);
        __syncthreads();
        f32x4 acc[16];
#pragma unroll 1
        for (int o = 0; o < 2; ++o) {
            const int chg = o * 1024 + c; SconvRow RG; sconv_row_load(tid, ZT + (size_t)chg * ML, RG);
            conv_mma(tid, lds, acc);
            __syncthreads();
            sconv_row_store<CV_GSTRIDE, false>(tid, RG, cw[chg], cw[3072 + chg], cw[6144 + chg], cb[chg], Gl);
            __syncthreads();
            { const float sk = skip[o * DM + c];
#pragma unroll
              for (int i = 0; i < 16; ++i) { const int n = nq + 16 * i; LAS u32x2* up = (LAS u32x2*)(Ul + b * CV_USTRIDE + 2 * n);
                  const u32x2 uw = *up, gw = *(const LAS u32x2*)(Gl + b * CV_GSTRIDE + 2 * n);
                  const float u[4] = {bflo(uw.x), bfhi(uw.x), bflo(uw.y), bfhi(uw.y)}, g[4] = {bflo(gw.x), bfhi(gw.x), bflo(gw.y), bfhi(gw.y)};
                  float y[4];
#pragma unroll
                  for (int e = 0; e < 4; ++e) y[e] = g[e] * (acc[i][e] + sk * u[e]);
                  *up = (u32x2){cvtpk(y[0], y[1]), cvtpk(y[2], y[3])}; } }
            __syncthreads();
            if (o == 0) { conv_build_copies(tid, lds, F + (size_t)(c * 2 + 1) * 4096); __syncthreads(); }
        }
        { const int bb_ = tid >> 5, m0 = (tid & 31) * 64; bf16_t* dst = Y2T + (size_t)c * ML + bb_ * SEQ + m0;
#pragma unroll
          for (int k8 = 0; k8 < 8; ++k8) *(u32x4*)(dst + 8 * k8) = *(const LAS u32x4*)(Ul + bb_ * CV_USTRIDE + 2 * (m0 + 8 * k8)); }
        __syncthreads();
    }
}

__device__ __forceinline__ void phase_transpose(const Ctx& p, LAS unsigned char* lds) {
    const int tid = p.tid, lane = tid & 63, wave = __builtin_amdgcn_readfirstlane(tid >> 6);
    const bf16_t* src = (const bf16_t*)(p.ws + WS_Y2T); bf16_t* dst = (bf16_t*)(p.ws + WS_Y2);
    LAS bf16_t* tile = (LAS bf16_t*)(lds + wave * 16384);
    const int gw = p.bid * NWAVES + wave, ngw = p.nblk * NWAVES;
    for (int it = gw; it < (DM / 64) * (ML / 64); it += ngw) {
        const int cb = it & 15, tb = it >> 4, c0 = cb * 64, t0 = tb * 64;
#pragma unroll
        for (int i = 0; i < 8; ++i) { const int r = 8 * i + (lane >> 3), ch = lane & 7;
            const u32x4 w = *(const u32x4*)(src + (size_t)(c0 + r) * ML + t0 + 8 * ch);
            LAS unsigned* d = (LAS unsigned*)(tile + r * 66 + 8 * ch); d[0] = w.x; d[1] = w.y; d[2] = w.z; d[3] = w.w; }
        asm volatile("s_waitcnt lgkmcnt(0)" ::: "memory");
#pragma unroll
        for (int i = 0; i < 8; ++i) { const int t = 8 * i + (lane >> 3), ch = lane & 7; unsigned short e[8];
#pragma unroll
            for (int k = 0; k < 8; ++k) e[k] = tile[(8 * ch + k) * 66 + t];
            u32x4 w; w.x = e[0] | ((unsigned)e[1] << 16); w.y = e[2] | ((unsigned)e[3] << 16); w.z = e[4] | ((unsigned)e[5] << 16); w.w = e[6] | ((unsigned)e[7] << 16);
            *(u32x4*)(dst + (size_t)(t0 + t) * DM + c0 + 8 * ch) = w; }
        asm volatile("s_waitcnt lgkmcnt(0)" ::: "memory");
    }
}

#define XB_TMO      128
#define XB_XCNT(j)  (256  + 64 * (j))
#define XB_XSUB(j)  (1280 + 64 * (j))
#define XB_XGEN(j)  (2304 + 64 * (j))
#define XB_TOP      3328
#define XB_TOPGEN   3392
#define XCD_BAR_WORDS 3456
#define XB_SPIN_CAP (1u << 18)
__device__ __forceinline__ unsigned xb_ld(unsigned* p)              { return __hip_atomic_load(p, __ATOMIC_RELAXED, __HIP_MEMORY_SCOPE_AGENT); }
__device__ __forceinline__ unsigned xb_add(unsigned* p, unsigned v) { return __hip_atomic_fetch_add(p, v, __ATOMIC_RELAXED, __HIP_MEMORY_SCOPE_AGENT); }
__device__ __forceinline__ unsigned xb_xcc_id() { return (unsigned)__builtin_amdgcn_s_getreg((3 << 11) | 20) & 0xFu; }
#define XB_SPIN(cond, bar) do { unsigned _sp = 0; while (cond) { __builtin_amdgcn_s_sleep(1); \
    if ((++_sp & 255u) == 0u) { if (xb_ld(&(bar)[XB_TMO])) break; if (_sp > XB_SPIN_CAP) { atomicAdd(&(bar)[XB_TMO], 1u); break; } } } } while (0)
struct XcdBarrier { unsigned* bar; unsigned x; volatile LAS unsigned* st; };
__device__ __forceinline__ XcdBarrier xcd_barrier_post(unsigned* bar, volatile LAS unsigned* st) {
    XcdBarrier b; b.bar = bar; b.x = xb_xcc_id(); b.st = st;
    if (threadIdx.x == 0) (void)xb_add(&bar[XB_XCNT(b.x)], 1u);
    return b;
}
__device__ __forceinline__ void xcd_barrier_complete(unsigned* bar, unsigned x, unsigned& nloc, unsigned& nx) {
    const unsigned G = gridDim.x * gridDim.y * gridDim.z;
    unsigned sum, cnt, mine, sp = 0u;
    for (;;) {
        sum = 0u; cnt = 0u; mine = 0u;
#pragma unroll
        for (unsigned j = 0; j < 16; ++j) { const unsigned c = xb_ld(&bar[XB_XCNT(j)]); sum += c; cnt += (c > 0u) ? 1u : 0u; mine = (j == x) ? c : mine; }
        if (sum == G) break;
        __builtin_amdgcn_s_sleep(1);
        if ((++sp & 255u) == 0u) { if (xb_ld(&bar[XB_TMO])) break; if (sp > XB_SPIN_CAP) { atomicAdd(&bar[XB_TMO], 1u); break; } }
    }
    nloc = mine > 0u ? mine : 1u; nx = cnt > 0u ? cnt : 1u;
}
__device__ __forceinline__ void xcd_barrier(const XcdBarrier& b) {
    asm volatile("s_waitcnt vmcnt(0)" ::: "memory");
    __syncthreads();
    if (threadIdx.x == 0) {
        unsigned* bar = b.bar;
        __builtin_amdgcn_s_waitcnt(0);
        unsigned nloc = b.st[0], nx = b.st[1];
        if (nloc == 0u) { xcd_barrier_complete(bar, b.x, nloc, nx); b.st[0] = nloc; b.st[1] = nx; }
        const unsigned old = xb_add(&bar[XB_XSUB(b.x)], 1u);
        const unsigned gen = old / nloc;
        if (old + 1u == (gen + 1u) * nloc) {
            __builtin_amdgcn_fence(__ATOMIC_RELEASE, "agent");
            asm volatile("s_waitcnt vmcnt(0)" ::: "memory");
            const unsigned og = xb_add(&bar[XB_TOP], 1u);
            const unsigned tg = og / nx;
            if (og + 1u == (tg + 1u) * nx) xb_add(&bar[XB_TOPGEN], 1u);
            else XB_SPIN(xb_ld(&bar[XB_TOPGEN]) == tg, bar);
            __builtin_amdgcn_fence(__ATOMIC_ACQUIRE, "agent");
            xb_add(&bar[XB_XGEN(b.x)], 1u);
            asm volatile("s_waitcnt vmcnt(0)" ::: "memory");
        } else {
            XB_SPIN(xb_ld(&bar[XB_XGEN(b.x)]) == gen, bar);
            __builtin_amdgcn_fence(__ATOMIC_ACQUIRE, "agent");
            asm volatile("s_waitcnt vmcnt(0)" ::: "memory");
        }
    }
    __syncthreads();
}
constexpr int LDS_CTL_OFF = LDS_BYTES - 64;
constexpr size_t CTL_BAR_OFF = 16384;
constexpr size_t CTL_STAMP_OFF = 65536;
constexpr size_t CTL_ZERO_BYTES = 131072;

enum { P_PRO = 0, P_MOD1_0, P_GEMM_IN, P_ZPOST, P_GEMM_QKV, P_ATTN, P_GEMM_OUT0, P_MOD2_0, P_MLP_UP0, P_MLP_DN0,
       P_MOD1_1, P_GEMM_HIN, P_CONV, P_TRANS, P_GEMM_OUT1, P_MOD2_1, P_MLP_UP1, P_MLP_DN1, P_FINAL,
       P_NC_FILT, P_NC_U0, P_NC_A, P_NC_B, P_NA_Q, P_NONE };
__host__ __device__ __forceinline__ int prog(int i) {
    int k = 0;
#define PRG(x) do { if (i == k) return (x); ++k; } while (0)
    PRG(P_PRO); PRG(P_MOD1_0); PRG(P_GEMM_IN); PRG(P_ZPOST); PRG(P_GEMM_QKV);
#if NAIVE_ATTN
    PRG(P_NA_Q);
#endif
    PRG(P_ATTN); PRG(P_GEMM_OUT0); PRG(P_MLP_UP0); PRG(P_MLP_DN0); PRG(P_GEMM_HIN);
#if NAIVE_CONV
    PRG(P_NC_FILT); PRG(P_NC_U0); PRG(P_NC_A); PRG(P_NC_B);
#else
    PRG(P_CONV);
#endif
    PRG(P_TRANS); PRG(P_GEMM_OUT1); PRG(P_MLP_UP1); PRG(P_MLP_DN1); PRG(P_FINAL);
#undef PRG
    return P_NONE;
}
constexpr int N_PROG = 16 + (NAIVE_ATTN ? 1 : 0) + (NAIVE_CONV ? 3 : 0);

__device__ __forceinline__ bool gemm_job(const Ctx& p, int ph, int jj, GemmJob& J) {
    unsigned char* ws = p.ws;
    const float* MODL = (const float*)(ws + WS_MODL);
    size_t a = 0, b = 0, o = 0, sq = 0, shw = 0; int M = 0, N = 0, K = 0, kind = 0, ldc = 0, shw_ld = 0; bool has_o = true, has_sq = false;
    const float* base = nullptr; const float* gate = nullptr; const float* ng = nullptr; const float* nsc = nullptr;
    if (jj == 0) {
        if (ph == P_GEMM_IN) { a = WS_HL; b = WS_WIN; o = WS_Z; M = MT; N = ZW; K = DM; ldc = ZW; }
        else if (ph == P_GEMM_QKV) { a = WS_CQN; b = WS_WQB; o = WS_QM; M = ML; N = 768; K = 384; ldc = 768; }
        else if (ph == P_GEMM_OUT0) { a = WS_O; b = WS_WOUT; M = ML; N = DM; K = DM; kind = 2; gate = MODL + 2 * DM;
            o = WS_HL; ng = p.in[I_N2G]; nsc = MODL + 4 * DM; sq = WS_SQA; has_sq = true; }
        else if (ph == P_MLP_UP0) { a = WS_HL; b = WS_W1_0; o = WS_HID; M = ML; N = 4096; K = DM; kind = 1; ldc = 4096; sq = WS_SQA; has_sq = true; shw = WS_SHW_UP0; shw_ld = 4096; }
        else if (ph == P_MLP_DN0) { a = WS_HID; b = WS_W2_0; M = ML; N = DM; K = 4096; kind = 2; gate = MODL + 5 * DM;
            o = WS_HL; ng = p.in[I_N1G] + DM; nsc = MODL + (size_t)16 * NMOD + DM; sq = WS_SQB; has_sq = true; }
        else if (ph == P_GEMM_HIN) { a = WS_HIN; b = WS_HL; o = WS_ZT; M = 3 * DM; N = ML; K = DM; ldc = ML; kind = 3; sq = WS_SQB; has_sq = true; shw = WS_SHW_HIN; shw_ld = 3 * DM; }
        else if (ph == P_GEMM_OUT1) { a = WS_Y2; b = WS_HOUT; M = ML; N = DM; K = DM; kind = 2; gate = MODL + (size_t)16 * NMOD + 2 * DM;
            o = WS_HL; ng = p.in[I_N2G] + DM; nsc = MODL + (size_t)16 * NMOD + 4 * DM; sq = WS_SQC; has_sq = true; }
        else if (ph == P_MLP_UP1) { a = WS_HL; b = WS_W1_1; o = WS_HID; M = ML; N = 4096; K = DM; kind = 1; ldc = 4096; sq = WS_SQC; has_sq = true; shw = WS_SHW_UP1; shw_ld = 4096; }
        else if (ph == P_MLP_DN1) { a = WS_HID; b = WS_W2_1; M = ML; N = DM; K = 4096; kind = 2; gate = MODL + (size_t)16 * NMOD + 5 * DM; has_o = false; sq = WS_SQA; has_sq = true; ng = p.in[I_FINALG]; nsc = MODL; }
        else return false;
    } else {
        if (ph == P_GEMM_QKV) { a = WS_CKVN; b = WS_WKVB; o = WS_KV; M = MT; N = 1024; K = 256; ldc = 1024; }
        else return false;
    }
    J.A = (const bf16_t*)(ws + a); J.Bt = (const bf16_t*)(ws + b); J.M = M; J.N = N; J.K = K; J.rot = (ph == P_GEMM_QKV && jj == 0) ? 128 : 0;
    J.E.kind = kind; J.E.O = has_o ? (bf16_t*)(ws + o) : nullptr; J.E.ldc = ldc; J.E.base = base; J.E.xres = (bf16_t*)(ws + WS_XW); J.E.gate = gate; J.E.ng = ng; J.E.nsc = nsc;
    J.E.sqp = has_sq ? (float*)(ws + sq) : nullptr; J.E.shw = (const float*)(ws + shw); J.E.shw_ld = shw_ld;
    return true;
}

__global__ void __launch_bounds__(NTHREADS, 2) fwd(Params kp) {
    extern __shared__ __attribute__((aligned(16))) unsigned char lds_raw[];
    LAS unsigned char* lds = (LAS unsigned char*)lds_raw;
    const int wave0 = __builtin_amdgcn_readfirstlane((int)threadIdx.x >> 6);
#if !CG_SYNC
    if (threadIdx.x < 16) ((volatile LAS unsigned*)(lds + LDS_CTL_OFF))[threadIdx.x] = 0u;
    __syncthreads();
    const XcdBarrier xbar = xcd_barrier_post((unsigned*)(kp.ws + WS_CTL + CTL_BAR_OFF), (volatile LAS unsigned*)(lds + LDS_CTL_OFF));
#endif
#if PROBE_A >= 0
#define STAMP(k) do { if (blockIdx.x == 0 && threadIdx.x == 0) ((unsigned long long*)(kp.ws + WS_CTL + CTL_STAMP_OFF))[(k)] = __builtin_amdgcn_s_memrealtime(); } while (0)
#else
#define STAMP(k) do { } while (0)
#endif
    for (int pi = kp.ph_lo; pi < kp.ph_hi; ++pi) {
        if (pi > kp.ph_lo) {
            STAMP(2 * pi - 1);
#if CG_SYNC
            cg::this_grid().sync();
#else
            xcd_barrier(xbar);
#endif
        }
        STAMP(2 * pi);
        const int ph = prog(pi);
        for (int rep = 0; rep < ((pi == REPEAT_PI) ? 2 : 1); ++rep) {
        if (rep) {
#if CG_SYNC
            cg::this_grid().sync();
#else
            xcd_barrier(xbar);
#endif
        }
#define MAKE_CTX(p) Ctx p; { int z_ = 0, lane_; asm volatile("v_mbcnt_lo_u32_b32 %0, -1, 0\n\tv_mbcnt_hi_u32_b32 %0, -1, %0" : "=v"(lane_)); asm volatile("" : "+s"(z_)); \
          p.in = (const CAS cfptr_t*)kp.in + z_; p.out = kp.out + z_; p.ws = kp.ws + z_; p.tid = ((wave0 + z_) << 6) + lane_; p.bid = (int)blockIdx.x + z_; p.nblk = (int)gridDim.x + z_; }
#ifndef NO_GEMM
        { MAKE_CTX(pg); for (int jj = 0; jj < 2; ++jj) { GemmJob J; if (!gemm_job(pg, ph, jj, J)) break; run_gemm(pg, lds, J); } }
#endif
        MAKE_CTX(p);
        if (ph == P_PRO && PHON(P_PRO)) phase_prologue(p, lds, true, false);
        else if (ph == P_MOD1_0 && PHON(P_MOD1_0)) { phase_prologue(p, lds, false, true); phase_modulate(p, p.in[I_X], 0, p.in[I_N1G], 0, DM, true); }
        else if (ph == P_ZPOST && PHON(P_ZPOST)) { phase_zpost(p, lds); phase_shw(p); }
        else if (ph == P_ATTN && PHON(P_ATTN)) {
#if NAIVE_ATTN
            phase_attn_naive(p);
#else
            phase_attn(p, lds);
#endif
        }
        else if (ph == P_NA_Q && PHON(P_NA_Q)) phase_naive_qrope(p);
        else if (ph == P_CONV && PHON(P_CONV)) phase_conv(p, lds);
        else if (ph == P_NC_FILT && PHON(P_NC_FILT)) phase_nconv_filt(p, lds);
        else if (ph == P_NC_U0 && PHON(P_NC_U0)) phase_nconv_u0(p);
        else if (ph == P_NC_A && PHON(P_NC_A)) phase_nconv_pass(p, 0);
        else if (ph == P_NC_B && PHON(P_NC_B)) phase_nconv_pass(p, 1);
        else if (ph == P_TRANS && PHON(P_TRANS)) phase_transpose(p, lds);
        else if (ph == P_FINAL && PHON(P_FINAL)) phase_final(p);
        }
    }
#if PROBE_A >= 0
    STAMP(2 * kp.ph_hi - 1);
    __syncthreads();
    if (blockIdx.x == 0) {
        asm volatile("s_waitcnt vmcnt(0)" ::: "memory");
        const unsigned long long* st = (const unsigned long long*)(kp.ws + WS_CTL + CTL_STAMP_OFF);
        const float dta = (float)(st[PROBE_A_TO] - st[PROBE_A]) * 0.01f, dtb = (float)(st[PROBE_B_TO] - st[PROBE_B]) * 0.01f;
        for (int i = threadIdx.x + 1024; i < 1024 + 100000; i += NTHREADS) kp.out[i] += 0.001f * dtb;
        if (threadIdx.x == 0) kp.out[0] += 0.004f * dta;
    }
#endif
}

extern "C" void kernel_launch(void* const* d_in, const int* in_sizes, int n_in, void* d_out, int out_size, void* d_ws, size_t ws_size, hipStream_t stream) {
    static int ok = 0;
    if (ok == 0) {
        ok = 1;
        if (n_in != 32 || in_sizes[0] != ML * DM || out_size != ML * DM || ws_size < WS_END) { fprintf(stderr, "kernel_launch: unexpected shapes (n_in %d, in0 %d, out %d, ws %zu)\n", n_in, n_in > 0 ? in_sizes[0] : -1, out_size, ws_size); ok = -1; }
        int dev = 0, cus = 0;
        if (hipGetDevice(&dev) != hipSuccess || hipDeviceGetAttribute(&cus, hipDeviceAttributeMultiprocessorCount, dev) != hipSuccess || cus < GRID) { fprintf(stderr, "kernel_launch: needs %d CUs, device reports %d\n", GRID, cus); ok = -1; }
        if (hipFuncSetAttribute((const void*)fwd, hipFuncAttributeMaxDynamicSharedMemorySize, LDS_BYTES) != hipSuccess) { fprintf(stderr, "kernel_launch: hipFuncSetAttribute failed\n"); ok = -1; }
        int per_cu = 0;
        if (hipOccupancyMaxActiveBlocksPerMultiprocessor(&per_cu, (const void*)fwd, NTHREADS, LDS_BYTES) != hipSuccess || per_cu < 1) { fprintf(stderr, "kernel_launch: occupancy query says %d blocks per CU\n", per_cu); }
        (void)hipGetLastError();
    }
    if (ok < 0) return;
    Params p{};
    for (int i = 0; i < 32; ++i) p.in[i] = (const float*)d_in[i];
    p.out = (float*)d_out; p.ws = (unsigned char*)d_ws;
#if !CG_SYNC || PROBE_A >= 0
    if (hipMemsetAsync((char*)d_ws + WS_CTL, 0, CTL_ZERO_BYTES, stream) != hipSuccess) { fprintf(stderr, "kernel_launch: memset of the control words failed\n"); return; }
#endif
#if ONE_LAUNCH
    p.ph_lo = 0; p.ph_hi = N_PROG;
    void* args[] = {&p};
    hipError_t e = hipLaunchCooperativeKernel((const void*)fwd, dim3(GRID), dim3(NTHREADS), args, LDS_BYTES, stream);
    if (e != hipSuccess) fprintf(stderr, "kernel_launch: cooperative launch failed: %s\n", hipGetErrorString(e));
#else
    for (int i = 0; i < N_PROG; ++i) { p.ph_lo = i; p.ph_hi = i + 1; hipLaunchKernelGGL(fwd, dim3(GRID), dim3(NTHREADS), LDS_BYTES, stream, p); }
#endif
}
```

```cpp
#include <hip/hip_runtime.h>
#include <hip/hip_cooperative_groups.h>
#include <cstdio>
#include <cstdint>
namespace cg = cooperative_groups;

#ifndef ONE_LAUNCH
#define ONE_LAUNCH 1
#endif
#ifndef CG_SYNC
#define CG_SYNC 0
#endif
#ifndef REPEAT_PI
#define REPEAT_PI -1
#endif
#ifndef PROBE_A
#define PROBE_A -1
#endif
#ifndef ATTN_V1
#define ATTN_V1 0
#endif
#ifndef ZPOST_REF
#define ZPOST_REF 0
#endif
#ifndef SIMPLE_GEMM
#define SIMPLE_GEMM 0
#endif
#ifndef NAIVE_ATTN
#define NAIVE_ATTN 0
#endif
#ifndef NAIVE_CONV
#define NAIVE_CONV 0
#endif

#ifndef PHASE_MASK
#define PHASE_MASK 0xFFFFFFFFu
#endif
#define PHON(x) (((PHASE_MASK) >> (x)) & 1u)
#define LAS __attribute__((address_space(3)))
typedef unsigned short bf16_t;
typedef short bf16x8 __attribute__((ext_vector_type(8)));
typedef short s16x4 __attribute__((ext_vector_type(4)));
typedef float f32x2 __attribute__((ext_vector_type(2)));
typedef float f32x4 __attribute__((ext_vector_type(4)));
typedef float f32x16 __attribute__((ext_vector_type(16)));
typedef unsigned u32x2 __attribute__((ext_vector_type(2)));
typedef unsigned u32x4 __attribute__((ext_vector_type(4)));
typedef __bf16 bf16x2_t __attribute__((ext_vector_type(2)));

constexpr int NB = 16, SEQ = 2048, DM = 1024, CTXL = 256, TKEYS = CTXL + SEQ;
constexpr int ML = NB * SEQ;
constexpr int MC = NB * CTXL;
constexpr int MT = ML + MC;
constexpr int NMOD = 6 * DM;
constexpr int ZW = 1536;
constexpr float EPS = 1e-6f;
constexpr int NWAVES = 8, NTHREADS = 512, GRID = 256, NGW = GRID * NWAVES;
constexpr int LDS_BYTES = 155648;
constexpr int ZC_CQ = 0, ZC_CKV = 384, ZC_KR = 640, ZC_GQ = 672, ZC_GK = 1184, ZC_GV = 1312;
constexpr float LOG2E = 1.4426950408889634f;
constexpr float QSCALE_MLA = 0.10206207261596577f * LOG2E;
constexpr float QSCALE_GQA = 0.125f * LOG2E;

constexpr size_t MiB = 1ull << 20;
constexpr size_t WS_CTL = 0;
constexpr size_t WS_MODL = 1 * MiB;
constexpr size_t WS_MODC = 1 * MiB + 786432;
constexpr size_t WS_H3 = 2 * MiB;
constexpr size_t WS_SHW_UP0 = 3 * MiB, WS_SHW_HIN = 3 * MiB + 262144, WS_SHW_UP1 = 3 * MiB + 262144 + 196608;
constexpr size_t WS_SQA = 244 * MiB, WS_SQB = 246 * MiB, WS_SQC = 248 * MiB;
constexpr size_t WS_WIN = 4 * MiB, WS_WQB = 7 * MiB, WS_WKVB = 8 * MiB, WS_WOUT = 9 * MiB;
constexpr size_t WS_W1_0 = 11 * MiB, WS_W2_0 = 19 * MiB, WS_W1_1 = 27 * MiB, WS_W2_1 = 35 * MiB, WS_HIN = 43 * MiB, WS_HOUT = 49 * MiB;
constexpr size_t WS_XW = 52 * MiB;
constexpr size_t WS_HL = 180 * MiB;
constexpr size_t WS_Z = 252 * MiB, WS_CQN = 360 * MiB, WS_CKVN = 384 * MiB, WS_KROPE = 402 * MiB, WS_QG = 405 * MiB, WS_KG = 437 * MiB, WS_VG = 446 * MiB, WS_QM = 455 * MiB;
constexpr size_t WS_KV = WS_HL, WS_O = 252 * MiB;
constexpr size_t WS_HID = 252 * MiB;
constexpr size_t WS_ZT = 252 * MiB, WS_Y2T = WS_HL, WS_Y2 = 252 * MiB;
constexpr size_t WS_QMR = 316 * MiB;
constexpr size_t WS_FILT = 4 * MiB, WS_U0T = 444 * MiB, WS_Y1T = 380 * MiB;
constexpr size_t WS_END = 508 * MiB;

struct Params { const float* in[32]; float* out; unsigned char* ws; int ph_lo, ph_hi; };
#define CAS __attribute__((address_space(4)))
typedef const float* cfptr_t;
struct Ctx { const CAS cfptr_t* in; float* out; unsigned char* ws; int tid, bid, nblk; };

enum { I_X = 0, I_C, I_CTX, I_CCTX, I_WMOD, I_BMOD, I_N1G, I_N2G, I_W1, I_W2, I_AWIN, I_AQAG, I_AWQB, I_AKVAG, I_AWKVB, I_AQNG, I_AKNG, I_AWOUT,
       I_HWIN, I_HCW, I_HCB, I_FW1, I_FB1, I_FW2, I_FB2, I_FW3, I_FB3, I_FFREQ, I_FW4, I_HSKIP, I_HWOUT, I_FINALG };

__device__ __forceinline__ unsigned f2bf(float f) { unsigned u = __float_as_uint(f); return (u + 0x7fffu + ((u >> 16) & 1u)) >> 16; }
__device__ __forceinline__ float bf2f(unsigned h) { return __uint_as_float(h << 16); }
__device__ __forceinline__ unsigned cvtpk(float lo, float hi) { f32x2 v = {lo, hi}; bf16x2_t b = __builtin_convertvector(v, bf16x2_t); return __builtin_bit_cast(unsigned, b); }
__device__ __forceinline__ float wave_sum(float v) {
#pragma unroll
    for (int o = 1; o < 64; o <<= 1) v += __shfl_xor(v, o);
    return v;
}
__device__ __forceinline__ float fsin(float x) { return __builtin_amdgcn_sinf(__builtin_amdgcn_fractf(x * 0.15915494309189535f)); }
__device__ __forceinline__ float fcos(float x) { return __builtin_amdgcn_cosf(__builtin_amdgcn_fractf(x * 0.15915494309189535f)); }
__device__ __forceinline__ float inv_theta(float x) { return exp2f(-x * 13.287712379549449f); }
__device__ __forceinline__ float dpp_xor1(float v) { return __builtin_bit_cast(float, __builtin_amdgcn_update_dpp(0, __builtin_bit_cast(int, v), 0xB1, 0xF, 0xF, true)); }
__device__ __forceinline__ float dpp_xor2(float v) { return __builtin_bit_cast(float, __builtin_amdgcn_update_dpp(0, __builtin_bit_cast(int, v), 0x4E, 0xF, 0xF, true)); }
__device__ __forceinline__ float dpp_hmirror(float v) { return __builtin_bit_cast(float, __builtin_amdgcn_update_dpp(0, __builtin_bit_cast(int, v), 0x141, 0xF, 0xF, true)); }
__device__ __forceinline__ float sum8(float v) { v += dpp_xor1(v); v += dpp_xor2(v); v += dpp_hmirror(v); return v; }
__device__ __forceinline__ float bflo(unsigned w) { return __uint_as_float(w << 16); }
__device__ __forceinline__ float bfhi(unsigned w) { return __uint_as_float(w & 0xffff0000u); }

namespace pg8 {
constexpr int BM = 256, BK = 64, HALF = 128, HTB = HALF * BK * 2, STAGE_BYTES = 8 * HTB, NXCD = 8, WGM = 8;
__host__ __device__ __forceinline__ int lds_byte(int r, int c) { const int st = (r >> 4) * 2 + (c >> 5), rr = r & 15, cc = c & 31, ob = rr * 64 + cc * 2; return st * 1024 + (ob ^ (((ob >> 9) & 1) << 5)); }
__host__ __device__ __forceinline__ void stage_rc(int b, int& R, int& C) { const int st = b / 1024, sb = b % 1024, swz = sb ^ (((sb >> 9) & 1) << 5); R = (st >> 1) * 16 + swz / 64; C = (st & 1) * 32 + (swz % 64) / 2; }
__host__ __device__ __forceinline__ int perm32(int rho) { const int n = rho >> 4, i = rho & 15; return 8 * (i >> 2) + 4 * n + (i & 3); }

struct Unit { int pm, pn; };
struct Gemm { const bf16_t* A; const bf16_t* Bt; int M, N, K; };

struct StaticOrder {
    int nM, nN, nwg, G, c;
    __host__ __device__ void init(int M, int N, int G_, int c_) { nM = M / BM; nN = N / BM; nwg = nM * nN; G = G_; c = c_; }
    __host__ __device__ bool next(int i, Unit& u) const {
        const long L = (long)i * G + c; if (L >= nwg) return false;
        int wgid = (int)L; { const int q = nwg / NXCD, r = nwg % NXCD, xcd = wgid % NXCD, off = wgid / NXCD; wgid = (xcd < r ? xcd * (q + 1) : r * (q + 1) + (xcd - r) * q) + off; }
        const int nig = WGM * nN, gid = wgid / nig, fm = gid * WGM, gsz = (nM - fm) < WGM ? (nM - fm) : WGM;
        u.pm = fm + ((wgid % nig) % gsz); u.pn = (wgid % nig) / gsz; return true;
    }
    __device__ __forceinline__ void a_ready(const Unit&) const {}
    __device__ __forceinline__ void done(const Unit&) const {}
};

struct EpiAny {
    static constexpr bool AFTER_DRAIN = false;
    int kind; bf16_t* O; int ldc; const float* base; bf16_t* xres; const float* gate; const float* ng; const float* nsc; float* sqp; const float* shw; int shw_ld; LAS float* tab;
    __device__ __forceinline__ bool perm() const { return true; }
    __device__ __forceinline__ void operator()(const f32x4 (&acc)[2][2][4][2], const Unit& u, int ui, int wr, int wc, int fr, int fq) const {
        const int rt = wr * 64 + fr, ct = wc * 32 + 8 * fq;
        const int row0 = u.pm * BM + rt, col0 = u.pn * BM + ct;
        if (kind != 2) {
            const LAS float* T0 = tab + ui * 512; const LAS float* T1 = T0 + 256;
            f32x4 cs[2][2], ca[2][2];
#pragma unroll
            for (int bj = 0; bj < 2; ++bj)
#pragma unroll
                for (int h = 0; h < 2; ++h) { cs[bj][h] = (f32x4){1.f, 1.f, 1.f, 1.f}; ca[bj][h] = (f32x4){0.f, 0.f, 0.f, 0.f}; }
            if (kind == 1) {
#pragma unroll
                for (int bj = 0; bj < 2; ++bj) { ca[bj][0] = *(const LAS f32x4*)(T1 + ct + bj * HALF); ca[bj][1] = *(const LAS f32x4*)(T1 + ct + bj * HALF + 4); } }
            if (kind == 3) {
#pragma unroll
                for (int bj = 0; bj < 2; ++bj) { cs[bj][0] = *(const LAS f32x4*)(T0 + ct + bj * HALF); cs[bj][1] = *(const LAS f32x4*)(T0 + ct + bj * HALF + 4); } }
#pragma unroll
            for (int ai = 0; ai < 2; ++ai)
#pragma unroll
                for (int m = 0; m < 4; ++m) { const int rr = rt + ai * HALF + m * 16; bf16_t* rowp = O + (size_t)(u.pm * BM + rr) * ldc + col0;
                    float rs = 1.f, ra = 0.f;
                    if (kind == 1) rs = T0[rr];
                    if (kind == 3) ra = T1[rr];
#pragma unroll
                    for (int bj = 0; bj < 2; ++bj) { f32x4 v0 = acc[ai][bj][m][0], v1 = acc[ai][bj][m][1];
                        if (kind == 1) { v0 = v0 * rs + ca[bj][0]; v1 = v1 * rs + ca[bj][1];
#pragma unroll
                            for (int e = 0; e < 4; ++e) { const float a = fmaxf(v0[e], 0.f), b = fmaxf(v1[e], 0.f); v0[e] = a * a; v1[e] = b * b; } }
                        if (kind == 3) { v0 = v0 * cs[bj][0] + ra; v1 = v1 * cs[bj][1] + ra; }
                        u32x4 w; w.x = cvtpk(v0[0], v0[1]); w.y = cvtpk(v0[2], v0[3]); w.z = cvtpk(v1[0], v1[1]); w.w = cvtpk(v1[2], v1[3]);
                        *(u32x4*)(rowp + bj * HALF) = w; } }
        } else {
            const bool hasO = O != nullptr;
            const LAS float* T0 = tab + ui * 512; const LAS float* T1 = T0 + 256;
#pragma unroll
            for (int ai = 0; ai < 2; ++ai) {
                u32x4 xb[4][2];
#pragma unroll
                for (int m = 0; m < 4; ++m)
#pragma unroll
                    for (int bj = 0; bj < 2; ++bj) xb[m][bj] = *(const u32x4*)(xres + (size_t)(row0 + ai * HALF + m * 16) * DM + col0 + bj * HALF);
                __builtin_amdgcn_sched_barrier(0);
#pragma unroll
                for (int m = 0; m < 4; ++m) { const size_t off = (size_t)(row0 + ai * HALF + m * 16) * DM + col0; float sq = 0.f;
#pragma unroll
                    for (int bj = 0; bj < 2; ++bj) {
                        const u32x4 xw = xb[m][bj];
                        const f32x4 x0 = {bflo(xw.x), bfhi(xw.x), bflo(xw.y), bfhi(xw.y)}, x1 = {bflo(xw.z), bfhi(xw.z), bflo(xw.w), bfhi(xw.w)};
                        const f32x4 gv0 = *(const LAS f32x4*)(T0 + ct + bj * HALF), gv1 = *(const LAS f32x4*)(T0 + ct + bj * HALF + 4);
                        const f32x4 y0 = x0 + gv0 * acc[ai][bj][m][0], y1 = x1 + gv1 * acc[ai][bj][m][1];
                        { u32x4 w; w.x = cvtpk(y0[0], y0[1]); w.y = cvtpk(y0[2], y0[3]); w.z = cvtpk(y1[0], y1[1]); w.w = cvtpk(y1[2], y1[3]); *(u32x4*)(xres + off + bj * HALF) = w; }
                        sq += ((y0[0] * y0[0] + y0[1] * y0[1]) + (y0[2] * y0[2] + y0[3] * y0[3])) + ((y1[0] * y1[0] + y1[1] * y1[1]) + (y1[2] * y1[2] + y1[3] * y1[3]));
                        if (hasO) { const f32x4 gs0 = *(const LAS f32x4*)(T1 + ct + bj * HALF), gs1 = *(const LAS f32x4*)(T1 + ct + bj * HALF + 4); const f32x4 a0 = y0 * gs0, a1 = y1 * gs1; u32x4 w; w.x = cvtpk(a0[0], a0[1]); w.y = cvtpk(a0[2], a0[3]); w.z = cvtpk(a1[0], a1[1]); w.w = cvtpk(a1[2], a1[3]);
                            *(u32x4*)(O + off + bj * HALF) = w; } }
                    if (sqp) { sq += __shfl_xor(sq, 16); sq += __shfl_xor(sq, 32); if (fq == 0) sqp[(size_t)(row0 + ai * HALF + m * 16) * 16 + u.pn * 4 + wc] = sq; }
                    __builtin_amdgcn_sched_barrier(0); }
            }
        }
    }
};

template <class Epi, class Sched>
__device__ __forceinline__ void gemm_simple(const int tid, const Gemm g, const Sched& S, const Epi& E) {
    const int  wid = __builtin_amdgcn_readfirstlane(tid >> 6), lane = tid & 63, wr = wid >> 2, wc = wid & 3, fr = lane & 15, fq = lane >> 4;
    const int K = g.K;
    Unit u;
    for (int ui = 0; S.next(ui, u); ++ui) {
        f32x4 acc[2][2][4][2];
#pragma unroll
        for (int a = 0; a < 2; ++a)
#pragma unroll
            for (int b = 0; b < 2; ++b)
#pragma unroll
                for (int m = 0; m < 4; ++m)
#pragma unroll
                    for (int n = 0; n < 2; ++n) acc[a][b][m][n] = (f32x4){0.f, 0.f, 0.f, 0.f};
        const bf16_t* Ab = g.A + (size_t)(u.pm * BM + wr * 64 + fr) * K + fq * 8;
        const bf16_t* Bb = g.Bt + (size_t)(u.pn * BM + wc * 32) * K + fq * 8;
        for (int k0 = 0; k0 < K; k0 += 32) {
            bf16x8 At[2][4], Bf[2][2];
#pragma unroll
            for (int ai = 0; ai < 2; ++ai)
#pragma unroll
                for (int m = 0; m < 4; ++m) At[ai][m] = *(const bf16x8*)(Ab + (size_t)(ai * HALF + m * 16) * K + k0);
#pragma unroll
            for (int bj = 0; bj < 2; ++bj)
#pragma unroll
                for (int n = 0; n < 2; ++n) { const int rr = E.perm() ? perm32(16 * n + fr) : (16 * n + fr);
                    Bf[bj][n] = *(const bf16x8*)(Bb + (size_t)(bj * HALF + rr) * K + k0); }
#pragma unroll
            for (int ai = 0; ai < 2; ++ai)
#pragma unroll
                for (int bj = 0; bj < 2; ++bj)
#pragma unroll
                    for (int m = 0; m < 4; ++m)
#pragma unroll
                        for (int n = 0; n < 2; ++n) acc[ai][bj][m][n] = __builtin_amdgcn_mfma_f32_16x16x32_bf16(Bf[bj][n], At[ai][m], acc[ai][bj][m][n], 0, 0, 0);
        }
        E(acc, u, ui, wr, wc, fr, fq);
    }
}

template <class Epi, class Sched, bool ALIGN_EPI = true>
__device__ __forceinline__ void gemm_phase(const int tid, LAS unsigned char* lds, const Gemm g, const Sched& S, const Epi& E) {
    const int  wid = __builtin_amdgcn_readfirstlane(tid >> 6), lane = tid & 63, wr = wid >> 2, wc = wid & 3, fr = lane & 15, fq = lane >> 4;
    const int K = g.K, nt = K / BK;
    unsigned voffA[2], voffB[2];
#pragma unroll
    for (int i = 0; i < 2; ++i) { int R, C; stage_rc(tid * 16 + i * 8192, R, C); const int Rb = E.perm() ? ((R & ~31) + perm32(R & 31)) : R;
        voffA[i] = (unsigned)(R * K + C) * 2u; voffB[i] = (unsigned)(Rb * K + C) * 2u; }
    const size_t kstep = (size_t)(BK * 2);
    const size_t hstep = (size_t)HALF * K * 2;
    const size_t tstep = 2 * hstep;
    const unsigned ldsw = (unsigned)wid * 1024u;
    const int aoff = lds_byte(wr * 64 + fr, fq * 8), boff = lds_byte(wc * 32 + fr, fq * 8);
#define PG8_SA(b, h) (((b) * 2 + (h)) * HTB)
#define PG8_SB(b, h) ((4 + (b) * 2 + (h)) * HTB)
#define PG8_STAGE(bufoff, gbase, voff) do { _Pragma("unroll") for (int _i = 0; _i < 2; ++_i) \
        __builtin_amdgcn_global_load_lds((const unsigned*)((const char*)(gbase) + (voff)[_i]), (LAS unsigned*)(lds + (bufoff) + ldsw + _i * 8192), 16, 0, 0); } while (0)
#define PG8_LDA(dst, b, h) do { _Pragma("unroll") for (int m = 0; m < 4; ++m) _Pragma("unroll") for (int k = 0; k < 2; ++k) dst[m][k] = *(const LAS bf16x8*)(lds + PG8_SA(b, h) + aoff + m * 2048 + k * 1024); } while (0)
#define PG8_LDB(dst, b, h) do { _Pragma("unroll") for (int n = 0; n < 2; ++n) _Pragma("unroll") for (int k = 0; k < 2; ++k) dst[n][k] = *(const LAS bf16x8*)(lds + PG8_SB(b, h) + boff + n * 2048 + k * 1024); } while (0)
#define PG8_MMA(ai, bj, At, Bt) do { __builtin_amdgcn_s_setprio(1); _Pragma("unroll") for (int m = 0; m < 4; ++m) _Pragma("unroll") for (int n = 0; n < 2; ++n) _Pragma("unroll") for (int k = 0; k < 2; ++k) \
        acc[ai][bj][m][n] = __builtin_amdgcn_mfma_f32_16x16x32_bf16(Bt[n][k], At[m][k], acc[ai][bj][m][n], 0, 0, 0); __builtin_amdgcn_s_setprio(0); } while (0)
#define PG8_WAIT_V(n) asm volatile("s_waitcnt vmcnt(" #n ")" ::: "memory")
#define PG8_WAIT_L(n) asm volatile("s_waitcnt lgkmcnt(" #n ")" ::: "memory")
#define PG8_BAR __builtin_amdgcn_s_barrier()
#define PG8_SCHED __builtin_amdgcn_sched_barrier(0)
    Unit cur, nxt; int ui = 0;
    if (!S.next(0, cur)) return;
    f32x4 acc[2][2][4][2];
#pragma unroll
    for (int a = 0; a < 2; ++a)
#pragma unroll
        for (int b = 0; b < 2; ++b)
#pragma unroll
            for (int m = 0; m < 4; ++m)
#pragma unroll
                for (int n = 0; n < 2; ++n) acc[a][b][m][n] = (f32x4){0.f, 0.f, 0.f, 0.f};
    bf16x8 At[4][2], B0[2][2], B1[2][2];
    const char* cA = (const char*)g.A + (size_t)cur.pm * tstep; const char* cB = (const char*)g.Bt + (size_t)cur.pn * tstep;
    S.a_ready(cur);
    PG8_STAGE(PG8_SB(0, 0), cB, voffB); PG8_STAGE(PG8_SB(0, 1), cB + hstep, voffB); PG8_STAGE(PG8_SA(0, 0), cA, voffA); PG8_STAGE(PG8_SA(0, 1), cA + hstep, voffA);
    if (wr == 1) PG8_BAR;
    PG8_WAIT_V(2); PG8_BAR;
    PG8_STAGE(PG8_SB(1, 0), cB + kstep, voffB); PG8_STAGE(PG8_SA(1, 0), cA + kstep, voffA); PG8_STAGE(PG8_SB(1, 1), cB + hstep + kstep, voffB);
    PG8_WAIT_V(6); PG8_BAR;
    for (;;) {
        const bool has_next = S.next(ui + 1, nxt);
        const char* nA = has_next ? (const char*)g.A + (size_t)nxt.pm * tstep : cA; const char* nB = has_next ? (const char*)g.Bt + (size_t)nxt.pn * tstep : cB;
        for (int t = 0; t < nt; t += 2) {
            const bool last = (t == nt - 2);
            const char* a1 = cA + (size_t)(t + 1) * kstep;
            const char* a2 = last ? nA : cA + (size_t)(t + 2) * kstep; const char* b2 = last ? nB : cB + (size_t)(t + 2) * kstep;
            const char* a3 = a2 + kstep; const char* b3 = b2 + kstep;
            if (last && has_next) S.a_ready(nxt);
            PG8_LDB(B0, 0, 0); PG8_LDB(B1, 0, 1); PG8_SCHED; PG8_LDA(At, 0, 0); PG8_STAGE(PG8_SA(1, 1), a1 + hstep, voffA);
            PG8_WAIT_V(8); PG8_WAIT_L(0); PG8_BAR; PG8_MMA(0, 0, At, B0); PG8_MMA(0, 1, At, B1); PG8_BAR; PG8_SCHED;
            PG8_LDA(At, 0, 1); PG8_STAGE(PG8_SB(0, 0), b2, voffB); PG8_STAGE(PG8_SB(0, 1), b2 + hstep, voffB); PG8_STAGE(PG8_SA(0, 0), a2, voffA);
            PG8_WAIT_V(8); PG8_WAIT_L(0); PG8_BAR; PG8_MMA(1, 0, At, B0); PG8_MMA(1, 1, At, B1); PG8_BAR; PG8_SCHED;
            PG8_LDB(B0, 1, 0); PG8_LDB(B1, 1, 1); PG8_SCHED; PG8_LDA(At, 1, 0); PG8_STAGE(PG8_SA(0, 1), a2 + hstep, voffA);
            PG8_WAIT_V(8); PG8_WAIT_L(0); PG8_BAR; PG8_MMA(0, 0, At, B0); PG8_MMA(0, 1, At, B1); PG8_BAR; PG8_SCHED;
            PG8_LDA(At, 1, 1); PG8_STAGE(PG8_SB(1, 0), b3, voffB); PG8_STAGE(PG8_SB(1, 1), b3 + hstep, voffB); PG8_STAGE(PG8_SA(1, 0), a3, voffA);
            PG8_WAIT_V(8); PG8_WAIT_L(0); PG8_BAR; PG8_MMA(1, 0, At, B0); PG8_MMA(1, 1, At, B1); PG8_BAR; PG8_SCHED;
        }
        if constexpr (ALIGN_EPI) { if (wr == 0) PG8_BAR; }
        E(acc, cur, ui, wr, wc, fr, fq); S.done(cur);
        if (!has_next) break;
#pragma unroll
        for (int a = 0; a < 2; ++a)
#pragma unroll
            for (int b = 0; b < 2; ++b)
#pragma unroll
                for (int m = 0; m < 4; ++m)
#pragma unroll
                    for (int n = 0; n < 2; ++n) acc[a][b][m][n] = (f32x4){0.f, 0.f, 0.f, 0.f};
        cur = nxt; cA = nA; cB = nB; ++ui;
        if constexpr (ALIGN_EPI) { if (wr == 1) PG8_BAR; }
    }
    PG8_WAIT_V(0);
    if constexpr (!ALIGN_EPI) { if (wr == 0) PG8_BAR; }
    PG8_BAR;
#undef PG8_SA
#undef PG8_SB
#undef PG8_STAGE
#undef PG8_LDA
#undef PG8_LDB
#undef PG8_MMA
#undef PG8_WAIT_V
#undef PG8_WAIT_L
#undef PG8_BAR
#undef PG8_SCHED
}
}

struct GemmJob { const bf16_t* A; const bf16_t* Bt; int M, N, K; pg8::EpiAny E; int rot; };
constexpr int GEMM_TAB_OFF = 131072;
__device__ __forceinline__ void gemm_tables(const Ctx& p, const GemmJob& J, const pg8::StaticOrder& S) {
    const int tid = p.tid; pg8::Unit u;
    for (int ui = 0; S.next(ui, u); ++ui) {
        LAS float* T = J.E.tab + ui * 512;
        const int r = tid & 255;
        if (J.E.kind == 2) {
            const size_t bo = (size_t)((u.pm * 256) / SEQ) * NMOD + u.pn * 256 + r;
            if (tid < 256) T[r] = J.E.gate[bo]; else T[256 + r] = J.E.O ? J.E.ng[u.pn * 256 + r] * (1.0f + J.E.nsc[bo]) : 0.f;
        } else {
            const int tokt = (J.E.kind == 1) ? u.pm : u.pn, vect = (J.E.kind == 1) ? u.pn : u.pm;
            if (tid < 256) { const f32x4* q = (const f32x4*)(J.E.sqp + (size_t)(tokt * 256 + r) * 16); const f32x4 a = q[0], b = q[1], c = q[2], d = q[3];
                const float sm = ((a[0] + a[1]) + (a[2] + a[3])) + ((b[0] + b[1]) + (b[2] + b[3])) + ((c[0] + c[1]) + (c[2] + c[3])) + ((d[0] + d[1]) + (d[2] + d[3]));
                T[r] = rsqrtf(sm * (1.0f / DM) + EPS); }
            else T[256 + r] = J.E.shw[(size_t)((tokt * 256) / SEQ) * J.E.shw_ld + vect * 256 + r];
        }
    }
    __syncthreads();
}
__device__ __forceinline__ void run_gemm(const Ctx& p, LAS unsigned char* lds, GemmJob& J) {
    J.E.tab = (LAS float*)(lds + GEMM_TAB_OFF);
    pg8::Gemm g{J.A, J.Bt, J.M, J.N, J.K}; pg8::StaticOrder S; S.init(J.M, J.N, p.nblk, (p.bid + J.rot) % p.nblk);
    if (J.E.kind != 0) gemm_tables(p, J, S);
#if SIMPLE_GEMM
    pg8::gemm_simple<pg8::EpiAny, pg8::StaticOrder>(p.tid, g, S, J.E);
#else
    { int tid2 = p.tid; asm volatile("" : "+v"(tid2));
      pg8::gemm_phase<pg8::EpiAny, pg8::StaticOrder, true>(tid2, lds, g, S, J.E); }
#endif
    __syncthreads();
}

__device__ __forceinline__ void transpose_item(const float* W, int K, int N, bf16_t* WT, LAS float* scr, int item, int lane) {
    const int nblk = N / 32, kb = item / nblk, nb = item % nblk, k0 = 64 * kb, n0 = 32 * nb;
    float v[32];
#pragma unroll
    for (int i = 0; i < 32; ++i) { const int kk = 2 * i + (lane >> 5); v[i] = W[(size_t)(k0 + kk) * N + n0 + (lane & 31)]; }
#pragma unroll
    for (int i = 0; i < 32; ++i) { const int kk = 2 * i + (lane >> 5); scr[kk * 33 + (lane & 31)] = v[i]; }
    asm volatile("s_waitcnt lgkmcnt(0)" ::: "memory");
    const int c = lane & 7;
#pragma unroll
    for (int j = 0; j < 4; ++j) { const int n = (lane >> 3) + 8 * j; const LAS float* s = scr + (8 * c) * 33 + n;
        u32x4 o; o.x = cvtpk(s[0 * 33], s[1 * 33]); o.y = cvtpk(s[2 * 33], s[3 * 33]); o.z = cvtpk(s[4 * 33], s[5 * 33]); o.w = cvtpk(s[6 * 33], s[7 * 33]);
        *(u32x4*)(WT + (size_t)(n0 + n) * K + k0 + 8 * c) = o; }
    asm volatile("s_waitcnt lgkmcnt(0)" ::: "memory");
}

__device__ __forceinline__ float silu_f(float v) { return v / (1.0f + expf(-v)); }

__device__ __forceinline__ void phase_prologue(const Ctx& p, LAS unsigned char* lds, const bool partA, const bool partB) {
    const int tid = p.tid, lane = tid & 63, wave = __builtin_amdgcn_readfirstlane(tid >> 6);
    unsigned char* ws = p.ws;
#ifndef PRO_SKIP1
    if (partA) {
        LAS float* S = (LAS float*)lds;
        LAS float* red = (LAS float*)(lds + 69632);
        float* MODL = (float*)(ws + WS_MODL); float* MODC = (float*)(ws + WS_MODC);
        if (p.bid < 192) {
            for (int i = tid; i < 17 * 1024; i += NTHREADS) { const float v = (i < 16 * 1024) ? p.in[I_C][i] : p.in[I_CCTX][i - 16 * 1024]; S[i] = silu_f(v); }
            __syncthreads();
            for (int it = p.bid; it < 192; it += p.nblk) {
                const int layer = it / 96, n0 = (it % 96) * 64, fr = lane & 15, fq = lane >> 4;
                const float* W = p.in[I_WMOD] + (size_t)layer * DM * NMOD + n0 + fr;
                f32x4 acc[2][4];
#pragma unroll
                for (int rt = 0; rt < 2; ++rt)
#pragma unroll
                    for (int ct = 0; ct < 4; ++ct) acc[rt][ct] = (f32x4){0.f, 0.f, 0.f, 0.f};
#pragma unroll 1
                for (int k0 = 0; k0 < 128; k0 += 32) {
                    float bv[8][4];
#pragma unroll
                    for (int j = 0; j < 8; ++j)
#pragma unroll
                        for (int ct = 0; ct < 4; ++ct) bv[j][ct] = W[(size_t)(wave * 128 + k0 + 4 * j + fq) * NMOD + 16 * ct];
#pragma unroll
                    for (int j = 0; j < 8; ++j) { const int k = wave * 128 + k0 + 4 * j + fq;
                        const float a0 = S[fr * 1024 + k], a1 = (fr == 0) ? S[16 * 1024 + k] : 0.f;
#pragma unroll
                        for (int ct = 0; ct < 4; ++ct) { acc[0][ct] = __builtin_amdgcn_mfma_f32_16x16x4f32(a0, bv[j][ct], acc[0][ct], 0, 0, 0);
                                                          acc[1][ct] = __builtin_amdgcn_mfma_f32_16x16x4f32(a1, bv[j][ct], acc[1][ct], 0, 0, 0); } }
                }
#pragma unroll
                for (int rt = 0; rt < 2; ++rt)
#pragma unroll
                    for (int ct = 0; ct < 4; ++ct) *(LAS f32x4*)(red + ((wave * 2 + rt) * 4 + ct) * 256 + lane * 4) = acc[rt][ct];
                __syncthreads();
                for (int idx = tid; idx < 17 * 64; idx += NTHREADS) { const int b = idx >> 6, nn = idx & 63, rt = b >> 4, bb = b & 15, ct = nn >> 4;
                    const int off = (rt * 4 + ct) * 256 + ((bb >> 2) * 16 + (nn & 15)) * 4 + (bb & 3);
                    float s_ = p.in[I_BMOD][layer * NMOD + n0 + nn];
#pragma unroll
                    for (int w = 0; w < 8; ++w) s_ += red[w * 2048 + off];
                    if (b < 16) MODL[(size_t)(layer * 16 + b) * NMOD + n0 + nn] = s_; else if (layer == 0) MODC[n0 + nn] = s_; }
                __syncthreads();
            }
        }
        __syncthreads();
    }
#endif
    const int gw = p.bid * NWAVES + wave, ngw = p.nblk * NWAVES;
#ifndef PRO_SKIP2
    if (partA) {
        float* H3 = (float*)(ws + WS_H3);
        const float* w1 = p.in[I_FW1]; const float* b1 = p.in[I_FB1]; const float* w2 = p.in[I_FW2]; const float* b2 = p.in[I_FB2];
        const float* w3 = p.in[I_FW3]; const float* b3 = p.in[I_FB3]; const float* fr = p.in[I_FFREQ];
        LAS float* w2s = (LAS float*)lds; LAS float* w3s = (LAS float*)(lds + 16384); LAS float* w1s = (LAS float*)(lds + 32768);
        for (int i = tid; i < 4096; i += NTHREADS) { w2s[i] = w2[i]; w3s[i] = w3[i]; if (i < 17 * 64) w1s[i] = w1[i]; }
        __syncthreads();
        for (int t = gw; t < SEQ; t += ngw) {
            const float tf = (float)t, tn = tf / 2048.0f, w = 6.283185307179586f * tf / 2048.0f;
            float feat = 0.f;
            if (lane == 0) feat = tn;
            else if (lane < 17) { const int bi = (lane - 1) & 7; const float band = 1e-4f + (float)bi * ((7.0f - 1e-4f) / 7.0f); const float fw = w * band; feat = (lane < 9) ? fcos(fw) : -fsin(fw); }
            float a = b1[lane];
#pragma unroll
            for (int i = 0; i < 17; ++i) a += __shfl(feat, i) * w1s[i * 64 + lane];
            float h = fsin(fr[lane] * a);
            a = b2[lane];
#pragma unroll 16
            for (int k = 0; k < 64; ++k) a += __shfl(h, k) * w2s[k * 64 + lane];
            h = fsin(fr[64 + lane] * a);
            a = b3[lane];
#pragma unroll 16
            for (int k = 0; k < 64; ++k) a += __shfl(h, k) * w3s[k * 64 + lane];
            h = fsin(fr[128 + lane] * a);
            H3[t * 64 + lane] = h;
        }
    }
#endif
#ifndef PRO_SKIP3
    if (partB) {
        LAS float* scr = (LAS float*)(lds + wave * 16384);
        struct TJob { int in_idx; size_t in_off; int K, N; size_t ws_off; };
        const TJob jobs[10] = {
            {I_AWIN, 0, 1024, 1440, WS_WIN}, {I_AWQB, 0, 384, 768, WS_WQB}, {I_AWKVB, 0, 256, 1024, WS_WKVB}, {I_AWOUT, 0, 1024, 1024, WS_WOUT},
            {I_W1, 0, 1024, 4096, WS_W1_0}, {I_W2, 0, 4096, 1024, WS_W2_0}, {I_W1, (size_t)1024 * 4096, 1024, 4096, WS_W1_1}, {I_W2, (size_t)4096 * 1024, 4096, 1024, WS_W2_1},
            {I_HWIN, 0, 1024, 3072, WS_HIN}, {I_HWOUT, 0, 1024, 1024, WS_HOUT}};
        int base = 0;
#pragma unroll
        for (int j = 0; j < 10; ++j) {
            const int K = jobs[j].K, N = jobs[j].N, nitems = (K / 64) * (N / 32);
            const float* W = p.in[jobs[j].in_idx] + jobs[j].in_off; bf16_t* WT = (bf16_t*)(ws + jobs[j].ws_off);
            int first = gw - (base % ngw); if (first < 0) first += ngw;
            for (int it = first; it < nitems; it += ngw) transpose_item(W, K, N, WT, scr, it, lane);
            base += nitems;
        }
        u32x4* z = (u32x4*)((bf16_t*)(ws + WS_WIN) + (size_t)1440 * 1024);
        unsigned zz = 0u; asm volatile("" : "+v"(zz));
        for (int i = p.bid * NTHREADS + tid; i < 96 * 1024 / 8; i += p.nblk * NTHREADS) z[i] = (u32x4){zz, zz, zz, zz};
    }
#endif
}

__device__ __forceinline__ void modulate_chunk(const float* src, int row0, int nrows, const float* g, const float* sc, const float* sh, bf16_t* dst, int lane, bf16_t* xcopy = nullptr) {
    f32x4 gs[4], sv[4];
#pragma unroll
    for (int j = 0; j < 4; ++j) { const int c4 = lane + 64 * j; const f32x4 gg = ((const f32x4*)g)[c4], ss = ((const f32x4*)sc)[c4]; gs[j] = gg * (ss + 1.0f); sv[j] = ((const f32x4*)sh)[c4]; }
    for (int r = row0; r < row0 + nrows; ++r) {
        const f32x4* xr = (const f32x4*)(src + (size_t)r * DM) + lane;
        f32x4 v[4]; float s = 0.f;
#pragma unroll
        for (int j = 0; j < 4; ++j) { v[j] = xr[64 * j]; s += (v[j].x * v[j].x + v[j].y * v[j].y) + (v[j].z * v[j].z + v[j].w * v[j].w); }
        const float rstd = rsqrtf(wave_sum(s) * (1.0f / DM) + EPS);
        u32x2* o8 = (u32x2*)(dst + (size_t)r * DM) + lane;
#pragma unroll
        for (int j = 0; j < 4; ++j) { const f32x4 y = v[j] * rstd * gs[j] + sv[j]; u32x2 w; w.x = cvtpk(y.x, y.y); w.y = cvtpk(y.z, y.w); o8[64 * j] = w; }
        if (xcopy) { u32x2* x8 = (u32x2*)(xcopy + (size_t)r * DM) + lane;
#pragma unroll
            for (int j = 0; j < 4; ++j) { u32x2 w; w.x = cvtpk(v[j].x, v[j].y); w.y = cvtpk(v[j].z, v[j].w); x8[64 * j] = w; } }
    }
}
__device__ __forceinline__ void phase_modulate(const Ctx& p, const float* src, int layer, const float* g, int shoff, int scoff, bool with_ctx) {
    const int lane = p.tid & 63, wave = __builtin_amdgcn_readfirstlane(p.tid >> 6);
    const int gw = p.bid * NWAVES + wave;
    const float* MODL = (const float*)(p.ws + WS_MODL); const float* MODC = (const float*)(p.ws + WS_MODC);
    bf16_t* HL = (bf16_t*)(p.ws + WS_HL);
    {   const int per = ML / NGW, row0 = gw * per, b = row0 / SEQ; const float* mv = MODL + (size_t)(layer * 16 + b) * NMOD;
        modulate_chunk(src, row0, per, g, mv + scoff, mv + shoff, HL, lane, (bf16_t*)(p.ws + WS_XW)); }
    if (with_ctx) { const int per = MC / NGW, row0 = gw * per;
        modulate_chunk(p.in[I_CTX], row0, per, g, MODC + scoff, MODC + shoff, HL + (size_t)ML * DM, lane); }
}
__device__ __forceinline__ void shw_group(const bf16_t* WT, int N, const float* sh, float* out, int g, int lane) {
    const int fr = lane & 15, fq = lane >> 4;
    f32x4 acc = {0.f, 0.f, 0.f, 0.f};
#pragma unroll 8
    for (int ks = 0; ks < 32; ++ks) {
        const float* sp = sh + (size_t)fr * NMOD + 32 * ks + 8 * fq;
        const f32x4 s0 = *(const f32x4*)sp, s1 = *(const f32x4*)(sp + 4);
        const u32x4 aw = {cvtpk(s0[0], s0[1]), cvtpk(s0[2], s0[3]), cvtpk(s1[0], s1[1]), cvtpk(s1[2], s1[3])};
        const bf16x8 bw = *(const bf16x8*)(WT + (size_t)(16 * g + fr) * DM + 32 * ks + 8 * fq);
        acc = __builtin_amdgcn_mfma_f32_16x16x32_bf16(__builtin_bit_cast(bf16x8, aw), bw, acc, 0, 0, 0);
    }
#pragma unroll
    for (int e = 0; e < 4; ++e) out[(size_t)(4 * fq + e) * N + 16 * g + fr] = acc[e];
}
__device__ __forceinline__ void phase_shw(const Ctx& p, int first) {
    if (p.bid < first) return;
    const int lane = p.tid & 63, wave = __builtin_amdgcn_readfirstlane(p.tid >> 6);
    const int gw = (p.bid - first) * NWAVES + wave, ngw = (p.nblk - first) * NWAVES;
    const float* MODL = (const float*)(p.ws + WS_MODL);
    for (int G = gw; G < 256 + 192 + 256; G += ngw) {
        if (G < 256) shw_group((const bf16_t*)(p.ws + WS_W1_0), 4096, MODL + 3 * DM, (float*)(p.ws + WS_SHW_UP0), G, lane);
        else if (G < 448) shw_group((const bf16_t*)(p.ws + WS_HIN), 3072, MODL + (size_t)16 * NMOD, (float*)(p.ws + WS_SHW_HIN), G - 256, lane);
        else shw_group((const bf16_t*)(p.ws + WS_W1_1), 4096, MODL + (size_t)16 * NMOD + 3 * DM, (float*)(p.ws + WS_SHW_UP1), G - 448, lane);
    }
}
__device__ __forceinline__ void phase_final(const Ctx& p) {
    const int lane = p.tid & 63, wave = __builtin_amdgcn_readfirstlane(p.tid >> 6);
    const int gw = p.bid * NWAVES + wave, per = ML / NGW;
    const bf16_t* X = (const bf16_t*)(p.ws + WS_XW); const float* g = p.in[I_FINALG]; const float* sqp = (const float*)(p.ws + WS_SQA);
    f32x4 gs[4];
#pragma unroll
    for (int j = 0; j < 2; ++j) { gs[2 * j] = *(const f32x4*)(g + 512 * j + 8 * lane); gs[2 * j + 1] = *(const f32x4*)(g + 512 * j + 8 * lane + 4); }
    for (int r = gw * per; r < (gw + 1) * per; ++r) {
        const float part = (lane < 16) ? sqp[(size_t)r * 16 + lane] : 0.f;
        const float rstd = rsqrtf(wave_sum(part) * (1.0f / DM) + EPS);
#pragma unroll
        for (int j = 0; j < 2; ++j) { const u32x4 xb = *(const u32x4*)(X + (size_t)r * DM + 512 * j + 8 * lane);
            const f32x4 v0 = {bflo(xb.x), bfhi(xb.x), bflo(xb.y), bfhi(xb.y)}, v1 = {bflo(xb.z), bfhi(xb.z), bflo(xb.w), bfhi(xb.w)};
            f32x4* o = (f32x4*)(p.out + (size_t)r * DM + 512 * j + 8 * lane);
            o[0] = v0 * rstd * gs[2 * j]; o[1] = v1 * rstd * gs[2 * j + 1]; }
    }
}

__device__ __forceinline__ void zpost_row(const Ctx& p, int row, bool latent, int lane, const LAS f32x2* tabM, const LAS f32x2* tabG) {
    unsigned char* ws = p.ws;
    const bf16_t* z = (const bf16_t*)(ws + WS_Z) + (size_t)row * ZW;
    int prow = 0, pcol = 0;
    if (latent) { const int s = row & (SEQ - 1); prow = s >> 6; pcol = s & 63; }
    if (latent) {
        float v[6], ss = 0.f;
#pragma unroll
        for (int i = 0; i < 6; ++i) { v[i] = bf2f(z[ZC_CQ + lane + 64 * i]); ss += v[i] * v[i]; }
        const float rstd = rsqrtf(wave_sum(ss) * (1.0f / 384.0f) + EPS);
        bf16_t* o = (bf16_t*)(ws + WS_CQN) + (size_t)row * 384;
#pragma unroll
        for (int i = 0; i < 6; ++i) o[lane + 64 * i] = (bf16_t)f2bf(v[i] * rstd * p.in[I_AQAG][lane + 64 * i]);
    }
    {
        float v[4], ss = 0.f;
#pragma unroll
        for (int i = 0; i < 4; ++i) { v[i] = bf2f(z[ZC_CKV + lane + 64 * i]); ss += v[i] * v[i]; }
        const float rstd = rsqrtf(wave_sum(ss) * (1.0f / 256.0f) + EPS);
        bf16_t* o = (bf16_t*)(ws + WS_CKVN) + (size_t)row * 256;
#pragma unroll
        for (int i = 0; i < 4; ++i) o[lane + 64 * i] = (bf16_t)f2bf(v[i] * rstd * p.in[I_AKVAG][lane + 64 * i]);
    }
    {
        const int d = lane & 31; const float y = bf2f(z[ZC_KR + d]);
        const float pr = __shfl_xor(y, 8);
        float o = y;
        if (latent) { const int pos = (d & 16) ? pcol : prow; const f32x2 cs = tabM[pos * 8 + (d & 7)];
            o = (d & 8) ? (pr * cs.y + y * cs.x) : (y * cs.x - pr * cs.y); }
        if (lane < 32) ((bf16_t*)(ws + WS_KROPE))[(size_t)row * 32 + d] = (bf16_t)f2bf(o);
    }
    if (latent) {
        const float gq = p.in[I_AQNG][lane];
        const int pos = (lane & 32) ? pcol : prow; const f32x2 cs = tabG[pos * 16 + (lane & 15)];
        bf16_t* o = (bf16_t*)(ws + WS_QG) + (size_t)row * 512;
#pragma unroll
        for (int hh = 0; hh < 8; ++hh) {
            const float v = bf2f(z[ZC_GQ + 64 * hh + lane]);
            const float rstd = rsqrtf(wave_sum(v * v) * (1.0f / 64.0f) + EPS);
            const float y = v * rstd * gq, pr = __shfl_xor(y, 16);
            const float r = (lane & 16) ? (pr * cs.y + y * cs.x) : (y * cs.x - pr * cs.y);
            o[64 * hh + lane] = (bf16_t)f2bf(r * QSCALE_GQA);
        }
    }
    {
        const float gk = p.in[I_AKNG][lane];
        f32x2 cs = {1.f, 0.f};
        if (latent) { const int pos = (lane & 32) ? pcol : prow; cs = tabG[pos * 16 + (lane & 15)]; }
        bf16_t* o = (bf16_t*)(ws + WS_KG) + (size_t)row * 128;
#pragma unroll
        for (int hh = 0; hh < 2; ++hh) {
            const float v = bf2f(z[ZC_GK + 64 * hh + lane]);
            const float rstd = rsqrtf(wave_sum(v * v) * (1.0f / 64.0f) + EPS);
            const float y = v * rstd * gk, pr = __shfl_xor(y, 16);
            const float r = (lane & 16) ? (pr * cs.y + y * cs.x) : (y * cs.x - pr * cs.y);
            o[64 * hh + lane] = (bf16_t)f2bf(r);
        }
    }
    {
        bf16_t* o = (bf16_t*)(ws + WS_VG) + (size_t)row * 128;
        o[lane] = z[ZC_GV + lane]; o[64 + lane] = z[ZC_GV + 64 + lane];
    }
}
struct ZGains { f32x4 qa[2], kva0[2], kva1[2], qn[2], kn[2]; };
__device__ __forceinline__ void unpack8(const u32x4 w, float (&v)[8]) { v[0] = bflo(w.x); v[1] = bfhi(w.x); v[2] = bflo(w.y); v[3] = bfhi(w.y); v[4] = bflo(w.z); v[5] = bfhi(w.z); v[6] = bflo(w.w); v[7] = bfhi(w.w); }
__device__ __forceinline__ u32x4 pack8(const float (&v)[8]) { u32x4 w; w.x = cvtpk(v[0], v[1]); w.y = cvtpk(v[2], v[3]); w.z = cvtpk(v[4], v[5]); w.w = cvtpk(v[6], v[7]); return w; }
__device__ __forceinline__ float sumsq8(const float (&v)[8]) { return ((v[0] * v[0] + v[1] * v[1]) + (v[2] * v[2] + v[3] * v[3])) + ((v[4] * v[4] + v[5] * v[5]) + (v[6] * v[6] + v[7] * v[7])); }
__device__ __forceinline__ void rope8(float (&y)[8], const float (&pr)[8], bool second, const LAS f32x2* cs) {
#pragma unroll
    for (int e = 0; e < 8; ++e) { const f32x2 c = cs[e]; y[e] = second ? (pr[e] * c.y + y[e] * c.x) : (y[e] * c.x - pr[e] * c.y); }
}
__device__ __forceinline__ void zpost_row_vec(const Ctx& p, int row, bool latent, int lane, const LAS f32x2* tabM, const LAS f32x2* tabG, const ZGains& G) {
    unsigned char* ws = p.ws;
    const bf16_t* z = (const bf16_t*)(ws + WS_Z) + (size_t)row * ZW;
    int prow = 0, pcol = 0;
    if (latent) { const int s_ = row & (SEQ - 1); prow = s_ >> 6; pcol = s_ & 63; }
    const int cB = 84 + lane, cC = lane < 16 ? 148 + lane : (lane < 32 ? 164 + (lane - 16) : 80 + (lane & 3));
    const u32x4 wA0 = *(const u32x4*)(z + 8 * lane);
    const u32x4 wA1 = *(const u32x4*)(z + 8 * (64 + (lane & 15)));
    const u32x4 wB = *(const u32x4*)(z + 8 * cB);
    const u32x4 wC = *(const u32x4*)(z + 8 * cC);
    float a0[8], a1[8], vb[8], vc[8];
    unpack8(wA0, a0); unpack8(wA1, a1); unpack8(wB, vb); unpack8(wC, vc);
    {
        const float s0 = sumsq8(a0), s1 = sumsq8(a1);
        const float sq_cq = wave_sum(lane < 48 ? s0 : 0.f), sq_ckv = wave_sum((lane >= 48 ? s0 : 0.f) + (lane < 16 ? s1 : 0.f));
        const float rq = rsqrtf(sq_cq * (1.0f / 384.0f) + EPS), rk = rsqrtf(sq_ckv * (1.0f / 256.0f) + EPS);
        float o[8];
        if (lane < 48) { if (latent) {
#pragma unroll
                for (int e = 0; e < 8; ++e) o[e] = a0[e] * rq * G.qa[e >> 2][e & 3];
                *(u32x4*)((bf16_t*)(ws + WS_CQN) + (size_t)row * 384 + 8 * lane) = pack8(o); } }
        else {
#pragma unroll
            for (int e = 0; e < 8; ++e) o[e] = a0[e] * rk * G.kva0[e >> 2][e & 3];
            *(u32x4*)((bf16_t*)(ws + WS_CKVN) + (size_t)row * 256 + 8 * (lane - 48)) = pack8(o); }
        if (lane < 16) {
#pragma unroll
            for (int e = 0; e < 8; ++e) o[e] = a1[e] * rk * G.kva1[e >> 2][e & 3];
            *(u32x4*)((bf16_t*)(ws + WS_CKVN) + (size_t)row * 256 + 128 + 8 * lane) = pack8(o); }
    }
    if (latent) {
        const float sq = sum8(sumsq8(vb));
        const float rs = rsqrtf(sq * (1.0f / 64.0f) + EPS);
        float y[8], pr[8];
#pragma unroll
        for (int e = 0; e < 8; ++e) y[e] = vb[e] * rs * G.qn[e >> 2][e & 3];
#pragma unroll
        for (int e = 0; e < 8; ++e) pr[e] = dpp_xor2(y[e]);
        const int pos = (lane & 4) ? pcol : prow;
        rope8(y, pr, (lane & 2) != 0, tabG + pos * 16 + 8 * (lane & 1));
#pragma unroll
        for (int e = 0; e < 8; ++e) y[e] *= QSCALE_GQA;
        *(u32x4*)((bf16_t*)(ws + WS_QG) + (size_t)row * 512 + 8 * lane) = pack8(y);
    }
    {
        const float sq = sum8(sumsq8(vc));
        const float rs = rsqrtf(sq * (1.0f / 64.0f) + EPS);
        float y[8], pr2[8], pr1[8];
#pragma unroll
        for (int e = 0; e < 8; ++e) y[e] = (lane < 16) ? vc[e] * rs * G.kn[e >> 2][e & 3] : vc[e];
#pragma unroll
        for (int e = 0; e < 8; ++e) { pr2[e] = dpp_xor2(y[e]); pr1[e] = dpp_xor1(y[e]); }
        if (lane < 16) {
            if (latent) { const int pos = (lane & 4) ? pcol : prow; rope8(y, pr2, (lane & 2) != 0, tabG + pos * 16 + 8 * (lane & 1)); }
            *(u32x4*)((bf16_t*)(ws + WS_KG) + (size_t)row * 128 + 8 * lane) = pack8(y);
        } else if (lane < 32) {
            *(u32x4*)((bf16_t*)(ws + WS_VG) + (size_t)row * 128 + 8 * (lane - 16)) = wC;
        } else if (lane < 36) {
            if (latent) { const int pos = (lane & 2) ? pcol : prow; rope8(y, pr1, (lane & 1) != 0, tabM + pos * 8); }
            *(u32x4*)((bf16_t*)(ws + WS_KROPE) + (size_t)row * 32 + 8 * (lane - 32)) = pack8(y);
        }
    }
}
__device__ __forceinline__ void phase_zpost(const Ctx& p, LAS unsigned char* lds) {
    const int tid = p.tid, lane = tid & 63, wave = __builtin_amdgcn_readfirstlane(tid >> 6);
    LAS f32x2* tabM = (LAS f32x2*)lds;
    LAS f32x2* tabG = (LAS f32x2*)(lds + 4096);
    for (int i = tid; i < 512; i += NTHREADS) { const int pos = i >> 3, f = i & 7; const float inv = inv_theta((float)f / 8.0f); const float a = (float)pos * inv; tabM[i] = (f32x2){fcos(a), fsin(a)}; }
    for (int i = tid; i < 1024; i += NTHREADS) { const int pos = i >> 4, f = i & 15; const float inv = inv_theta((float)f / 16.0f); const float a = (float)pos * inv; tabG[i] = (f32x2){fcos(a), fsin(a)}; }
    __syncthreads();
    const int gw = p.bid * NWAVES + wave;
#if ZPOST_REF
    { const int per = ML / NGW; for (int r = gw * per; r < (gw + 1) * per; ++r) zpost_row(p, r, true, lane, tabM, tabG); }
    { const int per = MC / NGW; for (int r = gw * per; r < (gw + 1) * per; ++r) zpost_row(p, ML + r, false, lane, tabM, tabG); }
#else
    ZGains G;
    { const float* qa = p.in[I_AQAG] + 8 * (lane < 48 ? lane : 0); const float* k0 = p.in[I_AKVAG] + 8 * (lane >= 48 ? lane - 48 : 0); const float* k1 = p.in[I_AKVAG] + 128 + 8 * (lane & 15);
      const float* qn = p.in[I_AQNG] + 8 * (lane & 7); const float* kn = p.in[I_AKNG] + 8 * (lane & 7);
#pragma unroll
      for (int h = 0; h < 2; ++h) { G.qa[h] = *(const f32x4*)(qa + 4 * h); G.kva0[h] = *(const f32x4*)(k0 + 4 * h); G.kva1[h] = *(const f32x4*)(k1 + 4 * h); G.qn[h] = *(const f32x4*)(qn + 4 * h); G.kn[h] = *(const f32x4*)(kn + 4 * h); } }
    { const int per = ML / NGW;
#pragma unroll 2
      for (int r = gw * per; r < (gw + 1) * per; ++r) zpost_row_vec(p, r, true, lane, tabM, tabG, G); }
    { const int per = MC / NGW; for (int r = gw * per; r < (gw + 1) * per; ++r) zpost_row_vec(p, ML + r, false, lane, tabM, tabG, G); }
#endif
    __syncthreads();
}

__device__ __forceinline__ float max3f(float a, float b, float c) { float r; asm("v_max3_f32 %0, %1, %2, %3" : "=v"(r) : "v"(a), "v"(b), "v"(c)); return r; }
__device__ __forceinline__ int crow(int r, int hi) { return (r & 3) + 8 * (r >> 2) + 4 * hi; }
__device__ __forceinline__ size_t key_row(int b, int t) { return t < CTXL ? (size_t)(ML + b * CTXL + t) : (size_t)(b * SEQ + (t - CTXL)); }

template <int DK>
__device__ __forceinline__ void attn_naive_one(const Ctx& p, int b, int h, int q) {
    unsigned char* ws = p.ws;
    const bf16_t* KV = (const bf16_t*)(ws + WS_KV); const bf16_t* KR = (const bf16_t*)(ws + WS_KROPE);
    const bf16_t* KG = (const bf16_t*)(ws + WS_KG); const bf16_t* VG = (const bf16_t*)(ws + WS_VG);
    const size_t row = (size_t)b * SEQ + q;
    float qv[DK];
    {
        const bf16_t* qp = (DK == 96) ? (const bf16_t*)(ws + WS_QMR) + row * 768 + h * 96 : (const bf16_t*)(ws + WS_QG) + row * 512 + (h - 8) * 64;
#pragma unroll
        for (int d8 = 0; d8 < DK / 8; ++d8) { const u32x4 w = *(const u32x4*)(qp + 8 * d8);
            qv[8 * d8 + 0] = bflo(w.x); qv[8 * d8 + 1] = bfhi(w.x); qv[8 * d8 + 2] = bflo(w.y); qv[8 * d8 + 3] = bfhi(w.y);
            qv[8 * d8 + 4] = bflo(w.z); qv[8 * d8 + 5] = bfhi(w.z); qv[8 * d8 + 6] = bflo(w.w); qv[8 * d8 + 7] = bfhi(w.w); }
    }
    float o[64];
#pragma unroll
    for (int d = 0; d < 64; ++d) o[d] = 0.f;
    float m = -1e30f, l = 0.f;
    for (int t = 0; t < TKEYS; ++t) {
        const size_t kr = key_row(b, t);
        float s = 0.f;
        const bf16_t* vp;
        if (DK == 96) {
            const bf16_t* kp = KV + kr * 1024 + h * 128; const bf16_t* rp = KR + kr * 32;
#pragma unroll
            for (int d = 0; d < 64; ++d) s += qv[d] * bf2f(kp[d]);
#pragma unroll
            for (int d = 0; d < 32; ++d) s += qv[64 + d] * bf2f(rp[d]);
            vp = kp + 64;
        } else {
            const int kvh = (h - 8) >> 2; const bf16_t* kp = KG + kr * 128 + kvh * 64;
#pragma unroll
            for (int d = 0; d < 64; ++d) s += qv[d] * bf2f(kp[d]);
            vp = VG + kr * 128 + kvh * 64;
        }
        const float mn = fmaxf(m, s), al = exp2f(m - mn), pe = exp2f(s - mn);
        l = l * al + pe; m = mn;
#pragma unroll
        for (int d = 0; d < 64; ++d) o[d] = o[d] * al + pe * bf2f(vp[d]);
    }
    const float rl = 1.0f / l;
    bf16_t* op = (bf16_t*)(ws + WS_O) + row * 1024 + h * 64;
#pragma unroll
    for (int d = 0; d < 64; ++d) op[d] = (bf16_t)f2bf(o[d] * rl);
}
__device__ __forceinline__ void phase_naive_qrope(const Ctx& p) {
    const bf16_t* QM = (const bf16_t*)(p.ws + WS_QM); bf16_t* QMR = (bf16_t*)(p.ws + WS_QMR);
    for (size_t idx = (size_t)p.bid * NTHREADS + p.tid; idx < (size_t)ML * 768; idx += (size_t)p.nblk * NTHREADS) {
        const int col = (int)(idx % 768), d = col % 96; const size_t row = idx / 768; const int q = (int)(row & (SEQ - 1));
        float v = bf2f(QM[idx]);
        if (d >= 64) {
            const int e = d - 64, prow = q >> 6, pcol = q & 63;
            const int pos = (e & 16) ? pcol : prow; const float inv = inv_theta((float)(e & 7) / 8.0f); const float ang = (float)pos * inv;
            const float cs = fcos(ang), sn = fsin(ang);
            const float a = bf2f(QM[idx - e + (e & ~8)]), bb = bf2f(QM[idx - e + (e | 8)]);
            v = (e & 8) ? (a * sn + bb * cs) : (a * cs - bb * sn);
        }
        QMR[idx] = (bf16_t)f2bf(v * QSCALE_MLA);
    }
}
__device__ __forceinline__ void phase_attn_naive(const Ctx& p) {
    for (int idx = p.bid * NTHREADS + p.tid; idx < NB * 16 * SEQ; idx += p.nblk * NTHREADS) {
        const int q = idx & (SEQ - 1), h = (idx >> 11) & 15, b = idx >> 15;
        if (h < 8) attn_naive_one<96>(p, b, h, q); else attn_naive_one<64>(p, b, h, q);
    }
}

template <int DK>
__device__ __forceinline__ void attn_unit(const Ctx& p, int b, int h, int qb, LAS unsigned char* lds) {
    constexpr int NC = DK / 8;
    constexpr int ND = DK / 16;
    constexpr int KB = 12288, VB = 8192;
    unsigned char* ws = p.ws;
    const int tid = p.tid, lane = tid & 63, r32 = lane & 31, hi = lane >> 5; const int wid = __builtin_amdgcn_readfirstlane(tid >> 6);
    const bf16_t* KV = (const bf16_t*)(ws + WS_KV); const bf16_t* KR = (const bf16_t*)(ws + WS_KROPE);
    const bf16_t* KG = (const bf16_t*)(ws + WS_KG); const bf16_t* VG = (const bf16_t*)(ws + WS_VG);
    const int kvh = (h - 8) >> 2;
    LAS unsigned char* Kb = lds; LAS unsigned char* Vb = lds + 2 * KB; LAS float* wsf = (LAS float*)(lds + 2 * KB + 2 * VB) + wid * 64;
    const int qs = qb * 256 + wid * 32 + r32;
    const size_t qrow = (size_t)b * SEQ + qs;
    bf16x8 qr[ND];
    if (DK == 96) {
        const bf16_t* qp = (const bf16_t*)(ws + WS_QM) + qrow * 768 + h * 96;
#pragma unroll
        for (int d0 = 0; d0 < 4; ++d0) { const u32x4 w = *(const u32x4*)(qp + 16 * d0 + 8 * hi); u32x4 o;
            o.x = cvtpk(bflo(w.x) * QSCALE_MLA, bfhi(w.x) * QSCALE_MLA); o.y = cvtpk(bflo(w.y) * QSCALE_MLA, bfhi(w.y) * QSCALE_MLA);
            o.z = cvtpk(bflo(w.z) * QSCALE_MLA, bfhi(w.z) * QSCALE_MLA); o.w = cvtpk(bflo(w.w) * QSCALE_MLA, bfhi(w.w) * QSCALE_MLA);
            qr[d0] = __builtin_bit_cast(bf16x8, o); }
        const int prow = qs >> 6, pcol = qs & 63;
#pragma unroll
        for (int c = 0; c < 2; ++c) {
            const u32x4 wa = *(const u32x4*)(qp + 64 + 16 * c);
            const u32x4 wb = *(const u32x4*)(qp + 64 + 16 * c + 8);
            const float pos = (float)(c == 0 ? prow : pcol);
            float av[8] = {bflo(wa.x), bfhi(wa.x), bflo(wa.y), bfhi(wa.y), bflo(wa.z), bfhi(wa.z), bflo(wa.w), bfhi(wa.w)};
            float bv[8] = {bflo(wb.x), bfhi(wb.x), bflo(wb.y), bfhi(wb.y), bflo(wb.z), bfhi(wb.z), bflo(wb.w), bfhi(wb.w)};
            float ov[8];
#pragma unroll
            for (int j = 0; j < 8; ++j) { const float inv = inv_theta((float)j / 8.0f); const float ang = pos * inv; const float cs = fcos(ang), sn = fsin(ang);
                const float lo = av[j] * cs - bv[j] * sn, hv = av[j] * sn + bv[j] * cs; ov[j] = (hi ? hv : lo) * QSCALE_MLA; }
            u32x4 o; o.x = cvtpk(ov[0], ov[1]); o.y = cvtpk(ov[2], ov[3]); o.z = cvtpk(ov[4], ov[5]); o.w = cvtpk(ov[6], ov[7]);
            qr[4 + c] = __builtin_bit_cast(bf16x8, o);
        }
    } else {
        const bf16_t* qp = (const bf16_t*)(ws + WS_QG) + qrow * 512 + (h - 8) * 64;
#pragma unroll
        for (int d0 = 0; d0 < ND; ++d0) qr[d0] = *(const bf16x8*)(qp + 16 * d0 + 8 * hi);
    }
    const int kkey = tid & 63, kc0 = tid >> 6;
    const int vkv = tid >> 3, vdc = tid & 7;
    const unsigned kdst0 = kc0 * 1024 + kkey * 16, kdst1 = (kc0 + 8) * 1024 + kkey * 16;
    const unsigned vdst = (vdc >> 2) * 4096 + (vkv >> 4) * 1024 + (vkv & 15) * 64 + (vdc & 3) * 16;
    u32x4 kreg0, kreg1, vreg;
    auto load_tile = [&](int kt) {
        const size_t rk = key_row(b, kt * 64 + kkey), rv = key_row(b, kt * 64 + vkv);
        if (DK == 96) {
            kreg0 = *(const u32x4*)(KV + rk * 1024 + h * 128 + 8 * kc0);
            if (wid < 4) kreg1 = *(const u32x4*)(KR + rk * 32 + 8 * kc0);
            vreg = *(const u32x4*)(KV + rv * 1024 + h * 128 + 64 + 8 * vdc);
        } else {
            kreg0 = *(const u32x4*)(KG + rk * 128 + kvh * 64 + 8 * kc0);
            vreg = *(const u32x4*)(VG + rv * 128 + kvh * 64 + 8 * vdc);
        }
    };
    auto store_tile = [&](int buf) {
        *(LAS u32x4*)(Kb + buf * KB + kdst0) = kreg0;
        if (DK == 96) { if (wid < 4) *(LAS u32x4*)(Kb + buf * KB + kdst1) = kreg1; }
        *(LAS u32x4*)(Vb + buf * VB + vdst) = vreg;
    };
    f32x16 o0 = {}, o1 = {};
    float mrun = -1e30f, lrun = 0.f;
    const unsigned kfo = hi * 1024 + r32 * 16;
    const unsigned vfo = ((lane >> 4) & 1) * 32 + (lane & 3) * 8 + (4 * hi + ((lane & 15) >> 2)) * 64;
    load_tile(0); store_tile(0);
    __syncthreads();
    constexpr int NT = TKEYS / 64;
    for (int kt = 0; kt < NT; ++kt) {
        const int buf = kt & 1;
        if (kt + 1 < NT) load_tile(kt + 1);
        f32x16 p0 = {}, p1 = {};
        const LAS unsigned char* kp = Kb + buf * KB + kfo;
#pragma unroll
        for (int d0 = 0; d0 < ND; ++d0) {
            const bf16x8 k0 = *(const LAS bf16x8*)(kp + d0 * 2048), k1 = *(const LAS bf16x8*)(kp + d0 * 2048 + 512);
            p0 = __builtin_amdgcn_mfma_f32_32x32x16_bf16(k0, qr[d0], p0, 0, 0, 0);
            p1 = __builtin_amdgcn_mfma_f32_32x32x16_bf16(k1, qr[d0], p1, 0, 0, 0);
        }
        float mx = fmaxf(p0[0], p1[0]);
#pragma unroll
        for (int r = 1; r < 16; ++r) mx = fmaxf(mx, fmaxf(p0[r], p1[r]));
        mx = fmaxf(mx, __shfl_xor(mx, 32));
        const float mnew = fmaxf(mrun, mx), alpha = __builtin_amdgcn_exp2f(mrun - mnew);
        mrun = mnew;
        float rs = 0.f;
#pragma unroll
        for (int r = 0; r < 16; ++r) { p0[r] = __builtin_amdgcn_exp2f(p0[r] - mnew); p1[r] = __builtin_amdgcn_exp2f(p1[r] - mnew); rs += p0[r] + p1[r]; }
        lrun = lrun * alpha + rs;
        if (hi == 0) wsf[r32] = alpha;
        asm volatile("s_waitcnt lgkmcnt(0)" ::: "memory");
#pragma unroll
        for (int g4 = 0; g4 < 4; ++g4) { const f32x4 a4 = *(const LAS f32x4*)(wsf + 8 * g4 + 4 * hi);
#pragma unroll
            for (int e = 0; e < 4; ++e) { o0[4 * g4 + e] *= a4[e]; o1[4 * g4 + e] *= a4[e]; } }
        u32x4 pw[4];
        pw[0] = (u32x4){cvtpk(p0[0], p0[1]), cvtpk(p0[2], p0[3]), cvtpk(p0[4], p0[5]), cvtpk(p0[6], p0[7])};
        pw[1] = (u32x4){cvtpk(p0[8], p0[9]), cvtpk(p0[10], p0[11]), cvtpk(p0[12], p0[13]), cvtpk(p0[14], p0[15])};
        pw[2] = (u32x4){cvtpk(p1[0], p1[1]), cvtpk(p1[2], p1[3]), cvtpk(p1[4], p1[5]), cvtpk(p1[6], p1[7])};
        pw[3] = (u32x4){cvtpk(p1[8], p1[9]), cvtpk(p1[10], p1[11]), cvtpk(p1[12], p1[13]), cvtpk(p1[14], p1[15])};
        const LAS unsigned char* vp = Vb + buf * VB + vfo;
#pragma unroll
        for (int ks = 0; ks < 4; ++ks) {
            const bf16x8 pa = __builtin_bit_cast(bf16x8, pw[ks]);
            const s16x4 l0 = __builtin_amdgcn_ds_read_tr16_b64_v4i16((LAS s16x4*)(vp + ks * 1024));
            const s16x4 h0 = __builtin_amdgcn_ds_read_tr16_b64_v4i16((LAS s16x4*)(vp + ks * 1024 + 512));
            const s16x4 l1 = __builtin_amdgcn_ds_read_tr16_b64_v4i16((LAS s16x4*)(vp + 4096 + ks * 1024));
            const s16x4 h1 = __builtin_amdgcn_ds_read_tr16_b64_v4i16((LAS s16x4*)(vp + 4096 + ks * 1024 + 512));
            const bf16x8 v0 = {l0[0], l0[1], l0[2], l0[3], h0[0], h0[1], h0[2], h0[3]};
            const bf16x8 v1 = {l1[0], l1[1], l1[2], l1[3], h1[0], h1[1], h1[2], h1[3]};
            o0 = __builtin_amdgcn_mfma_f32_32x32x16_bf16(pa, v0, o0, 0, 0, 0);
            o1 = __builtin_amdgcn_mfma_f32_32x32x16_bf16(pa, v1, o1, 0, 0, 0);
        }
        if (kt + 1 < NT) store_tile(buf ^ 1);
        __syncthreads();
    }
    lrun += __shfl_xor(lrun, 32);
    if (hi == 0) wsf[32 + r32] = lrun;
    asm volatile("s_waitcnt lgkmcnt(0)" ::: "memory");
    bf16_t* Ow = (bf16_t*)(ws + WS_O) + ((size_t)b * SEQ + qb * 256 + wid * 32) * 1024 + h * 64;
#pragma unroll
    for (int r = 0; r < 16; ++r) { const int orow = crow(r, hi); const float rl = __builtin_amdgcn_rcpf(wsf[32 + orow]);
        Ow[(size_t)orow * 1024 + r32] = (bf16_t)f2bf(o0[r] * rl); Ow[(size_t)orow * 1024 + 32 + r32] = (bf16_t)f2bf(o1[r] * rl); }
    __syncthreads();
}
template <int DK>
__device__ __forceinline__ void attn_unit2(const Ctx& p, const int tid, int b, int h, int qb, LAS unsigned char* lds) {
    constexpr int ND = DK / 16;
    constexpr int KB = 12288, VB = 8192, NT = TKEYS / 64;
    constexpr float THR = 8.0f;
    unsigned char* ws = p.ws;
    const int lane = tid & 63, r32 = lane & 31, hi = lane >> 5; const int wid = __builtin_amdgcn_readfirstlane(tid >> 6);
    const bf16_t* KV = (const bf16_t*)(ws + WS_KV); const bf16_t* KR = (const bf16_t*)(ws + WS_KROPE);
    const bf16_t* KG = (const bf16_t*)(ws + WS_KG); const bf16_t* VG = (const bf16_t*)(ws + WS_VG);
    const int kvh = (h - 8) >> 2;
    LAS unsigned char* Kb = lds; LAS unsigned char* Vb = lds + 2 * KB; LAS float* wsf = (LAS float*)(lds + 2 * KB + 2 * VB) + wid * 64;
    const int qs = qb * 256 + wid * 32 + r32;
    const size_t qrow = (size_t)b * SEQ + qs;
    bf16x8 qr[ND];
    if (DK == 96) {
        const bf16_t* qp = (const bf16_t*)(ws + WS_QM) + qrow * 768 + h * 96;
#pragma unroll
        for (int d0 = 0; d0 < 4; ++d0) { const u32x4 w = *(const u32x4*)(qp + 16 * d0 + 8 * hi); u32x4 o;
            o.x = cvtpk(bflo(w.x) * QSCALE_MLA, bfhi(w.x) * QSCALE_MLA); o.y = cvtpk(bflo(w.y) * QSCALE_MLA, bfhi(w.y) * QSCALE_MLA);
            o.z = cvtpk(bflo(w.z) * QSCALE_MLA, bfhi(w.z) * QSCALE_MLA); o.w = cvtpk(bflo(w.w) * QSCALE_MLA, bfhi(w.w) * QSCALE_MLA);
            qr[d0] = __builtin_bit_cast(bf16x8, o); }
        const int prow = qs >> 6, pcol = qs & 63;
#pragma unroll
        for (int c = 0; c < 2; ++c) {
            const u32x4 wa = *(const u32x4*)(qp + 64 + 16 * c);
            const u32x4 wb = *(const u32x4*)(qp + 64 + 16 * c + 8);
            const float pos = (float)(c == 0 ? prow : pcol);
            float av[8], bv[8], ov[8]; unpack8(wa, av); unpack8(wb, bv);
#pragma unroll
            for (int j = 0; j < 8; ++j) { const float inv = inv_theta((float)j / 8.0f); const float ang = pos * inv; const float cs = fcos(ang), sn = fsin(ang);
                const float lo = av[j] * cs - bv[j] * sn, hv = av[j] * sn + bv[j] * cs; ov[j] = (hi ? hv : lo) * QSCALE_MLA; }
            qr[4 + c] = __builtin_bit_cast(bf16x8, pack8(ov));
        }
    } else {
        const bf16_t* qp = (const bf16_t*)(ws + WS_QG) + qrow * 512 + (h - 8) * 64;
#pragma unroll
        for (int d0 = 0; d0 < ND; ++d0) qr[d0] = *(const bf16x8*)(qp + 16 * d0 + 8 * hi);
    }
    const int kkey = tid & 63, kc0 = tid >> 6, vkv = tid >> 3, vdc = tid & 7;
    const unsigned kdst0 = kc0 * 1024 + kkey * 16, kdst1 = (kc0 + 8) * 1024 + kkey * 16;
    const unsigned vdst = (vdc >> 2) * 4096 + (vkv >> 4) * 1024 + (vkv & 15) * 64 + (vdc & 3) * 16;
    u32x4 kreg0, kreg1, vreg;
    auto load_k = [&](int kt) { const size_t rk = key_row(b, kt * 64 + kkey);
        if (DK == 96) { kreg0 = *(const u32x4*)(KV + rk * 1024 + h * 128 + 8 * kc0); if (wid < 4) kreg1 = *(const u32x4*)(KR + rk * 32 + 8 * kc0); }
        else kreg0 = *(const u32x4*)(KG + rk * 128 + kvh * 64 + 8 * kc0); };
    auto load_v = [&](int kt) { const size_t rv = key_row(b, kt * 64 + vkv);
        if (DK == 96) vreg = *(const u32x4*)(KV + rv * 1024 + h * 128 + 64 + 8 * vdc); else vreg = *(const u32x4*)(VG + rv * 128 + kvh * 64 + 8 * vdc); };
    auto store_k = [&](int buf) { *(LAS u32x4*)(Kb + buf * KB + kdst0) = kreg0; if (DK == 96) { if (wid < 4) *(LAS u32x4*)(Kb + buf * KB + kdst1) = kreg1; } };
    auto store_v = [&](int buf) { *(LAS u32x4*)(Vb + buf * VB + vdst) = vreg; };
    f32x16 o0 = {}, o1 = {};
    float mhat = 0.f, lrun = 0.f;
    const unsigned kfo = hi * 1024 + r32 * 16;
    const unsigned vfo = ((lane >> 4) & 1) * 32 + (lane & 3) * 8 + (4 * hi + ((lane & 15) >> 2)) * 64;
#define A2_SBAR() __builtin_amdgcn_sched_barrier(0)
#define A2_EL(X0, X1, i) ((i) < 16 ? X0[(i) & 15] : X1[(i) & 15])
    f32x16 negm; { float z0 = 0.f; asm volatile("" : "+v"(z0));
#pragma unroll
        for (int r = 0; r < 16; ++r) negm[r] = z0; }
    float rmx = 0.f;
#define A2_STEP(C0, C1, P0, P1, T, HASK) do { const int t_ = (T); \
        float f_ = 1.0f; const bool resc_ = __any(rmx > THR); \
        if (resc_) { const float dl_ = __builtin_fmaxf(rmx, 0.f); mhat += dl_; f_ = __builtin_amdgcn_exp2f(-dl_); if (hi == 0) wsf[r32] = f_; \
            _Pragma("unroll") for (int r = 0; r < 16; ++r) negm[r] = -mhat; } \
        if (HASK) load_k(t_ + 1); \
        load_v(t_); \
        const LAS unsigned char* kp_ = Kb + (t_ & 1) * KB + kfo; const LAS unsigned char* vp_ = Vb + ((t_ + 1) & 1) * VB + vfo; \
        float sacc_ = 0.f; unsigned pw_[16]; s16x4 vl_[8], vh_[8]; bf16x8 kf_[2 * ND]; \
        kf_[0] = *(const LAS bf16x8*)(kp_); kf_[1] = *(const LAS bf16x8*)(kp_ + 512); \
        A2_SBAR(); \
        _Pragma("unroll") for (int g = 0; g < 2 * ND; ++g) { \
            if (g + 2 < 2 * ND) kf_[g + 2] = *(const LAS bf16x8*)(kp_ + ((g + 2) >> 1) * 2048 + ((g + 2) & 1) * 512); \
            if (g < 8) { vl_[g] = __builtin_amdgcn_ds_read_tr16_b64_v4i16((LAS s16x4*)(vp_ + (g >> 2) * 4096 + (g & 3) * 1024)); \
                         vh_[g] = __builtin_amdgcn_ds_read_tr16_b64_v4i16((LAS s16x4*)(vp_ + (g >> 2) * 4096 + (g & 3) * 1024 + 512)); } \
            if ((g & 1) == 0) { if (g == 0) C0 = __builtin_amdgcn_mfma_f32_32x32x16_bf16(kf_[g], qr[g >> 1], negm, 0, 0, 0); else C0 = __builtin_amdgcn_mfma_f32_32x32x16_bf16(kf_[g], qr[g >> 1], C0, 0, 0, 0); } \
            else { if (g == 1) C1 = __builtin_amdgcn_mfma_f32_32x32x16_bf16(kf_[g], qr[g >> 1], negm, 0, 0, 0); else C1 = __builtin_amdgcn_mfma_f32_32x32x16_bf16(kf_[g], qr[g >> 1], C1, 0, 0, 0); } \
            { constexpr int NA = (ND == 6) ? 3 : 4; \
                _Pragma("unroll") for (int i = 0; i < NA; ++i) { const int e = NA * g + i; if (e < 32) sacc_ += A2_EL(P0, P1, e); } \
                if (g < 8) { pw_[2 * g] = cvtpk(A2_EL(P0, P1, 4 * g), A2_EL(P0, P1, 4 * g + 1)); pw_[2 * g + 1] = cvtpk(A2_EL(P0, P1, 4 * g + 2), A2_EL(P0, P1, 4 * g + 3)); asm volatile("" : "+v"(pw_[2 * g]), "+v"(pw_[2 * g + 1])); } \
                asm volatile("" : "+v"(sacc_)); } \
            A2_SBAR(); } \
        lrun = (lrun + sacc_) * f_; \
        float rm_ = 0.f; \
        _Pragma("unroll") for (int g = 0; g < 8; ++g) { \
            { const int ks = g >> 1, dv = g & 1; const u32x4 pa_ = {pw_[4 * ks], pw_[4 * ks + 1], pw_[4 * ks + 2], pw_[4 * ks + 3]}; \
                const s16x4 l_ = vl_[dv * 4 + ks], h_ = vh_[dv * 4 + ks]; const bf16x8 vf_ = {l_[0], l_[1], l_[2], l_[3], h_[0], h_[1], h_[2], h_[3]}; \
                if (dv == 0) o0 = __builtin_amdgcn_mfma_f32_32x32x16_bf16(__builtin_bit_cast(bf16x8, pa_), vf_, o0, 0, 0, 0); \
                else o1 = __builtin_amdgcn_mfma_f32_32x32x16_bf16(__builtin_bit_cast(bf16x8, pa_), vf_, o1, 0, 0, 0); } \
            if (g == 0) { rm_ = __builtin_fmaxf(__builtin_fmaxf(C0[0], C0[1]), __builtin_fmaxf(C0[2], C0[3])); }          \
            else if (g == 4) { rm_ = __builtin_fmaxf(rm_, __builtin_fmaxf(__builtin_fmaxf(C1[0], C1[1]), __builtin_fmaxf(C1[2], C1[3]))); } \
            else if (g < 4) { rm_ = max3f(rm_, C0[4 * g], C0[4 * g + 1]); rm_ = max3f(rm_, C0[4 * g + 2], C0[4 * g + 3]); } \
            else { rm_ = max3f(rm_, C1[4 * g - 16], C1[4 * g - 15]); rm_ = max3f(rm_, C1[4 * g - 14], C1[4 * g - 13]); } \
            asm volatile("" : "+v"(rm_)); \
            _Pragma("unroll") for (int i = 0; i < 4; ++i) { const int e = 4 * g + i; if (e < 16) C0[e & 15] = __builtin_amdgcn_exp2f(C0[e & 15]); else C1[e & 15] = __builtin_amdgcn_exp2f(C1[e & 15]); } \
            if (g < 4) asm volatile("" : "+v"(C0)); else asm volatile("" : "+v"(C1)); \
            A2_SBAR(); } \
        { auto rr_ = __builtin_amdgcn_permlane32_swap(__float_as_uint(rm_), __float_as_uint(rm_), false, false); rmx = __builtin_fmaxf(__uint_as_float(rr_[0]), __uint_as_float(rr_[1])); } \
        if (resc_) { asm volatile("s_waitcnt lgkmcnt(0)" ::: "memory"); \
            _Pragma("unroll") for (int g4 = 0; g4 < 4; ++g4) { const f32x4 a4 = *(const LAS f32x4*)(wsf + 8 * g4 + 4 * hi); \
                _Pragma("unroll") for (int e = 0; e < 4; ++e) { o0[4 * g4 + e] *= a4[e]; o1[4 * g4 + e] *= a4[e]; } } } \
        if (HASK) store_k((t_ + 1) & 1); \
        store_v(t_ & 1); \
        __syncthreads(); } while (0)
    if (wid >= 4) __builtin_amdgcn_s_setprio(1);
    load_k(0); store_k(0);
    __syncthreads();
    f32x16 sA0, sA1, sB0, sB1;
    {
        load_k(1); load_v(0);
        const LAS unsigned char* kp_ = Kb + kfo;
#pragma unroll
        for (int d0 = 0; d0 < ND; ++d0) { const bf16x8 k0 = *(const LAS bf16x8*)(kp_ + d0 * 2048), k1 = *(const LAS bf16x8*)(kp_ + d0 * 2048 + 512);
            sA0 = __builtin_amdgcn_mfma_f32_32x32x16_bf16(k0, qr[d0], d0 == 0 ? negm : sA0, 0, 0, 0); sA1 = __builtin_amdgcn_mfma_f32_32x32x16_bf16(k1, qr[d0], d0 == 0 ? negm : sA1, 0, 0, 0); }
        float rm = __builtin_fmaxf(sA0[0], sA1[0]);
#pragma unroll
        for (int r = 1; r < 16; ++r) rm = __builtin_fmaxf(rm, __builtin_fmaxf(sA0[r], sA1[r]));
        { auto rr = __builtin_amdgcn_permlane32_swap(__float_as_uint(rm), __float_as_uint(rm), false, false); rm = __builtin_fmaxf(__uint_as_float(rr[0]), __uint_as_float(rr[1])); }
        mhat = rm;
#pragma unroll
        for (int r = 0; r < 16; ++r) { negm[r] = -mhat; sA0[r] = __builtin_amdgcn_exp2f(sA0[r] - mhat); sA1[r] = __builtin_amdgcn_exp2f(sA1[r] - mhat); }
        store_k(1); store_v(0);
        __syncthreads();
    }
    for (int t = 1; t + 1 < NT; t += 2) {
        A2_STEP(sB0, sB1, sA0, sA1, t, true);
        A2_STEP(sA0, sA1, sB0, sB1, t + 1, true);
    }
    A2_STEP(sB0, sB1, sA0, sA1, NT - 1, false);
    {
        float sacc = 0.f;
#pragma unroll
        for (int r = 0; r < 16; ++r) sacc += sB0[r] + sB1[r];
        lrun += sacc;
        const LAS unsigned char* vp = Vb + ((NT - 1) & 1) * VB + vfo;
#pragma unroll
        for (int ks = 0; ks < 4; ++ks) {
            const f32x16& P = (ks < 2) ? sB0 : sB1; const int bse = 8 * (ks & 1);
            const u32x4 pa = {cvtpk(P[bse], P[bse + 1]), cvtpk(P[bse + 2], P[bse + 3]), cvtpk(P[bse + 4], P[bse + 5]), cvtpk(P[bse + 6], P[bse + 7])};
            const s16x4 l0 = __builtin_amdgcn_ds_read_tr16_b64_v4i16((LAS s16x4*)(vp + ks * 1024)), h0 = __builtin_amdgcn_ds_read_tr16_b64_v4i16((LAS s16x4*)(vp + ks * 1024 + 512));
            const s16x4 l1 = __builtin_amdgcn_ds_read_tr16_b64_v4i16((LAS s16x4*)(vp + 4096 + ks * 1024)), h1 = __builtin_amdgcn_ds_read_tr16_b64_v4i16((LAS s16x4*)(vp + 4096 + ks * 1024 + 512));
            const bf16x8 v0 = {l0[0], l0[1], l0[2], l0[3], h0[0], h0[1], h0[2], h0[3]}, v1 = {l1[0], l1[1], l1[2], l1[3], h1[0], h1[1], h1[2], h1[3]};
            o0 = __builtin_amdgcn_mfma_f32_32x32x16_bf16(__builtin_bit_cast(bf16x8, pa), v0, o0, 0, 0, 0);
            o1 = __builtin_amdgcn_mfma_f32_32x32x16_bf16(__builtin_bit_cast(bf16x8, pa), v1, o1, 0, 0, 0);
        }
    }
#undef A2_STEP
#undef A2_EL
#undef A2_SBAR
    __builtin_amdgcn_s_setprio(0);
    lrun += __shfl_xor(lrun, 32);
    if (hi == 0) wsf[32 + r32] = lrun;
    asm volatile("s_waitcnt lgkmcnt(0)" ::: "memory");
    bf16_t* Ow = (bf16_t*)(ws + WS_O) + ((size_t)b * SEQ + qb * 256 + wid * 32) * 1024 + h * 64;
#pragma unroll
    for (int r = 0; r < 16; ++r) { const int orow = crow(r, hi); const float rl = __builtin_amdgcn_rcpf(wsf[32 + orow]);
        Ow[(size_t)orow * 1024 + r32] = (bf16_t)f2bf(o0[r] * rl); Ow[(size_t)orow * 1024 + 32 + r32] = (bf16_t)f2bf(o1[r] * rl); }
    __syncthreads();
}
__device__ __forceinline__ void phase_attn(const Ctx& p, LAS unsigned char* lds) {
    const int xcd = p.bid & 7, sl = p.bid >> 3, c = sl & 1, b = 2 * xcd + (sl >> 4), qb = (sl >> 1) & 7;
    for (int i = 0; i < 8; ++i) { const int h = 2 * i + (c & 1);
#if ATTN_V1
        if (h < 8) attn_unit<96>(p, b, h, qb, lds); else attn_unit<64>(p, b, h, qb, lds); }
#else
        int tid = p.tid; asm volatile("" : "+v"(tid));
        if (h < 8) attn_unit2<96>(p, tid, b, h, qb, lds); else attn_unit2<64>(p, tid, b, h, qb, lds); }
#endif
}

__device__ __forceinline__ void hyena_taps(const Ctx& p, int c, LAS unsigned char* scratch, float (&taps)[4][2][2]) {
    const int tid = p.tid, lane = tid & 63, wave = __builtin_amdgcn_readfirstlane(tid >> 6);
    LAS float* w4s = (LAS float*)scratch;
    LAS float* red = (LAS float*)(scratch + 1024);
    const float* w4 = p.in[I_FW4]; const float* H3 = (const float*)(p.ws + WS_H3);
    if (tid < 256) { const int cc = tid >> 6, k = tid & 63; w4s[cc * 64 + k] = w4[(size_t)k * 4096 + (cc >> 1) * 2048 + (cc & 1) * 1024 + c]; }
    __syncthreads();
    const float dmin = -3.0701134573253940f, dmax = -15.350567286626970f;
    const float delta = fabsf(dmin + (float)c * ((dmax - dmin) / 1023.0f));
    float ss0 = 0.f, ss1 = 0.f;
    float a[4][4];
#pragma unroll
    for (int i = 0; i < 4; ++i)
#pragma unroll
        for (int cc = 0; cc < 4; ++cc) a[i][cc] = 0.f;
#pragma unroll 2
    for (int k4 = 0; k4 < 16; ++k4) {
        f32x4 wv[4];
#pragma unroll
        for (int cc = 0; cc < 4; ++cc) wv[cc] = *(const LAS f32x4*)(w4s + cc * 64 + 4 * k4);
#pragma unroll
        for (int i = 0; i < 4; ++i) { const f32x4 hv = *((const f32x4*)(H3 + (size_t)(tid + 512 * i) * 64) + k4);
#pragma unroll
            for (int cc = 0; cc < 4; ++cc) a[i][cc] += (hv[0] * wv[cc][0] + hv[1] * wv[cc][1]) + (hv[2] * wv[cc][2] + hv[3] * wv[cc][3]); }
    }
#pragma unroll
    for (int i = 0; i < 4; ++i) {
        const int t = tid + 512 * i;
        const float win = expf(-((float)t / 2048.0f) * delta);
#pragma unroll
        for (int cc = 0; cc < 4; ++cc) a[i][cc] *= win;
        taps[i][0][0] = a[i][0]; taps[i][0][1] = a[i][1]; taps[i][1][0] = a[i][2]; taps[i][1][1] = a[i][3];
        ss0 += a[i][0] * a[i][0] + a[i][2] * a[i][2]; ss1 += a[i][1] * a[i][1] + a[i][3] * a[i][3];
    }
    ss0 = wave_sum(ss0); ss1 = wave_sum(ss1);
    if (lane == 0) { red[wave * 2] = ss0; red[wave * 2 + 1] = ss1; }
    __syncthreads();
    float t0 = 0.f, t1 = 0.f;
#pragma unroll
    for (int w = 0; w < 8; ++w) { t0 += red[w * 2]; t1 += red[w * 2 + 1]; }
    const float n0 = rsqrtf(t0 + EPS), n1 = rsqrtf(t1 + EPS);
#pragma unroll
    for (int i = 0; i < 4; ++i) { taps[i][0][0] *= n0; taps[i][1][0] *= n0; taps[i][0][1] *= n1; taps[i][1][1] *= n1; }
    __syncthreads();
}
__device__ __forceinline__ void hyena_taps_block(const Ctx& p, LAS unsigned char* lds) {
    const int tid = p.tid, lane = tid & 63, wave = __builtin_amdgcn_readfirstlane(tid >> 6), fr = lane & 15, fq = lane >> 4;
    LAS float* w4s = (LAS float*)lds;
    LAS float* red = (LAS float*)(lds + 4096);
    const float* w4 = p.in[I_FW4]; const float* H3 = (const float*)(p.ws + WS_H3); bf16_t* F = (bf16_t*)(p.ws + WS_FILT);
    for (int i = tid; i < 1024; i += NTHREADS) { const int col = i >> 6, k = i & 63, q = col >> 2, cc = col & 3; const int c = p.bid + p.nblk * q;
        w4s[i] = (c < DM) ? w4[(size_t)k * 4096 + (cc >> 1) * 2048 + (cc & 1) * 1024 + c] : 0.f; }
    __syncthreads();
    bf16x8 bfr[2];
#pragma unroll
    for (int ks = 0; ks < 2; ++ks) { const f32x4 b0 = *(const LAS f32x4*)(w4s + fr * 64 + 32 * ks + 8 * fq), b1 = *(const LAS f32x4*)(w4s + fr * 64 + 32 * ks + 8 * fq + 4);
        const u32x4 w = {cvtpk(b0[0], b0[1]), cvtpk(b0[2], b0[3]), cvtpk(b1[0], b1[1]), cvtpk(b1[2], b1[3])}; bfr[ks] = __builtin_bit_cast(bf16x8, w); }
    f32x4 acc[16];
#pragma unroll
    for (int g = 0; g < 4; ++g) {
        f32x4 hv[4][2][2];
#pragma unroll
        for (int j = 0; j < 4; ++j)
#pragma unroll
            for (int ks = 0; ks < 2; ++ks) { const float* hp = H3 + (size_t)(16 * (wave * 16 + 4 * g + j) + fr) * 64 + 32 * ks + 8 * fq; hv[j][ks][0] = *(const f32x4*)hp; hv[j][ks][1] = *(const f32x4*)(hp + 4); }
#pragma unroll
        for (int j = 0; j < 4; ++j) { f32x4 a = {0.f, 0.f, 0.f, 0.f};
#pragma unroll
            for (int ks = 0; ks < 2; ++ks) { const f32x4 h0 = hv[j][ks][0], h1 = hv[j][ks][1];
                const u32x4 w = {cvtpk(h0[0], h0[1]), cvtpk(h0[2], h0[3]), cvtpk(h1[0], h1[1]), cvtpk(h1[2], h1[3])};
                a = __builtin_amdgcn_mfma_f32_16x16x32_bf16(__builtin_bit_cast(bf16x8, w), bfr[ks], a, 0, 0, 0); }
            acc[4 * g + j] = a; }
        __builtin_amdgcn_sched_barrier(0);
    }
    const int q = fr >> 2, o = fr & 1, dir = (fr >> 1) & 1, c = p.bid + p.nblk * q;
    const float dmin = -3.0701134573253940f, dmax = -15.350567286626970f;
    const float delta = fabsf(dmin + (float)c * ((dmax - dmin) / 1023.0f));
    const float r1 = expf(-delta / 2048.0f);
    float ssq = 0.f;
#pragma unroll
    for (int tt = 0; tt < 16; ++tt) { const int tb = 16 * (16 * wave + tt) + 4 * fq; float win = expf(-((float)tb / 2048.0f) * delta);
#pragma unroll
        for (int e = 0; e < 4; ++e) { const float v = acc[tt][e] * win; acc[tt][e] = v; ssq += v * v; win *= r1; } }
    ssq += __shfl_xor(ssq, 16); ssq += __shfl_xor(ssq, 32); ssq += __shfl_xor(ssq, 2);
    if (fq == 0 && dir == 0) red[wave * 8 + q * 2 + o] = ssq;
    __syncthreads();
    float tot = 0.f;
#pragma unroll
    for (int w = 0; w < 8; ++w) tot += red[w * 8 + q * 2 + o];
    const float nrm = rsqrtf(tot + EPS);
    LAS bf16_t* st = (LAS bf16_t*)(lds + 8192) + (q * 2 + o) * 4096 + 2048;
#pragma unroll
    for (int tt = 0; tt < 16; ++tt)
#pragma unroll
        for (int e = 0; e < 4; ++e) { const int t = 16 * (16 * wave + tt) + 4 * fq + e; const bf16_t v = (bf16_t)f2bf(acc[tt][e] * nrm);
            if (dir == 0) st[-t] = v; else if (t > 0) st[t] = v; }
    __syncthreads();
#pragma unroll
    for (int j = 0; j < 8; ++j) { const int idx = tid + 512 * j, arr = idx >> 9, off = idx & 511; const int cq = p.bid + p.nblk * (arr >> 1);
        const u32x4 w = *(const LAS u32x4*)(lds + 8192 + arr * 8192 + off * 16);
        if (cq < DM) *(u32x4*)(F + (size_t)(cq * 2 + (arr & 1)) * 4096 + 8 * off) = w; }
    __builtin_amdgcn_fence(__ATOMIC_RELEASE, "workgroup");
    asm volatile("s_waitcnt vmcnt(0)" ::: "memory");
    __syncthreads();
    __builtin_amdgcn_fence(__ATOMIC_ACQUIRE, "workgroup");
}
__device__ __forceinline__ float sconv_at(const bf16_t* zr, int b, int n, float w0, float w1, float w2, float cb) {
    const bf16_t* q = zr + b * SEQ + n;
    const float l = n > 0 ? bf2f(q[-1]) : 0.f, m = bf2f(q[0]), r = n < SEQ - 1 ? bf2f(q[1]) : 0.f;
    return cb + w0 * l + w1 * m + w2 * r;
}

__device__ __forceinline__ void phase_nconv_filt(const Ctx& p, LAS unsigned char* lds) {
    bf16_t* F = (bf16_t*)(p.ws + WS_FILT);
    for (int c = p.bid; c < DM; c += p.nblk) {
        float taps[4][2][2];
        hyena_taps(p, c, lds, taps);
#pragma unroll
        for (int i = 0; i < 4; ++i) { const int t = p.tid + 512 * i;
#pragma unroll
            for (int o = 0; o < 2; ++o) { bf16_t* f = F + (size_t)(c * 2 + o) * 4096;
                f[2048 - t] = (bf16_t)f2bf(taps[i][0][o]);
                if (t > 0) f[2048 + t] = (bf16_t)f2bf(taps[i][1][o]); } }
    }
}
__device__ __forceinline__ void phase_nconv_u0(const Ctx& p) {
    const bf16_t* ZT = (const bf16_t*)(p.ws + WS_ZT); bf16_t* U0 = (bf16_t*)(p.ws + WS_U0T);
    const float* cw = p.in[I_HCW]; const float* cb = p.in[I_HCB];
    for (size_t idx = (size_t)p.bid * NTHREADS + p.tid; idx < (size_t)DM * ML; idx += (size_t)p.nblk * NTHREADS) {
        const int c = (int)(idx >> 15), bn = (int)(idx & 32767), b = bn >> 11, n = bn & 2047; const int ch = 2048 + c;
        U0[idx] = (bf16_t)f2bf(sconv_at(ZT + (size_t)ch * ML, b, n, cw[ch], cw[3072 + ch], cw[6144 + ch], cb[ch]));
    }
}
__device__ __forceinline__ void phase_nconv_pass(const Ctx& p, int o) {
    const bf16_t* ZT = (const bf16_t*)(p.ws + WS_ZT); const bf16_t* F = (const bf16_t*)(p.ws + WS_FILT);
    const bf16_t* U = (const bf16_t*)(p.ws + (o == 0 ? WS_U0T : WS_Y1T)); bf16_t* Y = (bf16_t*)(p.ws + (o == 0 ? WS_Y1T : WS_Y2T));
    const float* cw = p.in[I_HCW]; const float* cb = p.in[I_HCB]; const float* skip = p.in[I_HSKIP];
    for (size_t idx = (size_t)p.bid * NTHREADS + p.tid; idx < (size_t)DM * ML; idx += (size_t)p.nblk * NTHREADS) {
        const int c = (int)(idx >> 15), bn = (int)(idx & 32767), b = bn >> 11, n = bn & 2047;
        const bf16_t* u = U + (size_t)c * ML + b * SEQ; const bf16_t* f = F + (size_t)(c * 2 + o) * 4096 + 2048 - n;
        float acc = 0.f;
        for (int m = 0; m < SEQ; ++m) acc += bf2f(f[m]) * bf2f(u[m]);
        acc += skip[o * DM + c] * bf2f(u[n]);
        const int ch = o * 1024 + c;
        const float gate = sconv_at(ZT + (size_t)ch * ML, b, n, cw[ch], cw[3072 + ch], cw[6144 + ch], cb[ch]);
        Y[idx] = (bf16_t)f2bf(gate * acc);
    }
}

constexpr int CV_USTRIDE = 4112;
constexpr int CV_U = 0;
constexpr int CV_CP = 65792, CV_CPSTRIDE = 8208;
static_assert(CV_CP + 8 * CV_CPSTRIDE <= LDS_BYTES, "conv LDS map");

__device__ __forceinline__ void conv_build_copies(const int tid, LAS unsigned char* lds, const bf16_t* rev) {
    const u32x4 cur = *(const u32x4*)(rev + 8 * tid);
    u32x4 prv = {0u, 0u, 0u, 0u};
    if (tid > 0) prv = *(const u32x4*)(rev + 8 * tid - 8);
    const unsigned W[8] = {prv.x, prv.y, prv.z, prv.w, cur.x, cur.y, cur.z, cur.w};
#pragma unroll
    for (int rho = 0; rho < 8; ++rho) {
        unsigned o[4];
#pragma unroll
        for (int d = 0; d < 4; ++d) { const int e0 = 8 - rho + 2 * d;
            o[d] = (e0 & 1) ? __builtin_amdgcn_alignbit(W[(e0 >> 1) + 1], W[e0 >> 1], 16) : W[e0 >> 1]; }
        *(LAS u32x4*)(lds + CV_CP + rho * CV_CPSTRIDE + 16 * tid) = (u32x4){o[0], o[1], o[2], o[3]};
    }
}
__device__ __forceinline__ void sconv4(const bf16_t* zr, int n, float w0, float w1, float w2, float cb, float (&g)[4]) {
    const u32x2 w = *(const u32x2*)(zr + n);
    const float l = n > 0 ? bf2f(zr[n - 1]) : 0.f, r = n + 4 < SEQ ? bf2f(zr[n + 4]) : 0.f;
    const float x[6] = {l, bflo(w.x), bfhi(w.x), bflo(w.y), bfhi(w.y), r};
#pragma unroll
    for (int e = 0; e < 4; ++e) g[e] = cb + w0 * x[e] + w1 * x[e + 1] + w2 * x[e + 2];
}
__device__ __forceinline__ void conv_mma(const int tid, LAS unsigned char* lds, f32x4 (&acc)[16]) {
    const int lane = tid & 63, wave = __builtin_amdgcn_readfirstlane(tid >> 6);
#pragma unroll
    for (int i = 0; i < 16; ++i) acc[i] = (f32x4){0.f, 0.f, 0.f, 0.f};
    const LAS unsigned char* ab = lds + CV_CP + (lane & 7) * CV_CPSTRIDE + 2 * (2048 - 8 * ((lane & 15) >> 3) + 8 * (lane >> 4)) - 32 * (16 * wave);
    const LAS unsigned char* ub = lds + CV_U + (lane & 15) * CV_USTRIDE + 16 * (lane >> 4);
    bf16x8 w0, w1, w2, w3, w4, w5, w6, w7, w8, w9, w10, w11, w12, w13, w14, w15;
#define CV_LD(i) (*(const LAS bf16x8*)(ab - 32 * (i)))
    w0 = CV_LD(0); w1 = CV_LD(1); w2 = CV_LD(2); w3 = CV_LD(3); w4 = CV_LD(4); w5 = CV_LD(5); w6 = CV_LD(6); w7 = CV_LD(7);
    w8 = CV_LD(8); w9 = CV_LD(9); w10 = CV_LD(10); w11 = CV_LD(11); w12 = CV_LD(12); w13 = CV_LD(13); w14 = CV_LD(14); w15 = CV_LD(15);
#undef CV_LD
#define CV_MF(i, W) acc[i] = __builtin_amdgcn_mfma_f32_16x16x32_bf16(W, uf, acc[i], 0, 0, 0)
#define CV_STEP(jj, A0, A1, A2, A3, A4, A5, A6, A7, A8, A9, A10, A11, A12, A13, A14, A15) do { \
        const int j = J * 8 + (jj); \
        const int jn = (j + 1 < 64) ? (j + 1) : j; \
        const bf16x8 ufn = *(const LAS bf16x8*)(ub + 64 * jn); \
        const bf16x8 n0 = *(const LAS bf16x8*)(ab + 64 * jn), n1 = *(const LAS bf16x8*)(ab + 64 * jn - 32); \
        CV_MF(0, A0); CV_MF(1, A1); CV_MF(2, A2); CV_MF(3, A3); CV_MF(4, A4); CV_MF(5, A5); CV_MF(6, A6); CV_MF(7, A7); \
        CV_MF(8, A8); CV_MF(9, A9); CV_MF(10, A10); CV_MF(11, A11); CV_MF(12, A12); CV_MF(13, A13); CV_MF(14, A14); CV_MF(15, A15); \
        A14 = n0; A15 = n1; uf = ufn; } while (0)
    bf16x8 uf = *(const LAS bf16x8*)ub;
    for (int J = 0; J < 8; ++J) {
        CV_STEP(0, w0, w1, w2, w3, w4, w5, w6, w7, w8, w9, w10, w11, w12, w13, w14, w15);
        CV_STEP(1, w14, w15, w0, w1, w2, w3, w4, w5, w6, w7, w8, w9, w10, w11, w12, w13);
        CV_STEP(2, w12, w13, w14, w15, w0, w1, w2, w3, w4, w5, w6, w7, w8, w9, w10, w11);
        CV_STEP(3, w10, w11, w12, w13, w14, w15, w0, w1, w2, w3, w4, w5, w6, w7, w8, w9);
        CV_STEP(4, w8, w9, w10, w11, w12, w13, w14, w15, w0, w1, w2, w3, w4, w5, w6, w7);
        CV_STEP(5, w6, w7, w8, w9, w10, w11, w12, w13, w14, w15, w0, w1, w2, w3, w4, w5);
        CV_STEP(6, w4, w5, w6, w7, w8, w9, w10, w11, w12, w13, w14, w15, w0, w1, w2, w3);
        CV_STEP(7, w2, w3, w4, w5, w6, w7, w8, w9, w10, w11, w12, w13, w14, w15, w0, w1);
    }
#undef CV_STEP
#undef CV_MF
}
struct SconvRow { u32x4 w[8]; float prev, last; };
__device__ __forceinline__ void sconv_row_load(const int tid, const bf16_t* zrow, SconvRow& R) {
    const int b = tid >> 5, m0 = (tid & 31) * 64; const bf16_t* zr = zrow + b * SEQ;
#pragma unroll
    for (int k8 = 0; k8 < 8; ++k8) R.w[k8] = *(const u32x4*)(zr + m0 + 8 * k8);
    R.prev = m0 > 0 ? bf2f(zr[m0 - 1]) : 0.f;
    R.last = m0 + 64 < SEQ ? bf2f(zr[m0 + 64]) : 0.f;
}
template <int STRIDE, bool W16>
__device__ __forceinline__ void sconv_row_store(const int tid, const SconvRow& R, float w0, float w1, float w2, float bb, LAS unsigned char* dst) {
    const int b = tid >> 5, m0 = (tid & 31) * 64;
    float prev = R.prev;
#pragma unroll
    for (int k8 = 0; k8 < 8; ++k8) {
        const float nxt = k8 < 7 ? bflo(R.w[k8 < 7 ? k8 + 1 : 7].x) : R.last;
        const float x[10] = {prev, bflo(R.w[k8].x), bfhi(R.w[k8].x), bflo(R.w[k8].y), bfhi(R.w[k8].y), bflo(R.w[k8].z), bfhi(R.w[k8].z), bflo(R.w[k8].w), bfhi(R.w[k8].w), nxt};
        float y[8];
#pragma unroll
        for (int e = 0; e < 8; ++e) y[e] = bb + w0 * x[e] + w1 * x[e + 1] + w2 * x[e + 2];
        const u32x4 o = {cvtpk(y[0], y[1]), cvtpk(y[2], y[3]), cvtpk(y[4], y[5]), cvtpk(y[6], y[7])};
        LAS unsigned char* d = dst + b * STRIDE + 2 * (m0 + 8 * k8);
        if (W16) *(LAS u32x4*)d = o; else { *(LAS u32x2*)d = (u32x2){o.x, o.y}; *(LAS u32x2*)(d + 8) = (u32x2){o.z, o.w}; }
        prev = x[8];
    }
}
constexpr int CV_GSTRIDE = 4104;
static_assert(16 * CV_GSTRIDE <= 8 * CV_CPSTRIDE, "gate image fits the copies region");
__device__ __forceinline__ void phase_conv(const Ctx& p, LAS unsigned char* lds) {
    const bf16_t* ZT = (const bf16_t*)(p.ws + WS_ZT); bf16_t* Y2T = (bf16_t*)(p.ws + WS_Y2T); const bf16_t* F = (const bf16_t*)(p.ws + WS_FILT);
    const float* cw = p.in[I_HCW]; const float* cb = p.in[I_HCB]; const float* skip = p.in[I_HSKIP];
    hyena_taps_block(p, lds);
    for (int c = p.bid; c < DM; c += p.nblk) {
        int tid = p.tid; asm volatile("" : "+v"(tid));
        const int lane = tid & 63, wave = __builtin_amdgcn_readfirstlane(tid >> 6);
        const int b = lane & 15, nq = 256 * wave + 4 * (lane >> 4);
        LAS unsigned char* Ul = lds + CV_U; LAS unsigned char* Gl = lds + CV_CP;
        { const int ch = 2048 + c; SconvRow R; sconv_row_load(tid, ZT + (size_t)ch * ML, R); sconv_row_store<CV_USTRIDE, true>(tid, R, cw[ch], cw[3072 + ch], cw[6144 + ch], cb[ch], Ul); }
        conv_build_copies(tid, lds, F + (size_t)(c * 2 + 0) * 4096);
        __syncthreads();
        f32x4 acc[16];
#pragma unroll 1
        for (int o = 0; o < 2; ++o) {
            const int chg = o * 1024 + c; SconvRow RG; sconv_row_load(tid, ZT + (size_t)chg * ML, RG);
            conv_mma(tid, lds, acc);
            __syncthreads();
            sconv_row_store<CV_GSTRIDE, false>(tid, RG, cw[chg], cw[3072 + chg], cw[6144 + chg], cb[chg], Gl);
            __syncthreads();
            { const float sk = skip[o * DM + c];
#pragma unroll
              for (int i = 0; i < 16; ++i) { const int n = nq + 16 * i; LAS u32x2* up = (LAS u32x2*)(Ul + b * CV_USTRIDE + 2 * n);
                  const u32x2 uw = *up, gw = *(const LAS u32x2*)(Gl + b * CV_GSTRIDE + 2 * n);
                  const float u[4] = {bflo(uw.x), bfhi(uw.x), bflo(uw.y), bfhi(uw.y)}, g[4] = {bflo(gw.x), bfhi(gw.x), bflo(gw.y), bfhi(gw.y)};
                  float y[4];
#pragma unroll
                  for (int e = 0; e < 4; ++e) y[e] = g[e] * (acc[i][e] + sk * u[e]);
                  *up = (u32x2){cvtpk(y[0], y[1]), cvtpk(y[2], y[3])}; } }
            __syncthreads();
            if (o == 0) { conv_build_copies(tid, lds, F + (size_t)(c * 2 + 1) * 4096); __syncthreads(); }
        }
        { const int bb_ = tid >> 5, m0 = (tid & 31) * 64; bf16_t* dst = Y2T + (size_t)c * ML + bb_ * SEQ + m0;
#pragma unroll
          for (int k8 = 0; k8 < 8; ++k8) *(u32x4*)(dst + 8 * k8) = *(const LAS u32x4*)(Ul + bb_ * CV_USTRIDE + 2 * (m0 + 8 * k8)); }
        __syncthreads();
    }
}

__device__ __forceinline__ void phase_transpose(const Ctx& p, LAS unsigned char* lds) {
    const int tid = p.tid, lane = tid & 63, wave = __builtin_amdgcn_readfirstlane(tid >> 6);
    const bf16_t* src = (const bf16_t*)(p.ws + WS_Y2T); bf16_t* dst = (bf16_t*)(p.ws + WS_Y2);
    LAS bf16_t* tile = (LAS bf16_t*)(lds + wave * 16384);
    const int gw = p.bid * NWAVES + wave, ngw = p.nblk * NWAVES;
    for (int it = gw; it < (DM / 64) * (ML / 64); it += ngw) {
        const int cb = it & 15, tb = it >> 4, c0 = cb * 64, t0 = tb * 64;
#pragma unroll
        for (int i = 0; i < 8; ++i) { const int r = 8 * i + (lane >> 3), ch = lane & 7;
            const u32x4 w = *(const u32x4*)(src + (size_t)(c0 + r) * ML + t0 + 8 * ch);
            LAS unsigned* d = (LAS unsigned*)(tile + r * 66 + 8 * ch); d[0] = w.x; d[1] = w.y; d[2] = w.z; d[3] = w.w; }
        asm volatile("s_waitcnt lgkmcnt(0)" ::: "memory");
#pragma unroll
        for (int i = 0; i < 8; ++i) { const int t = 8 * i + (lane >> 3), ch = lane & 7; unsigned short e[8];
#pragma unroll
            for (int k = 0; k < 8; ++k) e[k] = tile[(8 * ch + k) * 66 + t];
            u32x4 w; w.x = e[0] | ((unsigned)e[1] << 16); w.y = e[2] | ((unsigned)e[3] << 16); w.z = e[4] | ((unsigned)e[5] << 16); w.w = e[6] | ((unsigned)e[7] << 16);
            *(u32x4*)(dst + (size_t)(t0 + t) * DM + c0 + 8 * ch) = w; }
        asm volatile("s_waitcnt lgkmcnt(0)" ::: "memory");
    }
}

#define XB_TMO      128
#define XB_XCNT(j)  (256  + 64 * (j))
#define XB_XSUB(j)  (1280 + 64 * (j))
#define XB_XGEN(j)  (2304 + 64 * (j))
#define XB_TOP      3328
#define XB_TOPGEN   3392
#define XCD_BAR_WORDS 3456
#define XB_SPIN_CAP (1u << 18)
__device__ __forceinline__ unsigned xb_ld(unsigned* p)              { return __hip_atomic_load(p, __ATOMIC_RELAXED, __HIP_MEMORY_SCOPE_AGENT); }
__device__ __forceinline__ unsigned xb_add(unsigned* p, unsigned v) { return __hip_atomic_fetch_add(p, v, __ATOMIC_RELAXED, __HIP_MEMORY_SCOPE_AGENT); }
__device__ __forceinline__ unsigned xb_xcc_id() { return (unsigned)__builtin_amdgcn_s_getreg((3 << 11) | 20) & 0xFu; }
#define XB_SPIN(cond, bar) do { unsigned _sp = 0; while (cond) { __builtin_amdgcn_s_sleep(1); \
    if ((++_sp & 255u) == 0u) { if (xb_ld(&(bar)[XB_TMO])) break; if (_sp > XB_SPIN_CAP) { atomicAdd(&(bar)[XB_TMO], 1u); break; } } } } while (0)
struct XcdBarrier { unsigned* bar; unsigned x; volatile LAS unsigned* st; };
__device__ __forceinline__ XcdBarrier xcd_barrier_post(unsigned* bar, volatile LAS unsigned* st) {
    XcdBarrier b; b.bar = bar; b.x = xb_xcc_id(); b.st = st;
    if (threadIdx.x == 0) (void)xb_add(&bar[XB_XCNT(b.x)], 1u);
    return b;
}
__device__ __forceinline__ void xcd_barrier_complete(unsigned* bar, unsigned x, unsigned& nloc, unsigned& nx) {
    const unsigned G = gridDim.x * gridDim.y * gridDim.z;
    unsigned sum, cnt, mine, sp = 0u;
    for (;;) {
        sum = 0u; cnt = 0u; mine = 0u;
#pragma unroll
        for (unsigned j = 0; j < 16; ++j) { const unsigned c = xb_ld(&bar[XB_XCNT(j)]); sum += c; cnt += (c > 0u) ? 1u : 0u; mine = (j == x) ? c : mine; }
        if (sum == G) break;
        __builtin_amdgcn_s_sleep(1);
        if ((++sp & 255u) == 0u) { if (xb_ld(&bar[XB_TMO])) break; if (sp > XB_SPIN_CAP) { atomicAdd(&bar[XB_TMO], 1u); break; } }
    }
    nloc = mine > 0u ? mine : 1u; nx = cnt > 0u ? cnt : 1u;
}
__device__ __forceinline__ void xcd_barrier(const XcdBarrier& b) {
    asm volatile("s_waitcnt vmcnt(0)" ::: "memory");
    __syncthreads();
    if (threadIdx.x == 0) {
        unsigned* bar = b.bar;
        __builtin_amdgcn_s_waitcnt(0);
        unsigned nloc = b.st[0], nx = b.st[1];
        if (nloc == 0u) { xcd_barrier_complete(bar, b.x, nloc, nx); b.st[0] = nloc; b.st[1] = nx; }
        const unsigned old = xb_add(&bar[XB_XSUB(b.x)], 1u);
        const unsigned gen = old / nloc;
        if (old + 1u == (gen + 1u) * nloc) {
            __builtin_amdgcn_fence(__ATOMIC_RELEASE, "agent");
            asm volatile("s_waitcnt vmcnt(0)" ::: "memory");
            const unsigned og = xb_add(&bar[XB_TOP], 1u);
            const unsigned tg = og / nx;
            if (og + 1u == (tg + 1u) * nx) xb_add(&bar[XB_TOPGEN], 1u);
            else XB_SPIN(xb_ld(&bar[XB_TOPGEN]) == tg, bar);
            __builtin_amdgcn_fence(__ATOMIC_ACQUIRE, "agent");
            xb_add(&bar[XB_XGEN(b.x)], 1u);
            asm volatile("s_waitcnt vmcnt(0)" ::: "memory");
        } else {
            XB_SPIN(xb_ld(&bar[XB_XGEN(b.x)]) == gen, bar);
            __builtin_amdgcn_fence(__ATOMIC_ACQUIRE, "agent");
            asm volatile("s_waitcnt vmcnt(0)" ::: "memory");
        }
    }
    __syncthreads();
}
constexpr int LDS_CTL_OFF = LDS_BYTES - 64;
constexpr size_t CTL_BAR_OFF = 16384;
constexpr size_t CTL_STAMP_OFF = 65536;
constexpr size_t CTL_ZERO_BYTES = 131072;

enum { P_PRO = 0, P_MOD1_0, P_GEMM_IN, P_ZPOST, P_GEMM_QKV, P_ATTN, P_GEMM_OUT0, P_MOD2_0, P_MLP_UP0, P_MLP_DN0,
       P_MOD1_1, P_GEMM_HIN, P_CONV, P_TRANS, P_GEMM_OUT1, P_MOD2_1, P_MLP_UP1, P_MLP_DN1, P_FINAL,
       P_NC_FILT, P_NC_U0, P_NC_A, P_NC_B, P_NA_Q, P_NONE };
__host__ __device__ __forceinline__ int prog(int i) {
    int k = 0;
#define PRG(x) do { if (i == k) return (x); ++k; } while (0)
    PRG(P_PRO); PRG(P_MOD1_0); PRG(P_GEMM_IN); PRG(P_ZPOST); PRG(P_GEMM_QKV);
#if NAIVE_ATTN
    PRG(P_NA_Q);
#endif
    PRG(P_ATTN); PRG(P_GEMM_OUT0); PRG(P_MLP_UP0); PRG(P_MLP_DN0); PRG(P_GEMM_HIN);
#if NAIVE_CONV
    PRG(P_NC_FILT); PRG(P_NC_U0); PRG(P_NC_A); PRG(P_NC_B);
#else
    PRG(P_CONV);
#endif
    PRG(P_TRANS); PRG(P_GEMM_OUT1); PRG(P_MLP_UP1); PRG(P_MLP_DN1); PRG(P_FINAL);
#undef PRG
    return P_NONE;
}
constexpr int N_PROG = 16 + (NAIVE_ATTN ? 1 : 0) + (NAIVE_CONV ? 3 : 0);

__device__ __forceinline__ bool gemm_job(const Ctx& p, int ph, int jj, GemmJob& J) {
    unsigned char* ws = p.ws;
    const float* MODL = (const float*)(ws + WS_MODL);
    size_t a = 0, b = 0, o = 0, sq = 0, shw = 0; int M = 0, N = 0, K = 0, kind = 0, ldc = 0, shw_ld = 0; bool has_o = true, has_sq = false;
    const float* base = nullptr; const float* gate = nullptr; const float* ng = nullptr; const float* nsc = nullptr;
    if (jj == 0) {
        if (ph == P_GEMM_IN) { a = WS_HL; b = WS_WIN; o = WS_Z; M = MT; N = ZW; K = DM; ldc = ZW; }
        else if (ph == P_GEMM_QKV) { a = WS_CQN; b = WS_WQB; o = WS_QM; M = ML; N = 768; K = 384; ldc = 768; }
        else if (ph == P_GEMM_OUT0) { a = WS_O; b = WS_WOUT; M = ML; N = DM; K = DM; kind = 2; gate = MODL + 2 * DM;
            o = WS_HL; ng = p.in[I_N2G]; nsc = MODL + 4 * DM; sq = WS_SQA; has_sq = true; }
        else if (ph == P_MLP_UP0) { a = WS_HL; b = WS_W1_0; o = WS_HID; M = ML; N = 4096; K = DM; kind = 1; ldc = 4096; sq = WS_SQA; has_sq = true; shw = WS_SHW_UP0; shw_ld = 4096; }
        else if (ph == P_MLP_DN0) { a = WS_HID; b = WS_W2_0; M = ML; N = DM; K = 4096; kind = 2; gate = MODL + 5 * DM;
            o = WS_HL; ng = p.in[I_N1G] + DM; nsc = MODL + (size_t)16 * NMOD + DM; sq = WS_SQB; has_sq = true; }
        else if (ph == P_GEMM_HIN) { a = WS_HIN; b = WS_HL; o = WS_ZT; M = 3 * DM; N = ML; K = DM; ldc = ML; kind = 3; sq = WS_SQB; has_sq = true; shw = WS_SHW_HIN; shw_ld = 3 * DM; }
        else if (ph == P_GEMM_OUT1) { a = WS_Y2; b = WS_HOUT; M = ML; N = DM; K = DM; kind = 2; gate = MODL + (size_t)16 * NMOD + 2 * DM;
            o = WS_HL; ng = p.in[I_N2G] + DM; nsc = MODL + (size_t)16 * NMOD + 4 * DM; sq = WS_SQC; has_sq = true; }
        else if (ph == P_MLP_UP1) { a = WS_HL; b = WS_W1_1; o = WS_HID; M = ML; N = 4096; K = DM; kind = 1; ldc = 4096; sq = WS_SQC; has_sq = true; shw = WS_SHW_UP1; shw_ld = 4096; }
        else if (ph == P_MLP_DN1) { a = WS_HID; b = WS_W2_1; M = ML; N = DM; K = 4096; kind = 2; gate = MODL + (size_t)16 * NMOD + 5 * DM; has_o = false; sq = WS_SQA; has_sq = true; ng = p.in[I_FINALG]; nsc = MODL; }
        else return false;
    } else {
        if (ph == P_GEMM_QKV) { a = WS_CKVN; b = WS_WKVB; o = WS_KV; M = MT; N = 1024; K = 256; ldc = 1024; }
        else return false;
    }
    J.A = (const bf16_t*)(ws + a); J.Bt = (const bf16_t*)(ws + b); J.M = M; J.N = N; J.K = K; J.rot = (ph == P_GEMM_QKV && jj == 0) ? 128 : 0;
    J.E.kind = kind; J.E.O = has_o ? (bf16_t*)(ws + o) : nullptr; J.E.ldc = ldc; J.E.base = base; J.E.xres = (bf16_t*)(ws + WS_XW); J.E.gate = gate; J.E.ng = ng; J.E.nsc = nsc;
    J.E.sqp = has_sq ? (float*)(ws + sq) : nullptr; J.E.shw = (const float*)(ws + shw); J.E.shw_ld = shw_ld;
    return true;
}

__global__ void __launch_bounds__(NTHREADS, 2) fwd(Params kp) {
    extern __shared__ __attribute__((aligned(16))) unsigned char lds_raw[];
    LAS unsigned char* lds = (LAS unsigned char*)lds_raw;
    const int wave0 = __builtin_amdgcn_readfirstlane((int)threadIdx.x >> 6);
#if !CG_SYNC
    if (threadIdx.x < 16) ((volatile LAS unsigned*)(lds + LDS_CTL_OFF))[threadIdx.x] = 0u;
    __syncthreads();
    const XcdBarrier xbar = xcd_barrier_post((unsigned*)(kp.ws + WS_CTL + CTL_BAR_OFF), (volatile LAS unsigned*)(lds + LDS_CTL_OFF));
#endif
#if PROBE_A >= 0
#define STAMP(k) do { if (blockIdx.x == 0 && threadIdx.x == 0) ((unsigned long long*)(kp.ws + WS_CTL + CTL_STAMP_OFF))[(k)] = __builtin_amdgcn_s_memrealtime(); } while (0)
#else
#define STAMP(k) do { } while (0)
#endif
    for (int pi = kp.ph_lo; pi < kp.ph_hi; ++pi) {
        if (pi > kp.ph_lo) {
            STAMP(2 * pi - 1);
#if CG_SYNC
            cg::this_grid().sync();
#else
            xcd_barrier(xbar);
#endif
        }
        STAMP(2 * pi);
        const int ph = prog(pi);
        for (int rep = 0; rep < ((pi == REPEAT_PI) ? 2 : 1); ++rep) {
        if (rep) {
#if CG_SYNC
            cg::this_grid().sync();
#else
            xcd_barrier(xbar);
#endif
        }
#define MAKE_CTX(p) Ctx p; { int z_ = 0, lane_; asm volatile("v_mbcnt_lo_u32_b32 %0, -1, 0\n\tv_mbcnt_hi_u32_b32 %0, -1, %0" : "=v"(lane_)); asm volatile("" : "+s"(z_)); \
          p.in = (const CAS cfptr_t*)kp.in + z_; p.out = kp.out + z_; p.ws = kp.ws + z_; p.tid = ((wave0 + z_) << 6) + lane_; p.bid = (int)blockIdx.x + z_; p.nblk = (int)gridDim.x + z_; }
#ifndef NO_GEMM
        { MAKE_CTX(pg); for (int jj = 0; jj < 2; ++jj) { GemmJob J; if (!gemm_job(pg, ph, jj, J)) break; run_gemm(pg, lds, J); } }
#endif
        MAKE_CTX(p);
        if (ph == P_PRO && PHON(P_PRO)) phase_prologue(p, lds, true, false);
        else if (ph == P_MOD1_0 && PHON(P_MOD1_0)) { phase_prologue(p, lds, false, true); phase_modulate(p, p.in[I_X], 0, p.in[I_N1G], 0, DM, true); }
        else if (ph == P_ZPOST && PHON(P_ZPOST)) { phase_zpost(p, lds); }
        else if (ph == P_GEMM_IN) phase_shw(p, 96);
        else if (ph == P_ATTN && PHON(P_ATTN)) {
#if NAIVE_ATTN
            phase_attn_naive(p);
#else
            phase_attn(p, lds);
#endif
        }
        else if (ph == P_NA_Q && PHON(P_NA_Q)) phase_naive_qrope(p);
        else if (ph == P_CONV && PHON(P_CONV)) phase_conv(p, lds);
        else if (ph == P_NC_FILT && PHON(P_NC_FILT)) phase_nconv_filt(p, lds);
        else if (ph == P_NC_U0 && PHON(P_NC_U0)) phase_nconv_u0(p);
        else if (ph == P_NC_A && PHON(P_NC_A)) phase_nconv_pass(p, 0);
        else if (ph == P_NC_B && PHON(P_NC_B)) phase_nconv_pass(p, 1);
        else if (ph == P_TRANS && PHON(P_TRANS)) phase_transpose(p, lds);
        else if (ph == P_FINAL && PHON(P_FINAL)) phase_final(p);
        }
    }
#if PROBE_A >= 0
    STAMP(2 * kp.ph_hi - 1);
    __syncthreads();
    if (blockIdx.x == 0) {
        asm volatile("s_waitcnt vmcnt(0)" ::: "memory");
        const unsigned long long* st = (const unsigned long long*)(kp.ws + WS_CTL + CTL_STAMP_OFF);
        const float dta = (float)(st[PROBE_A_TO] - st[PROBE_A]) * 0.01f, dtb = (float)(st[PROBE_B_TO] - st[PROBE_B]) * 0.01f;
        for (int i = threadIdx.x + 1024; i < 1024 + 100000; i += NTHREADS) kp.out[i] += 0.001f * dtb;
        if (threadIdx.x == 0) kp.out[0] += 0.004f * dta;
    }
#endif
}

extern "C" void kernel_launch(void* const* d_in, const int* in_sizes, int n_in, void* d_out, int out_size, void* d_ws, size_t ws_size, hipStream_t stream) {
    static int ok = 0;
    if (ok == 0) {
        ok = 1;
        if (n_in != 32 || in_sizes[0] != ML * DM || out_size != ML * DM || ws_size < WS_END) { fprintf(stderr, "kernel_launch: unexpected shapes (n_in %d, in0 %d, out %d, ws %zu)\n", n_in, n_in > 0 ? in_sizes[0] : -1, out_size, ws_size); ok = -1; }
        int dev = 0, cus = 0;
        if (hipGetDevice(&dev) != hipSuccess || hipDeviceGetAttribute(&cus, hipDeviceAttributeMultiprocessorCount, dev) != hipSuccess || cus < GRID) { fprintf(stderr, "kernel_launch: needs %d CUs, device reports %d\n", GRID, cus); ok = -1; }
        if (hipFuncSetAttribute((const void*)fwd, hipFuncAttributeMaxDynamicSharedMemorySize, LDS_BYTES) != hipSuccess) { fprintf(stderr, "kernel_launch: hipFuncSetAttribute failed\n"); ok = -1; }
        int per_cu = 0;
        if (hipOccupancyMaxActiveBlocksPerMultiprocessor(&per_cu, (const void*)fwd, NTHREADS, LDS_BYTES) != hipSuccess || per_cu < 1) { fprintf(stderr, "kernel_launch: occupancy query says %d blocks per CU\n", per_cu); }
        (void)hipGetLastError();
    }
    if (ok < 0) return;
    Params p{};
    for (int i = 0; i < 32; ++i) p.in[i] = (const float*)d_in[i];
    p.out = (float*)d_out; p.ws = (unsigned char*)d_ws;
#if !CG_SYNC || PROBE_A >= 0
    if (hipMemsetAsync((char*)d_ws + WS_CTL, 0, CTL_ZERO_BYTES, stream) != hipSuccess) { fprintf(stderr, "kernel_launch: memset of the control words failed\n"); return; }
#endif
#if ONE_LAUNCH
    p.ph_lo = 0; p.ph_hi = N_PROG;
    void* args[] = {&p};
    hipError_t e = hipLaunchCooperativeKernel((const void*)fwd, dim3(GRID), dim3(NTHREADS), args, LDS_BYTES, stream);
    if (e != hipSuccess) fprintf(stderr, "kernel_launch: cooperative launch failed: %s\n", hipGetErrorString(e));
#else
    for (int i = 0; i < N_PROG; ++i) { p.ph_lo = i; p.ph_hi = i + 1; hipLaunchKernelGGL(fwd, dim3(GRID), dim3(NTHREADS), LDS_BYTES, stream, p); }
#endif
}
```

```cpp
#include <hip/hip_runtime.h>
#include <hip/hip_cooperative_groups.h>
#include <cstdio>
#include <cstdint>
namespace cg = cooperative_groups;

#ifndef ONE_LAUNCH
#define ONE_LAUNCH 1
#endif
#ifndef CG_SYNC
#define CG_SYNC 0
#endif
#ifndef REPEAT_PI
#define REPEAT_PI -1
#endif
#ifndef PROBE_A
#define PROBE_A -1
#endif
#ifndef ATTN_V1
#define ATTN_V1 0
#endif
#ifndef ZPOST_REF
#define ZPOST_REF 0
#endif
#ifndef SIMPLE_GEMM
#define SIMPLE_GEMM 0
#endif
#ifndef NAIVE_ATTN
#define NAIVE_ATTN 0
#endif
#ifndef NAIVE_CONV
#define NAIVE_CONV 0
#endif

#ifndef PHASE_MASK
#define PHASE_MASK 0xFFFFFFFFu
#endif
#define PHON(x) (((PHASE_MASK) >> (x)) & 1u)
#define LAS __attribute__((address_space(3)))
typedef unsigned short bf16_t;
typedef short bf16x8 __attribute__((ext_vector_type(8)));
typedef short s16x4 __attribute__((ext_vector_type(4)));
typedef float f32x2 __attribute__((ext_vector_type(2)));
typedef float f32x4 __attribute__((ext_vector_type(4)));
typedef float f32x16 __attribute__((ext_vector_type(16)));
typedef unsigned u32x2 __attribute__((ext_vector_type(2)));
typedef unsigned u32x4 __attribute__((ext_vector_type(4)));
typedef __bf16 bf16x2_t __attribute__((ext_vector_type(2)));

constexpr int NB = 16, SEQ = 2048, DM = 1024, CTXL = 256, TKEYS = CTXL + SEQ;
constexpr int ML = NB * SEQ;
constexpr int MC = NB * CTXL;
constexpr int MT = ML + MC;
constexpr int NMOD = 6 * DM;
constexpr int ZW = 1536;
constexpr float EPS = 1e-6f;
constexpr int NWAVES = 8, NTHREADS = 512, GRID = 256, NGW = GRID * NWAVES;
constexpr int LDS_BYTES = 155648;
constexpr int ZC_CQ = 0, ZC_CKV = 384, ZC_KR = 640, ZC_GQ = 672, ZC_GK = 1184, ZC_GV = 1312;
constexpr float LOG2E = 1.4426950408889634f;
constexpr float QSCALE_MLA = 0.10206207261596577f * LOG2E;
constexpr float QSCALE_GQA = 0.125f * LOG2E;

constexpr size_t MiB = 1ull << 20;
constexpr size_t WS_CTL = 0;
constexpr size_t WS_MODL = 1 * MiB;
constexpr size_t WS_MODC = 1 * MiB + 786432;
constexpr size_t WS_H3 = 2 * MiB;
constexpr size_t WS_H3B = 2 * MiB + 524288;
constexpr size_t WS_SHW_UP0 = 3 * MiB, WS_SHW_HIN = 3 * MiB + 262144, WS_SHW_UP1 = 3 * MiB + 262144 + 196608;
constexpr size_t WS_SQA = 244 * MiB, WS_SQB = 246 * MiB, WS_SQC = 248 * MiB;
constexpr size_t WS_WIN = 4 * MiB, WS_WQB = 7 * MiB, WS_WKVB = 8 * MiB, WS_WOUT = 9 * MiB;
constexpr size_t WS_W1_0 = 11 * MiB, WS_W2_0 = 19 * MiB, WS_W1_1 = 27 * MiB, WS_W2_1 = 35 * MiB, WS_HIN = 43 * MiB, WS_HOUT = 49 * MiB;
constexpr size_t WS_XW = 52 * MiB;
constexpr size_t WS_HL = 180 * MiB;
constexpr size_t WS_Z = 252 * MiB, WS_CQN = 360 * MiB, WS_CKVN = 384 * MiB, WS_KROPE = 402 * MiB, WS_QG = 405 * MiB, WS_KG = 437 * MiB, WS_VG = 446 * MiB, WS_QM = 455 * MiB;
constexpr size_t WS_KV = WS_HL, WS_O = 252 * MiB;
constexpr size_t WS_HID = 252 * MiB;
constexpr size_t WS_ZT = 252 * MiB, WS_Y2T = WS_HL, WS_Y2 = 252 * MiB;
constexpr size_t WS_QMR = 316 * MiB;
constexpr size_t WS_FILT = 4 * MiB, WS_U0T = 444 * MiB, WS_Y1T = 380 * MiB;
constexpr size_t WS_END = 508 * MiB;

struct Params { const float* in[32]; float* out; unsigned char* ws; int ph_lo, ph_hi; };
#define CAS __attribute__((address_space(4)))
typedef const float* cfptr_t;
struct Ctx { const CAS cfptr_t* in; float* out; unsigned char* ws; int tid, bid, nblk; };

enum { I_X = 0, I_C, I_CTX, I_CCTX, I_WMOD, I_BMOD, I_N1G, I_N2G, I_W1, I_W2, I_AWIN, I_AQAG, I_AWQB, I_AKVAG, I_AWKVB, I_AQNG, I_AKNG, I_AWOUT,
       I_HWIN, I_HCW, I_HCB, I_FW1, I_FB1, I_FW2, I_FB2, I_FW3, I_FB3, I_FFREQ, I_FW4, I_HSKIP, I_HWOUT, I_FINALG };

__device__ __forceinline__ unsigned f2bf(float f) { unsigned u = __float_as_uint(f); return (u + 0x7fffu + ((u >> 16) & 1u)) >> 16; }
__device__ __forceinline__ float bf2f(unsigned h) { return __uint_as_float(h << 16); }
__device__ __forceinline__ unsigned cvtpk(float lo, float hi) { f32x2 v = {lo, hi}; bf16x2_t b = __builtin_convertvector(v, bf16x2_t); return __builtin_bit_cast(unsigned, b); }
__device__ __forceinline__ float wave_sum(float v) {
#pragma unroll
    for (int o = 1; o < 64; o <<= 1) v += __shfl_xor(v, o);
    return v;
}
__device__ __forceinline__ float fsin(float x) { return __builtin_amdgcn_sinf(__builtin_amdgcn_fractf(x * 0.15915494309189535f)); }
__device__ __forceinline__ float fcos(float x) { return __builtin_amdgcn_cosf(__builtin_amdgcn_fractf(x * 0.15915494309189535f)); }
__device__ __forceinline__ float inv_theta(float x) { return exp2f(-x * 13.287712379549449f); }
__device__ __forceinline__ float dpp_xor1(float v) { return __builtin_bit_cast(float, __builtin_amdgcn_update_dpp(0, __builtin_bit_cast(int, v), 0xB1, 0xF, 0xF, true)); }
__device__ __forceinline__ float dpp_xor2(float v) { return __builtin_bit_cast(float, __builtin_amdgcn_update_dpp(0, __builtin_bit_cast(int, v), 0x4E, 0xF, 0xF, true)); }
__device__ __forceinline__ float dpp_hmirror(float v) { return __builtin_bit_cast(float, __builtin_amdgcn_update_dpp(0, __builtin_bit_cast(int, v), 0x141, 0xF, 0xF, true)); }
__device__ __forceinline__ float sum8(float v) { v += dpp_xor1(v); v += dpp_xor2(v); v += dpp_hmirror(v); return v; }
__device__ __forceinline__ float bflo(unsigned w) { return __uint_as_float(w << 16); }
__device__ __forceinline__ float bfhi(unsigned w) { return __uint_as_float(w & 0xffff0000u); }

namespace pg8 {
constexpr int BM = 256, BK = 64, HALF = 128, HTB = HALF * BK * 2, STAGE_BYTES = 8 * HTB, NXCD = 8, WGM = 8;
__host__ __device__ __forceinline__ int lds_byte(int r, int c) { const int st = (r >> 4) * 2 + (c >> 5), rr = r & 15, cc = c & 31, ob = rr * 64 + cc * 2; return st * 1024 + (ob ^ (((ob >> 9) & 1) << 5)); }
__host__ __device__ __forceinline__ void stage_rc(int b, int& R, int& C) { const int st = b / 1024, sb = b % 1024, swz = sb ^ (((sb >> 9) & 1) << 5); R = (st >> 1) * 16 + swz / 64; C = (st & 1) * 32 + (swz % 64) / 2; }
__host__ __device__ __forceinline__ int perm32(int rho) { const int n = rho >> 4, i = rho & 15; return 8 * (i >> 2) + 4 * n + (i & 3); }

struct Unit { int pm, pn; };
struct Gemm { const bf16_t* A; const bf16_t* Bt; int M, N, K; };

struct StaticOrder {
    int nM, nN, nwg, G, c;
    __host__ __device__ void init(int M, int N, int G_, int c_) { nM = M / BM; nN = N / BM; nwg = nM * nN; G = G_; c = c_; }
    __host__ __device__ bool next(int i, Unit& u) const {
        const long L = (long)i * G + c; if (L >= nwg) return false;
        int wgid = (int)L; { const int q = nwg / NXCD, r = nwg % NXCD, xcd = wgid % NXCD, off = wgid / NXCD; wgid = (xcd < r ? xcd * (q + 1) : r * (q + 1) + (xcd - r) * q) + off; }
        const int nig = WGM * nN, gid = wgid / nig, fm = gid * WGM, gsz = (nM - fm) < WGM ? (nM - fm) : WGM;
        u.pm = fm + ((wgid % nig) % gsz); u.pn = (wgid % nig) / gsz; return true;
    }
    __device__ __forceinline__ void a_ready(const Unit&) const {}
    __device__ __forceinline__ void done(const Unit&) const {}
};

struct EpiAny {
    static constexpr bool AFTER_DRAIN = false;
    int kind; bf16_t* O; int ldc; const float* base; bf16_t* xres; const float* gate; const float* ng; const float* nsc; float* sqp; const float* shw; int shw_ld; LAS float* tab;
    __device__ __forceinline__ bool perm() const { return true; }
    __device__ __forceinline__ void operator()(const f32x4 (&acc)[2][2][4][2], const Unit& u, int ui, int wr, int wc, int fr, int fq) const {
        const int rt = wr * 64 + fr, ct = wc * 32 + 8 * fq;
        const int row0 = u.pm * BM + rt, col0 = u.pn * BM + ct;
        if (kind != 2) {
            const LAS float* T0 = tab + ui * 512; const LAS float* T1 = T0 + 256;
            f32x4 cs[2][2], ca[2][2];
#pragma unroll
            for (int bj = 0; bj < 2; ++bj)
#pragma unroll
                for (int h = 0; h < 2; ++h) { cs[bj][h] = (f32x4){1.f, 1.f, 1.f, 1.f}; ca[bj][h] = (f32x4){0.f, 0.f, 0.f, 0.f}; }
            if (kind == 1) {
#pragma unroll
                for (int bj = 0; bj < 2; ++bj) { ca[bj][0] = *(const LAS f32x4*)(T1 + ct + bj * HALF); ca[bj][1] = *(const LAS f32x4*)(T1 + ct + bj * HALF + 4); } }
            if (kind == 3) {
#pragma unroll
                for (int bj = 0; bj < 2; ++bj) { cs[bj][0] = *(const LAS f32x4*)(T0 + ct + bj * HALF); cs[bj][1] = *(const LAS f32x4*)(T0 + ct + bj * HALF + 4); } }
#pragma unroll
            for (int ai = 0; ai < 2; ++ai)
#pragma unroll
                for (int m = 0; m < 4; ++m) { const int rr = rt + ai * HALF + m * 16; bf16_t* rowp = O + (size_t)(u.pm * BM + rr) * ldc + col0;
                    float rs = 1.f, ra = 0.f;
                    if (kind == 1) rs = T0[rr];
                    if (kind == 3) ra = T1[rr];
#pragma unroll
                    for (int bj = 0; bj < 2; ++bj) { f32x4 v0 = acc[ai][bj][m][0], v1 = acc[ai][bj][m][1];
                        if (kind == 1) { v0 = v0 * rs + ca[bj][0]; v1 = v1 * rs + ca[bj][1];
#pragma unroll
                            for (int e = 0; e < 4; ++e) { const float a = fmaxf(v0[e], 0.f), b = fmaxf(v1[e], 0.f); v0[e] = a * a; v1[e] = b * b; } }
                        if (kind == 3) { v0 = v0 * cs[bj][0] + ra; v1 = v1 * cs[bj][1] + ra; }
                        u32x4 w; w.x = cvtpk(v0[0], v0[1]); w.y = cvtpk(v0[2], v0[3]); w.z = cvtpk(v1[0], v1[1]); w.w = cvtpk(v1[2], v1[3]);
                        *(u32x4*)(rowp + bj * HALF) = w; } }
        } else {
            const bool hasO = O != nullptr;
            const LAS float* T0 = tab + ui * 512; const LAS float* T1 = T0 + 256;
#pragma unroll
            for (int ai = 0; ai < 2; ++ai) {
                u32x4 xb[4][2];
#pragma unroll
                for (int m = 0; m < 4; ++m)
#pragma unroll
                    for (int bj = 0; bj < 2; ++bj) xb[m][bj] = *(const u32x4*)(xres + (size_t)(row0 + ai * HALF + m * 16) * DM + col0 + bj * HALF);
                __builtin_amdgcn_sched_barrier(0);
#pragma unroll
                for (int m = 0; m < 4; ++m) { const size_t off = (size_t)(row0 + ai * HALF + m * 16) * DM + col0; float sq = 0.f;
#pragma unroll
                    for (int bj = 0; bj < 2; ++bj) {
                        const u32x4 xw = xb[m][bj];
                        const f32x4 x0 = {bflo(xw.x), bfhi(xw.x), bflo(xw.y), bfhi(xw.y)}, x1 = {bflo(xw.z), bfhi(xw.z), bflo(xw.w), bfhi(xw.w)};
                        const f32x4 gv0 = *(const LAS f32x4*)(T0 + ct + bj * HALF), gv1 = *(const LAS f32x4*)(T0 + ct + bj * HALF + 4);
                        const f32x4 y0 = x0 + gv0 * acc[ai][bj][m][0], y1 = x1 + gv1 * acc[ai][bj][m][1];
                        { u32x4 w; w.x = cvtpk(y0[0], y0[1]); w.y = cvtpk(y0[2], y0[3]); w.z = cvtpk(y1[0], y1[1]); w.w = cvtpk(y1[2], y1[3]); *(u32x4*)(xres + off + bj * HALF) = w; }
                        sq += ((y0[0] * y0[0] + y0[1] * y0[1]) + (y0[2] * y0[2] + y0[3] * y0[3])) + ((y1[0] * y1[0] + y1[1] * y1[1]) + (y1[2] * y1[2] + y1[3] * y1[3]));
                        if (hasO) { const f32x4 gs0 = *(const LAS f32x4*)(T1 + ct + bj * HALF), gs1 = *(const LAS f32x4*)(T1 + ct + bj * HALF + 4); const f32x4 a0 = y0 * gs0, a1 = y1 * gs1; u32x4 w; w.x = cvtpk(a0[0], a0[1]); w.y = cvtpk(a0[2], a0[3]); w.z = cvtpk(a1[0], a1[1]); w.w = cvtpk(a1[2], a1[3]);
                            *(u32x4*)(O + off + bj * HALF) = w; } }
                    if (sqp) { sq += __shfl_xor(sq, 16); sq += __shfl_xor(sq, 32); if (fq == 0) sqp[(size_t)(row0 + ai * HALF + m * 16) * 16 + u.pn * 4 + wc] = sq; }
                    __builtin_amdgcn_sched_barrier(0); }
            }
        }
    }
};

template <class Epi, class Sched>
__device__ __forceinline__ void gemm_simple(const int tid, const Gemm g, const Sched& S, const Epi& E) {
    const int  wid = __builtin_amdgcn_readfirstlane(tid >> 6), lane = tid & 63, wr = wid >> 2, wc = wid & 3, fr = lane & 15, fq = lane >> 4;
    const int K = g.K;
    Unit u;
    for (int ui = 0; S.next(ui, u); ++ui) {
        f32x4 acc[2][2][4][2];
#pragma unroll
        for (int a = 0; a < 2; ++a)
#pragma unroll
            for (int b = 0; b < 2; ++b)
#pragma unroll
                for (int m = 0; m < 4; ++m)
#pragma unroll
                    for (int n = 0; n < 2; ++n) acc[a][b][m][n] = (f32x4){0.f, 0.f, 0.f, 0.f};
        const bf16_t* Ab = g.A + (size_t)(u.pm * BM + wr * 64 + fr) * K + fq * 8;
        const bf16_t* Bb = g.Bt + (size_t)(u.pn * BM + wc * 32) * K + fq * 8;
        for (int k0 = 0; k0 < K; k0 += 32) {
            bf16x8 At[2][4], Bf[2][2];
#pragma unroll
            for (int ai = 0; ai < 2; ++ai)
#pragma unroll
                for (int m = 0; m < 4; ++m) At[ai][m] = *(const bf16x8*)(Ab + (size_t)(ai * HALF + m * 16) * K + k0);
#pragma unroll
            for (int bj = 0; bj < 2; ++bj)
#pragma unroll
                for (int n = 0; n < 2; ++n) { const int rr = E.perm() ? perm32(16 * n + fr) : (16 * n + fr);
                    Bf[bj][n] = *(const bf16x8*)(Bb + (size_t)(bj * HALF + rr) * K + k0); }
#pragma unroll
            for (int ai = 0; ai < 2; ++ai)
#pragma unroll
                for (int bj = 0; bj < 2; ++bj)
#pragma unroll
                    for (int m = 0; m < 4; ++m)
#pragma unroll
                        for (int n = 0; n < 2; ++n) acc[ai][bj][m][n] = __builtin_amdgcn_mfma_f32_16x16x32_bf16(Bf[bj][n], At[ai][m], acc[ai][bj][m][n], 0, 0, 0);
        }
        E(acc, u, ui, wr, wc, fr, fq);
    }
}

template <class Epi, class Sched, bool ALIGN_EPI = true>
__device__ __forceinline__ void gemm_phase(const int tid, LAS unsigned char* lds, const Gemm g, const Sched& S, const Epi& E) {
    const int  wid = __builtin_amdgcn_readfirstlane(tid >> 6), lane = tid & 63, wr = wid >> 2, wc = wid & 3, fr = lane & 15, fq = lane >> 4;
    const int K = g.K, nt = K / BK;
    unsigned voffA[2], voffB[2];
#pragma unroll
    for (int i = 0; i < 2; ++i) { int R, C; stage_rc(tid * 16 + i * 8192, R, C); const int Rb = E.perm() ? ((R & ~31) + perm32(R & 31)) : R;
        voffA[i] = (unsigned)(R * K + C) * 2u; voffB[i] = (unsigned)(Rb * K + C) * 2u; }
    const size_t kstep = (size_t)(BK * 2);
    const size_t hstep = (size_t)HALF * K * 2;
    const size_t tstep = 2 * hstep;
    const unsigned ldsw = (unsigned)wid * 1024u;
    const int aoff = lds_byte(wr * 64 + fr, fq * 8), boff = lds_byte(wc * 32 + fr, fq * 8);
#define PG8_SA(b, h) (((b) * 2 + (h)) * HTB)
#define PG8_SB(b, h) ((4 + (b) * 2 + (h)) * HTB)
#define PG8_STAGE(bufoff, gbase, voff) do { _Pragma("unroll") for (int _i = 0; _i < 2; ++_i) \
        __builtin_amdgcn_global_load_lds((const unsigned*)((const char*)(gbase) + (voff)[_i]), (LAS unsigned*)(lds + (bufoff) + ldsw + _i * 8192), 16, 0, 0); } while (0)
#define PG8_LDA(dst, b, h) do { _Pragma("unroll") for (int m = 0; m < 4; ++m) _Pragma("unroll") for (int k = 0; k < 2; ++k) dst[m][k] = *(const LAS bf16x8*)(lds + PG8_SA(b, h) + aoff + m * 2048 + k * 1024); } while (0)
#define PG8_LDB(dst, b, h) do { _Pragma("unroll") for (int n = 0; n < 2; ++n) _Pragma("unroll") for (int k = 0; k < 2; ++k) dst[n][k] = *(const LAS bf16x8*)(lds + PG8_SB(b, h) + boff + n * 2048 + k * 1024); } while (0)
#define PG8_MMA(ai, bj, At, Bt) do { __builtin_amdgcn_s_setprio(1); _Pragma("unroll") for (int m = 0; m < 4; ++m) _Pragma("unroll") for (int n = 0; n < 2; ++n) _Pragma("unroll") for (int k = 0; k < 2; ++k) \
        acc[ai][bj][m][n] = __builtin_amdgcn_mfma_f32_16x16x32_bf16(Bt[n][k], At[m][k], acc[ai][bj][m][n], 0, 0, 0); __builtin_amdgcn_s_setprio(0); } while (0)
#define PG8_WAIT_V(n) asm volatile("s_waitcnt vmcnt(" #n ")" ::: "memory")
#define PG8_WAIT_L(n) asm volatile("s_waitcnt lgkmcnt(" #n ")" ::: "memory")
#define PG8_BAR __builtin_amdgcn_s_barrier()
#define PG8_SCHED __builtin_amdgcn_sched_barrier(0)
    Unit cur, nxt; int ui = 0;
    if (!S.next(0, cur)) return;
    f32x4 acc[2][2][4][2];
#pragma unroll
    for (int a = 0; a < 2; ++a)
#pragma unroll
        for (int b = 0; b < 2; ++b)
#pragma unroll
            for (int m = 0; m < 4; ++m)
#pragma unroll
                for (int n = 0; n < 2; ++n) acc[a][b][m][n] = (f32x4){0.f, 0.f, 0.f, 0.f};
    bf16x8 At[4][2], B0[2][2], B1[2][2];
    const char* cA = (const char*)g.A + (size_t)cur.pm * tstep; const char* cB = (const char*)g.Bt + (size_t)cur.pn * tstep;
    S.a_ready(cur);
    PG8_STAGE(PG8_SB(0, 0), cB, voffB); PG8_STAGE(PG8_SB(0, 1), cB + hstep, voffB); PG8_STAGE(PG8_SA(0, 0), cA, voffA); PG8_STAGE(PG8_SA(0, 1), cA + hstep, voffA);
    if (wr == 1) PG8_BAR;
    PG8_WAIT_V(2); PG8_BAR;
    PG8_STAGE(PG8_SB(1, 0), cB + kstep, voffB); PG8_STAGE(PG8_SA(1, 0), cA + kstep, voffA); PG8_STAGE(PG8_SB(1, 1), cB + hstep + kstep, voffB);
    PG8_WAIT_V(6); PG8_BAR;
    for (;;) {
        const bool has_next = S.next(ui + 1, nxt);
        const char* nA = has_next ? (const char*)g.A + (size_t)nxt.pm * tstep : cA; const char* nB = has_next ? (const char*)g.Bt + (size_t)nxt.pn * tstep : cB;
        for (int t = 0; t < nt; t += 2) {
            const bool last = (t == nt - 2);
            const char* a1 = cA + (size_t)(t + 1) * kstep;
            const char* a2 = last ? nA : cA + (size_t)(t + 2) * kstep; const char* b2 = last ? nB : cB + (size_t)(t + 2) * kstep;
            const char* a3 = a2 + kstep; const char* b3 = b2 + kstep;
            if (last && has_next) S.a_ready(nxt);
            PG8_LDB(B0, 0, 0); PG8_LDB(B1, 0, 1); PG8_SCHED; PG8_LDA(At, 0, 0); PG8_STAGE(PG8_SA(1, 1), a1 + hstep, voffA);
            PG8_WAIT_V(8); PG8_WAIT_L(0); PG8_BAR; PG8_MMA(0, 0, At, B0); PG8_MMA(0, 1, At, B1); PG8_BAR; PG8_SCHED;
            PG8_LDA(At, 0, 1); PG8_STAGE(PG8_SB(0, 0), b2, voffB); PG8_STAGE(PG8_SB(0, 1), b2 + hstep, voffB); PG8_STAGE(PG8_SA(0, 0), a2, voffA);
            PG8_WAIT_V(8); PG8_WAIT_L(0); PG8_BAR; PG8_MMA(1, 0, At, B0); PG8_MMA(1, 1, At, B1); PG8_BAR; PG8_SCHED;
            PG8_LDB(B0, 1, 0); PG8_LDB(B1, 1, 1); PG8_SCHED; PG8_LDA(At, 1, 0); PG8_STAGE(PG8_SA(0, 1), a2 + hstep, voffA);
            PG8_WAIT_V(8); PG8_WAIT_L(0); PG8_BAR; PG8_MMA(0, 0, At, B0); PG8_MMA(0, 1, At, B1); PG8_BAR; PG8_SCHED;
            PG8_LDA(At, 1, 1); PG8_STAGE(PG8_SB(1, 0), b3, voffB); PG8_STAGE(PG8_SB(1, 1), b3 + hstep, voffB); PG8_STAGE(PG8_SA(1, 0), a3, voffA);
            PG8_WAIT_V(8); PG8_WAIT_L(0); PG8_BAR; PG8_MMA(1, 0, At, B0); PG8_MMA(1, 1, At, B1); PG8_BAR; PG8_SCHED;
        }
        if constexpr (ALIGN_EPI) { if (wr == 0) PG8_BAR; }
        E(acc, cur, ui, wr, wc, fr, fq); S.done(cur);
        if (!has_next) break;
#pragma unroll
        for (int a = 0; a < 2; ++a)
#pragma unroll
            for (int b = 0; b < 2; ++b)
#pragma unroll
                for (int m = 0; m < 4; ++m)
#pragma unroll
                    for (int n = 0; n < 2; ++n) acc[a][b][m][n] = (f32x4){0.f, 0.f, 0.f, 0.f};
        cur = nxt; cA = nA; cB = nB; ++ui;
        if constexpr (ALIGN_EPI) { if (wr == 1) PG8_BAR; }
    }
    PG8_WAIT_V(0);
    if constexpr (!ALIGN_EPI) { if (wr == 0) PG8_BAR; }
    PG8_BAR;
#undef PG8_SA
#undef PG8_SB
#undef PG8_STAGE
#undef PG8_LDA
#undef PG8_LDB
#undef PG8_MMA
#undef PG8_WAIT_V
#undef PG8_WAIT_L
#undef PG8_BAR
#undef PG8_SCHED
}
}

struct GemmJob { const bf16_t* A; const bf16_t* Bt; int M, N, K; pg8::EpiAny E; int rot; };
constexpr int GEMM_TAB_OFF = 131072;
__device__ __forceinline__ void gemm_tables(const Ctx& p, const GemmJob& J, const pg8::StaticOrder& S) {
    const int tid = p.tid; pg8::Unit u;
    for (int ui = 0; S.next(ui, u); ++ui) {
        LAS float* T = J.E.tab + ui * 512;
        const int r = tid & 255;
        if (J.E.kind == 2) {
            const size_t bo = (size_t)((u.pm * 256) / SEQ) * NMOD + u.pn * 256 + r;
            if (tid < 256) T[r] = J.E.gate[bo]; else T[256 + r] = J.E.O ? J.E.ng[u.pn * 256 + r] * (1.0f + J.E.nsc[bo]) : 0.f;
        } else {
            const int tokt = (J.E.kind == 1) ? u.pm : u.pn, vect = (J.E.kind == 1) ? u.pn : u.pm;
            if (tid < 256) { const f32x4* q = (const f32x4*)(J.E.sqp + (size_t)(tokt * 256 + r) * 16); const f32x4 a = q[0], b = q[1], c = q[2], d = q[3];
                const float sm = ((a[0] + a[1]) + (a[2] + a[3])) + ((b[0] + b[1]) + (b[2] + b[3])) + ((c[0] + c[1]) + (c[2] + c[3])) + ((d[0] + d[1]) + (d[2] + d[3]));
                T[r] = rsqrtf(sm * (1.0f / DM) + EPS); }
            else T[256 + r] = J.E.shw[(size_t)((tokt * 256) / SEQ) * J.E.shw_ld + vect * 256 + r];
        }
    }
    __syncthreads();
}
__device__ __forceinline__ void run_gemm(const Ctx& p, LAS unsigned char* lds, GemmJob& J) {
    J.E.tab = (LAS float*)(lds + GEMM_TAB_OFF);
    pg8::Gemm g{J.A, J.Bt, J.M, J.N, J.K}; pg8::StaticOrder S; S.init(J.M, J.N, p.nblk, (p.bid + J.rot) % p.nblk);
    if (J.E.kind != 0) gemm_tables(p, J, S);
#if SIMPLE_GEMM
    pg8::gemm_simple<pg8::EpiAny, pg8::StaticOrder>(p.tid, g, S, J.E);
#else
    { int tid2 = p.tid; asm volatile("" : "+v"(tid2));
      pg8::gemm_phase<pg8::EpiAny, pg8::StaticOrder, true>(tid2, lds, g, S, J.E); }
#endif
    __syncthreads();
}

__device__ __forceinline__ void transpose_item(const float* W, int K, int N, bf16_t* WT, LAS float* scr, int item, int lane) {
    const int nblk = N / 32, kb = item / nblk, nb = item % nblk, k0 = 64 * kb, n0 = 32 * nb;
    float v[32];
#pragma unroll
    for (int i = 0; i < 32; ++i) { const int kk = 2 * i + (lane >> 5); v[i] = W[(size_t)(k0 + kk) * N + n0 + (lane & 31)]; }
#pragma unroll
    for (int i = 0; i < 32; ++i) { const int kk = 2 * i + (lane >> 5); scr[kk * 33 + (lane & 31)] = v[i]; }
    asm volatile("s_waitcnt lgkmcnt(0)" ::: "memory");
    const int c = lane & 7;
#pragma unroll
    for (int j = 0; j < 4; ++j) { const int n = (lane >> 3) + 8 * j; const LAS float* s = scr + (8 * c) * 33 + n;
        u32x4 o; o.x = cvtpk(s[0 * 33], s[1 * 33]); o.y = cvtpk(s[2 * 33], s[3 * 33]); o.z = cvtpk(s[4 * 33], s[5 * 33]); o.w = cvtpk(s[6 * 33], s[7 * 33]);
        *(u32x4*)(WT + (size_t)(n0 + n) * K + k0 + 8 * c) = o; }
    asm volatile("s_waitcnt lgkmcnt(0)" ::: "memory");
}

__device__ __forceinline__ float silu_f(float v) { return v / (1.0f + expf(-v)); }

__device__ __forceinline__ void phase_prologue(const Ctx& p, LAS unsigned char* lds, const bool partA, const bool partB) {
    const int tid = p.tid, lane = tid & 63, wave = __builtin_amdgcn_readfirstlane(tid >> 6);
    unsigned char* ws = p.ws;
#ifndef PRO_SKIP1
    if (partA) {
        LAS float* S = (LAS float*)lds;
        LAS float* red = (LAS float*)(lds + 69632);
        float* MODL = (float*)(ws + WS_MODL); float* MODC = (float*)(ws + WS_MODC);
        if (p.bid < 192) {
            for (int i = tid; i < 17 * 1024; i += NTHREADS) { const float v = (i < 16 * 1024) ? p.in[I_C][i] : p.in[I_CCTX][i - 16 * 1024]; S[i] = silu_f(v); }
            __syncthreads();
            for (int it = p.bid; it < 192; it += p.nblk) {
                const int layer = it / 96, n0 = (it % 96) * 64, fr = lane & 15, fq = lane >> 4;
                const float* W = p.in[I_WMOD] + (size_t)layer * DM * NMOD + n0 + fr;
                f32x4 acc[2][4];
#pragma unroll
                for (int rt = 0; rt < 2; ++rt)
#pragma unroll
                    for (int ct = 0; ct < 4; ++ct) acc[rt][ct] = (f32x4){0.f, 0.f, 0.f, 0.f};
#pragma unroll 1
                for (int k0 = 0; k0 < 128; k0 += 32) {
                    float bv[8][4];
#pragma unroll
                    for (int j = 0; j < 8; ++j)
#pragma unroll
                        for (int ct = 0; ct < 4; ++ct) bv[j][ct] = W[(size_t)(wave * 128 + k0 + 4 * j + fq) * NMOD + 16 * ct];
#pragma unroll
                    for (int j = 0; j < 8; ++j) { const int k = wave * 128 + k0 + 4 * j + fq;
                        const float a0 = S[fr * 1024 + k], a1 = (fr == 0) ? S[16 * 1024 + k] : 0.f;
#pragma unroll
                        for (int ct = 0; ct < 4; ++ct) { acc[0][ct] = __builtin_amdgcn_mfma_f32_16x16x4f32(a0, bv[j][ct], acc[0][ct], 0, 0, 0);
                                                          acc[1][ct] = __builtin_amdgcn_mfma_f32_16x16x4f32(a1, bv[j][ct], acc[1][ct], 0, 0, 0); } }
                }
#pragma unroll
                for (int rt = 0; rt < 2; ++rt)
#pragma unroll
                    for (int ct = 0; ct < 4; ++ct) *(LAS f32x4*)(red + ((wave * 2 + rt) * 4 + ct) * 256 + lane * 4) = acc[rt][ct];
                __syncthreads();
                for (int idx = tid; idx < 17 * 64; idx += NTHREADS) { const int b = idx >> 6, nn = idx & 63, rt = b >> 4, bb = b & 15, ct = nn >> 4;
                    const int off = (rt * 4 + ct) * 256 + ((bb >> 2) * 16 + (nn & 15)) * 4 + (bb & 3);
                    float s_ = p.in[I_BMOD][layer * NMOD + n0 + nn];
#pragma unroll
                    for (int w = 0; w < 8; ++w) s_ += red[w * 2048 + off];
                    if (b < 16) MODL[(size_t)(layer * 16 + b) * NMOD + n0 + nn] = s_; else if (layer == 0) MODC[n0 + nn] = s_; }
                __syncthreads();
            }
        }
        __syncthreads();
    }
#endif
    const int gw = p.bid * NWAVES + wave, ngw = p.nblk * NWAVES;
#ifndef PRO_SKIP2
    if (partA) {
        float* H3 = (float*)(ws + WS_H3);
        const float* w1 = p.in[I_FW1]; const float* b1 = p.in[I_FB1]; const float* w2 = p.in[I_FW2]; const float* b2 = p.in[I_FB2];
        const float* w3 = p.in[I_FW3]; const float* b3 = p.in[I_FB3]; const float* fr = p.in[I_FFREQ];
        LAS float* w2s = (LAS float*)lds; LAS float* w3s = (LAS float*)(lds + 16384); LAS float* w1s = (LAS float*)(lds + 32768);
        for (int i = tid; i < 4096; i += NTHREADS) { w2s[i] = w2[i]; w3s[i] = w3[i]; if (i < 17 * 64) w1s[i] = w1[i]; }
        __syncthreads();
        for (int t = gw; t < SEQ; t += ngw) {
            const float tf = (float)t, tn = tf / 2048.0f, w = 6.283185307179586f * tf / 2048.0f;
            float feat = 0.f;
            if (lane == 0) feat = tn;
            else if (lane < 17) { const int bi = (lane - 1) & 7; const float band = 1e-4f + (float)bi * ((7.0f - 1e-4f) / 7.0f); const float fw = w * band; feat = (lane < 9) ? fcos(fw) : -fsin(fw); }
            float a = b1[lane];
#pragma unroll
            for (int i = 0; i < 17; ++i) a += __shfl(feat, i) * w1s[i * 64 + lane];
            float h = fsin(fr[lane] * a);
            a = b2[lane];
#pragma unroll 16
            for (int k = 0; k < 64; ++k) a += __shfl(h, k) * w2s[k * 64 + lane];
            h = fsin(fr[64 + lane] * a);
            a = b3[lane];
#pragma unroll 16
            for (int k = 0; k < 64; ++k) a += __shfl(h, k) * w3s[k * 64 + lane];
            h = fsin(fr[128 + lane] * a);
            H3[t * 64 + lane] = h; ((bf16_t*)(ws + WS_H3B))[t * 64 + lane] = (bf16_t)f2bf(h);
        }
    }
#endif
#ifndef PRO_SKIP3
    if (partB) {
        LAS float* scr = (LAS float*)(lds + wave * 16384);
        struct TJob { int in_idx; size_t in_off; int K, N; size_t ws_off; };
        const TJob jobs[10] = {
            {I_AWIN, 0, 1024, 1440, WS_WIN}, {I_AWQB, 0, 384, 768, WS_WQB}, {I_AWKVB, 0, 256, 1024, WS_WKVB}, {I_AWOUT, 0, 1024, 1024, WS_WOUT},
            {I_W1, 0, 1024, 4096, WS_W1_0}, {I_W2, 0, 4096, 1024, WS_W2_0}, {I_W1, (size_t)1024 * 4096, 1024, 4096, WS_W1_1}, {I_W2, (size_t)4096 * 1024, 4096, 1024, WS_W2_1},
            {I_HWIN, 0, 1024, 3072, WS_HIN}, {I_HWOUT, 0, 1024, 1024, WS_HOUT}};
        int base = 0;
#pragma unroll
        for (int j = 0; j < 10; ++j) {
            const int K = jobs[j].K, N = jobs[j].N, nitems = (K / 64) * (N / 32);
            const float* W = p.in[jobs[j].in_idx] + jobs[j].in_off; bf16_t* WT = (bf16_t*)(ws + jobs[j].ws_off);
            int first = gw - (base % ngw); if (first < 0) first += ngw;
            for (int it = first; it < nitems; it += ngw) transpose_item(W, K, N, WT, scr, it, lane);
            base += nitems;
        }
        u32x4* z = (u32x4*)((bf16_t*)(ws + WS_WIN) + (size_t)1440 * 1024);
        unsigned zz = 0u; asm volatile("" : "+v"(zz));
        for (int i = p.bid * NTHREADS + tid; i < 96 * 1024 / 8; i += p.nblk * NTHREADS) z[i] = (u32x4){zz, zz, zz, zz};
    }
#endif
}

__device__ __forceinline__ void modulate_chunk(const float* src, int row0, int nrows, const float* g, const float* sc, const float* sh, bf16_t* dst, int lane, bf16_t* xcopy = nullptr) {
    f32x4 gs[4], sv[4];
#pragma unroll
    for (int j = 0; j < 4; ++j) { const int c4 = lane + 64 * j; const f32x4 gg = ((const f32x4*)g)[c4], ss = ((const f32x4*)sc)[c4]; gs[j] = gg * (ss + 1.0f); sv[j] = ((const f32x4*)sh)[c4]; }
    for (int r = row0; r < row0 + nrows; ++r) {
        const f32x4* xr = (const f32x4*)(src + (size_t)r * DM) + lane;
        f32x4 v[4]; float s = 0.f;
#pragma unroll
        for (int j = 0; j < 4; ++j) { v[j] = xr[64 * j]; s += (v[j].x * v[j].x + v[j].y * v[j].y) + (v[j].z * v[j].z + v[j].w * v[j].w); }
        const float rstd = rsqrtf(wave_sum(s) * (1.0f / DM) + EPS);
        u32x2* o8 = (u32x2*)(dst + (size_t)r * DM) + lane;
#pragma unroll
        for (int j = 0; j < 4; ++j) { const f32x4 y = v[j] * rstd * gs[j] + sv[j]; u32x2 w; w.x = cvtpk(y.x, y.y); w.y = cvtpk(y.z, y.w); o8[64 * j] = w; }
        if (xcopy) { u32x2* x8 = (u32x2*)(xcopy + (size_t)r * DM) + lane;
#pragma unroll
            for (int j = 0; j < 4; ++j) { u32x2 w; w.x = cvtpk(v[j].x, v[j].y); w.y = cvtpk(v[j].z, v[j].w); x8[64 * j] = w; } }
    }
}
__device__ __forceinline__ void phase_modulate(const Ctx& p, const float* src, int layer, const float* g, int shoff, int scoff, bool with_ctx) {
    const int lane = p.tid & 63, wave = __builtin_amdgcn_readfirstlane(p.tid >> 6);
    const int gw = p.bid * NWAVES + wave;
    const float* MODL = (const float*)(p.ws + WS_MODL); const float* MODC = (const float*)(p.ws + WS_MODC);
    bf16_t* HL = (bf16_t*)(p.ws + WS_HL);
    {   const int per = ML / NGW, row0 = gw * per, b = row0 / SEQ; const float* mv = MODL + (size_t)(layer * 16 + b) * NMOD;
        modulate_chunk(src, row0, per, g, mv + scoff, mv + shoff, HL, lane, (bf16_t*)(p.ws + WS_XW)); }
    if (with_ctx) { const int per = MC / NGW, row0 = gw * per;
        modulate_chunk(p.in[I_CTX], row0, per, g, MODC + scoff, MODC + shoff, HL + (size_t)ML * DM, lane); }
}
__device__ __forceinline__ void shw_group(const bf16_t* WT, int N, const float* sh, float* out, int g, int lane) {
    const int fr = lane & 15, fq = lane >> 4;
    f32x4 acc = {0.f, 0.f, 0.f, 0.f};
#pragma unroll 8
    for (int ks = 0; ks < 32; ++ks) {
        const float* sp = sh + (size_t)fr * NMOD + 32 * ks + 8 * fq;
        const f32x4 s0 = *(const f32x4*)sp, s1 = *(const f32x4*)(sp + 4);
        const u32x4 aw = {cvtpk(s0[0], s0[1]), cvtpk(s0[2], s0[3]), cvtpk(s1[0], s1[1]), cvtpk(s1[2], s1[3])};
        const bf16x8 bw = *(const bf16x8*)(WT + (size_t)(16 * g + fr) * DM + 32 * ks + 8 * fq);
        acc = __builtin_amdgcn_mfma_f32_16x16x32_bf16(__builtin_bit_cast(bf16x8, aw), bw, acc, 0, 0, 0);
    }
#pragma unroll
    for (int e = 0; e < 4; ++e) out[(size_t)(4 * fq + e) * N + 16 * g + fr] = acc[e];
}
__device__ __forceinline__ void phase_shw(const Ctx& p, int first) {
    if (p.bid < first) return;
    const int lane = p.tid & 63, wave = __builtin_amdgcn_readfirstlane(p.tid >> 6);
    const int gw = (p.bid - first) * NWAVES + wave, ngw = (p.nblk - first) * NWAVES;
    const float* MODL = (const float*)(p.ws + WS_MODL);
    for (int G = gw; G < 256 + 192 + 256; G += ngw) {
        if (G < 256) shw_group((const bf16_t*)(p.ws + WS_W1_0), 4096, MODL + 3 * DM, (float*)(p.ws + WS_SHW_UP0), G, lane);
        else if (G < 448) shw_group((const bf16_t*)(p.ws + WS_HIN), 3072, MODL + (size_t)16 * NMOD, (float*)(p.ws + WS_SHW_HIN), G - 256, lane);
        else shw_group((const bf16_t*)(p.ws + WS_W1_1), 4096, MODL + (size_t)16 * NMOD + 3 * DM, (float*)(p.ws + WS_SHW_UP1), G - 448, lane);
    }
}
__device__ __forceinline__ void phase_final(const Ctx& p) {
    const int lane = p.tid & 63, wave = __builtin_amdgcn_readfirstlane(p.tid >> 6);
    const int gw = p.bid * NWAVES + wave, per = ML / NGW;
    const bf16_t* X = (const bf16_t*)(p.ws + WS_XW); const float* g = p.in[I_FINALG]; const float* sqp = (const float*)(p.ws + WS_SQA);
    f32x4 gs[4];
#pragma unroll
    for (int j = 0; j < 2; ++j) { gs[2 * j] = *(const f32x4*)(g + 512 * j + 8 * lane); gs[2 * j + 1] = *(const f32x4*)(g + 512 * j + 8 * lane + 4); }
    for (int r = gw * per; r < (gw + 1) * per; ++r) {
        const float part = (lane < 16) ? sqp[(size_t)r * 16 + lane] : 0.f;
        const float rstd = rsqrtf(wave_sum(part) * (1.0f / DM) + EPS);
#pragma unroll
        for (int j = 0; j < 2; ++j) { const u32x4 xb = *(const u32x4*)(X + (size_t)r * DM + 512 * j + 8 * lane);
            const f32x4 v0 = {bflo(xb.x), bfhi(xb.x), bflo(xb.y), bfhi(xb.y)}, v1 = {bflo(xb.z), bfhi(xb.z), bflo(xb.w), bfhi(xb.w)};
            f32x4* o = (f32x4*)(p.out + (size_t)r * DM + 512 * j + 8 * lane);
            o[0] = v0 * rstd * gs[2 * j]; o[1] = v1 * rstd * gs[2 * j + 1]; }
    }
}

__device__ __forceinline__ void zpost_row(const Ctx& p, int row, bool latent, int lane, const LAS f32x2* tabM, const LAS f32x2* tabG) {
    unsigned char* ws = p.ws;
    const bf16_t* z = (const bf16_t*)(ws + WS_Z) + (size_t)row * ZW;
    int prow = 0, pcol = 0;
    if (latent) { const int s = row & (SEQ - 1); prow = s >> 6; pcol = s & 63; }
    if (latent) {
        float v[6], ss = 0.f;
#pragma unroll
        for (int i = 0; i < 6; ++i) { v[i] = bf2f(z[ZC_CQ + lane + 64 * i]); ss += v[i] * v[i]; }
        const float rstd = rsqrtf(wave_sum(ss) * (1.0f / 384.0f) + EPS);
        bf16_t* o = (bf16_t*)(ws + WS_CQN) + (size_t)row * 384;
#pragma unroll
        for (int i = 0; i < 6; ++i) o[lane + 64 * i] = (bf16_t)f2bf(v[i] * rstd * p.in[I_AQAG][lane + 64 * i]);
    }
    {
        float v[4], ss = 0.f;
#pragma unroll
        for (int i = 0; i < 4; ++i) { v[i] = bf2f(z[ZC_CKV + lane + 64 * i]); ss += v[i] * v[i]; }
        const float rstd = rsqrtf(wave_sum(ss) * (1.0f / 256.0f) + EPS);
        bf16_t* o = (bf16_t*)(ws + WS_CKVN) + (size_t)row * 256;
#pragma unroll
        for (int i = 0; i < 4; ++i) o[lane + 64 * i] = (bf16_t)f2bf(v[i] * rstd * p.in[I_AKVAG][lane + 64 * i]);
    }
    {
        const int d = lane & 31; const float y = bf2f(z[ZC_KR + d]);
        const float pr = __shfl_xor(y, 8);
        float o = y;
        if (latent) { const int pos = (d & 16) ? pcol : prow; const f32x2 cs = tabM[pos * 8 + (d & 7)];
            o = (d & 8) ? (pr * cs.y + y * cs.x) : (y * cs.x - pr * cs.y); }
        if (lane < 32) ((bf16_t*)(ws + WS_KROPE))[(size_t)row * 32 + d] = (bf16_t)f2bf(o);
    }
    if (latent) {
        const float gq = p.in[I_AQNG][lane];
        const int pos = (lane & 32) ? pcol : prow; const f32x2 cs = tabG[pos * 16 + (lane & 15)];
        bf16_t* o = (bf16_t*)(ws + WS_QG) + (size_t)row * 512;
#pragma unroll
        for (int hh = 0; hh < 8; ++hh) {
            const float v = bf2f(z[ZC_GQ + 64 * hh + lane]);
            const float rstd = rsqrtf(wave_sum(v * v) * (1.0f / 64.0f) + EPS);
            const float y = v * rstd * gq, pr = __shfl_xor(y, 16);
            const float r = (lane & 16) ? (pr * cs.y + y * cs.x) : (y * cs.x - pr * cs.y);
            o[64 * hh + lane] = (bf16_t)f2bf(r * QSCALE_GQA);
        }
    }
    {
        const float gk = p.in[I_AKNG][lane];
        f32x2 cs = {1.f, 0.f};
        if (latent) { const int pos = (lane & 32) ? pcol : prow; cs = tabG[pos * 16 + (lane & 15)]; }
        bf16_t* o = (bf16_t*)(ws + WS_KG) + (size_t)row * 128;
#pragma unroll
        for (int hh = 0; hh < 2; ++hh) {
            const float v = bf2f(z[ZC_GK + 64 * hh + lane]);
            const float rstd = rsqrtf(wave_sum(v * v) * (1.0f / 64.0f) + EPS);
            const float y = v * rstd * gk, pr = __shfl_xor(y, 16);
            const float r = (lane & 16) ? (pr * cs.y + y * cs.x) : (y * cs.x - pr * cs.y);
            o[64 * hh + lane] = (bf16_t)f2bf(r);
        }
    }
    {
        bf16_t* o = (bf16_t*)(ws + WS_VG) + (size_t)row * 128;
        o[lane] = z[ZC_GV + lane]; o[64 + lane] = z[ZC_GV + 64 + lane];
    }
}
struct ZGains { f32x4 qa[2], kva0[2], kva1[2], qn[2], kn[2]; };
__device__ __forceinline__ void unpack8(const u32x4 w, float (&v)[8]) { v[0] = bflo(w.x); v[1] = bfhi(w.x); v[2] = bflo(w.y); v[3] = bfhi(w.y); v[4] = bflo(w.z); v[5] = bfhi(w.z); v[6] = bflo(w.w); v[7] = bfhi(w.w); }
__device__ __forceinline__ u32x4 pack8(const float (&v)[8]) { u32x4 w; w.x = cvtpk(v[0], v[1]); w.y = cvtpk(v[2], v[3]); w.z = cvtpk(v[4], v[5]); w.w = cvtpk(v[6], v[7]); return w; }
__device__ __forceinline__ float sumsq8(const float (&v)[8]) { return ((v[0] * v[0] + v[1] * v[1]) + (v[2] * v[2] + v[3] * v[3])) + ((v[4] * v[4] + v[5] * v[5]) + (v[6] * v[6] + v[7] * v[7])); }
__device__ __forceinline__ void rope8(float (&y)[8], const float (&pr)[8], bool second, const LAS f32x2* cs) {
#pragma unroll
    for (int e = 0; e < 8; ++e) { const f32x2 c = cs[e]; y[e] = second ? (pr[e] * c.y + y[e] * c.x) : (y[e] * c.x - pr[e] * c.y); }
}
__device__ __forceinline__ void zpost_row_vec(const Ctx& p, int row, bool latent, int lane, const LAS f32x2* tabM, const LAS f32x2* tabG, const ZGains& G) {
    unsigned char* ws = p.ws;
    const bf16_t* z = (const bf16_t*)(ws + WS_Z) + (size_t)row * ZW;
    int prow = 0, pcol = 0;
    if (latent) { const int s_ = row & (SEQ - 1); prow = s_ >> 6; pcol = s_ & 63; }
    const int cB = 84 + lane, cC = lane < 16 ? 148 + lane : (lane < 32 ? 164 + (lane - 16) : 80 + (lane & 3));
    const u32x4 wA0 = *(const u32x4*)(z + 8 * lane);
    const u32x4 wA1 = *(const u32x4*)(z + 8 * (64 + (lane & 15)));
    const u32x4 wB = *(const u32x4*)(z + 8 * cB);
    const u32x4 wC = *(const u32x4*)(z + 8 * cC);
    float a0[8], a1[8], vb[8], vc[8];
    unpack8(wA0, a0); unpack8(wA1, a1); unpack8(wB, vb); unpack8(wC, vc);
    {
        const float s0 = sumsq8(a0), s1 = sumsq8(a1);
        const float sq_cq = wave_sum(lane < 48 ? s0 : 0.f), sq_ckv = wave_sum((lane >= 48 ? s0 : 0.f) + (lane < 16 ? s1 : 0.f));
        const float rq = rsqrtf(sq_cq * (1.0f / 384.0f) + EPS), rk = rsqrtf(sq_ckv * (1.0f / 256.0f) + EPS);
        float o[8];
        if (lane < 48) { if (latent) {
#pragma unroll
                for (int e = 0; e < 8; ++e) o[e] = a0[e] * rq * G.qa[e >> 2][e & 3];
                *(u32x4*)((bf16_t*)(ws + WS_CQN) + (size_t)row * 384 + 8 * lane) = pack8(o); } }
        else {
#pragma unroll
            for (int e = 0; e < 8; ++e) o[e] = a0[e] * rk * G.kva0[e >> 2][e & 3];
            *(u32x4*)((bf16_t*)(ws + WS_CKVN) + (size_t)row * 256 + 8 * (lane - 48)) = pack8(o); }
        if (lane < 16) {
#pragma unroll
            for (int e = 0; e < 8; ++e) o[e] = a1[e] * rk * G.kva1[e >> 2][e & 3];
            *(u32x4*)((bf16_t*)(ws + WS_CKVN) + (size_t)row * 256 + 128 + 8 * lane) = pack8(o); }
    }
    if (latent) {
        const float sq = sum8(sumsq8(vb));
        const float rs = rsqrtf(sq * (1.0f / 64.0f) + EPS);
        float y[8], pr[8];
#pragma unroll
        for (int e = 0; e < 8; ++e) y[e] = vb[e] * rs * G.qn[e >> 2][e & 3];
#pragma unroll
        for (int e = 0; e < 8; ++e) pr[e] = dpp_xor2(y[e]);
        const int pos = (lane & 4) ? pcol : prow;
        rope8(y, pr, (lane & 2) != 0, tabG + pos * 16 + 8 * (lane & 1));
#pragma unroll
        for (int e = 0; e < 8; ++e) y[e] *= QSCALE_GQA;
        *(u32x4*)((bf16_t*)(ws + WS_QG) + (size_t)row * 512 + 8 * lane) = pack8(y);
    }
    {
        const float sq = sum8(sumsq8(vc));
        const float rs = rsqrtf(sq * (1.0f / 64.0f) + EPS);
        float y[8], pr2[8], pr1[8];
#pragma unroll
        for (int e = 0; e < 8; ++e) y[e] = (lane < 16) ? vc[e] * rs * G.kn[e >> 2][e & 3] : vc[e];
#pragma unroll
        for (int e = 0; e < 8; ++e) { pr2[e] = dpp_xor2(y[e]); pr1[e] = dpp_xor1(y[e]); }
        if (lane < 16) {
            if (latent) { const int pos = (lane & 4) ? pcol : prow; rope8(y, pr2, (lane & 2) != 0, tabG + pos * 16 + 8 * (lane & 1)); }
            *(u32x4*)((bf16_t*)(ws + WS_KG) + (size_t)row * 128 + 8 * lane) = pack8(y);
        } else if (lane < 32) {
            *(u32x4*)((bf16_t*)(ws + WS_VG) + (size_t)row * 128 + 8 * (lane - 16)) = wC;
        } else if (lane < 36) {
            if (latent) { const int pos = (lane & 2) ? pcol : prow; rope8(y, pr1, (lane & 1) != 0, tabM + pos * 8); }
            *(u32x4*)((bf16_t*)(ws + WS_KROPE) + (size_t)row * 32 + 8 * (lane - 32)) = pack8(y);
        }
    }
}
__device__ __forceinline__ void phase_zpost(const Ctx& p, LAS unsigned char* lds) {
    const int tid = p.tid, lane = tid & 63, wave = __builtin_amdgcn_readfirstlane(tid >> 6);
    LAS f32x2* tabM = (LAS f32x2*)lds;
    LAS f32x2* tabG = (LAS f32x2*)(lds + 4096);
    for (int i = tid; i < 512; i += NTHREADS) { const int pos = i >> 3, f = i & 7; const float inv = inv_theta((float)f / 8.0f); const float a = (float)pos * inv; tabM[i] = (f32x2){fcos(a), fsin(a)}; }
    for (int i = tid; i < 1024; i += NTHREADS) { const int pos = i >> 4, f = i & 15; const float inv = inv_theta((float)f / 16.0f); const float a = (float)pos * inv; tabG[i] = (f32x2){fcos(a), fsin(a)}; }
    __syncthreads();
    const int gw = p.bid * NWAVES + wave;
#if ZPOST_REF
    { const int per = ML / NGW; for (int r = gw * per; r < (gw + 1) * per; ++r) zpost_row(p, r, true, lane, tabM, tabG); }
    { const int per = MC / NGW; for (int r = gw * per; r < (gw + 1) * per; ++r) zpost_row(p, ML + r, false, lane, tabM, tabG); }
#else
    ZGains G;
    { const float* qa = p.in[I_AQAG] + 8 * (lane < 48 ? lane : 0); const float* k0 = p.in[I_AKVAG] + 8 * (lane >= 48 ? lane - 48 : 0); const float* k1 = p.in[I_AKVAG] + 128 + 8 * (lane & 15);
      const float* qn = p.in[I_AQNG] + 8 * (lane & 7); const float* kn = p.in[I_AKNG] + 8 * (lane & 7);
#pragma unroll
      for (int h = 0; h < 2; ++h) { G.qa[h] = *(const f32x4*)(qa + 4 * h); G.kva0[h] = *(const f32x4*)(k0 + 4 * h); G.kva1[h] = *(const f32x4*)(k1 + 4 * h); G.qn[h] = *(const f32x4*)(qn + 4 * h); G.kn[h] = *(const f32x4*)(kn + 4 * h); } }
    { const int per = ML / NGW;
#pragma unroll 2
      for (int r = gw * per; r < (gw + 1) * per; ++r) zpost_row_vec(p, r, true, lane, tabM, tabG, G); }
    { const int per = MC / NGW; for (int r = gw * per; r < (gw + 1) * per; ++r) zpost_row_vec(p, ML + r, false, lane, tabM, tabG, G); }
#endif
    __syncthreads();
}

__device__ __forceinline__ float max3f(float a, float b, float c) { float r; asm("v_max3_f32 %0, %1, %2, %3" : "=v"(r) : "v"(a), "v"(b), "v"(c)); return r; }
__device__ __forceinline__ int crow(int r, int hi) { return (r & 3) + 8 * (r >> 2) + 4 * hi; }
__device__ __forceinline__ size_t key_row(int b, int t) { return t < CTXL ? (size_t)(ML + b * CTXL + t) : (size_t)(b * SEQ + (t - CTXL)); }

template <int DK>
__device__ __forceinline__ void attn_naive_one(const Ctx& p, int b, int h, int q) {
    unsigned char* ws = p.ws;
    const bf16_t* KV = (const bf16_t*)(ws + WS_KV); const bf16_t* KR = (const bf16_t*)(ws + WS_KROPE);
    const bf16_t* KG = (const bf16_t*)(ws + WS_KG); const bf16_t* VG = (const bf16_t*)(ws + WS_VG);
    const size_t row = (size_t)b * SEQ + q;
    float qv[DK];
    {
        const bf16_t* qp = (DK == 96) ? (const bf16_t*)(ws + WS_QMR) + row * 768 + h * 96 : (const bf16_t*)(ws + WS_QG) + row * 512 + (h - 8) * 64;
#pragma unroll
        for (int d8 = 0; d8 < DK / 8; ++d8) { const u32x4 w = *(const u32x4*)(qp + 8 * d8);
            qv[8 * d8 + 0] = bflo(w.x); qv[8 * d8 + 1] = bfhi(w.x); qv[8 * d8 + 2] = bflo(w.y); qv[8 * d8 + 3] = bfhi(w.y);
            qv[8 * d8 + 4] = bflo(w.z); qv[8 * d8 + 5] = bfhi(w.z); qv[8 * d8 + 6] = bflo(w.w); qv[8 * d8 + 7] = bfhi(w.w); }
    }
    float o[64];
#pragma unroll
    for (int d = 0; d < 64; ++d) o[d] = 0.f;
    float m = -1e30f, l = 0.f;
    for (int t = 0; t < TKEYS; ++t) {
        const size_t kr = key_row(b, t);
        float s = 0.f;
        const bf16_t* vp;
        if (DK == 96) {
            const bf16_t* kp = KV + kr * 1024 + h * 128; const bf16_t* rp = KR + kr * 32;
#pragma unroll
            for (int d = 0; d < 64; ++d) s += qv[d] * bf2f(kp[d]);
#pragma unroll
            for (int d = 0; d < 32; ++d) s += qv[64 + d] * bf2f(rp[d]);
            vp = kp + 64;
        } else {
            const int kvh = (h - 8) >> 2; const bf16_t* kp = KG + kr * 128 + kvh * 64;
#pragma unroll
            for (int d = 0; d < 64; ++d) s += qv[d] * bf2f(kp[d]);
            vp = VG + kr * 128 + kvh * 64;
        }
        const float mn = fmaxf(m, s), al = exp2f(m - mn), pe = exp2f(s - mn);
        l = l * al + pe; m = mn;
#pragma unroll
        for (int d = 0; d < 64; ++d) o[d] = o[d] * al + pe * bf2f(vp[d]);
    }
    const float rl = 1.0f / l;
    bf16_t* op = (bf16_t*)(ws + WS_O) + row * 1024 + h * 64;
#pragma unroll
    for (int d = 0; d < 64; ++d) op[d] = (bf16_t)f2bf(o[d] * rl);
}
__device__ __forceinline__ void phase_naive_qrope(const Ctx& p) {
    const bf16_t* QM = (const bf16_t*)(p.ws + WS_QM); bf16_t* QMR = (bf16_t*)(p.ws + WS_QMR);
    for (size_t idx = (size_t)p.bid * NTHREADS + p.tid; idx < (size_t)ML * 768; idx += (size_t)p.nblk * NTHREADS) {
        const int col = (int)(idx % 768), d = col % 96; const size_t row = idx / 768; const int q = (int)(row & (SEQ - 1));
        float v = bf2f(QM[idx]);
        if (d >= 64) {
            const int e = d - 64, prow = q >> 6, pcol = q & 63;
            const int pos = (e & 16) ? pcol : prow; const float inv = inv_theta((float)(e & 7) / 8.0f); const float ang = (float)pos * inv;
            const float cs = fcos(ang), sn = fsin(ang);
            const float a = bf2f(QM[idx - e + (e & ~8)]), bb = bf2f(QM[idx - e + (e | 8)]);
            v = (e & 8) ? (a * sn + bb * cs) : (a * cs - bb * sn);
        }
        QMR[idx] = (bf16_t)f2bf(v * QSCALE_MLA);
    }
}
__device__ __forceinline__ void phase_attn_naive(const Ctx& p) {
    for (int idx = p.bid * NTHREADS + p.tid; idx < NB * 16 * SEQ; idx += p.nblk * NTHREADS) {
        const int q = idx & (SEQ - 1), h = (idx >> 11) & 15, b = idx >> 15;
        if (h < 8) attn_naive_one<96>(p, b, h, q); else attn_naive_one<64>(p, b, h, q);
    }
}

template <int DK>
__device__ __forceinline__ void attn_unit(const Ctx& p, int b, int h, int qb, LAS unsigned char* lds) {
    constexpr int NC = DK / 8;
    constexpr int ND = DK / 16;
    constexpr int KB = 12288, VB = 8192;
    unsigned char* ws = p.ws;
    const int tid = p.tid, lane = tid & 63, r32 = lane & 31, hi = lane >> 5; const int wid = __builtin_amdgcn_readfirstlane(tid >> 6);
    const bf16_t* KV = (const bf16_t*)(ws + WS_KV); const bf16_t* KR = (const bf16_t*)(ws + WS_KROPE);
    const bf16_t* KG = (const bf16_t*)(ws + WS_KG); const bf16_t* VG = (const bf16_t*)(ws + WS_VG);
    const int kvh = (h - 8) >> 2;
    LAS unsigned char* Kb = lds; LAS unsigned char* Vb = lds + 2 * KB; LAS float* wsf = (LAS float*)(lds + 2 * KB + 2 * VB) + wid * 64;
    const int qs = qb * 256 + wid * 32 + r32;
    const size_t qrow = (size_t)b * SEQ + qs;
    bf16x8 qr[ND];
    if (DK == 96) {
        const bf16_t* qp = (const bf16_t*)(ws + WS_QM) + qrow * 768 + h * 96;
#pragma unroll
        for (int d0 = 0; d0 < 4; ++d0) { const u32x4 w = *(const u32x4*)(qp + 16 * d0 + 8 * hi); u32x4 o;
            o.x = cvtpk(bflo(w.x) * QSCALE_MLA, bfhi(w.x) * QSCALE_MLA); o.y = cvtpk(bflo(w.y) * QSCALE_MLA, bfhi(w.y) * QSCALE_MLA);
            o.z = cvtpk(bflo(w.z) * QSCALE_MLA, bfhi(w.z) * QSCALE_MLA); o.w = cvtpk(bflo(w.w) * QSCALE_MLA, bfhi(w.w) * QSCALE_MLA);
            qr[d0] = __builtin_bit_cast(bf16x8, o); }
        const int prow = qs >> 6, pcol = qs & 63;
#pragma unroll
        for (int c = 0; c < 2; ++c) {
            const u32x4 wa = *(const u32x4*)(qp + 64 + 16 * c);
            const u32x4 wb = *(const u32x4*)(qp + 64 + 16 * c + 8);
            const float pos = (float)(c == 0 ? prow : pcol);
            float av[8] = {bflo(wa.x), bfhi(wa.x), bflo(wa.y), bfhi(wa.y), bflo(wa.z), bfhi(wa.z), bflo(wa.w), bfhi(wa.w)};
            float bv[8] = {bflo(wb.x), bfhi(wb.x), bflo(wb.y), bfhi(wb.y), bflo(wb.z), bfhi(wb.z), bflo(wb.w), bfhi(wb.w)};
            float ov[8];
#pragma unroll
            for (int j = 0; j < 8; ++j) { const float inv = inv_theta((float)j / 8.0f); const float ang = pos * inv; const float cs = fcos(ang), sn = fsin(ang);
                const float lo = av[j] * cs - bv[j] * sn, hv = av[j] * sn + bv[j] * cs; ov[j] = (hi ? hv : lo) * QSCALE_MLA; }
            u32x4 o; o.x = cvtpk(ov[0], ov[1]); o.y = cvtpk(ov[2], ov[3]); o.z = cvtpk(ov[4], ov[5]); o.w = cvtpk(ov[6], ov[7]);
            qr[4 + c] = __builtin_bit_cast(bf16x8, o);
        }
    } else {
        const bf16_t* qp = (const bf16_t*)(ws + WS_QG) + qrow * 512 + (h - 8) * 64;
#pragma unroll
        for (int d0 = 0; d0 < ND; ++d0) qr[d0] = *(const bf16x8*)(qp + 16 * d0 + 8 * hi);
    }
    const int kkey = tid & 63, kc0 = tid >> 6;
    const int vkv = tid >> 3, vdc = tid & 7;
    const unsigned kdst0 = kc0 * 1024 + kkey * 16, kdst1 = (kc0 + 8) * 1024 + kkey * 16;
    const unsigned vdst = (vdc >> 2) * 4096 + (vkv >> 4) * 1024 + (vkv & 15) * 64 + (vdc & 3) * 16;
    u32x4 kreg0, kreg1, vreg;
    auto load_tile = [&](int kt) {
        const size_t rk = key_row(b, kt * 64 + kkey), rv = key_row(b, kt * 64 + vkv);
        if (DK == 96) {
            kreg0 = *(const u32x4*)(KV + rk * 1024 + h * 128 + 8 * kc0);
            if (wid < 4) kreg1 = *(const u32x4*)(KR + rk * 32 + 8 * kc0);
            vreg = *(const u32x4*)(KV + rv * 1024 + h * 128 + 64 + 8 * vdc);
        } else {
            kreg0 = *(const u32x4*)(KG + rk * 128 + kvh * 64 + 8 * kc0);
            vreg = *(const u32x4*)(VG + rv * 128 + kvh * 64 + 8 * vdc);
        }
    };
    auto store_tile = [&](int buf) {
        *(LAS u32x4*)(Kb + buf * KB + kdst0) = kreg0;
        if (DK == 96) { if (wid < 4) *(LAS u32x4*)(Kb + buf * KB + kdst1) = kreg1; }
        *(LAS u32x4*)(Vb + buf * VB + vdst) = vreg;
    };
    f32x16 o0 = {}, o1 = {};
    float mrun = -1e30f, lrun = 0.f;
    const unsigned kfo = hi * 1024 + r32 * 16;
    const unsigned vfo = ((lane >> 4) & 1) * 32 + (lane & 3) * 8 + (4 * hi + ((lane & 15) >> 2)) * 64;
    load_tile(0); store_tile(0);
    __syncthreads();
    constexpr int NT = TKEYS / 64;
    for (int kt = 0; kt < NT; ++kt) {
        const int buf = kt & 1;
        if (kt + 1 < NT) load_tile(kt + 1);
        f32x16 p0 = {}, p1 = {};
        const LAS unsigned char* kp = Kb + buf * KB + kfo;
#pragma unroll
        for (int d0 = 0; d0 < ND; ++d0) {
            const bf16x8 k0 = *(const LAS bf16x8*)(kp + d0 * 2048), k1 = *(const LAS bf16x8*)(kp + d0 * 2048 + 512);
            p0 = __builtin_amdgcn_mfma_f32_32x32x16_bf16(k0, qr[d0], p0, 0, 0, 0);
            p1 = __builtin_amdgcn_mfma_f32_32x32x16_bf16(k1, qr[d0], p1, 0, 0, 0);
        }
        float mx = fmaxf(p0[0], p1[0]);
#pragma unroll
        for (int r = 1; r < 16; ++r) mx = fmaxf(mx, fmaxf(p0[r], p1[r]));
        mx = fmaxf(mx, __shfl_xor(mx, 32));
        const float mnew = fmaxf(mrun, mx), alpha = __builtin_amdgcn_exp2f(mrun - mnew);
        mrun = mnew;
        float rs = 0.f;
#pragma unroll
        for (int r = 0; r < 16; ++r) { p0[r] = __builtin_amdgcn_exp2f(p0[r] - mnew); p1[r] = __builtin_amdgcn_exp2f(p1[r] - mnew); rs += p0[r] + p1[r]; }
        lrun = lrun * alpha + rs;
        if (hi == 0) wsf[r32] = alpha;
        asm volatile("s_waitcnt lgkmcnt(0)" ::: "memory");
#pragma unroll
        for (int g4 = 0; g4 < 4; ++g4) { const f32x4 a4 = *(const LAS f32x4*)(wsf + 8 * g4 + 4 * hi);
#pragma unroll
            for (int e = 0; e < 4; ++e) { o0[4 * g4 + e] *= a4[e]; o1[4 * g4 + e] *= a4[e]; } }
        u32x4 pw[4];
        pw[0] = (u32x4){cvtpk(p0[0], p0[1]), cvtpk(p0[2], p0[3]), cvtpk(p0[4], p0[5]), cvtpk(p0[6], p0[7])};
        pw[1] = (u32x4){cvtpk(p0[8], p0[9]), cvtpk(p0[10], p0[11]), cvtpk(p0[12], p0[13]), cvtpk(p0[14], p0[15])};
        pw[2] = (u32x4){cvtpk(p1[0], p1[1]), cvtpk(p1[2], p1[3]), cvtpk(p1[4], p1[5]), cvtpk(p1[6], p1[7])};
        pw[3] = (u32x4){cvtpk(p1[8], p1[9]), cvtpk(p1[10], p1[11]), cvtpk(p1[12], p1[13]), cvtpk(p1[14], p1[15])};
        const LAS unsigned char* vp = Vb + buf * VB + vfo;
#pragma unroll
        for (int ks = 0; ks < 4; ++ks) {
            const bf16x8 pa = __builtin_bit_cast(bf16x8, pw[ks]);
            const s16x4 l0 = __builtin_amdgcn_ds_read_tr16_b64_v4i16((LAS s16x4*)(vp + ks * 1024));
            const s16x4 h0 = __builtin_amdgcn_ds_read_tr16_b64_v4i16((LAS s16x4*)(vp + ks * 1024 + 512));
            const s16x4 l1 = __builtin_amdgcn_ds_read_tr16_b64_v4i16((LAS s16x4*)(vp + 4096 + ks * 1024));
            const s16x4 h1 = __builtin_amdgcn_ds_read_tr16_b64_v4i16((LAS s16x4*)(vp + 4096 + ks * 1024 + 512));
            const bf16x8 v0 = {l0[0], l0[1], l0[2], l0[3], h0[0], h0[1], h0[2], h0[3]};
            const bf16x8 v1 = {l1[0], l1[1], l1[2], l1[3], h1[0], h1[1], h1[2], h1[3]};
            o0 = __builtin_amdgcn_mfma_f32_32x32x16_bf16(pa, v0, o0, 0, 0, 0);
            o1 = __builtin_amdgcn_mfma_f32_32x32x16_bf16(pa, v1, o1, 0, 0, 0);
        }
        if (kt + 1 < NT) store_tile(buf ^ 1);
        __syncthreads();
    }
    lrun += __shfl_xor(lrun, 32);
    if (hi == 0) wsf[32 + r32] = lrun;
    asm volatile("s_waitcnt lgkmcnt(0)" ::: "memory");
    bf16_t* Ow = (bf16_t*)(ws + WS_O) + ((size_t)b * SEQ + qb * 256 + wid * 32) * 1024 + h * 64;
#pragma unroll
    for (int r = 0; r < 16; ++r) { const int orow = crow(r, hi); const float rl = __builtin_amdgcn_rcpf(wsf[32 + orow]);
        Ow[(size_t)orow * 1024 + r32] = (bf16_t)f2bf(o0[r] * rl); Ow[(size_t)orow * 1024 + 32 + r32] = (bf16_t)f2bf(o1[r] * rl); }
    __syncthreads();
}
template <int DK>
__device__ __forceinline__ void attn_unit2(const Ctx& p, const int tid, int b, int h, int qb, LAS unsigned char* lds) {
    constexpr int ND = DK / 16;
    constexpr int KB = 12288, VB = 8192, NT = TKEYS / 64;
    constexpr float THR = 8.0f;
    unsigned char* ws = p.ws;
    const int lane = tid & 63, r32 = lane & 31, hi = lane >> 5; const int wid = __builtin_amdgcn_readfirstlane(tid >> 6);
    const bf16_t* KV = (const bf16_t*)(ws + WS_KV); const bf16_t* KR = (const bf16_t*)(ws + WS_KROPE);
    const bf16_t* KG = (const bf16_t*)(ws + WS_KG); const bf16_t* VG = (const bf16_t*)(ws + WS_VG);
    const int kvh = (h - 8) >> 2;
    LAS unsigned char* Kb = lds; LAS unsigned char* Vb = lds + 2 * KB; LAS float* wsf = (LAS float*)(lds + 2 * KB + 2 * VB) + wid * 64;
    const int qs = qb * 256 + wid * 32 + r32;
    const size_t qrow = (size_t)b * SEQ + qs;
    bf16x8 qr[ND];
    if (DK == 96) {
        const bf16_t* qp = (const bf16_t*)(ws + WS_QM) + qrow * 768 + h * 96;
#pragma unroll
        for (int d0 = 0; d0 < 4; ++d0) { const u32x4 w = *(const u32x4*)(qp + 16 * d0 + 8 * hi); u32x4 o;
            o.x = cvtpk(bflo(w.x) * QSCALE_MLA, bfhi(w.x) * QSCALE_MLA); o.y = cvtpk(bflo(w.y) * QSCALE_MLA, bfhi(w.y) * QSCALE_MLA);
            o.z = cvtpk(bflo(w.z) * QSCALE_MLA, bfhi(w.z) * QSCALE_MLA); o.w = cvtpk(bflo(w.w) * QSCALE_MLA, bfhi(w.w) * QSCALE_MLA);
            qr[d0] = __builtin_bit_cast(bf16x8, o); }
        const int prow = qs >> 6, pcol = qs & 63;
#pragma unroll
        for (int c = 0; c < 2; ++c) {
            const u32x4 wa = *(const u32x4*)(qp + 64 + 16 * c);
            const u32x4 wb = *(const u32x4*)(qp + 64 + 16 * c + 8);
            const float pos = (float)(c == 0 ? prow : pcol);
            float av[8], bv[8], ov[8]; unpack8(wa, av); unpack8(wb, bv);
#pragma unroll
            for (int j = 0; j < 8; ++j) { const float inv = inv_theta((float)j / 8.0f); const float ang = pos * inv; const float cs = fcos(ang), sn = fsin(ang);
                const float lo = av[j] * cs - bv[j] * sn, hv = av[j] * sn + bv[j] * cs; ov[j] = (hi ? hv : lo) * QSCALE_MLA; }
            qr[4 + c] = __builtin_bit_cast(bf16x8, pack8(ov));
        }
    } else {
        const bf16_t* qp = (const bf16_t*)(ws + WS_QG) + qrow * 512 + (h - 8) * 64;
#pragma unroll
        for (int d0 = 0; d0 < ND; ++d0) qr[d0] = *(const bf16x8*)(qp + 16 * d0 + 8 * hi);
    }
    const int kkey = tid & 63, kc0 = tid >> 6, vkv = tid >> 3, vdc = tid & 7;
    const unsigned kdst0 = kc0 * 1024 + kkey * 16, kdst1 = (kc0 + 8) * 1024 + kkey * 16;
    const unsigned vdst = (vdc >> 2) * 4096 + (vkv >> 4) * 1024 + (vkv & 15) * 64 + (vdc & 3) * 16;
    u32x4 kreg0, kreg1, vreg;
    auto load_k = [&](int kt) { const size_t rk = key_row(b, kt * 64 + kkey);
        if (DK == 96) { kreg0 = *(const u32x4*)(KV + rk * 1024 + h * 128 + 8 * kc0); if (wid < 4) kreg1 = *(const u32x4*)(KR + rk * 32 + 8 * kc0); }
        else kreg0 = *(const u32x4*)(KG + rk * 128 + kvh * 64 + 8 * kc0); };
    auto load_v = [&](int kt) { const size_t rv = key_row(b, kt * 64 + vkv);
        if (DK == 96) vreg = *(const u32x4*)(KV + rv * 1024 + h * 128 + 64 + 8 * vdc); else vreg = *(const u32x4*)(VG + rv * 128 + kvh * 64 + 8 * vdc); };
    auto store_k = [&](int buf) { *(LAS u32x4*)(Kb + buf * KB + kdst0) = kreg0; if (DK == 96) { if (wid < 4) *(LAS u32x4*)(Kb + buf * KB + kdst1) = kreg1; } };
    auto store_v = [&](int buf) { *(LAS u32x4*)(Vb + buf * VB + vdst) = vreg; };
    f32x16 o0 = {}, o1 = {};
    float mhat = 0.f, lrun = 0.f;
    const unsigned kfo = hi * 1024 + r32 * 16;
    const unsigned vfo = ((lane >> 4) & 1) * 32 + (lane & 3) * 8 + (4 * hi + ((lane & 15) >> 2)) * 64;
#define A2_SBAR() __builtin_amdgcn_sched_barrier(0)
#define A2_EL(X0, X1, i) ((i) < 16 ? X0[(i) & 15] : X1[(i) & 15])
    f32x16 negm; { float z0 = 0.f; asm volatile("" : "+v"(z0));
#pragma unroll
        for (int r = 0; r < 16; ++r) negm[r] = z0; }
    float rmx = 0.f;
#define A2_STEP(C0, C1, P0, P1, T, HASK) do { const int t_ = (T); \
        float f_ = 1.0f; const bool resc_ = __any(rmx > THR); \
        if (resc_) { const float dl_ = __builtin_fmaxf(rmx, 0.f); mhat += dl_; f_ = __builtin_amdgcn_exp2f(-dl_); if (hi == 0) wsf[r32] = f_; \
            _Pragma("unroll") for (int r = 0; r < 16; ++r) negm[r] = -mhat; } \
        if (HASK) load_k(t_ + 1); \
        load_v(t_); \
        const LAS unsigned char* kp_ = Kb + (t_ & 1) * KB + kfo; const LAS unsigned char* vp_ = Vb + ((t_ + 1) & 1) * VB + vfo; \
        float sacc_ = 0.f; unsigned pw_[16]; s16x4 vl_[8], vh_[8]; bf16x8 kf_[2 * ND]; \
        kf_[0] = *(const LAS bf16x8*)(kp_); kf_[1] = *(const LAS bf16x8*)(kp_ + 512); \
        A2_SBAR(); \
        _Pragma("unroll") for (int g = 0; g < 2 * ND; ++g) { \
            if (g + 2 < 2 * ND) kf_[g + 2] = *(const LAS bf16x8*)(kp_ + ((g + 2) >> 1) * 2048 + ((g + 2) & 1) * 512); \
            if (g < 8) { vl_[g] = __builtin_amdgcn_ds_read_tr16_b64_v4i16((LAS s16x4*)(vp_ + (g >> 2) * 4096 + (g & 3) * 1024)); \
                         vh_[g] = __builtin_amdgcn_ds_read_tr16_b64_v4i16((LAS s16x4*)(vp_ + (g >> 2) * 4096 + (g & 3) * 1024 + 512)); } \
            if ((g & 1) == 0) { if (g == 0) C0 = __builtin_amdgcn_mfma_f32_32x32x16_bf16(kf_[g], qr[g >> 1], negm, 0, 0, 0); else C0 = __builtin_amdgcn_mfma_f32_32x32x16_bf16(kf_[g], qr[g >> 1], C0, 0, 0, 0); } \
            else { if (g == 1) C1 = __builtin_amdgcn_mfma_f32_32x32x16_bf16(kf_[g], qr[g >> 1], negm, 0, 0, 0); else C1 = __builtin_amdgcn_mfma_f32_32x32x16_bf16(kf_[g], qr[g >> 1], C1, 0, 0, 0); } \
            { constexpr int NA = (ND == 6) ? 3 : 4; \
                _Pragma("unroll") for (int i = 0; i < NA; ++i) { const int e = NA * g + i; if (e < 32) sacc_ += A2_EL(P0, P1, e); } \
                if (g < 8) { pw_[2 * g] = cvtpk(A2_EL(P0, P1, 4 * g), A2_EL(P0, P1, 4 * g + 1)); pw_[2 * g + 1] = cvtpk(A2_EL(P0, P1, 4 * g + 2), A2_EL(P0, P1, 4 * g + 3)); asm volatile("" : "+v"(pw_[2 * g]), "+v"(pw_[2 * g + 1])); } \
                asm volatile("" : "+v"(sacc_)); } \
            A2_SBAR(); } \
        lrun = (lrun + sacc_) * f_; \
        float rm_ = 0.f; \
        _Pragma("unroll") for (int g = 0; g < 8; ++g) { \
            { const int ks = g >> 1, dv = g & 1; const u32x4 pa_ = {pw_[4 * ks], pw_[4 * ks + 1], pw_[4 * ks + 2], pw_[4 * ks + 3]}; \
                const s16x4 l_ = vl_[dv * 4 + ks], h_ = vh_[dv * 4 + ks]; const bf16x8 vf_ = {l_[0], l_[1], l_[2], l_[3], h_[0], h_[1], h_[2], h_[3]}; \
                if (dv == 0) o0 = __builtin_amdgcn_mfma_f32_32x32x16_bf16(__builtin_bit_cast(bf16x8, pa_), vf_, o0, 0, 0, 0); \
                else o1 = __builtin_amdgcn_mfma_f32_32x32x16_bf16(__builtin_bit_cast(bf16x8, pa_), vf_, o1, 0, 0, 0); } \
            if (g == 0) { rm_ = __builtin_fmaxf(__builtin_fmaxf(C0[0], C0[1]), __builtin_fmaxf(C0[2], C0[3])); }          \
            else if (g == 4) { rm_ = __builtin_fmaxf(rm_, __builtin_fmaxf(__builtin_fmaxf(C1[0], C1[1]), __builtin_fmaxf(C1[2], C1[3]))); } \
            else if (g < 4) { rm_ = max3f(rm_, C0[4 * g], C0[4 * g + 1]); rm_ = max3f(rm_, C0[4 * g + 2], C0[4 * g + 3]); } \
            else { rm_ = max3f(rm_, C1[4 * g - 16], C1[4 * g - 15]); rm_ = max3f(rm_, C1[4 * g - 14], C1[4 * g - 13]); } \
            asm volatile("" : "+v"(rm_)); \
            _Pragma("unroll") for (int i = 0; i < 4; ++i) { const int e = 4 * g + i; if (e < 16) C0[e & 15] = __builtin_amdgcn_exp2f(C0[e & 15]); else C1[e & 15] = __builtin_amdgcn_exp2f(C1[e & 15]); } \
            if (g < 4) asm volatile("" : "+v"(C0)); else asm volatile("" : "+v"(C1)); \
            A2_SBAR(); } \
        { auto rr_ = __builtin_amdgcn_permlane32_swap(__float_as_uint(rm_), __float_as_uint(rm_), false, false); rmx = __builtin_fmaxf(__uint_as_float(rr_[0]), __uint_as_float(rr_[1])); } \
        if (resc_) { asm volatile("s_waitcnt lgkmcnt(0)" ::: "memory"); \
            _Pragma("unroll") for (int g4 = 0; g4 < 4; ++g4) { const f32x4 a4 = *(const LAS f32x4*)(wsf + 8 * g4 + 4 * hi); \
                _Pragma("unroll") for (int e = 0; e < 4; ++e) { o0[4 * g4 + e] *= a4[e]; o1[4 * g4 + e] *= a4[e]; } } } \
        if (HASK) store_k((t_ + 1) & 1); \
        store_v(t_ & 1); \
        __syncthreads(); } while (0)
    if (wid >= 4) __builtin_amdgcn_s_setprio(1);
    load_k(0); store_k(0);
    __syncthreads();
    f32x16 sA0, sA1, sB0, sB1;
    {
        load_k(1); load_v(0);
        const LAS unsigned char* kp_ = Kb + kfo;
#pragma unroll
        for (int d0 = 0; d0 < ND; ++d0) { const bf16x8 k0 = *(const LAS bf16x8*)(kp_ + d0 * 2048), k1 = *(const LAS bf16x8*)(kp_ + d0 * 2048 + 512);
            sA0 = __builtin_amdgcn_mfma_f32_32x32x16_bf16(k0, qr[d0], d0 == 0 ? negm : sA0, 0, 0, 0); sA1 = __builtin_amdgcn_mfma_f32_32x32x16_bf16(k1, qr[d0], d0 == 0 ? negm : sA1, 0, 0, 0); }
        float rm = __builtin_fmaxf(sA0[0], sA1[0]);
#pragma unroll
        for (int r = 1; r < 16; ++r) rm = __builtin_fmaxf(rm, __builtin_fmaxf(sA0[r], sA1[r]));
        { auto rr = __builtin_amdgcn_permlane32_swap(__float_as_uint(rm), __float_as_uint(rm), false, false); rm = __builtin_fmaxf(__uint_as_float(rr[0]), __uint_as_float(rr[1])); }
        mhat = rm;
#pragma unroll
        for (int r = 0; r < 16; ++r) { negm[r] = -mhat; sA0[r] = __builtin_amdgcn_exp2f(sA0[r] - mhat); sA1[r] = __builtin_amdgcn_exp2f(sA1[r] - mhat); }
        store_k(1); store_v(0);
        __syncthreads();
    }
    for (int t = 1; t + 1 < NT; t += 2) {
        A2_STEP(sB0, sB1, sA0, sA1, t, true);
        A2_STEP(sA0, sA1, sB0, sB1, t + 1, true);
    }
    A2_STEP(sB0, sB1, sA0, sA1, NT - 1, false);
    {
        float sacc = 0.f;
#pragma unroll
        for (int r = 0; r < 16; ++r) sacc += sB0[r] + sB1[r];
        lrun += sacc;
        const LAS unsigned char* vp = Vb + ((NT - 1) & 1) * VB + vfo;
#pragma unroll
        for (int ks = 0; ks < 4; ++ks) {
            const f32x16& P = (ks < 2) ? sB0 : sB1; const int bse = 8 * (ks & 1);
            const u32x4 pa = {cvtpk(P[bse], P[bse + 1]), cvtpk(P[bse + 2], P[bse + 3]), cvtpk(P[bse + 4], P[bse + 5]), cvtpk(P[bse + 6], P[bse + 7])};
            const s16x4 l0 = __builtin_amdgcn_ds_read_tr16_b64_v4i16((LAS s16x4*)(vp + ks * 1024)), h0 = __builtin_amdgcn_ds_read_tr16_b64_v4i16((LAS s16x4*)(vp + ks * 1024 + 512));
            const s16x4 l1 = __builtin_amdgcn_ds_read_tr16_b64_v4i16((LAS s16x4*)(vp + 4096 + ks * 1024)), h1 = __builtin_amdgcn_ds_read_tr16_b64_v4i16((LAS s16x4*)(vp + 4096 + ks * 1024 + 512));
            const bf16x8 v0 = {l0[0], l0[1], l0[2], l0[3], h0[0], h0[1], h0[2], h0[3]}, v1 = {l1[0], l1[1], l1[2], l1[3], h1[0], h1[1], h1[2], h1[3]};
            o0 = __builtin_amdgcn_mfma_f32_32x32x16_bf16(__builtin_bit_cast(bf16x8, pa), v0, o0, 0, 0, 0);
            o1 = __builtin_amdgcn_mfma_f32_32x32x16_bf16(__builtin_bit_cast(bf16x8, pa), v1, o1, 0, 0, 0);
        }
    }
#undef A2_STEP
#undef A2_EL
#undef A2_SBAR
    __builtin_amdgcn_s_setprio(0);
    lrun += __shfl_xor(lrun, 32);
    if (hi == 0) wsf[32 + r32] = lrun;
    asm volatile("s_waitcnt lgkmcnt(0)" ::: "memory");
    bf16_t* Ow = (bf16_t*)(ws + WS_O) + ((size_t)b * SEQ + qb * 256 + wid * 32) * 1024 + h * 64;
#pragma unroll
    for (int r = 0; r < 16; ++r) { const int orow = crow(r, hi); const float rl = __builtin_amdgcn_rcpf(wsf[32 + orow]);
        Ow[(size_t)orow * 1024 + r32] = (bf16_t)f2bf(o0[r] * rl); Ow[(size_t)orow * 1024 + 32 + r32] = (bf16_t)f2bf(o1[r] * rl); }
    __syncthreads();
}
__device__ __forceinline__ void phase_attn(const Ctx& p, LAS unsigned char* lds) {
    const int xcd = p.bid & 7, sl = p.bid >> 3, c = sl & 1, b = 2 * xcd + (sl >> 4), qb = (sl >> 1) & 7;
    for (int i = 0; i < 8; ++i) { const int h = 2 * i + (c & 1);
#if ATTN_V1
        if (h < 8) attn_unit<96>(p, b, h, qb, lds); else attn_unit<64>(p, b, h, qb, lds); }
#else
        int tid = p.tid; asm volatile("" : "+v"(tid));
        if (h < 8) attn_unit2<96>(p, tid, b, h, qb, lds); else attn_unit2<64>(p, tid, b, h, qb, lds); }
#endif
}

__device__ __forceinline__ void hyena_taps(const Ctx& p, int c, LAS unsigned char* scratch, float (&taps)[4][2][2]) {
    const int tid = p.tid, lane = tid & 63, wave = __builtin_amdgcn_readfirstlane(tid >> 6);
    LAS float* w4s = (LAS float*)scratch;
    LAS float* red = (LAS float*)(scratch + 1024);
    const float* w4 = p.in[I_FW4]; const float* H3 = (const float*)(p.ws + WS_H3);
    if (tid < 256) { const int cc = tid >> 6, k = tid & 63; w4s[cc * 64 + k] = w4[(size_t)k * 4096 + (cc >> 1) * 2048 + (cc & 1) * 1024 + c]; }
    __syncthreads();
    const float dmin = -3.0701134573253940f, dmax = -15.350567286626970f;
    const float delta = fabsf(dmin + (float)c * ((dmax - dmin) / 1023.0f));
    float ss0 = 0.f, ss1 = 0.f;
    float a[4][4];
#pragma unroll
    for (int i = 0; i < 4; ++i)
#pragma unroll
        for (int cc = 0; cc < 4; ++cc) a[i][cc] = 0.f;
#pragma unroll 2
    for (int k4 = 0; k4 < 16; ++k4) {
        f32x4 wv[4];
#pragma unroll
        for (int cc = 0; cc < 4; ++cc) wv[cc] = *(const LAS f32x4*)(w4s + cc * 64 + 4 * k4);
#pragma unroll
        for (int i = 0; i < 4; ++i) { const f32x4 hv = *((const f32x4*)(H3 + (size_t)(tid + 512 * i) * 64) + k4);
#pragma unroll
            for (int cc = 0; cc < 4; ++cc) a[i][cc] += (hv[0] * wv[cc][0] + hv[1] * wv[cc][1]) + (hv[2] * wv[cc][2] + hv[3] * wv[cc][3]); }
    }
#pragma unroll
    for (int i = 0; i < 4; ++i) {
        const int t = tid + 512 * i;
        const float win = expf(-((float)t / 2048.0f) * delta);
#pragma unroll
        for (int cc = 0; cc < 4; ++cc) a[i][cc] *= win;
        taps[i][0][0] = a[i][0]; taps[i][0][1] = a[i][1]; taps[i][1][0] = a[i][2]; taps[i][1][1] = a[i][3];
        ss0 += a[i][0] * a[i][0] + a[i][2] * a[i][2]; ss1 += a[i][1] * a[i][1] + a[i][3] * a[i][3];
    }
    ss0 = wave_sum(ss0); ss1 = wave_sum(ss1);
    if (lane == 0) { red[wave * 2] = ss0; red[wave * 2 + 1] = ss1; }
    __syncthreads();
    float t0 = 0.f, t1 = 0.f;
#pragma unroll
    for (int w = 0; w < 8; ++w) { t0 += red[w * 2]; t1 += red[w * 2 + 1]; }
    const float n0 = rsqrtf(t0 + EPS), n1 = rsqrtf(t1 + EPS);
#pragma unroll
    for (int i = 0; i < 4; ++i) { taps[i][0][0] *= n0; taps[i][1][0] *= n0; taps[i][0][1] *= n1; taps[i][1][1] *= n1; }
    __syncthreads();
}
__device__ __forceinline__ void hyena_taps_block(const Ctx& p, LAS unsigned char* lds) {
    const int tid = p.tid, lane = tid & 63, wave = __builtin_amdgcn_readfirstlane(tid >> 6), fr = lane & 15, fq = lane >> 4;
    LAS float* w4s = (LAS float*)lds;
    LAS float* red = (LAS float*)(lds + 4096);
    const float* w4 = p.in[I_FW4]; const bf16_t* H3B = (const bf16_t*)(p.ws + WS_H3B); bf16_t* F = (bf16_t*)(p.ws + WS_FILT);
    for (int i = tid; i < 1024; i += NTHREADS) { const int col = i >> 6, k = i & 63, q = col >> 2, cc = col & 3; const int c = p.bid + p.nblk * q;
        w4s[i] = (c < DM) ? w4[(size_t)k * 4096 + (cc >> 1) * 2048 + (cc & 1) * 1024 + c] : 0.f; }
    __syncthreads();
    bf16x8 bfr[2];
#pragma unroll
    for (int ks = 0; ks < 2; ++ks) { const f32x4 b0 = *(const LAS f32x4*)(w4s + fr * 64 + 32 * ks + 8 * fq), b1 = *(const LAS f32x4*)(w4s + fr * 64 + 32 * ks + 8 * fq + 4);
        const u32x4 w = {cvtpk(b0[0], b0[1]), cvtpk(b0[2], b0[3]), cvtpk(b1[0], b1[1]), cvtpk(b1[2], b1[3])}; bfr[ks] = __builtin_bit_cast(bf16x8, w); }
    f32x4 acc[16];
#pragma unroll
    for (int g = 0; g < 4; ++g) {
        bf16x8 hv[4][2];
#pragma unroll
        for (int j = 0; j < 4; ++j)
#pragma unroll
            for (int ks = 0; ks < 2; ++ks) hv[j][ks] = *(const bf16x8*)(H3B + (size_t)(16 * (wave * 16 + 4 * g + j) + fr) * 64 + 32 * ks + 8 * fq);
#pragma unroll
        for (int j = 0; j < 4; ++j) { f32x4 a = {0.f, 0.f, 0.f, 0.f};
#pragma unroll
            for (int ks = 0; ks < 2; ++ks) a = __builtin_amdgcn_mfma_f32_16x16x32_bf16(hv[j][ks], bfr[ks], a, 0, 0, 0);
            acc[4 * g + j] = a; }
        __builtin_amdgcn_sched_barrier(0);
    }
    const int q = fr >> 2, o = fr & 1, dir = (fr >> 1) & 1, c = p.bid + p.nblk * q;
    const float dmin = -3.0701134573253940f, dmax = -15.350567286626970f;
    const float delta = fabsf(dmin + (float)c * ((dmax - dmin) / 1023.0f));
    const float r1 = expf(-delta / 2048.0f);
    float ssq = 0.f;
#pragma unroll
    for (int tt = 0; tt < 16; ++tt) { const int tb = 16 * (16 * wave + tt) + 4 * fq; float win = expf(-((float)tb / 2048.0f) * delta);
#pragma unroll
        for (int e = 0; e < 4; ++e) { const float v = acc[tt][e] * win; acc[tt][e] = v; ssq += v * v; win *= r1; } }
    ssq += __shfl_xor(ssq, 16); ssq += __shfl_xor(ssq, 32); ssq += __shfl_xor(ssq, 2);
    if (fq == 0 && dir == 0) red[wave * 8 + q * 2 + o] = ssq;
    __syncthreads();
    float tot = 0.f;
#pragma unroll
    for (int w = 0; w < 8; ++w) tot += red[w * 8 + q * 2 + o];
    const float nrm = rsqrtf(tot + EPS);
    LAS bf16_t* st = (LAS bf16_t*)(lds + 8192 + (q * 2 + o) * 8208) + 2048;
#pragma unroll
    for (int tt = 0; tt < 16; ++tt)
#pragma unroll
        for (int e = 0; e < 4; ++e) { const int t = 16 * (16 * wave + tt) + 4 * fq + e; const bf16_t v = (bf16_t)f2bf(acc[tt][e] * nrm);
            if (dir == 0) st[-t] = v; else if (t > 0) st[t] = v; }
    __syncthreads();
#pragma unroll
    for (int j = 0; j < 8; ++j) { const int idx = tid + 512 * j, arr = idx >> 9, off = idx & 511; const int cq = p.bid + p.nblk * (arr >> 1);
        const u32x4 w = *(const LAS u32x4*)(lds + 8192 + arr * 8208 + off * 16);
        if (cq < DM) *(u32x4*)(F + (size_t)(cq * 2 + (arr & 1)) * 4096 + 8 * off) = w; }
    __builtin_amdgcn_fence(__ATOMIC_RELEASE, "workgroup");
    asm volatile("s_waitcnt vmcnt(0)" ::: "memory");
    __syncthreads();
    __builtin_amdgcn_fence(__ATOMIC_ACQUIRE, "workgroup");
}
__device__ __forceinline__ float sconv_at(const bf16_t* zr, int b, int n, float w0, float w1, float w2, float cb) {
    const bf16_t* q = zr + b * SEQ + n;
    const float l = n > 0 ? bf2f(q[-1]) : 0.f, m = bf2f(q[0]), r = n < SEQ - 1 ? bf2f(q[1]) : 0.f;
    return cb + w0 * l + w1 * m + w2 * r;
}

__device__ __forceinline__ void phase_nconv_filt(const Ctx& p, LAS unsigned char* lds) {
    bf16_t* F = (bf16_t*)(p.ws + WS_FILT);
    for (int c = p.bid; c < DM; c += p.nblk) {
        float taps[4][2][2];
        hyena_taps(p, c, lds, taps);
#pragma unroll
        for (int i = 0; i < 4; ++i) { const int t = p.tid + 512 * i;
#pragma unroll
            for (int o = 0; o < 2; ++o) { bf16_t* f = F + (size_t)(c * 2 + o) * 4096;
                f[2048 - t] = (bf16_t)f2bf(taps[i][0][o]);
                if (t > 0) f[2048 + t] = (bf16_t)f2bf(taps[i][1][o]); } }
    }
}
__device__ __forceinline__ void phase_nconv_u0(const Ctx& p) {
    const bf16_t* ZT = (const bf16_t*)(p.ws + WS_ZT); bf16_t* U0 = (bf16_t*)(p.ws + WS_U0T);
    const float* cw = p.in[I_HCW]; const float* cb = p.in[I_HCB];
    for (size_t idx = (size_t)p.bid * NTHREADS + p.tid; idx < (size_t)DM * ML; idx += (size_t)p.nblk * NTHREADS) {
        const int c = (int)(idx >> 15), bn = (int)(idx & 32767), b = bn >> 11, n = bn & 2047; const int ch = 2048 + c;
        U0[idx] = (bf16_t)f2bf(sconv_at(ZT + (size_t)ch * ML, b, n, cw[ch], cw[3072 + ch], cw[6144 + ch], cb[ch]));
    }
}
__device__ __forceinline__ void phase_nconv_pass(const Ctx& p, int o) {
    const bf16_t* ZT = (const bf16_t*)(p.ws + WS_ZT); const bf16_t* F = (const bf16_t*)(p.ws + WS_FILT);
    const bf16_t* U = (const bf16_t*)(p.ws + (o == 0 ? WS_U0T : WS_Y1T)); bf16_t* Y = (bf16_t*)(p.ws + (o == 0 ? WS_Y1T : WS_Y2T));
    const float* cw = p.in[I_HCW]; const float* cb = p.in[I_HCB]; const float* skip = p.in[I_HSKIP];
    for (size_t idx = (size_t)p.bid * NTHREADS + p.tid; idx < (size_t)DM * ML; idx += (size_t)p.nblk * NTHREADS) {
        const int c = (int)(idx >> 15), bn = (int)(idx & 32767), b = bn >> 11, n = bn & 2047;
        const bf16_t* u = U + (size_t)c * ML + b * SEQ; const bf16_t* f = F + (size_t)(c * 2 + o) * 4096 + 2048 - n;
        float acc = 0.f;
        for (int m = 0; m < SEQ; ++m) acc += bf2f(f[m]) * bf2f(u[m]);
        acc += skip[o * DM + c] * bf2f(u[n]);
        const int ch = o * 1024 + c;
        const float gate = sconv_at(ZT + (size_t)ch * ML, b, n, cw[ch], cw[3072 + ch], cw[6144 + ch], cb[ch]);
        Y[idx] = (bf16_t)f2bf(gate * acc);
    }
}

constexpr int CV_USEG = 144;
constexpr int CV_USTRIDE = 32 * CV_USEG + 16;
constexpr int CV_U = 0;
constexpr int CV_CP = 16 * CV_USTRIDE, CV_CPSTRIDE = 8208;
static_assert(CV_CP + 8 * CV_CPSTRIDE <= LDS_BYTES, "conv LDS map");

__device__ __forceinline__ void conv_build_copies(const int tid, LAS unsigned char* lds, const bf16_t* rev) {
    const u32x4 cur = *(const u32x4*)(rev + 8 * tid);
    u32x4 prv = {0u, 0u, 0u, 0u};
    if (tid > 0) prv = *(const u32x4*)(rev + 8 * tid - 8);
    const unsigned W[8] = {prv.x, prv.y, prv.z, prv.w, cur.x, cur.y, cur.z, cur.w};
#pragma unroll
    for (int rho = 0; rho < 8; ++rho) {
        unsigned o[4];
#pragma unroll
        for (int d = 0; d < 4; ++d) { const int e0 = 8 - rho + 2 * d;
            o[d] = (e0 & 1) ? __builtin_amdgcn_alignbit(W[(e0 >> 1) + 1], W[e0 >> 1], 16) : W[e0 >> 1]; }
        *(LAS u32x4*)(lds + CV_CP + rho * CV_CPSTRIDE + 16 * tid) = (u32x4){o[0], o[1], o[2], o[3]};
    }
}
constexpr int CV_GSEG = 136;
__device__ __forceinline__ int cv_uoff(int m) { return (m >> 6) * CV_USEG + (m & 63) * 2; }
__device__ __forceinline__ int cv_goff(int m) { return (m >> 6) * CV_GSEG + (m & 63) * 2; }
__device__ __forceinline__ void sconv4(const bf16_t* zr, int n, float w0, float w1, float w2, float cb, float (&g)[4]) {
    const u32x2 w = *(const u32x2*)(zr + n);
    const float l = n > 0 ? bf2f(zr[n - 1]) : 0.f, r = n + 4 < SEQ ? bf2f(zr[n + 4]) : 0.f;
    const float x[6] = {l, bflo(w.x), bfhi(w.x), bflo(w.y), bfhi(w.y), r};
#pragma unroll
    for (int e = 0; e < 4; ++e) g[e] = cb + w0 * x[e] + w1 * x[e + 1] + w2 * x[e + 2];
}
__device__ __forceinline__ void conv_mma(const int tid, LAS unsigned char* lds, f32x4 (&acc)[16]) {
    const int lane = tid & 63, wave = __builtin_amdgcn_readfirstlane(tid >> 6);
#pragma unroll
    for (int i = 0; i < 16; ++i) acc[i] = (f32x4){0.f, 0.f, 0.f, 0.f};
    const LAS unsigned char* ab = lds + CV_CP + (lane & 7) * CV_CPSTRIDE + 2 * (2048 - 8 * ((lane & 15) >> 3) + 8 * (lane >> 4)) - 32 * (16 * wave);
    const LAS unsigned char* ub = lds + CV_U + (lane & 15) * CV_USTRIDE + 16 * (lane >> 4);
    bf16x8 w0, w1, w2, w3, w4, w5, w6, w7, w8, w9, w10, w11, w12, w13, w14, w15;
#define CV_LD(i) (*(const LAS bf16x8*)(ab - 32 * (i)))
    w0 = CV_LD(0); w1 = CV_LD(1); w2 = CV_LD(2); w3 = CV_LD(3); w4 = CV_LD(4); w5 = CV_LD(5); w6 = CV_LD(6); w7 = CV_LD(7);
    w8 = CV_LD(8); w9 = CV_LD(9); w10 = CV_LD(10); w11 = CV_LD(11); w12 = CV_LD(12); w13 = CV_LD(13); w14 = CV_LD(14); w15 = CV_LD(15);
#undef CV_LD
#define CV_MF(i, W) acc[i] = __builtin_amdgcn_mfma_f32_16x16x32_bf16(W, uf, acc[i], 0, 0, 0)
#define CV_STEP(jj, A0, A1, A2, A3, A4, A5, A6, A7, A8, A9, A10, A11, A12, A13, A14, A15) do { \
        const int j = J * 8 + (jj); \
        const int jn = (j + 1 < 64) ? (j + 1) : j; \
        const bf16x8 ufn = *(const LAS bf16x8*)(ub + CV_USEG * (jn >> 1) + 64 * (jn & 1)); \
        const bf16x8 n0 = *(const LAS bf16x8*)(ab + 64 * jn), n1 = *(const LAS bf16x8*)(ab + 64 * jn - 32); \
        CV_MF(0, A0); CV_MF(1, A1); CV_MF(2, A2); CV_MF(3, A3); CV_MF(4, A4); CV_MF(5, A5); CV_MF(6, A6); CV_MF(7, A7); \
        CV_MF(8, A8); CV_MF(9, A9); CV_MF(10, A10); CV_MF(11, A11); CV_MF(12, A12); CV_MF(13, A13); CV_MF(14, A14); CV_MF(15, A15); \
        A14 = n0; A15 = n1; uf = ufn; } while (0)
    bf16x8 uf = *(const LAS bf16x8*)ub;
    for (int J = 0; J < 8; ++J) {
        CV_STEP(0, w0, w1, w2, w3, w4, w5, w6, w7, w8, w9, w10, w11, w12, w13, w14, w15);
        CV_STEP(1, w14, w15, w0, w1, w2, w3, w4, w5, w6, w7, w8, w9, w10, w11, w12, w13);
        CV_STEP(2, w12, w13, w14, w15, w0, w1, w2, w3, w4, w5, w6, w7, w8, w9, w10, w11);
        CV_STEP(3, w10, w11, w12, w13, w14, w15, w0, w1, w2, w3, w4, w5, w6, w7, w8, w9);
        CV_STEP(4, w8, w9, w10, w11, w12, w13, w14, w15, w0, w1, w2, w3, w4, w5, w6, w7);
        CV_STEP(5, w6, w7, w8, w9, w10, w11, w12, w13, w14, w15, w0, w1, w2, w3, w4, w5);
        CV_STEP(6, w4, w5, w6, w7, w8, w9, w10, w11, w12, w13, w14, w15, w0, w1, w2, w3);
        CV_STEP(7, w2, w3, w4, w5, w6, w7, w8, w9, w10, w11, w12, w13, w14, w15, w0, w1);
    }
#undef CV_STEP
#undef CV_MF
}
struct SconvRow { u32x4 w[8]; float prev, last; };
__device__ __forceinline__ void sconv_row_load(const int tid, const bf16_t* zrow, SconvRow& R) {
    const int b = tid >> 5, m0 = (tid & 31) * 64; const bf16_t* zr = zrow + b * SEQ;
#pragma unroll
    for (int k8 = 0; k8 < 8; ++k8) R.w[k8] = *(const u32x4*)(zr + m0 + 8 * k8);
    R.prev = m0 > 0 ? bf2f(zr[m0 - 1]) : 0.f;
    R.last = m0 + 64 < SEQ ? bf2f(zr[m0 + 64]) : 0.f;
}
template <int STRIDE, bool W16>
__device__ __forceinline__ void sconv_row_store(const int tid, const SconvRow& R, float w0, float w1, float w2, float bb, LAS unsigned char* dst) {
    const int b = tid >> 5, m0 = (tid & 31) * 64;
    float prev = R.prev;
#pragma unroll
    for (int k8 = 0; k8 < 8; ++k8) {
        const float nxt = k8 < 7 ? bflo(R.w[k8 < 7 ? k8 + 1 : 7].x) : R.last;
        const float x[10] = {prev, bflo(R.w[k8].x), bfhi(R.w[k8].x), bflo(R.w[k8].y), bfhi(R.w[k8].y), bflo(R.w[k8].z), bfhi(R.w[k8].z), bflo(R.w[k8].w), bfhi(R.w[k8].w), nxt};
        float y[8];
#pragma unroll
        for (int e = 0; e < 8; ++e) y[e] = bb + w0 * x[e] + w1 * x[e + 1] + w2 * x[e + 2];
        const u32x4 o = {cvtpk(y[0], y[1]), cvtpk(y[2], y[3]), cvtpk(y[4], y[5]), cvtpk(y[6], y[7])};
        if (W16) *(LAS u32x4*)(dst + b * STRIDE + cv_uoff(m0 + 8 * k8)) = o;
        else { LAS unsigned char* d = dst + b * STRIDE + cv_goff(m0 + 8 * k8); *(LAS u32x2*)d = (u32x2){o.x, o.y}; *(LAS u32x2*)(d + 8) = (u32x2){o.z, o.w}; }
        prev = x[8];
    }
}
constexpr int CV_GSTRIDE = 32 * CV_GSEG + 8;
static_assert(CV_CP + 16 * CV_GSTRIDE <= LDS_BYTES - 64 && CV_CP + 8 * CV_CPSTRIDE <= LDS_BYTES - 64, "gate image / copies fit behind U");
__device__ __forceinline__ void phase_conv(const Ctx& p, LAS unsigned char* lds) {
    const bf16_t* ZT = (const bf16_t*)(p.ws + WS_ZT); bf16_t* Y2T = (bf16_t*)(p.ws + WS_Y2T); const bf16_t* F = (const bf16_t*)(p.ws + WS_FILT);
    const float* cw = p.in[I_HCW]; const float* cb = p.in[I_HCB]; const float* skip = p.in[I_HSKIP];
    hyena_taps_block(p, lds);
    for (int c = p.bid; c < DM; c += p.nblk) {
        int tid = p.tid; asm volatile("" : "+v"(tid));
        const int lane = tid & 63, wave = __builtin_amdgcn_readfirstlane(tid >> 6);
        const int b = lane & 15, nq = 256 * wave + 4 * (lane >> 4);
        LAS unsigned char* Ul = lds + CV_U; LAS unsigned char* Gl = lds + CV_CP;
        { const int ch = 2048 + c; SconvRow R; sconv_row_load(tid, ZT + (size_t)ch * ML, R); sconv_row_store<CV_USTRIDE, true>(tid, R, cw[ch], cw[3072 + ch], cw[6144 + ch], cb[ch], Ul); }
        conv_build_copies(tid, lds, F + (size_t)(c * 2 + 0) * 4096);
        __syncthreads();
        f32x4 acc[16];
#pragma unroll 1
        for (int o = 0; o < 2; ++o) {
            const int chg = o * 1024 + c; SconvRow RG; sconv_row_load(tid, ZT + (size_t)chg * ML, RG);
            conv_mma(tid, lds, acc);
            __syncthreads();
            sconv_row_store<CV_GSTRIDE, false>(tid, RG, cw[chg], cw[3072 + chg], cw[6144 + chg], cb[chg], Gl);
            __syncthreads();
            { const float sk = skip[o * DM + c];
              LAS unsigned char* ubs = Ul + b * CV_USTRIDE + 4 * wave * CV_USEG + 8 * (lane >> 4); const LAS unsigned char* gbs = Gl + b * CV_GSTRIDE + 4 * wave * CV_GSEG + 8 * (lane >> 4);
#pragma unroll
              for (int i = 0; i < 16; ++i) { LAS u32x2* up = (LAS u32x2*)(ubs + (i >> 2) * CV_USEG + (i & 3) * 32);
                  const u32x2 uw = *up, gw = *(const LAS u32x2*)(gbs + (i >> 2) * CV_GSEG + (i & 3) * 32);
                  const float u[4] = {bflo(uw.x), bfhi(uw.x), bflo(uw.y), bfhi(uw.y)}, g[4] = {bflo(gw.x), bfhi(gw.x), bflo(gw.y), bfhi(gw.y)};
                  float y[4];
#pragma unroll
                  for (int e = 0; e < 4; ++e) y[e] = g[e] * (acc[i][e] + sk * u[e]);
                  *up = (u32x2){cvtpk(y[0], y[1]), cvtpk(y[2], y[3])}; } }
            __syncthreads();
            if (o == 0) { conv_build_copies(tid, lds, F + (size_t)(c * 2 + 1) * 4096); __syncthreads(); }
        }
        { const int bb_ = tid >> 5, m0 = (tid & 31) * 64; bf16_t* dst = Y2T + (size_t)c * ML + bb_ * SEQ + m0;
#pragma unroll
          for (int k8 = 0; k8 < 8; ++k8) *(u32x4*)(dst + 8 * k8) = *(const LAS u32x4*)(Ul + bb_ * CV_USTRIDE + cv_uoff(m0 + 8 * k8)); }
        __syncthreads();
    }
}

__device__ __forceinline__ void phase_transpose(const Ctx& p, LAS unsigned char* lds) {
    const int tid = p.tid, lane = tid & 63, wave = __builtin_amdgcn_readfirstlane(tid >> 6);
    const bf16_t* src = (const bf16_t*)(p.ws + WS_Y2T); bf16_t* dst = (bf16_t*)(p.ws + WS_Y2);
    LAS bf16_t* tile = (LAS bf16_t*)(lds + wave * 16384);
    const int gw = p.bid * NWAVES + wave, ngw = p.nblk * NWAVES;
    for (int it = gw; it < (DM / 64) * (ML / 64); it += ngw) {
        const int cb = it & 15, tb = it >> 4, c0 = cb * 64, t0 = tb * 64;
#pragma unroll
        for (int i = 0; i < 8; ++i) { const int r = 8 * i + (lane >> 3), ch = lane & 7;
            const u32x4 w = *(const u32x4*)(src + (size_t)(c0 + r) * ML + t0 + 8 * ch);
            LAS unsigned* d = (LAS unsigned*)(tile + r * 66 + 8 * ch); d[0] = w.x; d[1] = w.y; d[2] = w.z; d[3] = w.w; }
        asm volatile("s_waitcnt lgkmcnt(0)" ::: "memory");
#pragma unroll
        for (int i = 0; i < 8; ++i) { const int t = 8 * i + (lane >> 3), ch = lane & 7; unsigned short e[8];
#pragma unroll
            for (int k = 0; k < 8; ++k) e[k] = tile[(8 * ch + k) * 66 + t];
            u32x4 w; w.x = e[0] | ((unsigned)e[1] << 16); w.y = e[2] | ((unsigned)e[3] << 16); w.z = e[4] | ((unsigned)e[5] << 16); w.w = e[6] | ((unsigned)e[7] << 16);
            *(u32x4*)(dst + (size_t)(t0 + t) * DM + c0 + 8 * ch) = w; }
        asm volatile("s_waitcnt lgkmcnt(0)" ::: "memory");
    }
}

#define XB_TMO      128
#define XB_XCNT(j)  (256  + 64 * (j))
#define XB_XSUB(j)  (1280 + 64 * (j))
#define XB_XGEN(j)  (2304 + 64 * (j))
#define XB_TOP      3328
#define XB_TOPGEN   3392
#define XCD_BAR_WORDS 3456
#define XB_SPIN_CAP (1u << 18)
__device__ __forceinline__ unsigned xb_ld(unsigned* p)              { return __hip_atomic_load(p, __ATOMIC_RELAXED, __HIP_MEMORY_SCOPE_AGENT); }
__device__ __forceinline__ unsigned xb_add(unsigned* p, unsigned v) { return __hip_atomic_fetch_add(p, v, __ATOMIC_RELAXED, __HIP_MEMORY_SCOPE_AGENT); }
__device__ __forceinline__ unsigned xb_xcc_id() { return (unsigned)__builtin_amdgcn_s_getreg((3 << 11) | 20) & 0xFu; }
#define XB_SPIN(cond, bar) do { unsigned _sp = 0; while (cond) { __builtin_amdgcn_s_sleep(1); \
    if ((++_sp & 255u) == 0u) { if (xb_ld(&(bar)[XB_TMO])) break; if (_sp > XB_SPIN_CAP) { atomicAdd(&(bar)[XB_TMO], 1u); break; } } } } while (0)
struct XcdBarrier { unsigned* bar; unsigned x; volatile LAS unsigned* st; };
__device__ __forceinline__ XcdBarrier xcd_barrier_post(unsigned* bar, volatile LAS unsigned* st) {
    XcdBarrier b; b.bar = bar; b.x = xb_xcc_id(); b.st = st;
    if (threadIdx.x == 0) (void)xb_add(&bar[XB_XCNT(b.x)], 1u);
    return b;
}
__device__ __forceinline__ void xcd_barrier_complete(unsigned* bar, unsigned x, unsigned& nloc, unsigned& nx) {
    const unsigned G = gridDim.x * gridDim.y * gridDim.z;
    unsigned sum, cnt, mine, sp = 0u;
    for (;;) {
        sum = 0u; cnt = 0u; mine = 0u;
#pragma unroll
        for (unsigned j = 0; j < 16; ++j) { const unsigned c = xb_ld(&bar[XB_XCNT(j)]); sum += c; cnt += (c > 0u) ? 1u : 0u; mine = (j == x) ? c : mine; }
        if (sum == G) break;
        __builtin_amdgcn_s_sleep(1);
        if ((++sp & 255u) == 0u) { if (xb_ld(&bar[XB_TMO])) break; if (sp > XB_SPIN_CAP) { atomicAdd(&bar[XB_TMO], 1u); break; } }
    }
    nloc = mine > 0u ? mine : 1u; nx = cnt > 0u ? cnt : 1u;
}
__device__ __forceinline__ void xcd_barrier(const XcdBarrier& b) {
    asm volatile("s_waitcnt vmcnt(0)" ::: "memory");
    __syncthreads();
    if (threadIdx.x == 0) {
        unsigned* bar = b.bar;
        __builtin_amdgcn_s_waitcnt(0);
        unsigned nloc = b.st[0], nx = b.st[1];
        if (nloc == 0u) { xcd_barrier_complete(bar, b.x, nloc, nx); b.st[0] = nloc; b.st[1] = nx; }
        const unsigned old = xb_add(&bar[XB_XSUB(b.x)], 1u);
        const unsigned gen = old / nloc;
        if (old + 1u == (gen + 1u) * nloc) {
            __builtin_amdgcn_fence(__ATOMIC_RELEASE, "agent");
            asm volatile("s_waitcnt vmcnt(0)" ::: "memory");
            const unsigned og = xb_add(&bar[XB_TOP], 1u);
            const unsigned tg = og / nx;
            if (og + 1u == (tg + 1u) * nx) xb_add(&bar[XB_TOPGEN], 1u);
            else XB_SPIN(xb_ld(&bar[XB_TOPGEN]) == tg, bar);
            __builtin_amdgcn_fence(__ATOMIC_ACQUIRE, "agent");
            xb_add(&bar[XB_XGEN(b.x)], 1u);
            asm volatile("s_waitcnt vmcnt(0)" ::: "memory");
        } else {
            XB_SPIN(xb_ld(&bar[XB_XGEN(b.x)]) == gen, bar);
            __builtin_amdgcn_fence(__ATOMIC_ACQUIRE, "agent");
            asm volatile("s_waitcnt vmcnt(0)" ::: "memory");
        }
    }
    __syncthreads();
}
constexpr int LDS_CTL_OFF = LDS_BYTES - 64;
constexpr size_t CTL_BAR_OFF = 16384;
constexpr size_t CTL_STAMP_OFF = 65536;
constexpr size_t CTL_ZERO_BYTES = 131072;

enum { P_PRO = 0, P_MOD1_0, P_GEMM_IN, P_ZPOST, P_GEMM_QKV, P_ATTN, P_GEMM_OUT0, P_MOD2_0, P_MLP_UP0, P_MLP_DN0,
       P_MOD1_1, P_GEMM_HIN, P_CONV, P_TRANS, P_GEMM_OUT1, P_MOD2_1, P_MLP_UP1, P_MLP_DN1, P_FINAL,
       P_NC_FILT, P_NC_U0, P_NC_A, P_NC_B, P_NA_Q, P_NONE };
__host__ __device__ __forceinline__ int prog(int i) {
    int k = 0;
#define PRG(x) do { if (i == k) return (x); ++k; } while (0)
    PRG(P_PRO); PRG(P_MOD1_0); PRG(P_GEMM_IN); PRG(P_ZPOST); PRG(P_GEMM_QKV);
#if NAIVE_ATTN
    PRG(P_NA_Q);
#endif
    PRG(P_ATTN); PRG(P_GEMM_OUT0); PRG(P_MLP_UP0); PRG(P_MLP_DN0); PRG(P_GEMM_HIN);
#if NAIVE_CONV
    PRG(P_NC_FILT); PRG(P_NC_U0); PRG(P_NC_A); PRG(P_NC_B);
#else
    PRG(P_CONV);
#endif
    PRG(P_TRANS); PRG(P_GEMM_OUT1); PRG(P_MLP_UP1); PRG(P_MLP_DN1); PRG(P_FINAL);
#undef PRG
    return P_NONE;
}
constexpr int N_PROG = 16 + (NAIVE_ATTN ? 1 : 0) + (NAIVE_CONV ? 3 : 0);

__device__ __forceinline__ bool gemm_job(const Ctx& p, int ph, int jj, GemmJob& J) {
    unsigned char* ws = p.ws;
    const float* MODL = (const float*)(ws + WS_MODL);
    size_t a = 0, b = 0, o = 0, sq = 0, shw = 0; int M = 0, N = 0, K = 0, kind = 0, ldc = 0, shw_ld = 0; bool has_o = true, has_sq = false;
    const float* base = nullptr; const float* gate = nullptr; const float* ng = nullptr; const float* nsc = nullptr;
    if (jj == 0) {
        if (ph == P_GEMM_IN) { a = WS_HL; b = WS_WIN; o = WS_Z; M = MT; N = ZW; K = DM; ldc = ZW; }
        else if (ph == P_GEMM_QKV) { a = WS_CQN; b = WS_WQB; o = WS_QM; M = ML; N = 768; K = 384; ldc = 768; }
        else if (ph == P_GEMM_OUT0) { a = WS_O; b = WS_WOUT; M = ML; N = DM; K = DM; kind = 2; gate = MODL + 2 * DM;
            o = WS_HL; ng = p.in[I_N2G]; nsc = MODL + 4 * DM; sq = WS_SQA; has_sq = true; }
        else if (ph == P_MLP_UP0) { a = WS_HL; b = WS_W1_0; o = WS_HID; M = ML; N = 4096; K = DM; kind = 1; ldc = 4096; sq = WS_SQA; has_sq = true; shw = WS_SHW_UP0; shw_ld = 4096; }
        else if (ph == P_MLP_DN0) { a = WS_HID; b = WS_W2_0; M = ML; N = DM; K = 4096; kind = 2; gate = MODL + 5 * DM;
            o = WS_HL; ng = p.in[I_N1G] + DM; nsc = MODL + (size_t)16 * NMOD + DM; sq = WS_SQB; has_sq = true; }
        else if (ph == P_GEMM_HIN) { a = WS_HIN; b = WS_HL; o = WS_ZT; M = 3 * DM; N = ML; K = DM; ldc = ML; kind = 3; sq = WS_SQB; has_sq = true; shw = WS_SHW_HIN; shw_ld = 3 * DM; }
        else if (ph == P_GEMM_OUT1) { a = WS_Y2; b = WS_HOUT; M = ML; N = DM; K = DM; kind = 2; gate = MODL + (size_t)16 * NMOD + 2 * DM;
            o = WS_HL; ng = p.in[I_N2G] + DM; nsc = MODL + (size_t)16 * NMOD + 4 * DM; sq = WS_SQC; has_sq = true; }
        else if (ph == P_MLP_UP1) { a = WS_HL; b = WS_W1_1; o = WS_HID; M = ML; N = 4096; K = DM; kind = 1; ldc = 4096; sq = WS_SQC; has_sq = true; shw = WS_SHW_UP1; shw_ld = 4096; }
        else if (ph == P_MLP_DN1) { a = WS_HID; b = WS_W2_1; M = ML; N = DM; K = 4096; kind = 2; gate = MODL + (size_t)16 * NMOD + 5 * DM; has_o = false; sq = WS_SQA; has_sq = true; ng = p.in[I_FINALG]; nsc = MODL; }
        else return false;
    } else {
        if (ph == P_GEMM_QKV) { a = WS_CKVN; b = WS_WKVB; o = WS_KV; M = MT; N = 1024; K = 256; ldc = 1024; }
        else return false;
    }
    J.A = (const bf16_t*)(ws + a); J.Bt = (const bf16_t*)(ws + b); J.M = M; J.N = N; J.K = K; J.rot = (ph == P_GEMM_QKV && jj == 0) ? 128 : 0;
    J.E.kind = kind; J.E.O = has_o ? (bf16_t*)(ws + o) : nullptr; J.E.ldc = ldc; J.E.base = base; J.E.xres = (bf16_t*)(ws + WS_XW); J.E.gate = gate; J.E.ng = ng; J.E.nsc = nsc;
    J.E.sqp = has_sq ? (float*)(ws + sq) : nullptr; J.E.shw = (const float*)(ws + shw); J.E.shw_ld = shw_ld;
    return true;
}

__global__ void __launch_bounds__(NTHREADS, 2) fwd(Params kp) {
    extern __shared__ __attribute__((aligned(16))) unsigned char lds_raw[];
    LAS unsigned char* lds = (LAS unsigned char*)lds_raw;
    const int wave0 = __builtin_amdgcn_readfirstlane((int)threadIdx.x >> 6);
#if !CG_SYNC
    if (threadIdx.x < 16) ((volatile LAS unsigned*)(lds + LDS_CTL_OFF))[threadIdx.x] = 0u;
    __syncthreads();
    const XcdBarrier xbar = xcd_barrier_post((unsigned*)(kp.ws + WS_CTL + CTL_BAR_OFF), (volatile LAS unsigned*)(lds + LDS_CTL_OFF));
#endif
#if PROBE_A >= 0
#define STAMP(k) do { if (blockIdx.x == 0 && threadIdx.x == 0) ((unsigned long long*)(kp.ws + WS_CTL + CTL_STAMP_OFF))[(k)] = __builtin_amdgcn_s_memrealtime(); } while (0)
#else
#define STAMP(k) do { } while (0)
#endif
    for (int pi = kp.ph_lo; pi < kp.ph_hi; ++pi) {
        if (pi > kp.ph_lo) {
            STAMP(2 * pi - 1);
#if CG_SYNC
            cg::this_grid().sync();
#else
            xcd_barrier(xbar);
#endif
        }
        STAMP(2 * pi);
        const int ph = prog(pi);
        for (int rep = 0; rep < ((pi == REPEAT_PI) ? 2 : 1); ++rep) {
        if (rep) {
#if CG_SYNC
            cg::this_grid().sync();
#else
            xcd_barrier(xbar);
#endif
        }
#define MAKE_CTX(p) Ctx p; { int z_ = 0, lane_; asm volatile("v_mbcnt_lo_u32_b32 %0, -1, 0\n\tv_mbcnt_hi_u32_b32 %0, -1, %0" : "=v"(lane_)); asm volatile("" : "+s"(z_)); \
          p.in = (const CAS cfptr_t*)kp.in + z_; p.out = kp.out + z_; p.ws = kp.ws + z_; p.tid = ((wave0 + z_) << 6) + lane_; p.bid = (int)blockIdx.x + z_; p.nblk = (int)gridDim.x + z_; }
#ifndef NO_GEMM
        { MAKE_CTX(pg); for (int jj = 0; jj < 2; ++jj) { GemmJob J; if (!gemm_job(pg, ph, jj, J)) break; run_gemm(pg, lds, J); } }
#endif
        MAKE_CTX(p);
        if (ph == P_PRO && PHON(P_PRO)) phase_prologue(p, lds, true, false);
        else if (ph == P_MOD1_0 && PHON(P_MOD1_0)) { phase_prologue(p, lds, false, true); phase_modulate(p, p.in[I_X], 0, p.in[I_N1G], 0, DM, true); }
        else if (ph == P_ZPOST && PHON(P_ZPOST)) { phase_zpost(p, lds); }
        else if (ph == P_GEMM_IN) phase_shw(p, 96);
        else if (ph == P_ATTN && PHON(P_ATTN)) {
#if NAIVE_ATTN
            phase_attn_naive(p);
#else
            phase_attn(p, lds);
#endif
        }
#if NAIVE_ATTN
        else if (ph == P_NA_Q && PHON(P_NA_Q)) phase_naive_qrope(p);
#endif
#if !NAIVE_CONV
        else if (ph == P_CONV && PHON(P_CONV)) phase_conv(p, lds);
#endif
#if NAIVE_CONV
        else if (ph == P_NC_FILT && PHON(P_NC_FILT)) phase_nconv_filt(p, lds);
        else if (ph == P_NC_U0 && PHON(P_NC_U0)) phase_nconv_u0(p);
        else if (ph == P_NC_A && PHON(P_NC_A)) phase_nconv_pass(p, 0);
        else if (ph == P_NC_B && PHON(P_NC_B)) phase_nconv_pass(p, 1);
#endif
        else if (ph == P_TRANS && PHON(P_TRANS)) phase_transpose(p, lds);
        else if (ph == P_FINAL && PHON(P_FINAL)) phase_final(p);
        }
    }
#if PROBE_A >= 0
    STAMP(2 * kp.ph_hi - 1);
    __syncthreads();
    if (blockIdx.x == 0) {
        asm volatile("s_waitcnt vmcnt(0)" ::: "memory");
        const unsigned long long* st = (const unsigned long long*)(kp.ws + WS_CTL + CTL_STAMP_OFF);
        const float dta = (float)(st[PROBE_A_TO] - st[PROBE_A]) * 0.01f, dtb = (float)(st[PROBE_B_TO] - st[PROBE_B]) * 0.01f;
        for (int i = threadIdx.x + 1024; i < 1024 + 100000; i += NTHREADS) kp.out[i] += 0.001f * dtb;
        if (threadIdx.x == 0) kp.out[0] += 0.004f * dta;
    }
#endif
}

extern "C" void kernel_launch(void* const* d_in, const int* in_sizes, int n_in, void* d_out, int out_size, void* d_ws, size_t ws_size, hipStream_t stream) {
    static int ok = 0;
    if (ok == 0) {
        ok = 1;
        if (n_in != 32 || in_sizes[0] != ML * DM || out_size != ML * DM || ws_size < WS_END) { fprintf(stderr, "kernel_launch: unexpected shapes (n_in %d, in0 %d, out %d, ws %zu)\n", n_in, n_in > 0 ? in_sizes[0] : -1, out_size, ws_size); ok = -1; }
        int dev = 0, cus = 0;
        if (hipGetDevice(&dev) != hipSuccess || hipDeviceGetAttribute(&cus, hipDeviceAttributeMultiprocessorCount, dev) != hipSuccess || cus < GRID) { fprintf(stderr, "kernel_launch: needs %d CUs, device reports %d\n", GRID, cus); ok = -1; }
        if (hipFuncSetAttribute((const void*)fwd, hipFuncAttributeMaxDynamicSharedMemorySize, LDS_BYTES) != hipSuccess) { fprintf(stderr, "kernel_launch: hipFuncSetAttribute failed\n"); ok = -1; }
        int per_cu = 0;
        if (hipOccupancyMaxActiveBlocksPerMultiprocessor(&per_cu, (const void*)fwd, NTHREADS, LDS_BYTES) != hipSuccess || per_cu < 1) { fprintf(stderr, "kernel_launch: occupancy query says %d blocks per CU\n", per_cu); }
        (void)hipGetLastError();
    }
    if (ok < 0) return;
    Params p{};
    for (int i = 0; i < 32; ++i) p.in[i] = (const float*)d_in[i];
    p.out = (float*)d_out; p.ws = (unsigned char*)d_ws;
#if !CG_SYNC || PROBE_A >= 0
    if (hipMemsetAsync((char*)d_ws + WS_CTL, 0, CTL_ZERO_BYTES, stream) != hipSuccess) { fprintf(stderr, "kernel_launch: memset of the control words failed\n"); return; }
#endif
#if ONE_LAUNCH
    p.ph_lo = 0; p.ph_hi = N_PROG;
    void* args[] = {&p};
    hipError_t e = hipLaunchCooperativeKernel((const void*)fwd, dim3(GRID), dim3(NTHREADS), args, LDS_BYTES, stream);
    if (e != hipSuccess) fprintf(stderr, "kernel_launch: cooperative launch failed: %s\n", hipGetErrorString(e));
#else
    for (int i = 0; i < N_PROG; ++i) { p.ph_lo = i; p.ph_hi = i + 1; hipLaunchKernelGGL(fwd, dim3(GRID), dim3(NTHREADS), LDS_BYTES, stream, p); }
#endif
}
```
